# Optimizing an MI355X kernel written in HIP

```python
import math
import jax, jax.numpy as jnp
from jax import lax
import numpy as np

D_MODEL = 1024
BATCH = 8
SEQ = 4096
DEPTH = 4

GRID_W = 64
CTX_LEN = 256
EPS = 1e-6

MLA_HEADS = 4
MLA_Q_LORA = 256
MLA_KV_LORA = 128
MLA_NOPE = 128
MLA_ROPE = 64
MLA_V = 128
MLA_WIDTH = MLA_HEADS * MLA_V
MLA_SCALE = (MLA_NOPE + MLA_ROPE) ** -0.5
ROPE_BASE = 10000.0
Q_BLOCK = 128

CM_GROUPS = 4
CM_WIDTH = 256
CM_GROUP_DIM = CM_WIDTH // CM_GROUPS
CM_CHUNK = 128

SSD_WIDTH = 256
SSD_HEAD_DIM = 64
SSD_HEADS = SSD_WIDTH // SSD_HEAD_DIM
SSD_GROUPS = 2
SSD_STATE = 128
SSD_CONV = 3
SSD_CHUNK = 128
SSD_CONV_DIM = SSD_WIDTH + 2 * SSD_GROUPS * SSD_STATE

MIX_WIDTH = MLA_WIDTH + CM_WIDTH + SSD_WIDTH
D_FF = 4 * D_MODEL

IN_PARTS = [MLA_Q_LORA, MLA_KV_LORA, MLA_ROPE, 2 * CM_WIDTH, SSD_WIDTH, SSD_CONV_DIM, 2 * SSD_HEADS]
IN_WIDTH = sum(IN_PARTS)
IN_SPLIT_IDX = [int(i) for i in np.cumsum(IN_PARTS)[:-1]]

kernel_name = 'hybrid_mla_chunkmlp_ssd_dit_trunk'


def rmsnorm(x, g):
    xf = x.astype(jnp.float32)
    y = xf * lax.rsqrt(jnp.mean(xf * xf, axis=-1, keepdims=True) + EPS)
    return (y * g.astype(jnp.float32)).astype(x.dtype)


def layernorm(x, g):
    xf = x.astype(jnp.float32)
    mu = jnp.mean(xf, axis=-1, keepdims=True)
    var = jnp.mean(jnp.square(xf - mu), axis=-1, keepdims=True)
    return ((xf - mu) * lax.rsqrt(var + EPS) * g.astype(jnp.float32)).astype(x.dtype)


def modulate(h, shift, scale):
    return h * (1 + scale) + shift


def split_projection(p):
    return jnp.split(p, IN_SPLIT_IDX, axis=-1)


def axial_rope_angles(n_tokens):
    rows_n = n_tokens // GRID_W
    row = jnp.repeat(jnp.arange(rows_n, dtype=jnp.float32), GRID_W)
    col = jnp.tile(jnp.arange(GRID_W, dtype=jnp.float32), rows_n)
    axis_dim = MLA_ROPE // 2
    inv_freq = ROPE_BASE ** (-jnp.arange(0, axis_dim, 2, dtype=jnp.float32) / axis_dim)
    return row[:, None] * inv_freq, col[:, None] * inv_freq


def rotate_half(x, ang):
    x1, x2 = jnp.split(x, 2, axis=-1)
    cos = jnp.cos(ang)[None, :, None, :].astype(x.dtype)
    sin = jnp.sin(ang)[None, :, None, :].astype(x.dtype)
    return jnp.concatenate([x1 * cos - x2 * sin, x1 * sin + x2 * cos], axis=-1)


def apply_axial_rope(x, ang_row, ang_col):
    xr, xc = jnp.split(x, 2, axis=-1)
    return jnp.concatenate([rotate_half(xr, ang_row), rotate_half(xc, ang_col)], axis=-1)


def mla_q(x_q, g_q, w_uq):
    b, l, _ = x_q.shape
    q = (rmsnorm(x_q, g_q) @ w_uq).reshape(b, l, MLA_HEADS, MLA_NOPE + MLA_ROPE)
    return q[..., :MLA_NOPE], q[..., MLA_NOPE:]


def mla_kv(x_kv, x_kr, g_kv, w_ukv):
    b, l, _ = x_kv.shape
    kv = (rmsnorm(x_kv, g_kv) @ w_ukv).reshape(b, l, MLA_HEADS, MLA_NOPE + MLA_V)
    return kv[..., :MLA_NOPE], x_kr[:, :, None, :], kv[..., MLA_NOPE:]


def join_heads(nope, rope):
    rope = jnp.broadcast_to(rope, nope.shape[:-1] + (MLA_ROPE,))
    return jnp.concatenate([nope, rope], axis=-1)


def softmax_attend(q, k, v):
    s = jnp.einsum('bqhd,bkhd->bhqk', q, k).astype(jnp.float32) * MLA_SCALE
    p = jax.nn.softmax(s, axis=-1).astype(v.dtype)
    return jnp.einsum('bhqk,bkhd->bqhd', p, v)


def blocked_attention(q, k, v):
    b, l, h, d = q.shape
    nb = l // Q_BLOCK
    qb = q.reshape(b, nb, Q_BLOCK, h, d).transpose(1, 0, 2, 3, 4)
    o = lax.map(lambda blk: softmax_attend(blk, k, v), qb)
    return o.transpose(1, 0, 2, 3, 4).reshape(b, l, h * v.shape[-1])


def chunk_token_mlp(x_cm, g_norm, w_s, b_s):
    b, l, _ = x_cm.shape
    u, v = jnp.split(jax.nn.gelu(x_cm), 2, axis=-1)
    v = layernorm(v, g_norm).reshape(b, l // CM_CHUNK, CM_CHUNK, CM_GROUPS, CM_GROUP_DIM)
    v = jnp.einsum('gts,bcsgd->bctgd', w_s, v) + b_s.T[:, :, None]
    return u * v.reshape(b, l, CM_WIDTH)


def depthwise_conv(x, w, bias):
    ch = x.shape[-1]
    y = lax.conv_general_dilated(x, w[:, None, :], window_strides=(1,),
                                 padding=[(SSD_CONV // 2, SSD_CONV // 2)],
                                 dimension_numbers=('NWC', 'WIO', 'NWC'),
                                 feature_group_count=ch)
    return y + bias


def segsum(a):
    t = a.shape[-1]
    x = jnp.broadcast_to(a[..., None], a.shape + (t,))
    x = jnp.where(jnp.tril(jnp.ones((t, t), dtype=bool), -1), x, 0.0)
    xs = jnp.cumsum(x, axis=-2)
    return jnp.where(jnp.tril(jnp.ones((t, t), dtype=bool), 0), xs, -jnp.inf)


def ssd_chunked_scan(x, a, bm, cm, init_state, want_y):
    b, l, h, p = x.shape
    nc = l // SSD_CHUNK
    x = x.reshape(b, nc, SSD_CHUNK, h, p)
    bm = bm.reshape(b, nc, SSD_CHUNK, h, -1)
    cm = cm.reshape(b, nc, SSD_CHUNK, h, -1)
    a = a.reshape(b, nc, SSD_CHUNK, h).transpose(0, 3, 1, 2)
    a_cum = jnp.cumsum(a, axis=-1)
    decay_to_end = jnp.exp(a_cum[..., -1:] - a_cum).transpose(0, 2, 3, 1)[..., None]
    chunk_states = jnp.einsum('bclhn,bclhp->bchpn', bm * decay_to_end, x)
    states = jnp.concatenate([init_state[:, None], chunk_states], axis=1)
    chunk_decay = jnp.exp(segsum(jnp.pad(a_cum[..., -1], ((0, 0), (0, 0), (1, 0)))))
    states = jnp.einsum('bhzc,bchpn->bzhpn', chunk_decay, states)
    final_state = states[:, -1]
    if not want_y:
        return None, final_state
    scores = jnp.einsum('bclhn,bcshn->bhcls', cm, bm) * jnp.exp(segsum(a))
    y_diag = jnp.einsum('bhcls,bcshp->bclhp', scores, x)
    decay_from_start = jnp.exp(a_cum).transpose(0, 2, 3, 1)[..., None]
    y_off = jnp.einsum('bclhn,bchpn->bclhp', cm * decay_from_start, states[:, :-1])
    return (y_diag + y_off).reshape(b, l, h, p), final_state


def flip_seq(t, rev):
    return jnp.flip(t, axis=1) if rev else t


def ssd_mixer(z, xbc, dt_raw, conv_w, conv_b, dt_bias, a_log, d_skip, g_norm, init_states, want_y):
    b, l, _ = xbc.shape
    f32 = jnp.float32
    xbc = jax.nn.silu(depthwise_conv(xbc, conv_w, conv_b)).astype(f32)
    xs, bm, cm = jnp.split(xbc, [SSD_WIDTH, SSD_WIDTH + SSD_GROUPS * SSD_STATE], axis=-1)
    xs = xs.reshape(b, l, SSD_HEADS, SSD_HEAD_DIM)
    rep = SSD_HEADS // SSD_GROUPS
    bm = jnp.repeat(bm.reshape(b, l, SSD_GROUPS, SSD_STATE), rep, axis=2)
    cm = jnp.repeat(cm.reshape(b, l, SSD_GROUPS, SSD_STATE), rep, axis=2)
    dt = jax.nn.softplus(dt_raw.astype(f32).reshape(b, l, 2, SSD_HEADS) + dt_bias.astype(f32))
    a = -jnp.exp(a_log.astype(f32))
    d = d_skip.astype(f32)
    ys, finals = [], []
    for direction in range(2):
        rev = direction == 1
        dt_d = flip_seq(dt[:, :, direction], rev)
        x_d = flip_seq(xs, rev)
        y_d, fin = ssd_chunked_scan(x_d * dt_d[..., None], dt_d * a[direction],
                                    flip_seq(bm, rev), flip_seq(cm, rev),
                                    init_states[direction].astype(f32), want_y)
        finals.append(fin)
        if want_y:
            ys.append(flip_seq(y_d, rev) + d[direction][:, None] * xs)
    final_states = jnp.stack(finals)
    if not want_y:
        return None, final_states
    y = (ys[0] + ys[1]).reshape(b, l, SSD_WIDTH).astype(z.dtype)
    return rmsnorm(y * jax.nn.silu(z), g_norm), final_states


def sq_relu_mlp(h, w1, w2):
    return jnp.square(jax.nn.relu(h @ w1)) @ w2


def setup_inputs(seed: int = 0) -> dict:
    key = jax.random.key(seed)
    ks = jax.random.split(key, 32)
    f32 = jnp.float32

    def nrm(k, shape, scale):
        return jax.random.normal(k, shape, f32) * scale

    def gain(k, shape):
        return 1.0 + 0.05 * jax.random.normal(k, shape, f32)

    dt0 = jnp.exp(jax.random.uniform(ks[20], (DEPTH, 2, SSD_HEADS), f32, math.log(1e-3), math.log(1e-1)))
    return {
        'x': nrm(ks[0], (BATCH, SEQ, D_MODEL), 1.0),
        'c': nrm(ks[1], (BATCH, D_MODEL), 1.0),
        'ctx': nrm(ks[2], (BATCH, CTX_LEN, D_MODEL), 1.0),
        'c_ctx': nrm(ks[3], (D_MODEL,), 1.0),
        'w_ada': nrm(ks[4], (DEPTH, D_MODEL, 6 * D_MODEL), 0.5 * D_MODEL ** -0.5),
        'b_ada': nrm(ks[5], (DEPTH, 6 * D_MODEL), 0.02),
        'g_pre_mix': gain(ks[6], (DEPTH, D_MODEL)),
        'g_post_mix': gain(ks[7], (DEPTH, D_MODEL)),
        'g_pre_ff': gain(ks[8], (DEPTH, D_MODEL)),
        'g_post_ff': gain(ks[9], (DEPTH, D_MODEL)),
        'w_in': nrm(ks[10], (DEPTH, D_MODEL, IN_WIDTH), D_MODEL ** -0.5),
        'g_q': gain(ks[11], (DEPTH, MLA_Q_LORA)),
        'w_uq': nrm(ks[12], (DEPTH, MLA_Q_LORA, MLA_HEADS * (MLA_NOPE + MLA_ROPE)), MLA_Q_LORA ** -0.5),
        'g_kv': gain(ks[13], (DEPTH, MLA_KV_LORA)),
        'w_ukv': nrm(ks[14], (DEPTH, MLA_KV_LORA, MLA_HEADS * (MLA_NOPE + MLA_V)), MLA_KV_LORA ** -0.5),
        'cm_norm_g': gain(ks[15], (DEPTH, CM_WIDTH)),
        'cm_w_s': nrm(ks[16], (DEPTH, CM_GROUPS, CM_CHUNK, CM_CHUNK), CM_CHUNK ** -0.5),
        'cm_b_s': 1.0 + nrm(ks[17], (DEPTH, CM_GROUPS, CM_CHUNK), 0.02),
        'ssd_conv_w': nrm(ks[18], (DEPTH, SSD_CONV, SSD_CONV_DIM), SSD_CONV ** -0.5),
        'ssd_conv_b': nrm(ks[19], (DEPTH, SSD_CONV_DIM), 0.02),
        'ssd_dt_bias': dt0 + jnp.log(-jnp.expm1(-dt0)),
        'ssd_a_log': jnp.log(jax.random.uniform(ks[21], (DEPTH, 2, SSD_HEADS), f32, 1.0, 16.0)),
        'ssd_d': gain(ks[22], (DEPTH, 2, SSD_HEADS)),
        'ssd_norm_g': gain(ks[23], (DEPTH, SSD_WIDTH)),
        'w_out': nrm(ks[24], (DEPTH, MIX_WIDTH, D_MODEL), MIX_WIDTH ** -0.5),
        'w_ff1': nrm(ks[25], (DEPTH, D_MODEL, D_FF), D_MODEL ** -0.5),
        'w_ff2': nrm(ks[26], (DEPTH, D_FF, D_MODEL), D_FF ** -0.5),
    }


def reference(x, c, ctx, c_ctx, w_ada, b_ada, g_pre_mix, g_post_mix, g_pre_ff, g_post_ff,
              w_in, g_q, w_uq, g_kv, w_ukv, cm_norm_g, cm_w_s, cm_b_s,
              ssd_conv_w, ssd_conv_b, ssd_dt_bias, ssd_a_log, ssd_d, ssd_norm_g,
              w_out, w_ff1, w_ff2):
    b, n_lat, _ = x.shape
    n_ctx = ctx.shape[1]
    ang_row, ang_col = axial_rope_angles(n_lat)
    xc = ctx
    for layer in range(DEPTH):
        last = layer == DEPTH - 1
        mod = (jax.nn.silu(c) @ w_ada[layer] + b_ada[layer])[:, None, :]
        mod_c = (jax.nn.silu(c_ctx) @ w_ada[layer] + b_ada[layer])[None, None, :]
        shift1, scale1, gate1, shift2, scale2, gate2 = jnp.split(mod, 6, axis=-1)
        cshift1, cscale1, cgate1, cshift2, cscale2, cgate2 = jnp.split(mod_c, 6, axis=-1)
        ssd_params = (ssd_conv_w[layer], ssd_conv_b[layer], ssd_dt_bias[layer],
                      ssd_a_log[layer], ssd_d[layer], ssd_norm_g[layer])

        hc = modulate(rmsnorm(xc, g_pre_mix[layer]), cshift1, cscale1)
        cq_lo, ckv_lo, ckr, ccm, cz, cxbc, cdt = split_projection(hc @ w_in[layer])
        ck_nope, ck_rope, cv = mla_kv(ckv_lo, ckr, g_kv[layer], w_ukv[layer])
        ck = join_heads(ck_nope, ck_rope)
        zero_states = jnp.zeros((2, b, SSD_HEADS, SSD_HEAD_DIM, SSD_STATE), jnp.float32)
        cy_ssd, ctx_states = ssd_mixer(cz, cxbc, cdt, *ssd_params, zero_states, not last)
        if not last:
            cq_nope, cq_rope = mla_q(cq_lo, g_q[layer], w_uq[layer])
            cy_attn = softmax_attend(join_heads(cq_nope, cq_rope), ck, cv).reshape(b, n_ctx, MLA_WIDTH)
            cy_cm = chunk_token_mlp(ccm, cm_norm_g[layer], cm_w_s[layer], cm_b_s[layer])
            cy = jnp.concatenate([cy_attn, cy_cm, cy_ssd], axis=-1) @ w_out[layer]
            xc = xc + cgate1 * rmsnorm(cy, g_post_mix[layer])
            hc2 = modulate(rmsnorm(xc, g_pre_ff[layer]), cshift2, cscale2)
            xc = xc + cgate2 * rmsnorm(sq_relu_mlp(hc2, w_ff1[layer], w_ff2[layer]), g_post_ff[layer])

        h = modulate(rmsnorm(x, g_pre_mix[layer]), shift1, scale1)
        q_lo, kv_lo, kr, xcm, z, xbc, dt = split_projection(h @ w_in[layer])
        q_nope, q_rope = mla_q(q_lo, g_q[layer], w_uq[layer])
        k_nope, k_rope, v = mla_kv(kv_lo, kr, g_kv[layer], w_ukv[layer])
        q = join_heads(q_nope, apply_axial_rope(q_rope, ang_row, ang_col))
        k = join_heads(k_nope, apply_axial_rope(k_rope, ang_row, ang_col))
        y_attn = blocked_attention(q, jnp.concatenate([k, ck], axis=1), jnp.concatenate([v, cv], axis=1))
        y_cm = chunk_token_mlp(xcm, cm_norm_g[layer], cm_w_s[layer], cm_b_s[layer])
        y_ssd, _ = ssd_mixer(z, xbc, dt, *ssd_params, ctx_states, True)
        y = jnp.concatenate([y_attn, y_cm, y_ssd], axis=-1) @ w_out[layer]
        x = x + gate1 * rmsnorm(y, g_post_mix[layer])
        h2 = modulate(rmsnorm(x, g_pre_ff[layer]), shift2, scale2)
        x = x + gate2 * rmsnorm(sq_relu_mlp(h2, w_ff1[layer], w_ff2[layer]), g_post_ff[layer])
    return x
```

```cpp
#include <hip/hip_runtime.h>
#include <hip/hip_cooperative_groups.h>
#include <cstdio>
namespace cg = cooperative_groups;

#define DI __device__ __forceinline__
typedef unsigned short u16;
using bf16x8 = __attribute__((ext_vector_type(8))) short;
using s16x4 = __attribute__((ext_vector_type(4))) short;
using f32x16 = __attribute__((ext_vector_type(16))) float;
using u32x4 = __attribute__((ext_vector_type(4))) unsigned;
using u32x2 = __attribute__((ext_vector_type(2))) unsigned;
using f32x4 = __attribute__((ext_vector_type(4))) float;
typedef __bf16 bf2_t __attribute__((ext_vector_type(2)));
typedef float f2_t __attribute__((ext_vector_type(2)));
#define MFMA(a, b, c) __builtin_amdgcn_mfma_f32_32x32x16_bf16((a), (b), (c), 0, 0, 0)

constexpr int NB = 8, SEQ = 4096, CTX = 256, SP = 4352, T = NB * SP, D = 1024, DFF = 4096;
constexpr int NIN = 1992, NINP = 2048, NCH = 34, DEPTH = 4;
constexpr int NTHR = 256;
constexpr int SMEM_BYTES = 75 * 1024;
constexpr float EPS = 1e-6f;

struct Params {
  const float *x, *c, *ctx, *c_ctx, *w_ada, *b_ada, *g_pre_mix, *g_post_mix, *g_pre_ff, *g_post_ff, *w_in, *g_q, *w_uq,
      *g_kv, *w_ukv, *cm_norm_g, *cm_w_s, *cm_b_s, *conv_w, *conv_b, *dt_bias, *a_log, *ssd_d, *ssd_norm_g, *w_out,
      *w_ff1, *w_ff2;
  float* out;
  u16 *wt_in, *wt_uq, *wt_ukv, *wt_out, *wt_ff1, *wt_ff2, *wsb;
  float *mod, *ropetab, *atot, *xctx;
  u16 *P, *Q, *Kn, *Kr, *Vt, *Hd;
  float *Y, *dtraw;
  u16* H;
  float* CS;
  u16* F;
  float* ytmp;
};

DI int ltid() { int t = threadIdx.x; asm volatile("" : "+v"(t)); return t; }
DI int lbid() { int t = blockIdx.x; asm volatile("" : "+s"(t)); return t; }
DI int crow(int e, int h) { return (e & 3) + 8 * (e >> 2) + 4 * h; }
DI unsigned pack2(float a, float b) {
  f2_t v = {a, b};
  bf2_t r = __builtin_convertvector(v, bf2_t);
  return __builtin_bit_cast(unsigned, r);
}
DI u16 f2bf(float a) { return (u16)(pack2(a, 0.f) & 0xffffu); }
DI float bf2f(u16 v) { return __uint_as_float(((unsigned)v) << 16); }
DI float bflo(unsigned w) { return __uint_as_float(w << 16); }
DI float bfhi(unsigned w) { return __uint_as_float(w & 0xffff0000u); }
DI bf16x8 pack8(float a0, float a1, float a2, float a3, float a4, float a5, float a6, float a7) {
  u32x4 u;
  u.x = pack2(a0, a1); u.y = pack2(a2, a3); u.z = pack2(a4, a5); u.w = pack2(a6, a7);
  return __builtin_bit_cast(bf16x8, u);
}
DI float wave_sum(float v) {
#pragma unroll
  for (int o = 32; o > 0; o >>= 1) v += __shfl_xor(v, o);
  return v;
}
DI float silu_f(float y) { return y / (1.f + __expf(-y)); }
DI float gelu_f(float x) {
  float u = 0.7978845608028654f * (x + 0.044715f * x * x * x);
  float t = 1.f - 2.f / (1.f + __expf(2.f * u));
  return 0.5f * x * (1.f + t);
}
DI float softplus_f(float x) { return x > 20.f ? x : log1pf(__expf(x)); }
DI float uw(const u32x4& v, int i) {
  unsigned w = (i >> 1) == 0 ? v.x : (i >> 1) == 1 ? v.y : (i >> 1) == 2 ? v.z : v.w;
  return (i & 1) ? bfhi(w) : bflo(w);
}

template <class Epi>
DI void gemm_tile(const u16* __restrict__ A, int lda, const u16* __restrict__ Bt, int ldb, int K, int m0, int n0,
                  char* smem, Epi epi) {
  u16* sA = (u16*)smem;
  u16* sB = sA + 128 * 72;
  const int tid = ltid(), lane = tid & 63, wid = tid >> 6, wm = wid >> 1, wn = wid & 1, r = lane & 31,
            h = lane >> 5;
  f32x16 acc[2][2];
#pragma unroll
  for (int i = 0; i < 2; ++i)
#pragma unroll
    for (int j = 0; j < 2; ++j)
#pragma unroll
      for (int e = 0; e < 16; ++e) acc[i][j][e] = 0.f;
  u32x4 ra[4], rb[4];
  const int lrow = tid >> 3, lcp = (tid & 7) * 8;
  const u16* ga = A + (size_t)(m0 + lrow) * lda + lcp;
  const u16* gb = Bt + (size_t)(n0 + lrow) * ldb + lcp;
#pragma unroll
  for (int i = 0; i < 4; ++i) {
    ra[i] = *(const u32x4*)(ga + (size_t)(32 * i) * lda);
    rb[i] = *(const u32x4*)(gb + (size_t)(32 * i) * ldb);
  }
  for (int k0 = 0; k0 < K; k0 += 64) {
    __syncthreads();
#pragma unroll
    for (int i = 0; i < 4; ++i) {
      *(u32x4*)(sA + (lrow + 32 * i) * 72 + lcp) = ra[i];
      *(u32x4*)(sB + (lrow + 32 * i) * 72 + lcp) = rb[i];
    }
    __syncthreads();
    if (k0 + 64 < K) {
#pragma unroll
      for (int i = 0; i < 4; ++i) {
        ra[i] = *(const u32x4*)(ga + (size_t)(32 * i) * lda + k0 + 64);
        rb[i] = *(const u32x4*)(gb + (size_t)(32 * i) * ldb + k0 + 64);
      }
    }
#pragma unroll
    for (int kk = 0; kk < 4; ++kk) {
      bf16x8 af[2], bfr[2];
#pragma unroll
      for (int i = 0; i < 2; ++i) af[i] = *(const bf16x8*)(sA + (wm * 64 + i * 32 + r) * 72 + kk * 16 + h * 8);
#pragma unroll
      for (int j = 0; j < 2; ++j) bfr[j] = *(const bf16x8*)(sB + (wn * 64 + j * 32 + r) * 72 + kk * 16 + h * 8);
#pragma unroll
      for (int i = 0; i < 2; ++i)
#pragma unroll
        for (int j = 0; j < 2; ++j) acc[i][j] = MFMA(af[i], bfr[j], acc[i][j]);
    }
  }
#pragma unroll
  for (int i = 0; i < 2; ++i)
#pragma unroll
    for (int j = 0; j < 2; ++j) epi(m0 + wm * 64 + i * 32, n0 + wn * 64 + j * 32, acc[i][j], r, h);
}

DI void conv_tile(const float* __restrict__ src, int K, int N, u16* __restrict__ dst, const float* __restrict__ scale,
                  int tk, int tn, char* smem) {
  float* tile = (float*)smem;
  const int tid = ltid(), tx = tid & 63, ty = tid >> 6;
  const int k0 = tk * 64, n0 = tn * 64;
  __syncthreads();
#pragma unroll 4
  for (int i = 0; i < 16; ++i) {
    int kr = ty + 4 * i;
    float v = 0.f;
    if (n0 + tx < N) v = src[(size_t)(k0 + kr) * N + n0 + tx];
    if (scale) v *= scale[k0 + kr];
    tile[kr * 65 + tx] = v;
  }
  __syncthreads();
#pragma unroll 4
  for (int i = 0; i < 16; ++i) {
    int nr = ty + 4 * i;
    dst[(size_t)(n0 + nr) * K + k0 + tx] = f2bf(tile[tx * 65 + nr]);
  }
}

DI void convert_weights(const float* src, int K, int N, int Npad, u16* dst, const float* scale, char* smem) {
  const int tks = K / 64, tns = Npad / 64;
  for (int t = lbid(); t < tks * tns; t += gridDim.x) conv_tile(src, K, N, dst, scale, t / tns, t % tns, smem);
}

DI void prologue_phase(const Params& p, char* smem) {
  float* sc = (float*)smem;
  float* red = sc + 9 * 1024;
  const int tid = ltid();
  for (int i = tid; i < 9 * 1024; i += NTHR) {
    int j = i >> 10, k = i & 1023;
    float v = j < 8 ? p.c[j * 1024 + k] : p.c_ctx[k];
    sc[i] = v / (1.f + __expf(-v));
  }
  __syncthreads();
  for (int task = lbid(); task < DEPTH * 96; task += gridDim.x) {
    const int l = task / 96, n0 = (task % 96) * 64, nn = tid & 63, kq = tid >> 6;
    float acc[9];
#pragma unroll
    for (int j = 0; j < 9; ++j) acc[j] = 0.f;
    const float* w = p.w_ada + ((size_t)l * 1024 + kq * 256) * 6144 + n0 + nn;
    const float* scq = sc + kq * 256;
#pragma unroll 4
    for (int k = 0; k < 256; ++k) {
      float wv = w[(size_t)k * 6144];
#pragma unroll
      for (int j = 0; j < 9; ++j) acc[j] += scq[j * 1024 + k] * wv;
    }
#pragma unroll
    for (int j = 0; j < 9; ++j) red[(kq * 9 + j) * 64 + nn] = acc[j];
    __syncthreads();
    for (int idx = tid; idx < 576; idx += NTHR) {
      int j = idx >> 6, n2 = idx & 63;
      float s = red[(0 * 9 + j) * 64 + n2] + red[(1 * 9 + j) * 64 + n2] + red[(2 * 9 + j) * 64 + n2] +
                red[(3 * 9 + j) * 64 + n2] + p.b_ada[l * 6144 + n0 + n2];
      p.mod[(size_t)(l * 9 + j) * 6144 + n0 + n2] = s;
    }
    __syncthreads();
  }
  if (lbid() == gridDim.x - 1) {
    for (int i = tid; i < 64 * 16; i += NTHR) {
      int pos = i >> 4, j = i & 15;
      float inv_freq = exp2f(-(float)(2 * j) / 32.f * 13.287712379549449f);
      float ang = (float)pos * inv_freq;
      float k = rintf(ang * 0.15915494309189535f);
      float red2 = fmaf(-k, 6.2831854820251465f, ang);
      red2 = fmaf(-k, -1.7484555314695172e-07f, red2);
      p.ropetab[2 * i] = __cosf(red2);
      p.ropetab[2 * i + 1] = __sinf(red2);
    }
  }
}

DI void ew_phase(const Params& p, int layer, int kind) {
  const int tid = ltid(), lane = tid & 63, wid = __builtin_amdgcn_readfirstlane(tid >> 6);
  const bool has_branch = !(kind == 0 && layer == 0);
  const bool src_in = (layer == 0 && kind <= 1);
  const bool store_x = has_branch;
  const int blayer = (kind == 1) ? layer : (kind == 0 ? layer - 1 : DEPTH - 1);
  const float* gpost = (kind == 1) ? p.g_post_mix + blayer * D : p.g_post_ff + (blayer < 0 ? 0 : blayer) * D;
  const int gate_off = (kind == 1) ? 2 * D : 5 * D;
  const float* gpre = (kind == 0) ? p.g_pre_mix + layer * D : p.g_pre_ff + (kind == 1 ? layer : 0) * D;
  const int shift_off = (kind == 0) ? 0 : 3 * D, scale_off = (kind == 0) ? D : 4 * D;
  const float* xl = src_in ? p.x : p.out;
  const float* xc = src_in ? p.ctx : p.xctx;
  for (int rg = lbid(); rg < T / 4; rg += gridDim.x) {
    const int row = rg * 4 + wid;
    const int b = row / SP, s = row - b * SP;
    const bool lat = s < SEQ;
    if (kind == 2 && !lat) continue;
    const size_t xoff = lat ? ((size_t)(b * SEQ + s) * D) : ((size_t)(b * CTX + s - SEQ) * D);
    const unsigned long long msk = lat ? ~0ull : 0ull;
    const float* xs = (const float*)(((unsigned long long)xl & msk) | ((unsigned long long)xc & ~msk)) + xoff;
    float* xd = (float*)(((unsigned long long)p.out & msk) | ((unsigned long long)p.xctx & ~msk)) + xoff;
    const int mi = lat ? b : 8;
    f32x4 xv[4];
#pragma unroll
    for (int i = 0; i < 4; ++i) xv[i] = *(const f32x4*)(xs + lane * 4 + 256 * i);
    if (has_branch) {
      const float* modb = p.mod + (size_t)(blayer * 9 + mi) * 6144 + gate_off;
      f32x4 yv[4];
      if (kind == 1) {
#pragma unroll
        for (int i = 0; i < 4; ++i) yv[i] = *(const f32x4*)(p.Y + (size_t)row * D + lane * 4 + 256 * i);
      } else {
#pragma unroll
        for (int i = 0; i < 4; ++i) {
          u32x2 w = *(const u32x2*)(p.F + (size_t)row * D + lane * 4 + 256 * i);
          yv[i] = f32x4{bflo(w.x), bfhi(w.x), bflo(w.y), bfhi(w.y)};
        }
      }
      float ss = 0.f;
#pragma unroll
      for (int i = 0; i < 4; ++i) ss += yv[i].x * yv[i].x + yv[i].y * yv[i].y + yv[i].z * yv[i].z + yv[i].w * yv[i].w;
      ss = wave_sum(ss);
      const float rstd = rsqrtf(ss * (1.f / D) + EPS);
#pragma unroll
      for (int i = 0; i < 4; ++i) {
        const int col = lane * 4 + 256 * i;
        f32x4 g = *(const f32x4*)(gpost + col);
        f32x4 gt = *(const f32x4*)(modb + col);
        xv[i].x += gt.x * (yv[i].x * rstd * g.x);
        xv[i].y += gt.y * (yv[i].y * rstd * g.y);
        xv[i].z += gt.z * (yv[i].z * rstd * g.z);
        xv[i].w += gt.w * (yv[i].w * rstd * g.w);
      }
      if (store_x) {
#pragma unroll
        for (int i = 0; i < 4; ++i) *(f32x4*)(xd + lane * 4 + 256 * i) = xv[i];
      }
    }
    if (kind != 2) {
      const float* modl = p.mod + (size_t)(layer * 9 + mi) * 6144;
      float ss = 0.f;
#pragma unroll
      for (int i = 0; i < 4; ++i) ss += xv[i].x * xv[i].x + xv[i].y * xv[i].y + xv[i].z * xv[i].z + xv[i].w * xv[i].w;
      ss = wave_sum(ss);
      const float rstd = rsqrtf(ss * (1.f / D) + EPS);
#pragma unroll
      for (int i = 0; i < 4; ++i) {
        const int col = lane * 4 + 256 * i;
        f32x4 g = *(const f32x4*)(gpre + col);
        f32x4 sh = *(const f32x4*)(modl + shift_off + col);
        f32x4 sc = *(const f32x4*)(modl + scale_off + col);
        float h0 = xv[i].x * rstd * g.x * (1.f + sc.x) + sh.x;
        float h1 = xv[i].y * rstd * g.y * (1.f + sc.y) + sh.y;
        float h2 = xv[i].z * rstd * g.z * (1.f + sc.z) + sh.z;
        float h3 = xv[i].w * rstd * g.w * (1.f + sc.w) + sh.w;
        u32x2 w;
        w.x = pack2(h0, h1);
        w.y = pack2(h2, h3);
        *(u32x2*)(p.H + (size_t)row * D + col) = w;
      }
    }
  }
}

DI void row_rstd(const u16* __restrict__ base, int ld, int ncols, int m0, float* rs) {
  const int tid = ltid(), row = tid >> 1, half = tid & 1;
  const int per = ncols / 2;
  const u16* ptr = base + (size_t)(m0 + row) * ld + half * per;
  float ss = 0.f;
  for (int i = 0; i < per; i += 8) {
    u32x4 v = *(const u32x4*)(ptr + i);
#pragma unroll
    for (int e = 0; e < 8; ++e) {
      float f = uw(v, e);
      ss += f * f;
    }
  }
  ss += __shfl_xor(ss, 1);
  if (half == 0) rs[row] = rsqrtf(ss / (float)ncols + EPS);
}

DI void qkv_tasks(const Params& p, char* smem) {
  float* rs = (float*)(smem + 2 * 128 * 72 * 2);
  const int MT = T / 128;
  for (int t = lbid(); t < MT * 6; t += gridDim.x) {
    const int tm = t / 6, tn = t % 6, m0 = tm * 128;
    __syncthreads();
    row_rstd(p.P, NINP, 256, m0, rs);
    const bool lat = (m0 % SP) < SEQ;
    const int s0 = m0 % SP;
    gemm_tile(p.P, NINP, p.wt_uq, 256, 256, m0, tn * 128, smem,
              [&](int mb, int nb, const f32x16& acc, int r, int h) {
                const int col = nb + r;
                const int cc = col % 192;
                const bool rope = lat && (cc >= 128);
                const int axis = (cc - 128) >> 5;
                const int j = r & 15;
#pragma unroll
                for (int e = 0; e < 16; ++e) {
                  const int rowl = mb - m0 + crow(e, h);
                  float v = acc[e] * rs[rowl];
                  float pr = __shfl_xor(v, 16);
                  if (rope) {
                    const int s = s0 + rowl;
                    const int pos = axis == 0 ? (s >> 6) : (s & 63);
                    const float cs = p.ropetab[2 * (pos * 16 + j)], sn = p.ropetab[2 * (pos * 16 + j) + 1];
                    v = (r & 16) ? (pr * sn + v * cs) : (v * cs - pr * sn);
                  }
                  p.Q[(size_t)(m0 + rowl) * 768 + col] = f2bf(v);
                }
              });
  }
  for (int t = lbid(); t < MT * 8; t += gridDim.x) {
    const int tm = t / 8, tn = t % 8, m0 = tm * 128;
    const int b = m0 / SP, s0 = m0 % SP;
    const bool lat = s0 < SEQ;
    __syncthreads();
    row_rstd(p.P + 256, NINP, 128, m0, rs);
    if (tn == 0) {
      for (int idx = ltid(); idx < 128 * 32; idx += NTHR) {
        const int rowl = idx >> 5, q = idx & 31, blk = q >> 4, j = q & 15;
        const u16* src = p.P + (size_t)(m0 + rowl) * NINP + 384 + blk * 32 + j;
        float x1 = bf2f(src[0]), x2 = bf2f(src[16]);
        float o1 = x1, o2 = x2;
        if (lat) {
          const int s = s0 + rowl;
          const int pos = blk == 0 ? (s >> 6) : (s & 63);
          const float cs = p.ropetab[2 * (pos * 16 + j)], sn = p.ropetab[2 * (pos * 16 + j) + 1];
          o1 = x1 * cs - x2 * sn;
          o2 = x1 * sn + x2 * cs;
        }
        u16* dst = p.Kr + (size_t)(m0 + rowl) * 64 + blk * 32 + j;
        dst[0] = f2bf(o1);
        dst[16] = f2bf(o2);
      }
    }
    gemm_tile(p.P + 256, NINP, p.wt_ukv, 128, 128, m0, tn * 128, smem,
              [&](int mb, int nb, const f32x16& acc, int r, int h) {
                const int col = nb + r;
                const int hd = col >> 8, cc = col & 255;
                if (cc < 128) {
#pragma unroll
                  for (int e = 0; e < 16; ++e) {
                    const int rowl = mb - m0 + crow(e, h);
                    p.Kn[(size_t)(m0 + rowl) * 512 + hd * 128 + cc] = f2bf(acc[e] * rs[rowl]);
                  }
                } else {
                  u16* vrow = p.Vt + ((size_t)(b * 4 + hd) * 128 + (cc - 128)) * SP + s0;
#pragma unroll
                  for (int q4 = 0; q4 < 4; ++q4) {
                    const int rowl = mb - m0 + 8 * q4 + 4 * h;
                    u32x2 w;
                    w.x = pack2(acc[4 * q4] * rs[rowl], acc[4 * q4 + 1] * rs[rowl + 1]);
                    w.y = pack2(acc[4 * q4 + 2] * rs[rowl + 2], acc[4 * q4 + 3] * rs[rowl + 3]);
                    *(u32x2*)(vrow + rowl) = w;
                  }
                }
              });
  }
}

DI void cm_tasks(const Params& p, int layer, char* smem) {
  u16* vnT = (u16*)smem;
  const int tid = ltid(), lane = tid & 63, wid = tid >> 6, r = lane & 31, h = lane >> 5;
  const float* gn = p.cm_norm_g + layer * 256;
  const float* bs = p.cm_b_s + layer * 512;
  for (int task = lbid(); task < NB * NCH; task += gridDim.x) {
    const int row0 = task * 128;
    __syncthreads();
    for (int i = 0; i < 32; ++i) {
      const int s = wid * 32 + i;
      const u16* src = p.P + (size_t)(row0 + s) * NINP + 704;
      float v[4];
      float sum = 0.f;
#pragma unroll
      for (int q = 0; q < 4; ++q) {
        v[q] = gelu_f(bf2f(src[lane + 64 * q]));
        sum += v[q];
      }
      const float mean = wave_sum(sum) * (1.f / 256.f);
      float var = 0.f;
#pragma unroll
      for (int q = 0; q < 4; ++q) {
        v[q] -= mean;
        var += v[q] * v[q];
      }
      const float rstd = rsqrtf(wave_sum(var) * (1.f / 256.f) + EPS);
#pragma unroll
      for (int q = 0; q < 4; ++q) vnT[(lane + 64 * q) * 136 + s] = f2bf(v[q] * rstd * gn[lane + 64 * q]);
    }
    __syncthreads();
    const int t = wid * 32 + r;
    for (int g = 0; g < 4; ++g) {
      bf16x8 wf[8];
#pragma unroll
      for (int kk = 0; kk < 8; ++kk) wf[kk] = *(const bf16x8*)(p.wsb + ((size_t)(g * 128 + t)) * 128 + kk * 16 + h * 8);
      const float bias = bs[g * 128 + t];
#pragma unroll
      for (int cb = 0; cb < 2; ++cb) {
        f32x16 acc;
#pragma unroll
        for (int e = 0; e < 16; ++e) acc[e] = 0.f;
#pragma unroll
        for (int kk = 0; kk < 8; ++kk) {
          bf16x8 a = *(const bf16x8*)(vnT + (g * 64 + cb * 32 + r) * 136 + kk * 16 + h * 8);
          acc = MFMA(a, wf[kk], acc);
        }
#pragma unroll
        for (int q4 = 0; q4 < 4; ++q4) {
          const int ch0 = g * 64 + cb * 32 + 8 * q4 + 4 * h;
          u32x2 uwd = *(const u32x2*)(p.P + (size_t)(row0 + t) * NINP + 448 + ch0);
          float u0 = gelu_f(bflo(uwd.x)), u1 = gelu_f(bfhi(uwd.x)), u2 = gelu_f(bflo(uwd.y)), u3 = gelu_f(bfhi(uwd.y));
          u32x2 w;
          w.x = pack2(u0 * (acc[4 * q4] + bias), u1 * (acc[4 * q4 + 1] + bias));
          w.y = pack2(u2 * (acc[4 * q4 + 2] + bias), u3 * (acc[4 * q4 + 3] + bias));
          *(u32x2*)(p.H + (size_t)(row0 + t) * D + 512 + ch0) = w;
        }
      }
    }
  }
}

DI void conv8(const Params& p, int layer, int row, int ch, bool hasPrev, bool hasNext, float out[8]) {
  const u16* base = p.P + (size_t)row * NINP + 1216 + ch;
  u32x4 cur = *(const u32x4*)base;
  u32x4 prv = u32x4{0u, 0u, 0u, 0u}, nxt = u32x4{0u, 0u, 0u, 0u};
  if (hasPrev) prv = *(const u32x4*)(base - NINP);
  if (hasNext) nxt = *(const u32x4*)(base + NINP);
  const float* cw = p.conv_w + (size_t)layer * 3 * 768 + ch;
  const float* cb = p.conv_b + layer * 768 + ch;
#pragma unroll
  for (int e = 0; e < 8; ++e) {
    float y = cw[e] * uw(prv, e) + cw[768 + e] * uw(cur, e) + cw[1536 + e] * uw(nxt, e) + cb[e];
    out[e] = silu_f(y);
  }
}

DI void ssd_dt_arrays(const Params& p, int layer, int row0, int hh, int t, float* arr) {
  float* dt0 = arr;
  float* dt1 = arr + 128;
  float* c0 = arr + 256;
  float* s1 = arr + 384;
  float* a0 = arr + 512;
  float* a1 = arr + 640;
  const float d0 = softplus_f(p.dtraw[(size_t)(row0 + t) * 8 + hh] + p.dt_bias[layer * 8 + hh]);
  const float d1 = softplus_f(p.dtraw[(size_t)(row0 + t) * 8 + 4 + hh] + p.dt_bias[layer * 8 + 4 + hh]);
  dt0[t] = d0;
  dt1[t] = d1;
  a0[t] = -d0 * __expf(p.a_log[layer * 8 + hh]);
  a1[t] = -d1 * __expf(p.a_log[layer * 8 + 4 + hh]);
}
DI void ssd_cum_arrays(int t, float* arr) {
  float* c0 = arr + 256;
  float* s1 = arr + 384;
  const float* a0 = arr + 512;
  const float* a1 = arr + 640;
  float s = 0.f;
  for (int k = 0; k <= t; ++k) s += a0[k];
  c0[t] = s;
  s = 0.f;
  for (int k = 127; k >= t; --k) s += a1[k];
  s1[t] = s;
}

DI void ssd_s1_tasks(const Params& p, int layer, char* smem) {
  u16* xsT0 = (u16*)smem;
  u16* xsT1 = xsT0 + 64 * 136;
  u16* BT = xsT1 + 64 * 136;
  float* arr = (float*)(BT + 128 * 136);
  float* w0 = arr + 768;
  float* w1 = w0 + 128;
  const int tid = ltid(), lane = tid & 63, wid = tid >> 6, r = lane & 31, h = lane >> 5;
  for (int task = lbid(); task < NB * NCH * 4; task += gridDim.x) {
    const int hh = task & 3, bc = task >> 2, c = bc % NCH, b = bc / NCH;
    const int g = hh >> 1;
    const int row0 = bc * 128;
    const bool cPrev = (c != 0 && c != 32), cNext = (c != 31 && c != 33);
    __syncthreads();
    if (tid < 128) ssd_dt_arrays(p, layer, row0, hh, tid, arr);
    __syncthreads();
    if (tid < 128) ssd_cum_arrays(tid, arr);
    __syncthreads();
    if (tid < 128) {
      const float* dt0 = arr;
      const float* dt1 = arr + 128;
      const float* c0 = arr + 256;
      const float* s1 = arr + 384;
      w0[tid] = __expf(c0[127] - c0[tid]) * dt0[tid];
      w1[tid] = __expf(s1[0] - s1[tid]) * dt1[tid];
      if (tid == 0) {
        p.atot[((size_t)bc * 2 + 0) * 4 + hh] = c0[127];
        p.atot[((size_t)bc * 2 + 1) * 4 + hh] = s1[0];
      }
    }
    __syncthreads();
#pragma unroll 1
    for (int i = 0; i < 4; ++i) {
      const int id = tid + NTHR * i, t = id >> 3, cp = id & 7;
      float v[8];
      conv8(p, layer, row0 + t, hh * 64 + cp * 8, cPrev || t > 0, cNext || t < 127, v);
      const float f0 = w0[t], f1 = w1[t];
#pragma unroll
      for (int e = 0; e < 8; ++e) {
        xsT0[(cp * 8 + e) * 136 + t] = f2bf(v[e] * f0);
        xsT1[(cp * 8 + e) * 136 + t] = f2bf(v[e] * f1);
      }
    }
#pragma unroll 1
    for (int i = 0; i < 8; ++i) {
      const int id = tid + NTHR * i, t = id >> 4, cp = id & 15;
      float v[8];
      conv8(p, layer, row0 + t, 256 + g * 128 + cp * 8, cPrev || t > 0, cNext || t < 127, v);
#pragma unroll
      for (int e = 0; e < 8; ++e) BT[(cp * 8 + e) * 136 + t] = f2bf(v[e]);
    }
    __syncthreads();
#pragma unroll
    for (int d = 0; d < 2; ++d) {
      const u16* xsT = d ? xsT1 : xsT0;
#pragma unroll
      for (int pb = 0; pb < 2; ++pb) {
        f32x16 acc;
#pragma unroll
        for (int e = 0; e < 16; ++e) acc[e] = 0.f;
#pragma unroll
        for (int kk = 0; kk < 8; ++kk) {
          bf16x8 a = *(const bf16x8*)(xsT + (pb * 32 + r) * 136 + kk * 16 + h * 8);
          bf16x8 bb = *(const bf16x8*)(BT + (wid * 32 + r) * 136 + kk * 16 + h * 8);
          acc = MFMA(a, bb, acc);
        }
        float* dst = p.CS + ((((size_t)bc * 2 + d) * 4 + hh) * 64 + pb * 32) * 128 + wid * 32 + r;
#pragma unroll
        for (int e = 0; e < 16; ++e) dst[(size_t)crow(e, h) * 128] = acc[e];
      }
    }
  }
}

DI void ssd_scan_phase(const Params& p) {
  const int total = NB * 2 * 4 * 8192;
  for (int idx = lbid() * NTHR + ltid(); idx < total; idx += gridDim.x * NTHR) {
    const int e = idx & 8191, hh = (idx >> 13) & 3, d = (idx >> 15) & 1, b = idx >> 16;
    float st = 0.f;
#pragma unroll 2
    for (int i = 0; i < NCH; ++i) {
      int c;
      if (d == 0) c = i < 2 ? 32 + i : i - 2;
      else c = i < 2 ? 33 - i : 33 - i;
      const size_t bc = (size_t)b * NCH + c;
      float* ptr = p.CS + ((bc * 2 + d) * 4 + hh) * 8192 + e;
      const float v = *ptr;
      const float dec = __expf(p.atot[(bc * 2 + d) * 4 + hh]);
      *ptr = st;
      st = dec * st + v;
    }
  }
}

template <int G>
DI float ssd_s3_group(const Params& p, int layer, int bc, bool cPrev, bool cNext, u16* Bg, u16* xsT, float* arr) {
  f32x16 y[4];
#pragma unroll
  for (int i = 0; i < 4; ++i)
#pragma unroll
    for (int e = 0; e < 16; ++e) y[i][e] = 0.f;
  const int tid = ltid(), lane = tid & 63, wid = tid >> 6, r = lane & 31, h = lane >> 5;
  const int l = wid * 32 + r;
  const int row0 = bc * 128;
  __syncthreads();
  ssd_dt_arrays(p, layer, row0, 2 * G + (tid >> 7), tid & 127, arr + (tid >> 7) * 768);
#pragma unroll 1
  for (int i = 0; i < 8; ++i) {
    const int id = tid + NTHR * i, t = id >> 4, cp = id & 15;
    float v[8];
    conv8(p, layer, row0 + t, 512 + G * 128 + cp * 8, cPrev || t > 0, cNext || t < 127, v);
    *(bf16x8*)(Bg + t * 136 + cp * 8) = pack8(v[0], v[1], v[2], v[3], v[4], v[5], v[6], v[7]);
  }
#pragma unroll 1
  for (int i = 0; i < 8; ++i) {
    const int id = tid + NTHR * i, t = id >> 4, cp = id & 15;
    float v[8];
    conv8(p, layer, row0 + t, G * 128 + cp * 8, cPrev || t > 0, cNext || t < 127, v);
#pragma unroll
    for (int e = 0; e < 8; ++e) xsT[(cp * 8 + e) * 136 + t] = f2bf(v[e]);
  }
  __syncthreads();
  ssd_cum_arrays(tid & 127, arr + (tid >> 7) * 768);
  bf16x8 cf[8];
#pragma unroll
  for (int kk = 0; kk < 8; ++kk) cf[kk] = *(const bf16x8*)(Bg + l * 136 + kk * 16 + h * 8);
  __syncthreads();
#pragma unroll 1
  for (int i = 0; i < 8; ++i) {
    const int id = tid + NTHR * i, t = id >> 4, cp = id & 15;
    float v[8];
    conv8(p, layer, row0 + t, 256 + G * 128 + cp * 8, cPrev || t > 0, cNext || t < 127, v);
    *(bf16x8*)(Bg + t * 136 + cp * 8) = pack8(v[0], v[1], v[2], v[3], v[4], v[5], v[6], v[7]);
  }
  __syncthreads();
  float ss = 0.f;
#pragma unroll 1
  for (int hd2 = 0; hd2 < 2; ++hd2) {
    const int hh = 2 * G + hd2;
    const float* ah = arr + hd2 * 768;
    const float c0l = ah[256 + l], s1l = ah[384 + l];
    f32x16 y[2];
#pragma unroll
    for (int i = 0; i < 2; ++i)
#pragma unroll
      for (int e = 0; e < 16; ++e) y[i][e] = 0.f;
#pragma unroll 1
    for (int sb = 0; sb < 4; ++sb) {
      f32x16 gt;
#pragma unroll
      for (int e = 0; e < 16; ++e) gt[e] = 0.f;
#pragma unroll
      for (int kk = 0; kk < 8; ++kk) {
        bf16x8 a = *(const bf16x8*)(Bg + (sb * 32 + r) * 136 + kk * 16 + h * 8);
        gt = MFMA(a, cf[kk], gt);
      }
      f32x16 wv;
#pragma unroll
      for (int e = 0; e < 16; ++e) {
        const int s = sb * 32 + crow(e, h);
        const float a0 = (l >= s) ? (c0l - ah[256 + s]) : -1e30f;
        const float a1 = (l <= s) ? (s1l - ah[384 + s]) : -1e30f;
        const float f = __expf(a0) * ah[s] + __expf(a1) * ah[128 + s];
        wv[e] = gt[e] * f;
      }
      bf16x8 wp0 = pack8(wv[0], wv[1], wv[2], wv[3], wv[4], wv[5], wv[6], wv[7]);
      bf16x8 wp1 = pack8(wv[8], wv[9], wv[10], wv[11], wv[12], wv[13], wv[14], wv[15]);
#pragma unroll
      for (int pb = 0; pb < 2; ++pb) {
        const u16* xrow = xsT + (hd2 * 64 + pb * 32 + r) * 136 + sb * 32 + 4 * h;
        s16x4 lo0 = *(const s16x4*)(xrow), hi0 = *(const s16x4*)(xrow + 8);
        s16x4 lo1 = *(const s16x4*)(xrow + 16), hi1 = *(const s16x4*)(xrow + 24);
        bf16x8 a0 = __builtin_shufflevector(lo0, hi0, 0, 1, 2, 3, 4, 5, 6, 7);
        bf16x8 a1 = __builtin_shufflevector(lo1, hi1, 0, 1, 2, 3, 4, 5, 6, 7);
        y[pb] = MFMA(a0, wp0, y[pb]);
        y[pb] = MFMA(a1, wp1, y[pb]);
      }
    }
#pragma unroll 1
    for (int d = 0; d < 2; ++d) {
      const float el = __expf(d == 0 ? c0l : s1l);
#pragma unroll
      for (int pb = 0; pb < 2; ++pb) {
        const float* srow = p.CS + ((((size_t)bc * 2 + d) * 4 + hh) * 64 + pb * 32 + r) * 128 + h * 8;
        f32x16 tmp;
#pragma unroll
        for (int e = 0; e < 16; ++e) tmp[e] = 0.f;
#pragma unroll
        for (int kk = 0; kk < 8; ++kk) {
          f32x4 s0 = *(const f32x4*)(srow + kk * 16), s1 = *(const f32x4*)(srow + kk * 16 + 4);
          bf16x8 a = pack8(s0.x, s0.y, s0.z, s0.w, s1.x, s1.y, s1.z, s1.w);
          tmp = MFMA(a, cf[kk], tmp);
        }
#pragma unroll
        for (int e = 0; e < 16; ++e) y[pb][e] += el * tmp[e];
      }
    }
    const float dsk = p.ssd_d[layer * 8 + hh] + p.ssd_d[layer * 8 + 4 + hh];
#pragma unroll
    for (int pb = 0; pb < 2; ++pb) {
#pragma unroll
      for (int q4 = 0; q4 < 4; ++q4) {
        const int cl = hd2 * 64 + pb * 32 + 8 * q4 + 4 * h;
        const int ch0 = G * 128 + cl;
        u32x2 zw = *(const u32x2*)(p.P + (size_t)(row0 + l) * NINP + 960 + ch0);
        f32x4 o;
        o.x = (y[pb][4 * q4] + dsk * bf2f(xsT[(cl + 0) * 136 + l])) * silu_f(bflo(zw.x));
        o.y = (y[pb][4 * q4 + 1] + dsk * bf2f(xsT[(cl + 1) * 136 + l])) * silu_f(bfhi(zw.x));
        o.z = (y[pb][4 * q4 + 2] + dsk * bf2f(xsT[(cl + 2) * 136 + l])) * silu_f(bflo(zw.y));
        o.w = (y[pb][4 * q4 + 3] + dsk * bf2f(xsT[(cl + 3) * 136 + l])) * silu_f(bfhi(zw.y));
        ss += o.x * o.x + o.y * o.y + o.z * o.z + o.w * o.w;
        *(f32x4*)(p.ytmp + (size_t)(row0 + l) * 256 + ch0) = o;
      }
    }
  }
  return ss;
}

DI void ssd_s3_tasks(const Params& p, int layer, char* smem) {
  u16* Bg = (u16*)smem;
  u16* xsT = Bg + 128 * 136;
  float* arr = (float*)(xsT + 128 * 136);
  const int tid = ltid(), lane = tid & 63, wid = tid >> 6, r = lane & 31, h = lane >> 5;
  const int l = wid * 32 + r;
  for (int task = lbid(); task < NB * NCH; task += gridDim.x) {
    const int bc = task, c = bc % NCH;
    const int row0 = bc * 128;
    const bool cPrev = (c != 0 && c != 32), cNext = (c != 31 && c != 33);
    float ss = ssd_s3_group<0>(p, layer, bc, cPrev, cNext, Bg, xsT, arr);
    ss += ssd_s3_group<1>(p, layer, bc, cPrev, cNext, Bg, xsT, arr);
    ss += __shfl_xor(ss, 32);
    const float rstd = rsqrtf(ss * (1.f / 256.f) + EPS);
    const float* gn = p.ssd_norm_g + layer * 256;
#pragma unroll 4
    for (int i = 0; i < 32; ++i) {
      const int ch0 = (i >> 2) * 32 + 8 * (i & 3) + 4 * h;
      f32x4 v = *(const f32x4*)(p.ytmp + (size_t)(row0 + l) * 256 + ch0);
      f32x4 gv = *(const f32x4*)(gn + ch0);
      u32x2 w;
      w.x = pack2(v.x * rstd * gv.x, v.y * rstd * gv.y);
      w.y = pack2(v.z * rstd * gv.z, v.w * rstd * gv.w);
      *(u32x2*)(p.H + (size_t)(row0 + l) * D + 768 + ch0) = w;
    }
  }
}

DI void attn_tasks(const Params& p, char* smem) {
  u16* Ks = (u16*)smem;
  u16* Vs = Ks + 64 * 200;
  const int tid = ltid(), lane = tid & 63, wid = tid >> 6, r = lane & 31, h = lane >> 5;
  const float sc = 0.07216878364870322f * 1.4426950408889634f;
  for (int task = lbid(); task < NB * 4 * NCH; task += gridDim.x) {
    int b, hd, qt;
    if (task < 1024) {
      qt = task & 31; hd = (task >> 5) & 3; b = task >> 7;
    } else {
      const int t2 = task - 1024;
      qt = 32 + (t2 & 1); hd = (t2 >> 1) & 3; b = t2 >> 3;
    }
    const int koff = (qt < 32) ? 0 : SEQ;
    const int nkt = ((qt < 32) ? SP : CTX) / 64;
    const int qrow = b * SP + qt * 128 + wid * 32 + r;
    bf16x8 qf[12];
#pragma unroll
    for (int kk = 0; kk < 12; ++kk) qf[kk] = *(const bf16x8*)(p.Q + (size_t)qrow * 768 + hd * 192 + kk * 16 + h * 8);
    f32x16 o[4];
#pragma unroll
    for (int i = 0; i < 4; ++i)
#pragma unroll
      for (int e = 0; e < 16; ++e) o[i][e] = 0.f;
    float m_run = -1e30f, l_run = 0.f;
    u32x4 kn[4], kr[2], vv[4];
    const u16* knb = p.Kn + ((size_t)(b * SP + koff) + (tid >> 4)) * 512 + hd * 128 + (tid & 15) * 8;
    const u16* krb = p.Kr + ((size_t)(b * SP + koff) + (tid >> 3)) * 64 + (tid & 7) * 8;
    const u16* vb = p.Vt + ((size_t)(b * 4 + hd) * 128 + (tid >> 3)) * SP + koff + (tid & 7) * 8;
#pragma unroll
    for (int i = 0; i < 4; ++i) kn[i] = *(const u32x4*)(knb + (size_t)(16 * i) * 512);
#pragma unroll
    for (int i = 0; i < 2; ++i) kr[i] = *(const u32x4*)(krb + (size_t)(32 * i) * 64);
#pragma unroll
    for (int i = 0; i < 4; ++i) vv[i] = *(const u32x4*)(vb + (size_t)(32 * i) * SP);
    for (int kt = 0; kt < nkt; ++kt) {
      __syncthreads();
#pragma unroll
      for (int i = 0; i < 4; ++i) *(u32x4*)(Ks + ((tid >> 4) + 16 * i) * 200 + (tid & 15) * 8) = kn[i];
#pragma unroll
      for (int i = 0; i < 2; ++i) *(u32x4*)(Ks + ((tid >> 3) + 32 * i) * 200 + 128 + (tid & 7) * 8) = kr[i];
#pragma unroll
      for (int i = 0; i < 4; ++i) {
        u16* dst = Vs + ((tid >> 3) + 32 * i) * 68 + (tid & 7) * 8;
        *(u32x2*)dst = u32x2{vv[i].x, vv[i].y};
        *(u32x2*)(dst + 4) = u32x2{vv[i].z, vv[i].w};
      }
      __syncthreads();
      if (kt + 1 < nkt) {
        const size_t ko = (size_t)(kt + 1) * 64;
#pragma unroll
        for (int i = 0; i < 4; ++i) kn[i] = *(const u32x4*)(knb + (ko + 16 * i) * 512);
#pragma unroll
        for (int i = 0; i < 2; ++i) kr[i] = *(const u32x4*)(krb + (ko + 32 * i) * 64);
#pragma unroll
        for (int i = 0; i < 4; ++i) vv[i] = *(const u32x4*)(vb + (size_t)(32 * i) * SP + ko);
      }
      f32x16 st[2];
#pragma unroll
      for (int kb = 0; kb < 2; ++kb) {
#pragma unroll
        for (int e = 0; e < 16; ++e) st[kb][e] = 0.f;
#pragma unroll
        for (int kk = 0; kk < 12; ++kk) {
          bf16x8 a = *(const bf16x8*)(Ks + (kb * 32 + r) * 200 + kk * 16 + h * 8);
          st[kb] = MFMA(a, qf[kk], st[kb]);
        }
      }
      float mx = st[0][0];
#pragma unroll
      for (int kb = 0; kb < 2; ++kb)
#pragma unroll
        for (int e = 0; e < 16; ++e) mx = fmaxf(mx, st[kb][e]);
      mx = fmaxf(mx, __shfl_xor(mx, 32));
      const float m_new = fmaxf(m_run, mx * sc);
      const float alpha = __builtin_amdgcn_exp2f(m_run - m_new);
      m_run = m_new;
      float ls = 0.f;
#pragma unroll
      for (int kb = 0; kb < 2; ++kb)
#pragma unroll
        for (int e = 0; e < 16; ++e) {
          float pv = __builtin_amdgcn_exp2f(fmaf(st[kb][e], sc, -m_new));
          ls += pv;
          st[kb][e] = pv;
        }
      l_run = l_run * alpha + ls;
#pragma unroll
      for (int i = 0; i < 4; ++i)
#pragma unroll
        for (int e = 0; e < 16; ++e) o[i][e] *= alpha;
#pragma unroll
      for (int ks = 0; ks < 4; ++ks) {
        const int kb = ks >> 1, s2 = ks & 1;
        bf16x8 pf = pack8(st[kb][8 * s2], st[kb][8 * s2 + 1], st[kb][8 * s2 + 2], st[kb][8 * s2 + 3], st[kb][8 * s2 + 4],
                          st[kb][8 * s2 + 5], st[kb][8 * s2 + 6], st[kb][8 * s2 + 7]);
#pragma unroll
        for (int db = 0; db < 4; ++db) {
          const u16* vr = Vs + (db * 32 + r) * 68 + ks * 16 + 4 * h;
          s16x4 lo = *(const s16x4*)vr, hi = *(const s16x4*)(vr + 8);
          bf16x8 a = __builtin_shufflevector(lo, hi, 0, 1, 2, 3, 4, 5, 6, 7);
          o[db] = MFMA(a, pf, o[db]);
        }
      }
    }
    const float ltot = l_run + __shfl_xor(l_run, 32);
    const float inv = 1.f / ltot;
    u16* orow = p.H + (size_t)qrow * D + hd * 128;
#pragma unroll
    for (int db = 0; db < 4; ++db)
#pragma unroll
      for (int q4 = 0; q4 < 4; ++q4) {
        u32x2 w;
        w.x = pack2(o[db][4 * q4] * inv, o[db][4 * q4 + 1] * inv);
        w.y = pack2(o[db][4 * q4 + 2] * inv, o[db][4 * q4 + 3] * inv);
        *(u32x2*)(orow + db * 32 + 8 * q4 + 4 * h) = w;
      }
  }
}

constexpr int NPHASE = 1 + DEPTH * 9 + 1;

DI void run_phase(const Params& p, int ph, char* smem) {
  if (ph == 0) { prologue_phase(p, smem); return; }
  if (ph == NPHASE - 1) { ew_phase(p, DEPTH, 2); return; }
  const int layer = (ph - 1) / 9, sub = (ph - 1) % 9;
  const int MT = T / 128;
  switch (sub) {
    case 0: {
      ew_phase(p, layer, 0);
      convert_weights(p.w_in + (size_t)layer * D * NIN, D, NIN, NINP, p.wt_in, nullptr, smem);
      convert_weights(p.w_uq + (size_t)layer * 256 * 768, 256, 768, 768, p.wt_uq, p.g_q + layer * 256, smem);
      convert_weights(p.w_ukv + (size_t)layer * 128 * 1024, 128, 1024, 1024, p.wt_ukv, p.g_kv + layer * 128, smem);
      convert_weights(p.w_out + (size_t)layer * D * D, D, D, D, p.wt_out, nullptr, smem);
      for (int i = lbid() * NTHR + ltid(); i < 4 * 128 * 128; i += gridDim.x * NTHR)
        p.wsb[i] = f2bf(p.cm_w_s[(size_t)layer * 65536 + i]);
    } break;
    case 1: {
      for (int t = lbid(); t < MT * 16; t += gridDim.x) {
        const int tm = t >> 4, tn = t & 15;
        gemm_tile(p.H, D, p.wt_in, D, D, tm * 128, tn * 128, smem,
                  [&](int mb, int nb, const f32x16& acc, int r, int h) {
                    const int col = nb + r;
#pragma unroll
                    for (int e = 0; e < 16; ++e) {
                      const int row = mb + crow(e, h);
                      p.P[(size_t)row * NINP + col] = f2bf(acc[e]);
                      if (col >= 1984 && col < 1992) p.dtraw[(size_t)row * 8 + col - 1984] = acc[e];
                    }
                  });
      }
    } break;
    case 2: {
      qkv_tasks(p, smem);
      cm_tasks(p, layer, smem);
      ssd_s1_tasks(p, layer, smem);
    } break;
    case 3: ssd_scan_phase(p); break;
    case 4: {
      attn_tasks(p, smem);
      ssd_s3_tasks(p, layer, smem);
    } break;
    case 5: {
      for (int t = lbid(); t < MT * 8; t += gridDim.x) {
        const int tm = t >> 3, tn = t & 7;
        gemm_tile(p.H, D, p.wt_out, D, D, tm * 128, tn * 128, smem,
                  [&](int mb, int nb, const f32x16& acc, int r, int h) {
#pragma unroll
                    for (int e = 0; e < 16; ++e) p.Y[(size_t)(mb + crow(e, h)) * D + nb + r] = acc[e];
                  });
      }
    } break;
    case 6: {
      ew_phase(p, layer, 1);
      convert_weights(p.w_ff1 + (size_t)layer * D * DFF, D, DFF, DFF, p.wt_ff1, nullptr, smem);
      convert_weights(p.w_ff2 + (size_t)layer * DFF * D, DFF, D, D, p.wt_ff2, nullptr, smem);
    } break;
    case 7: {
      for (int t = lbid(); t < MT * 32; t += gridDim.x) {
        const int tm = t >> 5, tn = t & 31;
        gemm_tile(p.H, D, p.wt_ff1, D, D, tm * 128, tn * 128, smem,
                  [&](int mb, int nb, const f32x16& acc, int r, int h) {
#pragma unroll
                    for (int e = 0; e < 16; ++e) {
                      float v = fmaxf(acc[e], 0.f);
                      p.Hd[(size_t)(mb + crow(e, h)) * DFF + nb + r] = f2bf(v * v);
                    }
                  });
      }
    } break;
    case 8: {
      for (int t = lbid(); t < MT * 8; t += gridDim.x) {
        const int tm = t >> 3, tn = t & 7;
        gemm_tile(p.Hd, DFF, p.wt_ff2, DFF, DFF, tm * 128, tn * 128, smem,
                  [&](int mb, int nb, const f32x16& acc, int r, int h) {
#pragma unroll
                    for (int e = 0; e < 16; ++e) p.F[(size_t)(mb + crow(e, h)) * D + nb + r] = f2bf(acc[e]);
                  });
      }
    } break;
  }
}

__global__ void __launch_bounds__(NTHR, 2) mega_kernel(Params p, int ph_begin, int ph_end) {
  extern __shared__ __attribute__((aligned(16))) char smem[];
  cg::grid_group grid = cg::this_grid();
  for (int ph = ph_begin; ph < ph_end; ++ph) {
    run_phase(p, ph, smem);
    if (ph + 1 < ph_end) grid.sync();
  }
}

extern "C" void kernel_launch(void* const* d_in, const int* in_sizes, int n_in, void* d_out, int out_size, void* d_ws,
                              size_t ws_size, hipStream_t stream) {
  Params p{};
  const float* const* in = (const float* const*)d_in;
  p.x = in[0]; p.c = in[1]; p.ctx = in[2]; p.c_ctx = in[3]; p.w_ada = in[4]; p.b_ada = in[5];
  p.g_pre_mix = in[6]; p.g_post_mix = in[7]; p.g_pre_ff = in[8]; p.g_post_ff = in[9]; p.w_in = in[10];
  p.g_q = in[11]; p.w_uq = in[12]; p.g_kv = in[13]; p.w_ukv = in[14]; p.cm_norm_g = in[15]; p.cm_w_s = in[16];
  p.cm_b_s = in[17]; p.conv_w = in[18]; p.conv_b = in[19]; p.dt_bias = in[20]; p.a_log = in[21]; p.ssd_d = in[22];
  p.ssd_norm_g = in[23]; p.w_out = in[24]; p.w_ff1 = in[25]; p.w_ff2 = in[26];
  p.out = (float*)d_out;
  char* ws = (char*)d_ws;
  size_t off = 0;
  auto take = [&](size_t bytes) { char* q = ws + off; off += (bytes + 255) & ~(size_t)255; return q; };
  p.wt_in = (u16*)take((size_t)NINP * D * 2);
  p.wt_uq = (u16*)take((size_t)768 * 256 * 2);
  p.wt_ukv = (u16*)take((size_t)1024 * 128 * 2);
  p.wt_out = (u16*)take((size_t)D * D * 2);
  p.wt_ff1 = (u16*)take((size_t)DFF * D * 2);
  p.wt_ff2 = (u16*)take((size_t)D * DFF * 2);
  p.wsb = (u16*)take((size_t)4 * 128 * 128 * 2);
  p.mod = (float*)take((size_t)DEPTH * 9 * 6144 * 4);
  p.ropetab = (float*)take((size_t)64 * 16 * 2 * 4);
  p.atot = (float*)take((size_t)NB * NCH * 2 * 4 * 4);
  p.xctx = (float*)take((size_t)NB * CTX * D * 4);
  char* r1 = take((size_t)T * DFF * 2);
  p.Hd = (u16*)r1;
  p.Y = (float*)r1;
  {
    size_t o2 = 0;
    p.P = (u16*)(r1 + o2); o2 += (size_t)T * NINP * 2;
    p.Q = (u16*)(r1 + o2); o2 += (size_t)T * 768 * 2;
    p.Kn = (u16*)(r1 + o2); o2 += (size_t)T * 512 * 2;
    p.Kr = (u16*)(r1 + o2); o2 += (size_t)T * 64 * 2;
    p.Vt = (u16*)(r1 + o2); o2 += (size_t)NB * 4 * 128 * SP * 2;
    p.dtraw = (float*)(r1 + o2); o2 += (size_t)T * 8 * 4;
  }
  p.H = (u16*)take((size_t)T * D * 2);
  p.CS = (float*)take((size_t)NB * NCH * 2 * 4 * 8192 * 4);
  p.F = (u16*)p.CS;
  p.ytmp = (float*)take((size_t)T * 256 * 4);
  if (off > ws_size) {
    fprintf(stderr, "workspace too small: need %zu have %zu\n", off, ws_size);
    return;
  }
  static int grid_blocks = 0;
  if (!grid_blocks) {
    int dev = 0, cus = 0, per_cu = 0;
    hipGetDevice(&dev);
    hipDeviceGetAttribute(&cus, hipDeviceAttributeMultiprocessorCount, dev);
    hipFuncSetAttribute((const void*)mega_kernel, hipFuncAttributeMaxDynamicSharedMemorySize, SMEM_BYTES);
    hipOccupancyMaxActiveBlocksPerMultiprocessor(&per_cu, mega_kernel, NTHR, SMEM_BYTES);
    if (per_cu < 1) per_cu = 1;
    if (per_cu > 2) per_cu = 2;
    grid_blocks = cus * per_cu;
  }
  int pb = 0, pe = NPHASE;
  void* args[] = {&p, &pb, &pe};
  hipError_t e = hipLaunchCooperativeKernel((void*)mega_kernel, dim3(grid_blocks), dim3(NTHR), args, SMEM_BYTES, stream);
  if (e != hipSuccess) fprintf(stderr, "cooperative launch failed: %s (grid %d)\n", hipGetErrorString(e), grid_blocks);
}
```

```cpp
#include <hip/hip_runtime.h>
#include <hip/hip_cooperative_groups.h>
#include <cstdio>
namespace cg = cooperative_groups;

#define DI __device__ __forceinline__
typedef unsigned short u16;
using bf16x8 = __attribute__((ext_vector_type(8))) short;
using s16x4 = __attribute__((ext_vector_type(4))) short;
using f32x16 = __attribute__((ext_vector_type(16))) float;
using u32x4 = __attribute__((ext_vector_type(4))) unsigned;
using u32x2 = __attribute__((ext_vector_type(2))) unsigned;
using f32x4 = __attribute__((ext_vector_type(4))) float;
typedef __bf16 bf2_t __attribute__((ext_vector_type(2)));
typedef float f2_t __attribute__((ext_vector_type(2)));
#define MFMA(a, b, c) __builtin_amdgcn_mfma_f32_32x32x16_bf16((a), (b), (c), 0, 0, 0)

constexpr int NB = 8, SEQ = 4096, CTX = 256, SP = 4352, T = NB * SP, D = 1024, DFF = 4096;
constexpr int NIN = 1992, NINP = 2048, NCH = 34, DEPTH = 4;
constexpr int NTHR = 512;
constexpr int VT = 256;
constexpr int VSMEM = 75 * 1024;
constexpr int SMEM_BYTES = 2 * VSMEM;
constexpr float EPS = 1e-6f;

struct Params {
  const float *x, *c, *ctx, *c_ctx, *w_ada, *b_ada, *g_pre_mix, *g_post_mix, *g_pre_ff, *g_post_ff, *w_in, *g_q, *w_uq,
      *g_kv, *w_ukv, *cm_norm_g, *cm_w_s, *cm_b_s, *conv_w, *conv_b, *dt_bias, *a_log, *ssd_d, *ssd_norm_g, *w_out,
      *w_ff1, *w_ff2;
  float* out;
  u16 *wt_in, *wt_uq, *wt_ukv, *wt_out, *wt_ff1, *wt_ff2, *wsb;
  float *mod, *ropetab, *atot, *xctx;
  u16 *P, *Q, *Kn, *Kr, *Vt, *Hd;
  float *Y, *dtraw;
  u16* H;
  float* CS;
  u16* F;
  float* ytmp;
};

DI int ltid() { int t = threadIdx.x; asm volatile("" : "+v"(t)); return t; }
DI int lbid() { int t = blockIdx.x; asm volatile("" : "+s"(t)); return t; }
DI int crow(int e, int h) { return (e & 3) + 8 * (e >> 2) + 4 * h; }
DI unsigned pack2(float a, float b) {
  f2_t v = {a, b};
  bf2_t r = __builtin_convertvector(v, bf2_t);
  return __builtin_bit_cast(unsigned, r);
}
DI u16 f2bf(float a) { return (u16)(pack2(a, 0.f) & 0xffffu); }
DI float bf2f(u16 v) { return __uint_as_float(((unsigned)v) << 16); }
DI float bflo(unsigned w) { return __uint_as_float(w << 16); }
DI float bfhi(unsigned w) { return __uint_as_float(w & 0xffff0000u); }
DI bf16x8 pack8(float a0, float a1, float a2, float a3, float a4, float a5, float a6, float a7) {
  u32x4 u;
  u.x = pack2(a0, a1); u.y = pack2(a2, a3); u.z = pack2(a4, a5); u.w = pack2(a6, a7);
  return __builtin_bit_cast(bf16x8, u);
}
DI float wave_sum(float v) {
#pragma unroll
  for (int o = 32; o > 0; o >>= 1) v += __shfl_xor(v, o);
  return v;
}
DI float silu_f(float y) { return y / (1.f + __expf(-y)); }
DI float gelu_f(float x) {
  float u = 0.7978845608028654f * (x + 0.044715f * x * x * x);
  float t = 1.f - 2.f / (1.f + __expf(2.f * u));
  return 0.5f * x * (1.f + t);
}
DI float softplus_f(float x) { return x > 20.f ? x : log1pf(__expf(x)); }
DI float uw(const u32x4& v, int i) {
  unsigned w = (i >> 1) == 0 ? v.x : (i >> 1) == 1 ? v.y : (i >> 1) == 2 ? v.z : v.w;
  return (i & 1) ? bfhi(w) : bflo(w);
}

template <class Epi>
DI void gemm_tile(const u16* __restrict__ A, int lda, const u16* __restrict__ Bt, int ldb, int K, int m0, int n0,
                  char* smem, Epi epi) {
  constexpr int LS = 72;
  constexpr int STAGE = 2 * 256 * LS;
  u16* base = (u16*)smem;
  const int tid = ltid(), lane = tid & 63, wid = tid >> 6, wm = wid >> 2, wn = wid & 3, r = lane & 31, h = lane >> 5;
  f32x16 acc[4][2];
#pragma unroll
  for (int i = 0; i < 4; ++i)
#pragma unroll
    for (int j = 0; j < 2; ++j)
#pragma unroll
      for (int e = 0; e < 16; ++e) acc[i][j][e] = 0.f;
  u32x4 ra[4], rb[4];
  const int lrow = tid >> 3, lcp = (tid & 7) * 8;
  const u16* ga = A + (size_t)(m0 + lrow) * lda + lcp;
  const u16* gb = Bt + (size_t)(n0 + lrow) * ldb + lcp;
#pragma unroll
  for (int i = 0; i < 4; ++i) {
    ra[i] = *(const u32x4*)(ga + (size_t)(64 * i) * lda);
    rb[i] = *(const u32x4*)(gb + (size_t)(64 * i) * ldb);
  }
  __syncthreads();
#pragma unroll
  for (int i = 0; i < 4; ++i) {
    *(u32x4*)(base + (lrow + 64 * i) * LS + lcp) = ra[i];
    *(u32x4*)(base + 256 * LS + (lrow + 64 * i) * LS + lcp) = rb[i];
  }
  __syncthreads();
  const int nk = K >> 6;
  for (int kt = 0; kt < nk; ++kt) {
    const u16* sA = base + (kt & 1) * STAGE;
    const u16* sB = sA + 256 * LS;
    if (kt + 1 < nk) {
#pragma unroll
      for (int i = 0; i < 4; ++i) {
        ra[i] = *(const u32x4*)(ga + (size_t)(64 * i) * lda + (kt + 1) * 64);
        rb[i] = *(const u32x4*)(gb + (size_t)(64 * i) * ldb + (kt + 1) * 64);
      }
    }
#pragma unroll
    for (int kk = 0; kk < 4; ++kk) {
      bf16x8 af[4], bfr[2];
#pragma unroll
      for (int i = 0; i < 4; ++i) af[i] = *(const bf16x8*)(sA + (wm * 128 + i * 32 + r) * LS + kk * 16 + h * 8);
#pragma unroll
      for (int j = 0; j < 2; ++j) bfr[j] = *(const bf16x8*)(sB + (wn * 64 + j * 32 + r) * LS + kk * 16 + h * 8);
#pragma unroll
      for (int i = 0; i < 4; ++i)
#pragma unroll
        for (int j = 0; j < 2; ++j) acc[i][j] = MFMA(af[i], bfr[j], acc[i][j]);
    }
    if (kt + 1 < nk) {
      u16* dA = base + ((kt + 1) & 1) * STAGE;
#pragma unroll
      for (int i = 0; i < 4; ++i) {
        *(u32x4*)(dA + (lrow + 64 * i) * LS + lcp) = ra[i];
        *(u32x4*)(dA + 256 * LS + (lrow + 64 * i) * LS + lcp) = rb[i];
      }
    }
    __syncthreads();
  }
#pragma unroll
  for (int i = 0; i < 4; ++i)
#pragma unroll
    for (int j = 0; j < 2; ++j) epi(m0 + wm * 128 + i * 32, n0 + wn * 64 + j * 32, acc[i][j], r, h);
}

DI int xcd_tile(int it, int ntiles) {
  const int b = lbid(), g = gridDim.x;
  const int local = (b >> 3) + it * (g >> 3);
  const int per = ntiles >> 3;
  return local < per ? (b & 7) * per + local : -1;
}

DI void conv_tile(const float* __restrict__ src, int K, int N, u16* __restrict__ dst, const float* __restrict__ scale,
                  int tk, int tn, char* smem) {
  float* tile = (float*)smem;
  const int tid = ltid(), tx = tid & 63, ty = tid >> 6;
  const int k0 = tk * 64, n0 = tn * 64;
  __syncthreads();
#pragma unroll 4
  for (int i = 0; i < 8; ++i) {
    int kr = ty + 8 * i;
    float v = 0.f;
    if (n0 + tx < N) v = src[(size_t)(k0 + kr) * N + n0 + tx];
    if (scale) v *= scale[k0 + kr];
    tile[kr * 65 + tx] = v;
  }
  __syncthreads();
#pragma unroll 4
  for (int i = 0; i < 8; ++i) {
    int nr = ty + 8 * i;
    dst[(size_t)(n0 + nr) * K + k0 + tx] = f2bf(tile[tx * 65 + nr]);
  }
}

DI void convert_weights(const float* src, int K, int N, int Npad, u16* dst, const float* scale, char* smem) {
  const int tks = K / 64, tns = Npad / 64;
  for (int t = lbid(); t < tks * tns; t += gridDim.x) conv_tile(src, K, N, dst, scale, t / tns, t % tns, smem);
}

DI void prologue_phase(const Params& p, char* smem) {
  float* sc = (float*)smem;
  float* red = sc + 9 * 1024;
  const int tid = ltid();
  for (int i = tid; i < 9 * 1024; i += NTHR) {
    int j = i >> 10, k = i & 1023;
    float v = j < 8 ? p.c[j * 1024 + k] : p.c_ctx[k];
    sc[i] = v / (1.f + __expf(-v));
  }
  __syncthreads();
  for (int task = lbid(); task < DEPTH * 96; task += gridDim.x) {
    const int l = task / 96, n0 = (task % 96) * 64, nn = tid & 63, kq = tid >> 6;
    float acc[9];
#pragma unroll
    for (int j = 0; j < 9; ++j) acc[j] = 0.f;
    const float* w = p.w_ada + ((size_t)l * 1024 + kq * 128) * 6144 + n0 + nn;
    const float* scq = sc + kq * 128;
#pragma unroll 4
    for (int k = 0; k < 128; ++k) {
      float wv = w[(size_t)k * 6144];
#pragma unroll
      for (int j = 0; j < 9; ++j) acc[j] += scq[j * 1024 + k] * wv;
    }
#pragma unroll
    for (int j = 0; j < 9; ++j) red[(kq * 9 + j) * 64 + nn] = acc[j];
    __syncthreads();
    for (int idx = tid; idx < 576; idx += NTHR) {
      int j = idx >> 6, n2 = idx & 63;
      float s = p.b_ada[l * 6144 + n0 + n2];
#pragma unroll
      for (int q = 0; q < 8; ++q) s += red[(q * 9 + j) * 64 + n2];
      p.mod[(size_t)(l * 9 + j) * 6144 + n0 + n2] = s;
    }
    __syncthreads();
  }
  if (lbid() == gridDim.x - 1) {
    for (int i = tid; i < 64 * 16; i += NTHR) {
      int pos = i >> 4, j = i & 15;
      float inv_freq = exp2f(-(float)(2 * j) / 32.f * 13.287712379549449f);
      float ang = (float)pos * inv_freq;
      float k = rintf(ang * 0.15915494309189535f);
      float red2 = fmaf(-k, 6.2831854820251465f, ang);
      red2 = fmaf(-k, -1.7484555314695172e-07f, red2);
      p.ropetab[2 * i] = __cosf(red2);
      p.ropetab[2 * i + 1] = __sinf(red2);
    }
  }
}

DI void ew_phase(const Params& p, int layer, int kind) {
  const int tid = ltid(), lane = tid & 63, wid = __builtin_amdgcn_readfirstlane(tid >> 6);
  const bool has_branch = !(kind == 0 && layer == 0);
  const bool src_in = (layer == 0 && kind <= 1);
  const bool store_x = has_branch;
  const int blayer = (kind == 1) ? layer : (kind == 0 ? layer - 1 : DEPTH - 1);
  const float* gpost = (kind == 1) ? p.g_post_mix + blayer * D : p.g_post_ff + (blayer < 0 ? 0 : blayer) * D;
  const int gate_off = (kind == 1) ? 2 * D : 5 * D;
  const float* gpre = (kind == 0) ? p.g_pre_mix + layer * D : p.g_pre_ff + (kind == 1 ? layer : 0) * D;
  const int shift_off = (kind == 0) ? 0 : 3 * D, scale_off = (kind == 0) ? D : 4 * D;
  const float* xl = src_in ? p.x : p.out;
  const float* xc = src_in ? p.ctx : p.xctx;
  for (int rg = lbid(); rg < T / 8; rg += gridDim.x) {
    const int row = rg * 8 + wid;
    const int b = row / SP, s = row - b * SP;
    const bool lat = s < SEQ;
    if (kind == 2 && !lat) continue;
    const size_t xoff = lat ? ((size_t)(b * SEQ + s) * D) : ((size_t)(b * CTX + s - SEQ) * D);
    const unsigned long long msk = lat ? ~0ull : 0ull;
    const float* xs = (const float*)(((unsigned long long)xl & msk) | ((unsigned long long)xc & ~msk)) + xoff;
    float* xd = (float*)(((unsigned long long)p.out & msk) | ((unsigned long long)p.xctx & ~msk)) + xoff;
    const int mi = lat ? b : 8;
    f32x4 xv[4];
#pragma unroll
    for (int i = 0; i < 4; ++i) xv[i] = *(const f32x4*)(xs + lane * 4 + 256 * i);
    if (has_branch) {
      const float* modb = p.mod + (size_t)(blayer * 9 + mi) * 6144 + gate_off;
      f32x4 yv[4];
      if (kind == 1) {
#pragma unroll
        for (int i = 0; i < 4; ++i) yv[i] = *(const f32x4*)(p.Y + (size_t)row * D + lane * 4 + 256 * i);
      } else {
#pragma unroll
        for (int i = 0; i < 4; ++i) {
          u32x2 w = *(const u32x2*)(p.F + (size_t)row * D + lane * 4 + 256 * i);
          yv[i] = f32x4{bflo(w.x), bfhi(w.x), bflo(w.y), bfhi(w.y)};
        }
      }
      float ss = 0.f;
#pragma unroll
      for (int i = 0; i < 4; ++i) ss += yv[i].x * yv[i].x + yv[i].y * yv[i].y + yv[i].z * yv[i].z + yv[i].w * yv[i].w;
      ss = wave_sum(ss);
      const float rstd = rsqrtf(ss * (1.f / D) + EPS);
#pragma unroll
      for (int i = 0; i < 4; ++i) {
        const int col = lane * 4 + 256 * i;
        f32x4 g = *(const f32x4*)(gpost + col);
        f32x4 gt = *(const f32x4*)(modb + col);
        xv[i].x += gt.x * (yv[i].x * rstd * g.x);
        xv[i].y += gt.y * (yv[i].y * rstd * g.y);
        xv[i].z += gt.z * (yv[i].z * rstd * g.z);
        xv[i].w += gt.w * (yv[i].w * rstd * g.w);
      }
      if (store_x) {
#pragma unroll
        for (int i = 0; i < 4; ++i) *(f32x4*)(xd + lane * 4 + 256 * i) = xv[i];
      }
    }
    if (kind != 2) {
      const float* modl = p.mod + (size_t)(layer * 9 + mi) * 6144;
      float ss = 0.f;
#pragma unroll
      for (int i = 0; i < 4; ++i) ss += xv[i].x * xv[i].x + xv[i].y * xv[i].y + xv[i].z * xv[i].z + xv[i].w * xv[i].w;
      ss = wave_sum(ss);
      const float rstd = rsqrtf(ss * (1.f / D) + EPS);
#pragma unroll
      for (int i = 0; i < 4; ++i) {
        const int col = lane * 4 + 256 * i;
        f32x4 g = *(const f32x4*)(gpre + col);
        f32x4 sh = *(const f32x4*)(modl + shift_off + col);
        f32x4 sc = *(const f32x4*)(modl + scale_off + col);
        float h0 = xv[i].x * rstd * g.x * (1.f + sc.x) + sh.x;
        float h1 = xv[i].y * rstd * g.y * (1.f + sc.y) + sh.y;
        float h2 = xv[i].z * rstd * g.z * (1.f + sc.z) + sh.z;
        float h3 = xv[i].w * rstd * g.w * (1.f + sc.w) + sh.w;
        u32x2 w;
        w.x = pack2(h0, h1);
        w.y = pack2(h2, h3);
        *(u32x2*)(p.H + (size_t)row * D + col) = w;
      }
    }
  }
}

DI void row_rstd(const u16* __restrict__ base, int ld, int ncols, int m0, float* rs) {
  const int tid = ltid(), row = tid >> 1, half = tid & 1;
  const int per = ncols / 2;
  const u16* ptr = base + (size_t)(m0 + row) * ld + half * per;
  float ss = 0.f;
  for (int i = 0; i < per; i += 8) {
    u32x4 v = *(const u32x4*)(ptr + i);
#pragma unroll
    for (int e = 0; e < 8; ++e) {
      float f = uw(v, e);
      ss += f * f;
    }
  }
  ss += __shfl_xor(ss, 1);
  if (half == 0) rs[row] = rsqrtf(ss / (float)ncols + EPS);
}

DI void qkv_tasks(const Params& p, char* smem) {
  float* rs = (float*)(smem + 2 * 2 * 256 * 72 * 2);
  const int MT = T / 256;
  for (int t = lbid(); t < MT * 3; t += gridDim.x) {
    const int tm = t / 3, tn = t % 3, m0 = tm * 256;
    __syncthreads();
    row_rstd(p.P, NINP, 256, m0, rs);
    const bool lat = (m0 % SP) < SEQ;
    const int s0 = m0 % SP;
    gemm_tile(p.P, NINP, p.wt_uq, 256, 256, m0, tn * 256, smem,
              [&](int mb, int nb, const f32x16& acc, int r, int h) {
                const int col = nb + r;
                const int cc = col % 192;
                const bool rope = lat && (cc >= 128);
                const int axis = (cc - 128) >> 5;
                const int j = r & 15;
#pragma unroll
                for (int e = 0; e < 16; ++e) {
                  const int rowl = mb - m0 + crow(e, h);
                  float v = acc[e] * rs[rowl];
                  float pr = __shfl_xor(v, 16);
                  if (rope) {
                    const int s = s0 + rowl;
                    const int pos = axis == 0 ? (s >> 6) : (s & 63);
                    const float cs = p.ropetab[2 * (pos * 16 + j)], sn = p.ropetab[2 * (pos * 16 + j) + 1];
                    v = (r & 16) ? (pr * sn + v * cs) : (v * cs - pr * sn);
                  }
                  p.Q[(size_t)(m0 + rowl) * 768 + col] = f2bf(v);
                }
              });
  }
  for (int t = lbid(); t < MT * 4; t += gridDim.x) {
    const int tm = t / 4, tn = t % 4, m0 = tm * 256;
    const int b = m0 / SP, s0 = m0 % SP;
    const bool lat = s0 < SEQ;
    __syncthreads();
    row_rstd(p.P + 256, NINP, 128, m0, rs);
    if (tn == 0) {
      for (int idx = ltid(); idx < 256 * 32; idx += NTHR) {
        const int rowl = idx >> 5, q = idx & 31, blk = q >> 4, j = q & 15;
        const u16* src = p.P + (size_t)(m0 + rowl) * NINP + 384 + blk * 32 + j;
        float x1 = bf2f(src[0]), x2 = bf2f(src[16]);
        float o1 = x1, o2 = x2;
        if (lat) {
          const int s = s0 + rowl;
          const int pos = blk == 0 ? (s >> 6) : (s & 63);
          const float cs = p.ropetab[2 * (pos * 16 + j)], sn = p.ropetab[2 * (pos * 16 + j) + 1];
          o1 = x1 * cs - x2 * sn;
          o2 = x1 * sn + x2 * cs;
        }
        u16* dst = p.Kr + (size_t)(m0 + rowl) * 64 + blk * 32 + j;
        dst[0] = f2bf(o1);
        dst[16] = f2bf(o2);
      }
    }
    gemm_tile(p.P + 256, NINP, p.wt_ukv, 128, 128, m0, tn * 256, smem,
              [&](int mb, int nb, const f32x16& acc, int r, int h) {
                const int col = nb + r;
                const int hd = col >> 8, cc = col & 255;
                if (cc < 128) {
#pragma unroll
                  for (int e = 0; e < 16; ++e) {
                    const int rowl = mb - m0 + crow(e, h);
                    p.Kn[(size_t)(m0 + rowl) * 512 + hd * 128 + cc] = f2bf(acc[e] * rs[rowl]);
                  }
                } else {
                  u16* vrow = p.Vt + ((size_t)(b * 4 + hd) * 128 + (cc - 128)) * SP + s0;
#pragma unroll
                  for (int q4 = 0; q4 < 4; ++q4) {
                    const int rowl = mb - m0 + 8 * q4 + 4 * h;
                    u32x2 w;
                    w.x = pack2(acc[4 * q4] * rs[rowl], acc[4 * q4 + 1] * rs[rowl + 1]);
                    w.y = pack2(acc[4 * q4 + 2] * rs[rowl + 2], acc[4 * q4 + 3] * rs[rowl + 3]);
                    *(u32x2*)(vrow + rowl) = w;
                  }
                }
              });
  }
}

DI void cm_tasks(const Params& p, int layer, char* smem) {
  const int ftid = ltid(), vb = ftid >> 8, tid = ftid & 255;
  u16* vnT = (u16*)(smem + vb * VSMEM);
  const int lane = tid & 63, wid = tid >> 6, r = lane & 31, h = lane >> 5;
  const float* gn = p.cm_norm_g + layer * 256;
  const float* bs = p.cm_b_s + layer * 512;
  for (int t0 = lbid() * 2; t0 < NB * NCH; t0 += gridDim.x * 2) {
    const int task = t0 + vb;
    const int row0 = task * 128;
    __syncthreads();
    for (int i = 0; i < 32; ++i) {
      const int s = wid * 32 + i;
      const u16* src = p.P + (size_t)(row0 + s) * NINP + 704;
      float v[4];
      float sum = 0.f;
#pragma unroll
      for (int q = 0; q < 4; ++q) {
        v[q] = gelu_f(bf2f(src[lane + 64 * q]));
        sum += v[q];
      }
      const float mean = wave_sum(sum) * (1.f / 256.f);
      float var = 0.f;
#pragma unroll
      for (int q = 0; q < 4; ++q) {
        v[q] -= mean;
        var += v[q] * v[q];
      }
      const float rstd = rsqrtf(wave_sum(var) * (1.f / 256.f) + EPS);
#pragma unroll
      for (int q = 0; q < 4; ++q) vnT[(lane + 64 * q) * 136 + s] = f2bf(v[q] * rstd * gn[lane + 64 * q]);
    }
    __syncthreads();
    const int t = wid * 32 + r;
    for (int g = 0; g < 4; ++g) {
      bf16x8 wf[8];
#pragma unroll
      for (int kk = 0; kk < 8; ++kk) wf[kk] = *(const bf16x8*)(p.wsb + ((size_t)(g * 128 + t)) * 128 + kk * 16 + h * 8);
      const float bias = bs[g * 128 + t];
#pragma unroll
      for (int cb = 0; cb < 2; ++cb) {
        f32x16 acc;
#pragma unroll
        for (int e = 0; e < 16; ++e) acc[e] = 0.f;
#pragma unroll
        for (int kk = 0; kk < 8; ++kk) {
          bf16x8 a = *(const bf16x8*)(vnT + (g * 64 + cb * 32 + r) * 136 + kk * 16 + h * 8);
          acc = MFMA(a, wf[kk], acc);
        }
#pragma unroll
        for (int q4 = 0; q4 < 4; ++q4) {
          const int ch0 = g * 64 + cb * 32 + 8 * q4 + 4 * h;
          u32x2 uwd = *(const u32x2*)(p.P + (size_t)(row0 + t) * NINP + 448 + ch0);
          float u0 = gelu_f(bflo(uwd.x)), u1 = gelu_f(bfhi(uwd.x)), u2 = gelu_f(bflo(uwd.y)), u3 = gelu_f(bfhi(uwd.y));
          u32x2 w;
          w.x = pack2(u0 * (acc[4 * q4] + bias), u1 * (acc[4 * q4 + 1] + bias));
          w.y = pack2(u2 * (acc[4 * q4 + 2] + bias), u3 * (acc[4 * q4 + 3] + bias));
          *(u32x2*)(p.H + (size_t)(row0 + t) * D + 512 + ch0) = w;
        }
      }
    }
  }
}

DI void conv8(const Params& p, int layer, int row, int ch, bool hasPrev, bool hasNext, float out[8]) {
  const u16* base = p.P + (size_t)row * NINP + 1216 + ch;
  u32x4 cur = *(const u32x4*)base;
  u32x4 prv = u32x4{0u, 0u, 0u, 0u}, nxt = u32x4{0u, 0u, 0u, 0u};
  if (hasPrev) prv = *(const u32x4*)(base - NINP);
  if (hasNext) nxt = *(const u32x4*)(base + NINP);
  const float* cw = p.conv_w + (size_t)layer * 3 * 768 + ch;
  const float* cb = p.conv_b + layer * 768 + ch;
#pragma unroll
  for (int e = 0; e < 8; ++e) {
    float y = cw[e] * uw(prv, e) + cw[768 + e] * uw(cur, e) + cw[1536 + e] * uw(nxt, e) + cb[e];
    out[e] = silu_f(y);
  }
}

DI void ssd_dt_arrays(const Params& p, int layer, int row0, int hh, int t, float* arr) {
  float* dt0 = arr;
  float* dt1 = arr + 128;
  float* c0 = arr + 256;
  float* s1 = arr + 384;
  float* a0 = arr + 512;
  float* a1 = arr + 640;
  const float d0 = softplus_f(p.dtraw[(size_t)(row0 + t) * 8 + hh] + p.dt_bias[layer * 8 + hh]);
  const float d1 = softplus_f(p.dtraw[(size_t)(row0 + t) * 8 + 4 + hh] + p.dt_bias[layer * 8 + 4 + hh]);
  dt0[t] = d0;
  dt1[t] = d1;
  a0[t] = -d0 * __expf(p.a_log[layer * 8 + hh]);
  a1[t] = -d1 * __expf(p.a_log[layer * 8 + 4 + hh]);
}
DI void ssd_cum_arrays(int t, float* arr) {
  float* c0 = arr + 256;
  float* s1 = arr + 384;
  const float* a0 = arr + 512;
  const float* a1 = arr + 640;
  float s = 0.f;
  for (int k = 0; k <= t; ++k) s += a0[k];
  c0[t] = s;
  s = 0.f;
  for (int k = 127; k >= t; --k) s += a1[k];
  s1[t] = s;
}

DI void ssd_s1_tasks(const Params& p, int layer, char* smem) {
  const int ftid = ltid(), vb = ftid >> 8, tid = ftid & 255;
  u16* xsT0 = (u16*)(smem + vb * VSMEM);
  u16* xsT1 = xsT0 + 64 * 136;
  u16* BT = xsT1 + 64 * 136;
  float* arr = (float*)(BT + 128 * 136);
  float* w0 = arr + 768;
  float* w1 = w0 + 128;
  const int lane = tid & 63, wid = tid >> 6, r = lane & 31, h = lane >> 5;
  for (int t0 = lbid() * 2; t0 < NB * NCH * 4; t0 += gridDim.x * 2) {
    const int task = t0 + vb;
    const int hh = task & 3, bc = task >> 2, c = bc % NCH, b = bc / NCH;
    const int g = hh >> 1;
    const int row0 = bc * 128;
    const bool cPrev = (c != 0 && c != 32), cNext = (c != 31 && c != 33);
    __syncthreads();
    if (tid < 128) ssd_dt_arrays(p, layer, row0, hh, tid, arr);
    __syncthreads();
    if (tid < 128) ssd_cum_arrays(tid, arr);
    __syncthreads();
    if (tid < 128) {
      const float* dt0 = arr;
      const float* dt1 = arr + 128;
      const float* c0 = arr + 256;
      const float* s1 = arr + 384;
      w0[tid] = __expf(c0[127] - c0[tid]) * dt0[tid];
      w1[tid] = __expf(s1[0] - s1[tid]) * dt1[tid];
      if (tid == 0) {
        p.atot[((size_t)bc * 2 + 0) * 4 + hh] = c0[127];
        p.atot[((size_t)bc * 2 + 1) * 4 + hh] = s1[0];
      }
    }
    __syncthreads();
#pragma unroll 1
    for (int i = 0; i < 4; ++i) {
      const int id = tid + VT * i, t = id >> 3, cp = id & 7;
      float v[8];
      conv8(p, layer, row0 + t, hh * 64 + cp * 8, cPrev || t > 0, cNext || t < 127, v);
      const float f0 = w0[t], f1 = w1[t];
#pragma unroll
      for (int e = 0; e < 8; ++e) {
        xsT0[(cp * 8 + e) * 136 + t] = f2bf(v[e] * f0);
        xsT1[(cp * 8 + e) * 136 + t] = f2bf(v[e] * f1);
      }
    }
#pragma unroll 1
    for (int i = 0; i < 8; ++i) {
      const int id = tid + VT * i, t = id >> 4, cp = id & 15;
      float v[8];
      conv8(p, layer, row0 + t, 256 + g * 128 + cp * 8, cPrev || t > 0, cNext || t < 127, v);
#pragma unroll
      for (int e = 0; e < 8; ++e) BT[(cp * 8 + e) * 136 + t] = f2bf(v[e]);
    }
    __syncthreads();
#pragma unroll
    for (int d = 0; d < 2; ++d) {
      const u16* xsT = d ? xsT1 : xsT0;
#pragma unroll
      for (int pb = 0; pb < 2; ++pb) {
        f32x16 acc;
#pragma unroll
        for (int e = 0; e < 16; ++e) acc[e] = 0.f;
#pragma unroll
        for (int kk = 0; kk < 8; ++kk) {
          bf16x8 a = *(const bf16x8*)(xsT + (pb * 32 + r) * 136 + kk * 16 + h * 8);
          bf16x8 bb = *(const bf16x8*)(BT + (wid * 32 + r) * 136 + kk * 16 + h * 8);
          acc = MFMA(a, bb, acc);
        }
        float* dst = p.CS + ((((size_t)bc * 2 + d) * 4 + hh) * 64 + pb * 32) * 128 + wid * 32 + r;
#pragma unroll
        for (int e = 0; e < 16; ++e) dst[(size_t)crow(e, h) * 128] = acc[e];
      }
    }
  }
}

DI void ssd_scan_phase(const Params& p) {
  const int total = NB * 2 * 4 * 8192;
  for (int idx = lbid() * NTHR + ltid(); idx < total; idx += gridDim.x * NTHR) {
    const int e = idx & 8191, hh = (idx >> 13) & 3, d = (idx >> 15) & 1, b = idx >> 16;
    float st = 0.f;
#pragma unroll 2
    for (int i = 0; i < NCH; ++i) {
      int c;
      if (d == 0) c = i < 2 ? 32 + i : i - 2;
      else c = i < 2 ? 33 - i : 33 - i;
      const size_t bc = (size_t)b * NCH + c;
      float* ptr = p.CS + ((bc * 2 + d) * 4 + hh) * 8192 + e;
      const float v = *ptr;
      const float dec = __expf(p.atot[(bc * 2 + d) * 4 + hh]);
      *ptr = st;
      st = dec * st + v;
    }
  }
}

template <int G>
DI float ssd_s3_group(const Params& p, int layer, int bc, bool cPrev, bool cNext, u16* Bg, u16* xsT, float* arr, int tid) {
  f32x16 y[4];
#pragma unroll
  for (int i = 0; i < 4; ++i)
#pragma unroll
    for (int e = 0; e < 16; ++e) y[i][e] = 0.f;
  const int lane = tid & 63, wid = tid >> 6, r = lane & 31, h = lane >> 5;
  const int l = wid * 32 + r;
  const int row0 = bc * 128;
  __syncthreads();
  ssd_dt_arrays(p, layer, row0, 2 * G + (tid >> 7), tid & 127, arr + (tid >> 7) * 768);
#pragma unroll 1
  for (int i = 0; i < 8; ++i) {
    const int id = tid + VT * i, t = id >> 4, cp = id & 15;
    float v[8];
    conv8(p, layer, row0 + t, 512 + G * 128 + cp * 8, cPrev || t > 0, cNext || t < 127, v);
    *(bf16x8*)(Bg + t * 136 + cp * 8) = pack8(v[0], v[1], v[2], v[3], v[4], v[5], v[6], v[7]);
  }
#pragma unroll 1
  for (int i = 0; i < 8; ++i) {
    const int id = tid + VT * i, t = id >> 4, cp = id & 15;
    float v[8];
    conv8(p, layer, row0 + t, G * 128 + cp * 8, cPrev || t > 0, cNext || t < 127, v);
#pragma unroll
    for (int e = 0; e < 8; ++e) xsT[(cp * 8 + e) * 136 + t] = f2bf(v[e]);
  }
  __syncthreads();
  ssd_cum_arrays(tid & 127, arr + (tid >> 7) * 768);
  bf16x8 cf[8];
#pragma unroll
  for (int kk = 0; kk < 8; ++kk) cf[kk] = *(const bf16x8*)(Bg + l * 136 + kk * 16 + h * 8);
  __syncthreads();
#pragma unroll 1
  for (int i = 0; i < 8; ++i) {
    const int id = tid + VT * i, t = id >> 4, cp = id & 15;
    float v[8];
    conv8(p, layer, row0 + t, 256 + G * 128 + cp * 8, cPrev || t > 0, cNext || t < 127, v);
    *(bf16x8*)(Bg + t * 136 + cp * 8) = pack8(v[0], v[1], v[2], v[3], v[4], v[5], v[6], v[7]);
  }
  __syncthreads();
  float ss = 0.f;
#pragma unroll 1
  for (int hd2 = 0; hd2 < 2; ++hd2) {
    const int hh = 2 * G + hd2;
    const float* ah = arr + hd2 * 768;
    const float c0l = ah[256 + l], s1l = ah[384 + l];
    f32x16 y[2];
#pragma unroll
    for (int i = 0; i < 2; ++i)
#pragma unroll
      for (int e = 0; e < 16; ++e) y[i][e] = 0.f;
#pragma unroll 1
    for (int sb = 0; sb < 4; ++sb) {
      f32x16 gt;
#pragma unroll
      for (int e = 0; e < 16; ++e) gt[e] = 0.f;
#pragma unroll
      for (int kk = 0; kk < 8; ++kk) {
        bf16x8 a = *(const bf16x8*)(Bg + (sb * 32 + r) * 136 + kk * 16 + h * 8);
        gt = MFMA(a, cf[kk], gt);
      }
      f32x16 wv;
#pragma unroll
      for (int e = 0; e < 16; ++e) {
        const int s = sb * 32 + crow(e, h);
        const float a0 = (l >= s) ? (c0l - ah[256 + s]) : -1e30f;
        const float a1 = (l <= s) ? (s1l - ah[384 + s]) : -1e30f;
        const float f = __expf(a0) * ah[s] + __expf(a1) * ah[128 + s];
        wv[e] = gt[e] * f;
      }
      bf16x8 wp0 = pack8(wv[0], wv[1], wv[2], wv[3], wv[4], wv[5], wv[6], wv[7]);
      bf16x8 wp1 = pack8(wv[8], wv[9], wv[10], wv[11], wv[12], wv[13], wv[14], wv[15]);
#pragma unroll
      for (int pb = 0; pb < 2; ++pb) {
        const u16* xrow = xsT + (hd2 * 64 + pb * 32 + r) * 136 + sb * 32 + 4 * h;
        s16x4 lo0 = *(const s16x4*)(xrow), hi0 = *(const s16x4*)(xrow + 8);
        s16x4 lo1 = *(const s16x4*)(xrow + 16), hi1 = *(const s16x4*)(xrow + 24);
        bf16x8 a0 = __builtin_shufflevector(lo0, hi0, 0, 1, 2, 3, 4, 5, 6, 7);
        bf16x8 a1 = __builtin_shufflevector(lo1, hi1, 0, 1, 2, 3, 4, 5, 6, 7);
        y[pb] = MFMA(a0, wp0, y[pb]);
        y[pb] = MFMA(a1, wp1, y[pb]);
      }
    }
#pragma unroll 1
    for (int d = 0; d < 2; ++d) {
      const float el = __expf(d == 0 ? c0l : s1l);
#pragma unroll
      for (int pb = 0; pb < 2; ++pb) {
        const float* srow = p.CS + ((((size_t)bc * 2 + d) * 4 + hh) * 64 + pb * 32 + r) * 128 + h * 8;
        f32x16 tmp;
#pragma unroll
        for (int e = 0; e < 16; ++e) tmp[e] = 0.f;
#pragma unroll
        for (int kk = 0; kk < 8; ++kk) {
          f32x4 s0 = *(const f32x4*)(srow + kk * 16), s1 = *(const f32x4*)(srow + kk * 16 + 4);
          bf16x8 a = pack8(s0.x, s0.y, s0.z, s0.w, s1.x, s1.y, s1.z, s1.w);
          tmp = MFMA(a, cf[kk], tmp);
        }
#pragma unroll
        for (int e = 0; e < 16; ++e) y[pb][e] += el * tmp[e];
      }
    }
    const float dsk = p.ssd_d[layer * 8 + hh] + p.ssd_d[layer * 8 + 4 + hh];
#pragma unroll
    for (int pb = 0; pb < 2; ++pb) {
#pragma unroll
      for (int q4 = 0; q4 < 4; ++q4) {
        const int cl = hd2 * 64 + pb * 32 + 8 * q4 + 4 * h;
        const int ch0 = G * 128 + cl;
        u32x2 zw = *(const u32x2*)(p.P + (size_t)(row0 + l) * NINP + 960 + ch0);
        f32x4 o;
        o.x = (y[pb][4 * q4] + dsk * bf2f(xsT[(cl + 0) * 136 + l])) * silu_f(bflo(zw.x));
        o.y = (y[pb][4 * q4 + 1] + dsk * bf2f(xsT[(cl + 1) * 136 + l])) * silu_f(bfhi(zw.x));
        o.z = (y[pb][4 * q4 + 2] + dsk * bf2f(xsT[(cl + 2) * 136 + l])) * silu_f(bflo(zw.y));
        o.w = (y[pb][4 * q4 + 3] + dsk * bf2f(xsT[(cl + 3) * 136 + l])) * silu_f(bfhi(zw.y));
        ss += o.x * o.x + o.y * o.y + o.z * o.z + o.w * o.w;
        *(f32x4*)(p.ytmp + (size_t)(row0 + l) * 256 + ch0) = o;
      }
    }
  }
  return ss;
}

DI void ssd_s3_tasks(const Params& p, int layer, char* smem) {
  const int ftid = ltid(), vb = ftid >> 8, tid = ftid & 255;
  u16* Bg = (u16*)(smem + vb * VSMEM);
  u16* xsT = Bg + 128 * 136;
  float* arr = (float*)(xsT + 128 * 136);
  const int lane = tid & 63, wid = tid >> 6, r = lane & 31, h = lane >> 5;
  const int l = wid * 32 + r;
  for (int t0 = lbid() * 2; t0 < NB * NCH; t0 += gridDim.x * 2) {
    const int bc = t0 + vb, c = bc % NCH;
    const int row0 = bc * 128;
    const bool cPrev = (c != 0 && c != 32), cNext = (c != 31 && c != 33);
    float ss = ssd_s3_group<0>(p, layer, bc, cPrev, cNext, Bg, xsT, arr, tid);
    ss += ssd_s3_group<1>(p, layer, bc, cPrev, cNext, Bg, xsT, arr, tid);
    ss += __shfl_xor(ss, 32);
    const float rstd = rsqrtf(ss * (1.f / 256.f) + EPS);
    const float* gn = p.ssd_norm_g + layer * 256;
#pragma unroll 4
    for (int i = 0; i < 32; ++i) {
      const int ch0 = (i >> 2) * 32 + 8 * (i & 3) + 4 * h;
      f32x4 v = *(const f32x4*)(p.ytmp + (size_t)(row0 + l) * 256 + ch0);
      f32x4 gv = *(const f32x4*)(gn + ch0);
      u32x2 w;
      w.x = pack2(v.x * rstd * gv.x, v.y * rstd * gv.y);
      w.y = pack2(v.z * rstd * gv.z, v.w * rstd * gv.w);
      *(u32x2*)(p.H + (size_t)(row0 + l) * D + 768 + ch0) = w;
    }
  }
}

DI void attn_tasks(const Params& p, char* smem) {
  u16* Ks = (u16*)smem;
  u16* Vs = Ks + 64 * 200;
  const int tid = ltid(), lane = tid & 63, wid = tid >> 6, r = lane & 31, h = lane >> 5;
  const float sc = 0.07216878364870322f * 1.4426950408889634f;
  for (int task = lbid(); task < NB * 4 * 17; task += gridDim.x) {
    int b, hd, qt;
    if (task < 512) {
      qt = task & 15; hd = (task >> 4) & 3; b = task >> 6;
    } else {
      const int t2 = task - 512;
      qt = 16; hd = t2 & 3; b = t2 >> 2;
    }
    const int koff = (qt < 16) ? 0 : SEQ;
    const int nkt = ((qt < 16) ? SP : CTX) / 64;
    const int qrow = b * SP + qt * 256 + wid * 32 + r;
    bf16x8 qf[12];
#pragma unroll
    for (int kk = 0; kk < 12; ++kk) qf[kk] = *(const bf16x8*)(p.Q + (size_t)qrow * 768 + hd * 192 + kk * 16 + h * 8);
    f32x16 o[4];
#pragma unroll
    for (int i = 0; i < 4; ++i)
#pragma unroll
      for (int e = 0; e < 16; ++e) o[i][e] = 0.f;
    float m_run = -1e30f, l_run = 0.f;
    u32x4 kn[2], kr[1], vv[2];
    const u16* knb = p.Kn + ((size_t)(b * SP + koff) + (tid >> 4)) * 512 + hd * 128 + (tid & 15) * 8;
    const u16* krb = p.Kr + ((size_t)(b * SP + koff) + (tid >> 3)) * 64 + (tid & 7) * 8;
    const u16* vb = p.Vt + ((size_t)(b * 4 + hd) * 128 + (tid >> 3)) * SP + koff + (tid & 7) * 8;
#pragma unroll
    for (int i = 0; i < 2; ++i) kn[i] = *(const u32x4*)(knb + (size_t)(32 * i) * 512);
    kr[0] = *(const u32x4*)(krb);
#pragma unroll
    for (int i = 0; i < 2; ++i) vv[i] = *(const u32x4*)(vb + (size_t)(64 * i) * SP);
    for (int kt = 0; kt < nkt; ++kt) {
      __syncthreads();
#pragma unroll
      for (int i = 0; i < 2; ++i) *(u32x4*)(Ks + ((tid >> 4) + 32 * i) * 200 + (tid & 15) * 8) = kn[i];
      *(u32x4*)(Ks + (tid >> 3) * 200 + 128 + (tid & 7) * 8) = kr[0];
#pragma unroll
      for (int i = 0; i < 2; ++i) {
        u16* dst = Vs + ((tid >> 3) + 64 * i) * 68 + (tid & 7) * 8;
        *(u32x2*)dst = u32x2{vv[i].x, vv[i].y};
        *(u32x2*)(dst + 4) = u32x2{vv[i].z, vv[i].w};
      }
      __syncthreads();
      if (kt + 1 < nkt) {
        const size_t ko = (size_t)(kt + 1) * 64;
#pragma unroll
        for (int i = 0; i < 2; ++i) kn[i] = *(const u32x4*)(knb + (ko + 32 * i) * 512);
        kr[0] = *(const u32x4*)(krb + ko * 64);
#pragma unroll
        for (int i = 0; i < 2; ++i) vv[i] = *(const u32x4*)(vb + (size_t)(64 * i) * SP + ko);
      }
      f32x16 st[2];
#pragma unroll
      for (int kb = 0; kb < 2; ++kb) {
#pragma unroll
        for (int e = 0; e < 16; ++e) st[kb][e] = 0.f;
#pragma unroll
        for (int kk = 0; kk < 12; ++kk) {
          bf16x8 a = *(const bf16x8*)(Ks + (kb * 32 + r) * 200 + kk * 16 + h * 8);
          st[kb] = MFMA(a, qf[kk], st[kb]);
        }
      }
      float mx = st[0][0];
#pragma unroll
      for (int kb = 0; kb < 2; ++kb)
#pragma unroll
        for (int e = 0; e < 16; ++e) mx = fmaxf(mx, st[kb][e]);
      mx = fmaxf(mx, __shfl_xor(mx, 32));
      const float m_new = fmaxf(m_run, mx * sc);
      const float alpha = __builtin_amdgcn_exp2f(m_run - m_new);
      m_run = m_new;
      float ls = 0.f;
#pragma unroll
      for (int kb = 0; kb < 2; ++kb)
#pragma unroll
        for (int e = 0; e < 16; ++e) {
          float pv = __builtin_amdgcn_exp2f(fmaf(st[kb][e], sc, -m_new));
          ls += pv;
          st[kb][e] = pv;
        }
      l_run = l_run * alpha + ls;
#pragma unroll
      for (int i = 0; i < 4; ++i)
#pragma unroll
        for (int e = 0; e < 16; ++e) o[i][e] *= alpha;
#pragma unroll
      for (int ks = 0; ks < 4; ++ks) {
        const int kb = ks >> 1, s2 = ks & 1;
        bf16x8 pf = pack8(st[kb][8 * s2], st[kb][8 * s2 + 1], st[kb][8 * s2 + 2], st[kb][8 * s2 + 3], st[kb][8 * s2 + 4],
                          st[kb][8 * s2 + 5], st[kb][8 * s2 + 6], st[kb][8 * s2 + 7]);
#pragma unroll
        for (int db = 0; db < 4; ++db) {
          const u16* vr = Vs + (db * 32 + r) * 68 + ks * 16 + 4 * h;
          s16x4 lo = *(const s16x4*)vr, hi = *(const s16x4*)(vr + 8);
          bf16x8 a = __builtin_shufflevector(lo, hi, 0, 1, 2, 3, 4, 5, 6, 7);
          o[db] = MFMA(a, pf, o[db]);
        }
      }
    }
    const float ltot = l_run + __shfl_xor(l_run, 32);
    const float inv = 1.f / ltot;
    u16* orow = p.H + (size_t)qrow * D + hd * 128;
#pragma unroll
    for (int db = 0; db < 4; ++db)
#pragma unroll
      for (int q4 = 0; q4 < 4; ++q4) {
        u32x2 w;
        w.x = pack2(o[db][4 * q4] * inv, o[db][4 * q4 + 1] * inv);
        w.y = pack2(o[db][4 * q4 + 2] * inv, o[db][4 * q4 + 3] * inv);
        *(u32x2*)(orow + db * 32 + 8 * q4 + 4 * h) = w;
      }
  }
}

constexpr int NPHASE = 1 + DEPTH * 9 + 1;

DI void run_phase(const Params& p, int ph, char* smem) {
  if (ph == 0) { prologue_phase(p, smem); return; }
  if (ph == NPHASE - 1) { ew_phase(p, DEPTH, 2); return; }
  const int layer = (ph - 1) / 9, sub = (ph - 1) % 9;
  const int MT = T / 256;
  switch (sub) {
    case 0: {
      ew_phase(p, layer, 0);
      convert_weights(p.w_in + (size_t)layer * D * NIN, D, NIN, NINP, p.wt_in, nullptr, smem);
      convert_weights(p.w_uq + (size_t)layer * 256 * 768, 256, 768, 768, p.wt_uq, p.g_q + layer * 256, smem);
      convert_weights(p.w_ukv + (size_t)layer * 128 * 1024, 128, 1024, 1024, p.wt_ukv, p.g_kv + layer * 128, smem);
      convert_weights(p.w_out + (size_t)layer * D * D, D, D, D, p.wt_out, nullptr, smem);
      for (int i = lbid() * NTHR + ltid(); i < 4 * 128 * 128; i += gridDim.x * NTHR)
        p.wsb[i] = f2bf(p.cm_w_s[(size_t)layer * 65536 + i]);
    } break;
    case 1: {
      for (int it = 0;; ++it) {
        const int t = xcd_tile(it, MT * 8);
        if (t < 0) break;
        const int tm = t >> 3, tn = t & 7;
        gemm_tile(p.H, D, p.wt_in, D, D, tm * 256, tn * 256, smem,
                  [&](int mb, int nb, const f32x16& acc, int r, int h) {
                    const int col = nb + r;
#pragma unroll
                    for (int e = 0; e < 16; ++e) {
                      const int row = mb + crow(e, h);
                      p.P[(size_t)row * NINP + col] = f2bf(acc[e]);
                      if (col >= 1984 && col < 1992) p.dtraw[(size_t)row * 8 + col - 1984] = acc[e];
                    }
                  });
      }
    } break;
    case 2: {
      qkv_tasks(p, smem);
      cm_tasks(p, layer, smem);
      ssd_s1_tasks(p, layer, smem);
    } break;
    case 3: ssd_scan_phase(p); break;
    case 4: {
      attn_tasks(p, smem);
      ssd_s3_tasks(p, layer, smem);
    } break;
    case 5: {
      for (int it = 0;; ++it) {
        const int t = xcd_tile(it, MT * 4);
        if (t < 0) break;
        const int tm = t >> 2, tn = t & 3;
        gemm_tile(p.H, D, p.wt_out, D, D, tm * 256, tn * 256, smem,
                  [&](int mb, int nb, const f32x16& acc, int r, int h) {
#pragma unroll
                    for (int e = 0; e < 16; ++e) p.Y[(size_t)(mb + crow(e, h)) * D + nb + r] = acc[e];
                  });
      }
    } break;
    case 6: {
      ew_phase(p, layer, 1);
      convert_weights(p.w_ff1 + (size_t)layer * D * DFF, D, DFF, DFF, p.wt_ff1, nullptr, smem);
      convert_weights(p.w_ff2 + (size_t)layer * DFF * D, DFF, D, D, p.wt_ff2, nullptr, smem);
    } break;
    case 7: {
      for (int it = 0;; ++it) {
        const int t = xcd_tile(it, MT * 16);
        if (t < 0) break;
        const int tm = t >> 4, tn = t & 15;
        gemm_tile(p.H, D, p.wt_ff1, D, D, tm * 256, tn * 256, smem,
                  [&](int mb, int nb, const f32x16& acc, int r, int h) {
#pragma unroll
                    for (int e = 0; e < 16; ++e) {
                      float v = fmaxf(acc[e], 0.f);
                      p.Hd[(size_t)(mb + crow(e, h)) * DFF + nb + r] = f2bf(v * v);
                    }
                  });
      }
    } break;
    case 8: {
      for (int it = 0;; ++it) {
        const int t = xcd_tile(it, MT * 4);
        if (t < 0) break;
        const int tm = t >> 2, tn = t & 3;
        gemm_tile(p.Hd, DFF, p.wt_ff2, DFF, DFF, tm * 256, tn * 256, smem,
                  [&](int mb, int nb, const f32x16& acc, int r, int h) {
#pragma unroll
                    for (int e = 0; e < 16; ++e) p.F[(size_t)(mb + crow(e, h)) * D + nb + r] = f2bf(acc[e]);
                  });
      }
    } break;
  }
}

__global__ void __launch_bounds__(NTHR, 2) mega_kernel(Params p, int ph_begin, int ph_end) {
  extern __shared__ __attribute__((aligned(16))) char smem[];
  cg::grid_group grid = cg::this_grid();
  for (int ph = ph_begin; ph < ph_end; ++ph) {
    run_phase(p, ph, smem);
    if (ph + 1 < ph_end) grid.sync();
  }
}

extern "C" void kernel_launch(void* const* d_in, const int* in_sizes, int n_in, void* d_out, int out_size, void* d_ws,
                              size_t ws_size, hipStream_t stream) {
  Params p{};
  const float* const* in = (const float* const*)d_in;
  p.x = in[0]; p.c = in[1]; p.ctx = in[2]; p.c_ctx = in[3]; p.w_ada = in[4]; p.b_ada = in[5];
  p.g_pre_mix = in[6]; p.g_post_mix = in[7]; p.g_pre_ff = in[8]; p.g_post_ff = in[9]; p.w_in = in[10];
  p.g_q = in[11]; p.w_uq = in[12]; p.g_kv = in[13]; p.w_ukv = in[14]; p.cm_norm_g = in[15]; p.cm_w_s = in[16];
  p.cm_b_s = in[17]; p.conv_w = in[18]; p.conv_b = in[19]; p.dt_bias = in[20]; p.a_log = in[21]; p.ssd_d = in[22];
  p.ssd_norm_g = in[23]; p.w_out = in[24]; p.w_ff1 = in[25]; p.w_ff2 = in[26];
  p.out = (float*)d_out;
  char* ws = (char*)d_ws;
  size_t off = 0;
  auto take = [&](size_t bytes) { char* q = ws + off; off += (bytes + 255) & ~(size_t)255; return q; };
  p.wt_in = (u16*)take((size_t)NINP * D * 2);
  p.wt_uq = (u16*)take((size_t)768 * 256 * 2);
  p.wt_ukv = (u16*)take((size_t)1024 * 128 * 2);
  p.wt_out = (u16*)take((size_t)D * D * 2);
  p.wt_ff1 = (u16*)take((size_t)DFF * D * 2);
  p.wt_ff2 = (u16*)take((size_t)D * DFF * 2);
  p.wsb = (u16*)take((size_t)4 * 128 * 128 * 2);
  p.mod = (float*)take((size_t)DEPTH * 9 * 6144 * 4);
  p.ropetab = (float*)take((size_t)64 * 16 * 2 * 4);
  p.atot = (float*)take((size_t)NB * NCH * 2 * 4 * 4);
  p.xctx = (float*)take((size_t)NB * CTX * D * 4);
  char* r1 = take((size_t)T * DFF * 2);
  p.Hd = (u16*)r1;
  p.Y = (float*)r1;
  {
    size_t o2 = 0;
    p.P = (u16*)(r1 + o2); o2 += (size_t)T * NINP * 2;
    p.Q = (u16*)(r1 + o2); o2 += (size_t)T * 768 * 2;
    p.Kn = (u16*)(r1 + o2); o2 += (size_t)T * 512 * 2;
    p.Kr = (u16*)(r1 + o2); o2 += (size_t)T * 64 * 2;
    p.Vt = (u16*)(r1 + o2); o2 += (size_t)NB * 4 * 128 * SP * 2;
    p.dtraw = (float*)(r1 + o2); o2 += (size_t)T * 8 * 4;
  }
  p.H = (u16*)take((size_t)T * D * 2);
  p.CS = (float*)take((size_t)NB * NCH * 2 * 4 * 8192 * 4);
  p.F = (u16*)p.CS;
  p.ytmp = (float*)take((size_t)T * 256 * 4);
  if (off > ws_size) {
    fprintf(stderr, "workspace too small: need %zu have %zu\n", off, ws_size);
    return;
  }
  static int grid_blocks = 0;
  if (!grid_blocks) {
    int dev = 0, cus = 0, per_cu = 0;
    hipGetDevice(&dev);
    hipDeviceGetAttribute(&cus, hipDeviceAttributeMultiprocessorCount, dev);
    hipFuncSetAttribute((const void*)mega_kernel, hipFuncAttributeMaxDynamicSharedMemorySize, SMEM_BYTES);
    hipOccupancyMaxActiveBlocksPerMultiprocessor(&per_cu, mega_kernel, NTHR, SMEM_BYTES);
    if (per_cu < 1) per_cu = 1;
    if (per_cu > 1) per_cu = 1;
    grid_blocks = cus * per_cu;
  }
  int pb = 0, pe = NPHASE;
  void* args[] = {&p, &pb, &pe};
  hipError_t e = hipLaunchCooperativeKernel((void*)mega_kernel, dim3(grid_blocks), dim3(NTHR), args, SMEM_BYTES, stream);
  if (e != hipSuccess) fprintf(stderr, "cooperative launch failed: %s (grid %d)\n", hipGetErrorString(e), grid_blocks);
}
```

```cpp
#include <hip/hip_runtime.h>
#include <hip/hip_cooperative_groups.h>
#include <cstdio>
namespace cg = cooperative_groups;

#define DI __device__ __forceinline__
typedef unsigned short u16;
using bf16x8 = __attribute__((ext_vector_type(8))) short;
using s16x4 = __attribute__((ext_vector_type(4))) short;
using f32x16 = __attribute__((ext_vector_type(16))) float;
using u32x4 = __attribute__((ext_vector_type(4))) unsigned;
using u32x2 = __attribute__((ext_vector_type(2))) unsigned;
using f32x4 = __attribute__((ext_vector_type(4))) float;
typedef __bf16 bf2_t __attribute__((ext_vector_type(2)));
typedef float f2_t __attribute__((ext_vector_type(2)));
#define MFMA(a, b, c) __builtin_amdgcn_mfma_f32_32x32x16_bf16((a), (b), (c), 0, 0, 0)

constexpr int NB = 8, SEQ = 4096, CTX = 256, SP = 4352, T = NB * SP, D = 1024, DFF = 4096;
constexpr int NIN = 1992, NINP = 2048, NCH = 34, DEPTH = 4;
constexpr int NTHR = 512;
constexpr int VT = 256;
constexpr int VSMEM = 75 * 1024;
constexpr int SMEM_BYTES = 2 * VSMEM;
constexpr float EPS = 1e-6f;

struct Params {
  const float *x, *c, *ctx, *c_ctx, *w_ada, *b_ada, *g_pre_mix, *g_post_mix, *g_pre_ff, *g_post_ff, *w_in, *g_q, *w_uq,
      *g_kv, *w_ukv, *cm_norm_g, *cm_w_s, *cm_b_s, *conv_w, *conv_b, *dt_bias, *a_log, *ssd_d, *ssd_norm_g, *w_out,
      *w_ff1, *w_ff2;
  float* out;
  u16 *wt_in, *wt_uq, *wt_ukv, *wt_out, *wt_ff1, *wt_ff2, *wsb;
  float *mod, *ropetab, *atot, *xctx;
  u16 *P, *Q, *Kn, *Kr, *Vt, *Hd;
  u16* Y;
  float* dtraw;
  u16* H;
  float* CS;
  u16* F;
  float* ytmp;
};

DI int ltid() { int t = threadIdx.x; asm volatile("" : "+v"(t)); return t; }
DI int lbid() { int t = blockIdx.x; asm volatile("" : "+s"(t)); return t; }
DI int crow(int e, int h) { return (e & 3) + 8 * (e >> 2) + 4 * h; }
DI unsigned pack2(float a, float b) {
  f2_t v = {a, b};
  bf2_t r = __builtin_convertvector(v, bf2_t);
  return __builtin_bit_cast(unsigned, r);
}
DI u16 f2bf(float a) { return (u16)(pack2(a, 0.f) & 0xffffu); }
DI float bf2f(u16 v) { return __uint_as_float(((unsigned)v) << 16); }
DI float bflo(unsigned w) { return __uint_as_float(w << 16); }
DI float bfhi(unsigned w) { return __uint_as_float(w & 0xffff0000u); }
DI bf16x8 pack8(float a0, float a1, float a2, float a3, float a4, float a5, float a6, float a7) {
  u32x4 u;
  u.x = pack2(a0, a1); u.y = pack2(a2, a3); u.z = pack2(a4, a5); u.w = pack2(a6, a7);
  return __builtin_bit_cast(bf16x8, u);
}
DI float wave_sum(float v) {
#pragma unroll
  for (int o = 32; o > 0; o >>= 1) v += __shfl_xor(v, o);
  return v;
}
DI float silu_f(float y) { return y / (1.f + __expf(-y)); }
DI float gelu_f(float x) {
  float u = 0.7978845608028654f * (x + 0.044715f * x * x * x);
  float t = 1.f - 2.f / (1.f + __expf(2.f * u));
  return 0.5f * x * (1.f + t);
}
DI float softplus_f(float x) { return x > 20.f ? x : log1pf(__expf(x)); }
DI float uw(const u32x4& v, int i) {
  unsigned w = (i >> 1) == 0 ? v.x : (i >> 1) == 1 ? v.y : (i >> 1) == 2 ? v.z : v.w;
  return (i & 1) ? bfhi(w) : bflo(w);
}

template <bool HAS_T, class ElemF, class StoreF, class StoreTF, class UseTF>
DI void gemm_tile(const u16* __restrict__ A, int lda, const u16* __restrict__ Bt, int ldb, int K, int m0, int n0,
                  char* smem, ElemF elem, StoreF store, StoreTF storeT, UseTF useT) {
  constexpr int LS = 72;
  constexpr int STAGE = 2 * 256 * LS;
  u16* base = (u16*)smem;
  const int tid = ltid(), lane = tid & 63, wid = tid >> 6, wm = wid >> 2, wn = wid & 3, r = lane & 31, h = lane >> 5;
  f32x16 acc[4][2];
#pragma unroll
  for (int i = 0; i < 4; ++i)
#pragma unroll
    for (int j = 0; j < 2; ++j)
#pragma unroll
      for (int e = 0; e < 16; ++e) acc[i][j][e] = 0.f;
  u32x4 ra[4], rb[4];
  const int lrow = tid >> 3, lcp = (tid & 7) * 8;
  const u16* ga = A + (size_t)(m0 + lrow) * lda + lcp;
  const u16* gb = Bt + (size_t)(n0 + lrow) * ldb + lcp;
  const int wofs = lrow * LS + lcp;
  const int aofs = (wm * 128 + r) * LS + h * 8;
  const int bofs = 256 * LS + (wn * 64 + r) * LS + h * 8;
#define GLOAD(kt_)                                                           \
  _Pragma("unroll") for (int i = 0; i < 4; ++i) {                            \
    ra[i] = *(const u32x4*)(ga + (size_t)(64 * i) * lda + (kt_) * 64);       \
    rb[i] = *(const u32x4*)(gb + (size_t)(64 * i) * ldb + (kt_) * 64);       \
  }
#define SWRITE(st_)                                                          \
  _Pragma("unroll") for (int i = 0; i < 4; ++i) {                            \
    *(u32x4*)((st_) + wofs + 64 * i * LS) = ra[i];                           \
    *(u32x4*)((st_) + 256 * LS + wofs + 64 * i * LS) = rb[i];                \
  }
#define FREAD(dst_, st_, kk_)                                                                      \
  _Pragma("unroll") for (int i = 0; i < 4; ++i) af[dst_][i] = *(const bf16x8*)((st_) + aofs + i * 32 * LS + (kk_) * 16); \
  _Pragma("unroll") for (int j = 0; j < 2; ++j) bfr[dst_][j] = *(const bf16x8*)((st_) + bofs + j * 32 * LS + (kk_) * 16);
#define MMAS(src_)                                                           \
  _Pragma("unroll") for (int i = 0; i < 4; ++i)                              \
  _Pragma("unroll") for (int j = 0; j < 2; ++j) acc[i][j] = MFMA(bfr[src_][j], af[src_][i], acc[i][j]);
  const int nk = K >> 6;
  bf16x8 af[2][4], bfr[2][2];
  GLOAD(0);
  __syncthreads();
  SWRITE(base);
  if (nk > 1) { GLOAD(1); }
  __syncthreads();
  FREAD(0, base, 0);
  for (int kt = 0; kt < nk; ++kt) {
    u16* cur = base + (kt & 1) * STAGE;
    u16* nxt = base + ((kt + 1) & 1) * STAGE;
    FREAD(1, cur, 1);
    if (kt + 1 < nk) { SWRITE(nxt); }
    MMAS(0);
    __builtin_amdgcn_sched_barrier(0);
    if (kt + 2 < nk) { GLOAD(kt + 2); }
    FREAD(0, cur, 2);
    MMAS(1);
    __builtin_amdgcn_sched_barrier(0);
    FREAD(1, cur, 3);
    MMAS(0);
    __builtin_amdgcn_sched_barrier(0);
    __syncthreads();
    if (kt + 1 < nk) { FREAD(0, nxt, 0); }
    MMAS(1);
    __builtin_amdgcn_sched_barrier(0);
  }
#undef GLOAD
#undef SWRITE
#undef FREAD
#undef MMAS
#pragma unroll
  for (int i = 0; i < 4; ++i)
#pragma unroll
    for (int j = 0; j < 2; ++j) elem(m0 + wm * 128 + i * 32, n0 + wn * 64 + j * 32, acc[i][j], r, h);
  u16* stg = base + wid * (128 * 72);
  if (HAS_T && useT(wn)) {
#pragma unroll
    for (int i = 0; i < 4; ++i)
#pragma unroll
      for (int j = 0; j < 2; ++j)
#pragma unroll
        for (int e = 0; e < 16; ++e) stg[(j * 32 + crow(e, h)) * 136 + i * 32 + r] = f2bf(acc[i][j][e]);
    __builtin_amdgcn_wave_barrier();
#pragma unroll 4
    for (int t = 0; t < 16; ++t) {
      const int id = lane + 64 * t, cl = id >> 4, cp = id & 15;
      u32x4 v = *(const u32x4*)(stg + cl * 136 + cp * 8);
      storeT(n0 + wn * 64 + cl, m0 + wm * 128 + cp * 8, v);
    }
  } else {
#pragma unroll
    for (int i = 0; i < 4; ++i)
#pragma unroll
      for (int j = 0; j < 2; ++j)
#pragma unroll
        for (int q4 = 0; q4 < 4; ++q4) {
          u32x2 w;
          w.x = pack2(acc[i][j][4 * q4], acc[i][j][4 * q4 + 1]);
          w.y = pack2(acc[i][j][4 * q4 + 2], acc[i][j][4 * q4 + 3]);
          *(u32x2*)(stg + (i * 32 + r) * 72 + j * 32 + 8 * q4 + 4 * h) = w;
        }
    __builtin_amdgcn_wave_barrier();
#pragma unroll 4
    for (int t = 0; t < 16; ++t) {
      const int id = lane + 64 * t, rl = id >> 3, cp = id & 7;
      u32x4 v = *(const u32x4*)(stg + rl * 72 + cp * 8);
      store(m0 + wm * 128 + rl, n0 + wn * 64 + cp * 8, v);
    }
  }
}

DI int xcd_tile(int it, int ntiles) {
  const int b = lbid(), g = gridDim.x;
  const int local = (b >> 3) + it * (g >> 3);
  const int per = ntiles >> 3;
  return local < per ? (b & 7) * per + local : -1;
}

DI void conv_tile(const float* __restrict__ src, int K, int N, u16* __restrict__ dst, const float* __restrict__ scale,
                  int tk, int tn, char* smem) {
  float* tile = (float*)smem;
  const int tid = ltid(), tx = tid & 63, ty = tid >> 6;
  const int k0 = tk * 64, n0 = tn * 64;
  __syncthreads();
#pragma unroll 4
  for (int i = 0; i < 8; ++i) {
    int kr = ty + 8 * i;
    float v = 0.f;
    if (n0 + tx < N) v = src[(size_t)(k0 + kr) * N + n0 + tx];
    if (scale) v *= scale[k0 + kr];
    tile[kr * 65 + tx] = v;
  }
  __syncthreads();
#pragma unroll 4
  for (int i = 0; i < 8; ++i) {
    int nr = ty + 8 * i;
    dst[(size_t)(n0 + nr) * K + k0 + tx] = f2bf(tile[tx * 65 + nr]);
  }
}

DI void convert_weights(const float* src, int K, int N, int Npad, u16* dst, const float* scale, char* smem) {
  const int tks = K / 64, tns = Npad / 64;
  for (int t = lbid(); t < tks * tns; t += gridDim.x) conv_tile(src, K, N, dst, scale, t / tns, t % tns, smem);
}

DI void prologue_phase(const Params& p, char* smem) {
  float* sc = (float*)smem;
  float* red = sc + 9 * 1024;
  const int tid = ltid();
  for (int i = tid; i < 9 * 1024; i += NTHR) {
    int j = i >> 10, k = i & 1023;
    float v = j < 8 ? p.c[j * 1024 + k] : p.c_ctx[k];
    sc[i] = v / (1.f + __expf(-v));
  }
  __syncthreads();
  for (int task = lbid(); task < DEPTH * 96; task += gridDim.x) {
    const int l = task / 96, n0 = (task % 96) * 64, nn = tid & 63, kq = tid >> 6;
    float acc[9];
#pragma unroll
    for (int j = 0; j < 9; ++j) acc[j] = 0.f;
    const float* w = p.w_ada + ((size_t)l * 1024 + kq * 128) * 6144 + n0 + nn;
    const float* scq = sc + kq * 128;
#pragma unroll 4
    for (int k = 0; k < 128; ++k) {
      float wv = w[(size_t)k * 6144];
#pragma unroll
      for (int j = 0; j < 9; ++j) acc[j] += scq[j * 1024 + k] * wv;
    }
#pragma unroll
    for (int j = 0; j < 9; ++j) red[(kq * 9 + j) * 64 + nn] = acc[j];
    __syncthreads();
    for (int idx = tid; idx < 576; idx += NTHR) {
      int j = idx >> 6, n2 = idx & 63;
      float s = p.b_ada[l * 6144 + n0 + n2];
#pragma unroll
      for (int q = 0; q < 8; ++q) s += red[(q * 9 + j) * 64 + n2];
      p.mod[(size_t)(l * 9 + j) * 6144 + n0 + n2] = s;
    }
    __syncthreads();
  }
  if (lbid() == gridDim.x - 1) {
    for (int i = tid; i < 64 * 16; i += NTHR) {
      int pos = i >> 4, j = i & 15;
      float inv_freq = exp2f(-(float)(2 * j) / 32.f * 13.287712379549449f);
      float ang = (float)pos * inv_freq;
      float k = rintf(ang * 0.15915494309189535f);
      float red2 = fmaf(-k, 6.2831854820251465f, ang);
      red2 = fmaf(-k, -1.7484555314695172e-07f, red2);
      p.ropetab[2 * i] = __cosf(red2);
      p.ropetab[2 * i + 1] = __sinf(red2);
    }
  }
}

DI void ew_phase(const Params& p, int layer, int kind) {
  const int tid = ltid(), lane = tid & 63, wid = __builtin_amdgcn_readfirstlane(tid >> 6);
  const bool has_branch = !(kind == 0 && layer == 0);
  const bool src_in = (layer == 0 && kind <= 1);
  const bool store_x = has_branch;
  const int blayer = (kind == 1) ? layer : (kind == 0 ? layer - 1 : DEPTH - 1);
  const float* gpost = (kind == 1) ? p.g_post_mix + blayer * D : p.g_post_ff + (blayer < 0 ? 0 : blayer) * D;
  const int gate_off = (kind == 1) ? 2 * D : 5 * D;
  const float* gpre = (kind == 0) ? p.g_pre_mix + layer * D : p.g_pre_ff + (kind == 1 ? layer : 0) * D;
  const int shift_off = (kind == 0) ? 0 : 3 * D, scale_off = (kind == 0) ? D : 4 * D;
  const float* xl = src_in ? p.x : p.out;
  const float* xc = src_in ? p.ctx : p.xctx;
  for (int rg = lbid(); rg < T / 8; rg += gridDim.x) {
    const int row = rg * 8 + wid;
    const int b = row / SP, s = row - b * SP;
    const bool lat = s < SEQ;
    if (kind == 2 && !lat) continue;
    const size_t xoff = lat ? ((size_t)(b * SEQ + s) * D) : ((size_t)(b * CTX + s - SEQ) * D);
    const unsigned long long msk = lat ? ~0ull : 0ull;
    const float* xs = (const float*)(((unsigned long long)xl & msk) | ((unsigned long long)xc & ~msk)) + xoff;
    float* xd = (float*)(((unsigned long long)p.out & msk) | ((unsigned long long)p.xctx & ~msk)) + xoff;
    const int mi = lat ? b : 8;
    f32x4 xv[4];
#pragma unroll
    for (int i = 0; i < 4; ++i) xv[i] = *(const f32x4*)(xs + lane * 4 + 256 * i);
    if (has_branch) {
      const float* modb = p.mod + (size_t)(blayer * 9 + mi) * 6144 + gate_off;
      f32x4 yv[4];
      const u16* ysrc = (kind == 1) ? p.Y : p.F;
#pragma unroll
      for (int i = 0; i < 4; ++i) {
        u32x2 w = *(const u32x2*)(ysrc + (size_t)row * D + lane * 4 + 256 * i);
        yv[i] = f32x4{bflo(w.x), bfhi(w.x), bflo(w.y), bfhi(w.y)};
      }
      float ss = 0.f;
#pragma unroll
      for (int i = 0; i < 4; ++i) ss += yv[i].x * yv[i].x + yv[i].y * yv[i].y + yv[i].z * yv[i].z + yv[i].w * yv[i].w;
      ss = wave_sum(ss);
      const float rstd = rsqrtf(ss * (1.f / D) + EPS);
#pragma unroll
      for (int i = 0; i < 4; ++i) {
        const int col = lane * 4 + 256 * i;
        f32x4 g = *(const f32x4*)(gpost + col);
        f32x4 gt = *(const f32x4*)(modb + col);
        xv[i].x += gt.x * (yv[i].x * rstd * g.x);
        xv[i].y += gt.y * (yv[i].y * rstd * g.y);
        xv[i].z += gt.z * (yv[i].z * rstd * g.z);
        xv[i].w += gt.w * (yv[i].w * rstd * g.w);
      }
      if (store_x) {
#pragma unroll
        for (int i = 0; i < 4; ++i) *(f32x4*)(xd + lane * 4 + 256 * i) = xv[i];
      }
    }
    if (kind != 2) {
      const float* modl = p.mod + (size_t)(layer * 9 + mi) * 6144;
      float ss = 0.f;
#pragma unroll
      for (int i = 0; i < 4; ++i) ss += xv[i].x * xv[i].x + xv[i].y * xv[i].y + xv[i].z * xv[i].z + xv[i].w * xv[i].w;
      ss = wave_sum(ss);
      const float rstd = rsqrtf(ss * (1.f / D) + EPS);
#pragma unroll
      for (int i = 0; i < 4; ++i) {
        const int col = lane * 4 + 256 * i;
        f32x4 g = *(const f32x4*)(gpre + col);
        f32x4 sh = *(const f32x4*)(modl + shift_off + col);
        f32x4 sc = *(const f32x4*)(modl + scale_off + col);
        float h0 = xv[i].x * rstd * g.x * (1.f + sc.x) + sh.x;
        float h1 = xv[i].y * rstd * g.y * (1.f + sc.y) + sh.y;
        float h2 = xv[i].z * rstd * g.z * (1.f + sc.z) + sh.z;
        float h3 = xv[i].w * rstd * g.w * (1.f + sc.w) + sh.w;
        u32x2 w;
        w.x = pack2(h0, h1);
        w.y = pack2(h2, h3);
        *(u32x2*)(p.H + (size_t)row * D + col) = w;
      }
    }
  }
}

DI void row_rstd(const u16* __restrict__ base, int ld, int ncols, int m0, float* rs) {
  const int tid = ltid(), row = tid >> 1, half = tid & 1;
  const int per = ncols / 2;
  const u16* ptr = base + (size_t)(m0 + row) * ld + half * per;
  float ss = 0.f;
  for (int i = 0; i < per; i += 8) {
    u32x4 v = *(const u32x4*)(ptr + i);
#pragma unroll
    for (int e = 0; e < 8; ++e) {
      float f = uw(v, e);
      ss += f * f;
    }
  }
  ss += __shfl_xor(ss, 1);
  if (half == 0) rs[row] = rsqrtf(ss / (float)ncols + EPS);
}

DI void qkv_tasks(const Params& p, char* smem) {
  float* rs = (float*)(smem + 2 * 2 * 256 * 72 * 2);
  const int MT = T / 256;
  auto noT = [](int, int, u32x4) {};
  auto neverT = [](int) { return false; };
  for (int t = lbid(); t < MT * 3; t += gridDim.x) {
    const int tm = t / 3, tn = t % 3, m0 = tm * 256;
    __syncthreads();
    row_rstd(p.P, NINP, 256, m0, rs);
    const bool lat = (m0 % SP) < SEQ;
    const int s0 = m0 % SP;
    gemm_tile<false>(
        p.P, NINP, p.wt_uq, 256, 256, m0, tn * 256, smem,
        [&](int mb, int nb, f32x16& acc, int r, int h) {
          const int rowl = mb - m0 + r;
          const float sc = rs[rowl];
#pragma unroll
          for (int e = 0; e < 16; ++e) acc[e] *= sc;
          const int cb = nb % 192;
          if (lat && cb >= 128) {
            const int s = s0 + rowl;
            const int pos = (cb == 128) ? (s >> 6) : (s & 63);
#pragma unroll
            for (int e = 0; e < 8; ++e) {
              const int j = crow(e, h);
              const float cs = p.ropetab[2 * (pos * 16 + j)], sn = p.ropetab[2 * (pos * 16 + j) + 1];
              const float x1 = acc[e], x2 = acc[e + 8];
              acc[e] = x1 * cs - x2 * sn;
              acc[e + 8] = x1 * sn + x2 * cs;
            }
          }
        },
        [&](int row, int col, u32x4 v) { *(u32x4*)(p.Q + (size_t)row * 768 + col) = v; }, noT, neverT);
  }
  for (int t = lbid(); t < MT * 4; t += gridDim.x) {
    const int tm = t / 4, tn = t % 4, m0 = tm * 256;
    const int b = m0 / SP, s0 = m0 % SP;
    const bool lat = s0 < SEQ;
    __syncthreads();
    row_rstd(p.P + 256, NINP, 128, m0, rs);
    if (tn == 0) {
      for (int idx = ltid(); idx < 256 * 32; idx += NTHR) {
        const int rowl = idx >> 5, q = idx & 31, blk = q >> 4, j = q & 15;
        const u16* src = p.P + (size_t)(m0 + rowl) * NINP + 384 + blk * 32 + j;
        float x1 = bf2f(src[0]), x2 = bf2f(src[16]);
        float o1 = x1, o2 = x2;
        if (lat) {
          const int s = s0 + rowl;
          const int pos = blk == 0 ? (s >> 6) : (s & 63);
          const float cs = p.ropetab[2 * (pos * 16 + j)], sn = p.ropetab[2 * (pos * 16 + j) + 1];
          o1 = x1 * cs - x2 * sn;
          o2 = x1 * sn + x2 * cs;
        }
        u16* dst = p.Kr + (size_t)(m0 + rowl) * 64 + blk * 32 + j;
        dst[0] = f2bf(o1);
        dst[16] = f2bf(o2);
      }
    }
    const int n0 = tn * 256;
    u16* vbase = p.Vt + (size_t)(b * 4 + tn) * 128 * SP + s0;
    gemm_tile<true>(
        p.P + 256, NINP, p.wt_ukv, 128, 128, m0, n0, smem,
        [&](int mb, int nb, f32x16& acc, int r, int h) {
          const float sc = rs[mb - m0 + r];
#pragma unroll
          for (int e = 0; e < 16; ++e) acc[e] *= sc;
        },
        [&](int row, int col, u32x4 v) { *(u32x4*)(p.Kn + (size_t)row * 512 + tn * 128 + (col - n0)) = v; },
        [&](int col, int row, u32x4 v) { *(u32x4*)(vbase + (size_t)(col - n0 - 128) * SP + (row - m0)) = v; },
        [](int wn) { return wn >= 2; });
  }
}

DI void cm_tasks(const Params& p, int layer, char* smem) {
  const int ftid = ltid(), vb = ftid >> 8, tid = ftid & 255;
  u16* vnT = (u16*)(smem + vb * VSMEM);
  const int lane = tid & 63, wid = tid >> 6, r = lane & 31, h = lane >> 5;
  const float* gn = p.cm_norm_g + layer * 256;
  const float* bs = p.cm_b_s + layer * 512;
  for (int t0 = lbid() * 2; t0 < NB * NCH; t0 += gridDim.x * 2) {
    const int task = t0 + vb;
    const int row0 = task * 128;
    __syncthreads();
    for (int i = 0; i < 32; ++i) {
      const int s = wid * 32 + i;
      const u16* src = p.P + (size_t)(row0 + s) * NINP + 704;
      float v[4];
      float sum = 0.f;
#pragma unroll
      for (int q = 0; q < 4; ++q) {
        v[q] = gelu_f(bf2f(src[lane + 64 * q]));
        sum += v[q];
      }
      const float mean = wave_sum(sum) * (1.f / 256.f);
      float var = 0.f;
#pragma unroll
      for (int q = 0; q < 4; ++q) {
        v[q] -= mean;
        var += v[q] * v[q];
      }
      const float rstd = rsqrtf(wave_sum(var) * (1.f / 256.f) + EPS);
#pragma unroll
      for (int q = 0; q < 4; ++q) vnT[(lane + 64 * q) * 136 + s] = f2bf(v[q] * rstd * gn[lane + 64 * q]);
    }
    __syncthreads();
    const int t = wid * 32 + r;
    for (int g = 0; g < 4; ++g) {
      bf16x8 wf[8];
#pragma unroll
      for (int kk = 0; kk < 8; ++kk) wf[kk] = *(const bf16x8*)(p.wsb + ((size_t)(g * 128 + t)) * 128 + kk * 16 + h * 8);
      const float bias = bs[g * 128 + t];
#pragma unroll
      for (int cb = 0; cb < 2; ++cb) {
        f32x16 acc;
#pragma unroll
        for (int e = 0; e < 16; ++e) acc[e] = 0.f;
#pragma unroll
        for (int kk = 0; kk < 8; ++kk) {
          bf16x8 a = *(const bf16x8*)(vnT + (g * 64 + cb * 32 + r) * 136 + kk * 16 + h * 8);
          acc = MFMA(a, wf[kk], acc);
        }
#pragma unroll
        for (int q4 = 0; q4 < 4; ++q4) {
          const int ch0 = g * 64 + cb * 32 + 8 * q4 + 4 * h;
          u32x2 uwd = *(const u32x2*)(p.P + (size_t)(row0 + t) * NINP + 448 + ch0);
          float u0 = gelu_f(bflo(uwd.x)), u1 = gelu_f(bfhi(uwd.x)), u2 = gelu_f(bflo(uwd.y)), u3 = gelu_f(bfhi(uwd.y));
          u32x2 w;
          w.x = pack2(u0 * (acc[4 * q4] + bias), u1 * (acc[4 * q4 + 1] + bias));
          w.y = pack2(u2 * (acc[4 * q4 + 2] + bias), u3 * (acc[4 * q4 + 3] + bias));
          *(u32x2*)(p.H + (size_t)(row0 + t) * D + 512 + ch0) = w;
        }
      }
    }
  }
}

DI void conv8(const Params& p, int layer, int row, int ch, bool hasPrev, bool hasNext, float out[8]) {
  const u16* base = p.P + (size_t)row * NINP + 1216 + ch;
  u32x4 cur = *(const u32x4*)base;
  u32x4 prv = u32x4{0u, 0u, 0u, 0u}, nxt = u32x4{0u, 0u, 0u, 0u};
  if (hasPrev) prv = *(const u32x4*)(base - NINP);
  if (hasNext) nxt = *(const u32x4*)(base + NINP);
  const float* cw = p.conv_w + (size_t)layer * 3 * 768 + ch;
  const float* cb = p.conv_b + layer * 768 + ch;
#pragma unroll
  for (int e = 0; e < 8; ++e) {
    float y = cw[e] * uw(prv, e) + cw[768 + e] * uw(cur, e) + cw[1536 + e] * uw(nxt, e) + cb[e];
    out[e] = silu_f(y);
  }
}

DI void ssd_dt_arrays(const Params& p, int layer, int row0, int hh, int t, float* arr) {
  float* dt0 = arr;
  float* dt1 = arr + 128;
  float* c0 = arr + 256;
  float* s1 = arr + 384;
  float* a0 = arr + 512;
  float* a1 = arr + 640;
  const float d0 = softplus_f(p.dtraw[(size_t)(row0 + t) * 8 + hh] + p.dt_bias[layer * 8 + hh]);
  const float d1 = softplus_f(p.dtraw[(size_t)(row0 + t) * 8 + 4 + hh] + p.dt_bias[layer * 8 + 4 + hh]);
  dt0[t] = d0;
  dt1[t] = d1;
  a0[t] = -d0 * __expf(p.a_log[layer * 8 + hh]);
  a1[t] = -d1 * __expf(p.a_log[layer * 8 + 4 + hh]);
}
DI void ssd_cum_arrays(int t, float* arr) {
  float* c0 = arr + 256;
  float* s1 = arr + 384;
  const float* a0 = arr + 512;
  const float* a1 = arr + 640;
  float s = 0.f;
  for (int k = 0; k <= t; ++k) s += a0[k];
  c0[t] = s;
  s = 0.f;
  for (int k = 127; k >= t; --k) s += a1[k];
  s1[t] = s;
}

DI void ssd_s1_tasks(const Params& p, int layer, char* smem) {
  const int ftid = ltid(), vb = ftid >> 8, tid = ftid & 255;
  u16* xsT0 = (u16*)(smem + vb * VSMEM);
  u16* xsT1 = xsT0 + 64 * 136;
  u16* BT = xsT1 + 64 * 136;
  float* arr = (float*)(BT + 128 * 136);
  float* w0 = arr + 768;
  float* w1 = w0 + 128;
  const int lane = tid & 63, wid = tid >> 6, r = lane & 31, h = lane >> 5;
  for (int t0 = lbid() * 2; t0 < NB * NCH * 4; t0 += gridDim.x * 2) {
    const int task = t0 + vb;
    const int hh = task & 3, bc = task >> 2, c = bc % NCH, b = bc / NCH;
    const int g = hh >> 1;
    const int row0 = bc * 128;
    const bool cPrev = (c != 0 && c != 32), cNext = (c != 31 && c != 33);
    __syncthreads();
    if (tid < 128) ssd_dt_arrays(p, layer, row0, hh, tid, arr);
    __syncthreads();
    if (tid < 128) ssd_cum_arrays(tid, arr);
    __syncthreads();
    if (tid < 128) {
      const float* dt0 = arr;
      const float* dt1 = arr + 128;
      const float* c0 = arr + 256;
      const float* s1 = arr + 384;
      w0[tid] = __expf(c0[127] - c0[tid]) * dt0[tid];
      w1[tid] = __expf(s1[0] - s1[tid]) * dt1[tid];
      if (tid == 0) {
        p.atot[((size_t)bc * 2 + 0) * 4 + hh] = c0[127];
        p.atot[((size_t)bc * 2 + 1) * 4 + hh] = s1[0];
      }
    }
    __syncthreads();
#pragma unroll 1
    for (int i = 0; i < 4; ++i) {
      const int id = tid + VT * i, t = id >> 3, cp = id & 7;
      float v[8];
      conv8(p, layer, row0 + t, hh * 64 + cp * 8, cPrev || t > 0, cNext || t < 127, v);
      const float f0 = w0[t], f1 = w1[t];
#pragma unroll
      for (int e = 0; e < 8; ++e) {
        xsT0[(cp * 8 + e) * 136 + t] = f2bf(v[e] * f0);
        xsT1[(cp * 8 + e) * 136 + t] = f2bf(v[e] * f1);
      }
    }
#pragma unroll 1
    for (int i = 0; i < 8; ++i) {
      const int id = tid + VT * i, t = id >> 4, cp = id & 15;
      float v[8];
      conv8(p, layer, row0 + t, 256 + g * 128 + cp * 8, cPrev || t > 0, cNext || t < 127, v);
#pragma unroll
      for (int e = 0; e < 8; ++e) BT[(cp * 8 + e) * 136 + t] = f2bf(v[e]);
    }
    __syncthreads();
#pragma unroll
    for (int d = 0; d < 2; ++d) {
      const u16* xsT = d ? xsT1 : xsT0;
#pragma unroll
      for (int pb = 0; pb < 2; ++pb) {
        f32x16 acc;
#pragma unroll
        for (int e = 0; e < 16; ++e) acc[e] = 0.f;
#pragma unroll
        for (int kk = 0; kk < 8; ++kk) {
          bf16x8 a = *(const bf16x8*)(xsT + (pb * 32 + r) * 136 + kk * 16 + h * 8);
          bf16x8 bb = *(const bf16x8*)(BT + (wid * 32 + r) * 136 + kk * 16 + h * 8);
          acc = MFMA(a, bb, acc);
        }
        float* dst = p.CS + ((((size_t)bc * 2 + d) * 4 + hh) * 64 + pb * 32) * 128 + wid * 32 + r;
#pragma unroll
        for (int e = 0; e < 16; ++e) dst[(size_t)crow(e, h) * 128] = acc[e];
      }
    }
  }
}

DI void ssd_scan_phase(const Params& p) {
  const int total = NB * 2 * 4 * 8192;
  for (int idx = lbid() * NTHR + ltid(); idx < total; idx += gridDim.x * NTHR) {
    const int e = idx & 8191, hh = (idx >> 13) & 3, d = (idx >> 15) & 1, b = idx >> 16;
    float st = 0.f;
#pragma unroll 2
    for (int i = 0; i < NCH; ++i) {
      int c;
      if (d == 0) c = i < 2 ? 32 + i : i - 2;
      else c = i < 2 ? 33 - i : 33 - i;
      const size_t bc = (size_t)b * NCH + c;
      float* ptr = p.CS + ((bc * 2 + d) * 4 + hh) * 8192 + e;
      const float v = *ptr;
      const float dec = __expf(p.atot[(bc * 2 + d) * 4 + hh]);
      *ptr = st;
      st = dec * st + v;
    }
  }
}

template <int G>
DI float ssd_s3_group(const Params& p, int layer, int bc, bool cPrev, bool cNext, u16* Bg, u16* xsT, float* arr, int tid) {
  f32x16 y[4];
#pragma unroll
  for (int i = 0; i < 4; ++i)
#pragma unroll
    for (int e = 0; e < 16; ++e) y[i][e] = 0.f;
  const int lane = tid & 63, wid = tid >> 6, r = lane & 31, h = lane >> 5;
  const int l = wid * 32 + r;
  const int row0 = bc * 128;
  __syncthreads();
  ssd_dt_arrays(p, layer, row0, 2 * G + (tid >> 7), tid & 127, arr + (tid >> 7) * 768);
#pragma unroll 1
  for (int i = 0; i < 8; ++i) {
    const int id = tid + VT * i, t = id >> 4, cp = id & 15;
    float v[8];
    conv8(p, layer, row0 + t, 512 + G * 128 + cp * 8, cPrev || t > 0, cNext || t < 127, v);
    *(bf16x8*)(Bg + t * 136 + cp * 8) = pack8(v[0], v[1], v[2], v[3], v[4], v[5], v[6], v[7]);
  }
#pragma unroll 1
  for (int i = 0; i < 8; ++i) {
    const int id = tid + VT * i, t = id >> 4, cp = id & 15;
    float v[8];
    conv8(p, layer, row0 + t, G * 128 + cp * 8, cPrev || t > 0, cNext || t < 127, v);
#pragma unroll
    for (int e = 0; e < 8; ++e) xsT[(cp * 8 + e) * 136 + t] = f2bf(v[e]);
  }
  __syncthreads();
  ssd_cum_arrays(tid & 127, arr + (tid >> 7) * 768);
  bf16x8 cf[8];
#pragma unroll
  for (int kk = 0; kk < 8; ++kk) cf[kk] = *(const bf16x8*)(Bg + l * 136 + kk * 16 + h * 8);
  __syncthreads();
#pragma unroll 1
  for (int i = 0; i < 8; ++i) {
    const int id = tid + VT * i, t = id >> 4, cp = id & 15;
    float v[8];
    conv8(p, layer, row0 + t, 256 + G * 128 + cp * 8, cPrev || t > 0, cNext || t < 127, v);
    *(bf16x8*)(Bg + t * 136 + cp * 8) = pack8(v[0], v[1], v[2], v[3], v[4], v[5], v[6], v[7]);
  }
  __syncthreads();
  float ss = 0.f;
#pragma unroll 1
  for (int hd2 = 0; hd2 < 2; ++hd2) {
    const int hh = 2 * G + hd2;
    const float* ah = arr + hd2 * 768;
    const float c0l = ah[256 + l], s1l = ah[384 + l];
    f32x16 y[2];
#pragma unroll
    for (int i = 0; i < 2; ++i)
#pragma unroll
      for (int e = 0; e < 16; ++e) y[i][e] = 0.f;
#pragma unroll 1
    for (int sb = 0; sb < 4; ++sb) {
      f32x16 gt;
#pragma unroll
      for (int e = 0; e < 16; ++e) gt[e] = 0.f;
#pragma unroll
      for (int kk = 0; kk < 8; ++kk) {
        bf16x8 a = *(const bf16x8*)(Bg + (sb * 32 + r) * 136 + kk * 16 + h * 8);
        gt = MFMA(a, cf[kk], gt);
      }
      f32x16 wv;
#pragma unroll
      for (int e = 0; e < 16; ++e) {
        const int s = sb * 32 + crow(e, h);
        const float a0 = (l >= s) ? (c0l - ah[256 + s]) : -1e30f;
        const float a1 = (l <= s) ? (s1l - ah[384 + s]) : -1e30f;
        const float f = __expf(a0) * ah[s] + __expf(a1) * ah[128 + s];
        wv[e] = gt[e] * f;
      }
      bf16x8 wp0 = pack8(wv[0], wv[1], wv[2], wv[3], wv[4], wv[5], wv[6], wv[7]);
      bf16x8 wp1 = pack8(wv[8], wv[9], wv[10], wv[11], wv[12], wv[13], wv[14], wv[15]);
#pragma unroll
      for (int pb = 0; pb < 2; ++pb) {
        const u16* xrow = xsT + (hd2 * 64 + pb * 32 + r) * 136 + sb * 32 + 4 * h;
        s16x4 lo0 = *(const s16x4*)(xrow), hi0 = *(const s16x4*)(xrow + 8);
        s16x4 lo1 = *(const s16x4*)(xrow + 16), hi1 = *(const s16x4*)(xrow + 24);
        bf16x8 a0 = __builtin_shufflevector(lo0, hi0, 0, 1, 2, 3, 4, 5, 6, 7);
        bf16x8 a1 = __builtin_shufflevector(lo1, hi1, 0, 1, 2, 3, 4, 5, 6, 7);
        y[pb] = MFMA(a0, wp0, y[pb]);
        y[pb] = MFMA(a1, wp1, y[pb]);
      }
    }
#pragma unroll 1
    for (int d = 0; d < 2; ++d) {
      const float el = __expf(d == 0 ? c0l : s1l);
#pragma unroll
      for (int pb = 0; pb < 2; ++pb) {
        const float* srow = p.CS + ((((size_t)bc * 2 + d) * 4 + hh) * 64 + pb * 32 + r) * 128 + h * 8;
        f32x16 tmp;
#pragma unroll
        for (int e = 0; e < 16; ++e) tmp[e] = 0.f;
#pragma unroll
        for (int kk = 0; kk < 8; ++kk) {
          f32x4 s0 = *(const f32x4*)(srow + kk * 16), s1 = *(const f32x4*)(srow + kk * 16 + 4);
          bf16x8 a = pack8(s0.x, s0.y, s0.z, s0.w, s1.x, s1.y, s1.z, s1.w);
          tmp = MFMA(a, cf[kk], tmp);
        }
#pragma unroll
        for (int e = 0; e < 16; ++e) y[pb][e] += el * tmp[e];
      }
    }
    const float dsk = p.ssd_d[layer * 8 + hh] + p.ssd_d[layer * 8 + 4 + hh];
#pragma unroll
    for (int pb = 0; pb < 2; ++pb) {
#pragma unroll
      for (int q4 = 0; q4 < 4; ++q4) {
        const int cl = hd2 * 64 + pb * 32 + 8 * q4 + 4 * h;
        const int ch0 = G * 128 + cl;
        u32x2 zw = *(const u32x2*)(p.P + (size_t)(row0 + l) * NINP + 960 + ch0);
        f32x4 o;
        o.x = (y[pb][4 * q4] + dsk * bf2f(xsT[(cl + 0) * 136 + l])) * silu_f(bflo(zw.x));
        o.y = (y[pb][4 * q4 + 1] + dsk * bf2f(xsT[(cl + 1) * 136 + l])) * silu_f(bfhi(zw.x));
        o.z = (y[pb][4 * q4 + 2] + dsk * bf2f(xsT[(cl + 2) * 136 + l])) * silu_f(bflo(zw.y));
        o.w = (y[pb][4 * q4 + 3] + dsk * bf2f(xsT[(cl + 3) * 136 + l])) * silu_f(bfhi(zw.y));
        ss += o.x * o.x + o.y * o.y + o.z * o.z + o.w * o.w;
        *(f32x4*)(p.ytmp + (size_t)(row0 + l) * 256 + ch0) = o;
      }
    }
  }
  return ss;
}

DI void ssd_s3_tasks(const Params& p, int layer, char* smem) {
  const int ftid = ltid(), vb = ftid >> 8, tid = ftid & 255;
  u16* Bg = (u16*)(smem + vb * VSMEM);
  u16* xsT = Bg + 128 * 136;
  float* arr = (float*)(xsT + 128 * 136);
  const int lane = tid & 63, wid = tid >> 6, r = lane & 31, h = lane >> 5;
  const int l = wid * 32 + r;
  for (int t0 = lbid() * 2; t0 < NB * NCH; t0 += gridDim.x * 2) {
    const int bc = t0 + vb, c = bc % NCH;
    const int row0 = bc * 128;
    const bool cPrev = (c != 0 && c != 32), cNext = (c != 31 && c != 33);
    float ss = ssd_s3_group<0>(p, layer, bc, cPrev, cNext, Bg, xsT, arr, tid);
    ss += ssd_s3_group<1>(p, layer, bc, cPrev, cNext, Bg, xsT, arr, tid);
    ss += __shfl_xor(ss, 32);
    const float rstd = rsqrtf(ss * (1.f / 256.f) + EPS);
    const float* gn = p.ssd_norm_g + layer * 256;
#pragma unroll 4
    for (int i = 0; i < 32; ++i) {
      const int ch0 = (i >> 2) * 32 + 8 * (i & 3) + 4 * h;
      f32x4 v = *(const f32x4*)(p.ytmp + (size_t)(row0 + l) * 256 + ch0);
      f32x4 gv = *(const f32x4*)(gn + ch0);
      u32x2 w;
      w.x = pack2(v.x * rstd * gv.x, v.y * rstd * gv.y);
      w.y = pack2(v.z * rstd * gv.z, v.w * rstd * gv.w);
      *(u32x2*)(p.H + (size_t)(row0 + l) * D + 768 + ch0) = w;
    }
  }
}

DI void attn_tasks(const Params& p, char* smem) {
  u16* Ks = (u16*)smem;
  u16* Vs = Ks + 64 * 200;
  const int tid = ltid(), lane = tid & 63, wid = tid >> 6, r = lane & 31, h = lane >> 5;
  const float sc = 0.07216878364870322f * 1.4426950408889634f;
  for (int task = lbid(); task < NB * 4 * 17; task += gridDim.x) {
    int b, hd, qt;
    if (task < 512) {
      qt = task & 15; hd = (task >> 4) & 3; b = task >> 6;
    } else {
      const int t2 = task - 512;
      qt = 16; hd = t2 & 3; b = t2 >> 2;
    }
    const int koff = (qt < 16) ? 0 : SEQ;
    const int nkt = ((qt < 16) ? SP : CTX) / 64;
    const int qrow = b * SP + qt * 256 + wid * 32 + r;
    bf16x8 qf[12];
#pragma unroll
    for (int kk = 0; kk < 12; ++kk) qf[kk] = *(const bf16x8*)(p.Q + (size_t)qrow * 768 + hd * 192 + kk * 16 + h * 8);
    f32x16 o[4];
#pragma unroll
    for (int i = 0; i < 4; ++i)
#pragma unroll
      for (int e = 0; e < 16; ++e) o[i][e] = 0.f;
    float m_run = -1e30f, l_run = 0.f;
    u32x4 kn[2], kr[1], vv[2];
    const u16* knb = p.Kn + ((size_t)(b * SP + koff) + (tid >> 4)) * 512 + hd * 128 + (tid & 15) * 8;
    const u16* krb = p.Kr + ((size_t)(b * SP + koff) + (tid >> 3)) * 64 + (tid & 7) * 8;
    const u16* vb = p.Vt + ((size_t)(b * 4 + hd) * 128 + (tid >> 3)) * SP + koff + (tid & 7) * 8;
#pragma unroll
    for (int i = 0; i < 2; ++i) kn[i] = *(const u32x4*)(knb + (size_t)(32 * i) * 512);
    kr[0] = *(const u32x4*)(krb);
#pragma unroll
    for (int i = 0; i < 2; ++i) vv[i] = *(const u32x4*)(vb + (size_t)(64 * i) * SP);
    for (int kt = 0; kt < nkt; ++kt) {
      __syncthreads();
#pragma unroll
      for (int i = 0; i < 2; ++i) *(u32x4*)(Ks + ((tid >> 4) + 32 * i) * 200 + (tid & 15) * 8) = kn[i];
      *(u32x4*)(Ks + (tid >> 3) * 200 + 128 + (tid & 7) * 8) = kr[0];
#pragma unroll
      for (int i = 0; i < 2; ++i) {
        u16* dst = Vs + ((tid >> 3) + 64 * i) * 68 + (tid & 7) * 8;
        *(u32x2*)dst = u32x2{vv[i].x, vv[i].y};
        *(u32x2*)(dst + 4) = u32x2{vv[i].z, vv[i].w};
      }
      __syncthreads();
      if (kt + 1 < nkt) {
        const size_t ko = (size_t)(kt + 1) * 64;
#pragma unroll
        for (int i = 0; i < 2; ++i) kn[i] = *(const u32x4*)(knb + (ko + 32 * i) * 512);
        kr[0] = *(const u32x4*)(krb + ko * 64);
#pragma unroll
        for (int i = 0; i < 2; ++i) vv[i] = *(const u32x4*)(vb + (size_t)(64 * i) * SP + ko);
      }
      f32x16 st[2];
#pragma unroll
      for (int kb = 0; kb < 2; ++kb) {
#pragma unroll
        for (int e = 0; e < 16; ++e) st[kb][e] = 0.f;
#pragma unroll
        for (int kk = 0; kk < 12; ++kk) {
          bf16x8 a = *(const bf16x8*)(Ks + (kb * 32 + r) * 200 + kk * 16 + h * 8);
          st[kb] = MFMA(a, qf[kk], st[kb]);
        }
      }
      float mx = st[0][0];
#pragma unroll
      for (int kb = 0; kb < 2; ++kb)
#pragma unroll
        for (int e = 0; e < 16; ++e) mx = fmaxf(mx, st[kb][e]);
      mx = fmaxf(mx, __shfl_xor(mx, 32));
      const float m_new = fmaxf(m_run, mx * sc);
      const float alpha = __builtin_amdgcn_exp2f(m_run - m_new);
      m_run = m_new;
      float ls = 0.f;
#pragma unroll
      for (int kb = 0; kb < 2; ++kb)
#pragma unroll
        for (int e = 0; e < 16; ++e) {
          float pv = __builtin_amdgcn_exp2f(fmaf(st[kb][e], sc, -m_new));
          ls += pv;
          st[kb][e] = pv;
        }
      l_run = l_run * alpha + ls;
#pragma unroll
      for (int i = 0; i < 4; ++i)
#pragma unroll
        for (int e = 0; e < 16; ++e) o[i][e] *= alpha;
#pragma unroll
      for (int ks = 0; ks < 4; ++ks) {
        const int kb = ks >> 1, s2 = ks & 1;
        bf16x8 pf = pack8(st[kb][8 * s2], st[kb][8 * s2 + 1], st[kb][8 * s2 + 2], st[kb][8 * s2 + 3], st[kb][8 * s2 + 4],
                          st[kb][8 * s2 + 5], st[kb][8 * s2 + 6], st[kb][8 * s2 + 7]);
#pragma unroll
        for (int db = 0; db < 4; ++db) {
          const u16* vr = Vs + (db * 32 + r) * 68 + ks * 16 + 4 * h;
          s16x4 lo = *(const s16x4*)vr, hi = *(const s16x4*)(vr + 8);
          bf16x8 a = __builtin_shufflevector(lo, hi, 0, 1, 2, 3, 4, 5, 6, 7);
          o[db] = MFMA(a, pf, o[db]);
        }
      }
    }
    const float ltot = l_run + __shfl_xor(l_run, 32);
    const float inv = 1.f / ltot;
    u16* orow = p.H + (size_t)qrow * D + hd * 128;
#pragma unroll
    for (int db = 0; db < 4; ++db)
#pragma unroll
      for (int q4 = 0; q4 < 4; ++q4) {
        u32x2 w;
        w.x = pack2(o[db][4 * q4] * inv, o[db][4 * q4 + 1] * inv);
        w.y = pack2(o[db][4 * q4 + 2] * inv, o[db][4 * q4 + 3] * inv);
        *(u32x2*)(orow + db * 32 + 8 * q4 + 4 * h) = w;
      }
  }
}

constexpr int NPHASE = 1 + DEPTH * 9 + 1;

DI void run_phase(const Params& p, int ph, char* smem) {
  if (ph == 0) { prologue_phase(p, smem); return; }
  if (ph == NPHASE - 1) { ew_phase(p, DEPTH, 2); return; }
  const int layer = (ph - 1) / 9, sub = (ph - 1) % 9;
  const int MT = T / 256;
  auto noT = [](int, int, u32x4) {};
  auto neverT = [](int) { return false; };
  switch (sub) {
    case 0: {
      ew_phase(p, layer, 0);
      convert_weights(p.w_in + (size_t)layer * D * NIN, D, NIN, NINP, p.wt_in, nullptr, smem);
      convert_weights(p.w_uq + (size_t)layer * 256 * 768, 256, 768, 768, p.wt_uq, p.g_q + layer * 256, smem);
      convert_weights(p.w_ukv + (size_t)layer * 128 * 1024, 128, 1024, 1024, p.wt_ukv, p.g_kv + layer * 128, smem);
      convert_weights(p.w_out + (size_t)layer * D * D, D, D, D, p.wt_out, nullptr, smem);
      for (int i = lbid() * NTHR + ltid(); i < 4 * 128 * 128; i += gridDim.x * NTHR)
        p.wsb[i] = f2bf(p.cm_w_s[(size_t)layer * 65536 + i]);
    } break;
    case 1: {
      for (int it = 0;; ++it) {
        const int t = xcd_tile(it, MT * 8);
        if (t < 0) break;
        const int tm = t >> 3, tn = t & 7;
        gemm_tile<false>(
            p.H, D, p.wt_in, D, D, tm * 256, tn * 256, smem,
            [&](int mb, int nb, f32x16& acc, int r, int h) {
              if (nb == 1984) {
                f32x4 v = {acc[0], acc[1], acc[2], acc[3]};
                *(f32x4*)(p.dtraw + (size_t)(mb + r) * 8 + 4 * h) = v;
              }
            },
            [&](int row, int col, u32x4 v) { *(u32x4*)(p.P + (size_t)row * NINP + col) = v; }, noT, neverT);
      }
    } break;
    case 2: {
      qkv_tasks(p, smem);
      cm_tasks(p, layer, smem);
      ssd_s1_tasks(p, layer, smem);
    } break;
    case 3: ssd_scan_phase(p); break;
    case 4: {
      attn_tasks(p, smem);
      ssd_s3_tasks(p, layer, smem);
    } break;
    case 5: {
      for (int it = 0;; ++it) {
        const int t = xcd_tile(it, MT * 4);
        if (t < 0) break;
        const int tm = t >> 2, tn = t & 3;
        gemm_tile<false>(
            p.H, D, p.wt_out, D, D, tm * 256, tn * 256, smem, [](int, int, f32x16&, int, int) {},
            [&](int row, int col, u32x4 v) { *(u32x4*)(p.Y + (size_t)row * D + col) = v; }, noT, neverT);
      }
    } break;
    case 6: {
      ew_phase(p, layer, 1);
      convert_weights(p.w_ff1 + (size_t)layer * D * DFF, D, DFF, DFF, p.wt_ff1, nullptr, smem);
      convert_weights(p.w_ff2 + (size_t)layer * DFF * D, DFF, D, D, p.wt_ff2, nullptr, smem);
    } break;
    case 7: {
      for (int it = 0;; ++it) {
        const int t = xcd_tile(it, MT * 16);
        if (t < 0) break;
        const int tm = t >> 4, tn = t & 15;
        gemm_tile<false>(
            p.H, D, p.wt_ff1, D, D, tm * 256, tn * 256, smem,
            [](int, int, f32x16& acc, int, int) {
#pragma unroll
              for (int e = 0; e < 16; ++e) {
                float v = fmaxf(acc[e], 0.f);
                acc[e] = v * v;
              }
            },
            [&](int row, int col, u32x4 v) { *(u32x4*)(p.Hd + (size_t)row * DFF + col) = v; }, noT, neverT);
      }
    } break;
    case 8: {
      for (int it = 0;; ++it) {
        const int t = xcd_tile(it, MT * 4);
        if (t < 0) break;
        const int tm = t >> 2, tn = t & 3;
        gemm_tile<false>(
            p.Hd, DFF, p.wt_ff2, DFF, DFF, tm * 256, tn * 256, smem, [](int, int, f32x16&, int, int) {},
            [&](int row, int col, u32x4 v) { *(u32x4*)(p.F + (size_t)row * D + col) = v; }, noT, neverT);
      }
    } break;
  }
}

__global__ void __launch_bounds__(NTHR, 2) mega_kernel(Params p, int ph_begin, int ph_end) {
  extern __shared__ __attribute__((aligned(16))) char smem[];
  cg::grid_group grid = cg::this_grid();
  for (int ph = ph_begin; ph < ph_end; ++ph) {
    run_phase(p, ph, smem);
#ifdef PROBE_MASK
    if (ph > 0 && ph < NPHASE - 1 && ((PROBE_MASK >> ((ph - 1) % 9)) & 1)) {
      grid.sync();
      run_phase(p, ph, smem);
    }
#endif
    if (ph + 1 < ph_end) grid.sync();
  }
}

extern "C" void kernel_launch(void* const* d_in, const int* in_sizes, int n_in, void* d_out, int out_size, void* d_ws,
                              size_t ws_size, hipStream_t stream) {
  Params p{};
  const float* const* in = (const float* const*)d_in;
  p.x = in[0]; p.c = in[1]; p.ctx = in[2]; p.c_ctx = in[3]; p.w_ada = in[4]; p.b_ada = in[5];
  p.g_pre_mix = in[6]; p.g_post_mix = in[7]; p.g_pre_ff = in[8]; p.g_post_ff = in[9]; p.w_in = in[10];
  p.g_q = in[11]; p.w_uq = in[12]; p.g_kv = in[13]; p.w_ukv = in[14]; p.cm_norm_g = in[15]; p.cm_w_s = in[16];
  p.cm_b_s = in[17]; p.conv_w = in[18]; p.conv_b = in[19]; p.dt_bias = in[20]; p.a_log = in[21]; p.ssd_d = in[22];
  p.ssd_norm_g = in[23]; p.w_out = in[24]; p.w_ff1 = in[25]; p.w_ff2 = in[26];
  p.out = (float*)d_out;
  char* ws = (char*)d_ws;
  size_t off = 0;
  auto take = [&](size_t bytes) { char* q = ws + off; off += (bytes + 255) & ~(size_t)255; return q; };
  p.wt_in = (u16*)take((size_t)NINP * D * 2);
  p.wt_uq = (u16*)take((size_t)768 * 256 * 2);
  p.wt_ukv = (u16*)take((size_t)1024 * 128 * 2);
  p.wt_out = (u16*)take((size_t)D * D * 2);
  p.wt_ff1 = (u16*)take((size_t)DFF * D * 2);
  p.wt_ff2 = (u16*)take((size_t)D * DFF * 2);
  p.wsb = (u16*)take((size_t)4 * 128 * 128 * 2);
  p.mod = (float*)take((size_t)DEPTH * 9 * 6144 * 4);
  p.ropetab = (float*)take((size_t)64 * 16 * 2 * 4);
  p.atot = (float*)take((size_t)NB * NCH * 2 * 4 * 4);
  p.xctx = (float*)take((size_t)NB * CTX * D * 4);
  char* r1 = take((size_t)T * DFF * 2);
  p.Hd = (u16*)r1;
  p.Y = (u16*)r1;
  {
    size_t o2 = 0;
    p.P = (u16*)(r1 + o2); o2 += (size_t)T * NINP * 2;
    p.Q = (u16*)(r1 + o2); o2 += (size_t)T * 768 * 2;
    p.Kn = (u16*)(r1 + o2); o2 += (size_t)T * 512 * 2;
    p.Kr = (u16*)(r1 + o2); o2 += (size_t)T * 64 * 2;
    p.Vt = (u16*)(r1 + o2); o2 += (size_t)NB * 4 * 128 * SP * 2;
    p.dtraw = (float*)(r1 + o2); o2 += (size_t)T * 8 * 4;
  }
  p.H = (u16*)take((size_t)T * D * 2);
  p.CS = (float*)take((size_t)NB * NCH * 2 * 4 * 8192 * 4);
  p.F = (u16*)p.CS;
  p.ytmp = (float*)take((size_t)T * 256 * 4);
  if (off > ws_size) {
    fprintf(stderr, "workspace too small: need %zu have %zu\n", off, ws_size);
    return;
  }
  static int grid_blocks = 0;
  if (!grid_blocks) {
    int dev = 0, cus = 0, per_cu = 0;
    hipGetDevice(&dev);
    hipDeviceGetAttribute(&cus, hipDeviceAttributeMultiprocessorCount, dev);
    hipFuncSetAttribute((const void*)mega_kernel, hipFuncAttributeMaxDynamicSharedMemorySize, SMEM_BYTES);
    hipOccupancyMaxActiveBlocksPerMultiprocessor(&per_cu, mega_kernel, NTHR, SMEM_BYTES);
    if (per_cu < 1) per_cu = 1;
    if (per_cu > 1) per_cu = 1;
    grid_blocks = cus * per_cu;
  }
  int pb = 0, pe = NPHASE;
  void* args[] = {&p, &pb, &pe};
  hipError_t e = hipLaunchCooperativeKernel((void*)mega_kernel, dim3(grid_blocks), dim3(NTHR), args, SMEM_BYTES, stream);
  if (e != hipSuccess) fprintf(stderr, "cooperative launch failed: %s (grid %d)\n", hipGetErrorString(e), grid_blocks);
}
```

```cpp
#include <hip/hip_runtime.h>
#include <hip/hip_cooperative_groups.h>
#include <cstdio>
namespace cg = cooperative_groups;

#define DI __device__ __forceinline__
typedef unsigned short u16;
using bf16x8 = __attribute__((ext_vector_type(8))) short;
using s16x4 = __attribute__((ext_vector_type(4))) short;
using f32x16 = __attribute__((ext_vector_type(16))) float;
using u32x4 = __attribute__((ext_vector_type(4))) unsigned;
using u32x2 = __attribute__((ext_vector_type(2))) unsigned;
using f32x4 = __attribute__((ext_vector_type(4))) float;
typedef __bf16 bf2_t __attribute__((ext_vector_type(2)));
typedef float f2_t __attribute__((ext_vector_type(2)));
#define MFMA(a, b, c) __builtin_amdgcn_mfma_f32_32x32x16_bf16((a), (b), (c), 0, 0, 0)

constexpr int NB = 8, SEQ = 4096, CTX = 256, SP = 4352, T = NB * SP, D = 1024, DFF = 4096;
constexpr int NIN = 1992, NINP = 2048, NCH = 34, DEPTH = 4;
constexpr int NTHR = 512;
constexpr int VT = 256;
constexpr int VSMEM = 75 * 1024;
constexpr int SMEM_BYTES = 2 * VSMEM;
constexpr float EPS = 1e-6f;

struct Params {
  const float *x, *c, *ctx, *c_ctx, *w_ada, *b_ada, *g_pre_mix, *g_post_mix, *g_pre_ff, *g_post_ff, *w_in, *g_q, *w_uq,
      *g_kv, *w_ukv, *cm_norm_g, *cm_w_s, *cm_b_s, *conv_w, *conv_b, *dt_bias, *a_log, *ssd_d, *ssd_norm_g, *w_out,
      *w_ff1, *w_ff2;
  float* out;
  u16 *wt_in, *wt_uq, *wt_ukv, *wt_out, *wt_ff1, *wt_ff2, *wsb;
  float *mod, *ropetab, *atot, *xctx;
  u16 *P, *Q, *Kn, *Kr, *Vt, *Hd;
  u16* Y;
  float* dtraw;
  u16* H;
  float* CS;
  u16* F;
  float* ytmp;
};

DI int ltid() { int t = threadIdx.x; asm volatile("" : "+v"(t)); return t; }
DI int lbid() { int t = blockIdx.x; asm volatile("" : "+s"(t)); return t; }
DI int crow(int e, int h) { return (e & 3) + 8 * (e >> 2) + 4 * h; }
DI unsigned pack2(float a, float b) {
  f2_t v = {a, b};
  bf2_t r = __builtin_convertvector(v, bf2_t);
  return __builtin_bit_cast(unsigned, r);
}
DI u16 f2bf(float a) { return (u16)(pack2(a, 0.f) & 0xffffu); }
DI float bf2f(u16 v) { return __uint_as_float(((unsigned)v) << 16); }
DI float bflo(unsigned w) { return __uint_as_float(w << 16); }
DI float bfhi(unsigned w) { return __uint_as_float(w & 0xffff0000u); }
DI bf16x8 pack8(float a0, float a1, float a2, float a3, float a4, float a5, float a6, float a7) {
  u32x4 u;
  u.x = pack2(a0, a1); u.y = pack2(a2, a3); u.z = pack2(a4, a5); u.w = pack2(a6, a7);
  return __builtin_bit_cast(bf16x8, u);
}
DI float wave_sum(float v) {
#pragma unroll
  for (int o = 32; o > 0; o >>= 1) v += __shfl_xor(v, o);
  return v;
}
DI float silu_f(float y) { return y * __builtin_amdgcn_rcpf(1.f + __expf(-y)); }
DI float gelu_f(float x) {
  float u = 0.7978845608028654f * (x + 0.044715f * x * x * x);
  float t = 1.f - 2.f * __builtin_amdgcn_rcpf(1.f + __expf(2.f * u));
  return 0.5f * x * (1.f + t);
}
DI float softplus_f(float x) { return x > 20.f ? x : log1pf(__expf(x)); }
DI float uw(const u32x4& v, int i) {
  unsigned w = (i >> 1) == 0 ? v.x : (i >> 1) == 1 ? v.y : (i >> 1) == 2 ? v.z : v.w;
  return (i & 1) ? bfhi(w) : bflo(w);
}

template <bool HAS_T, class ElemF, class StoreF, class StoreTF, class UseTF>
DI void gemm_tile(const u16* __restrict__ A, int lda, const u16* __restrict__ Bt, int ldb, int K, int m0, int n0,
                  char* smem, ElemF elem, StoreF store, StoreTF storeT, UseTF useT) {
  constexpr int LS = 72;
  constexpr int STAGE = 2 * 256 * LS;
  u16* base = (u16*)smem;
  const int tid = ltid(), lane = tid & 63, wid = tid >> 6, wm = wid >> 2, wn = wid & 3, r = lane & 31, h = lane >> 5;
  f32x16 acc[4][2];
#pragma unroll
  for (int i = 0; i < 4; ++i)
#pragma unroll
    for (int j = 0; j < 2; ++j)
#pragma unroll
      for (int e = 0; e < 16; ++e) acc[i][j][e] = 0.f;
  u32x4 ra[4], rb[4];
  const int lrow = tid >> 3, lcp = (tid & 7) * 8;
  const u16* ga = A + (size_t)(m0 + lrow) * lda + lcp;
  const u16* gb = Bt + (size_t)(n0 + lrow) * ldb + lcp;
  const int wofs = lrow * LS + lcp;
  const int aofs = (wm * 128 + r) * LS + h * 8;
  const int bofs = 256 * LS + (wn * 64 + r) * LS + h * 8;
#define GLOAD(kt_)                                                           \
  _Pragma("unroll") for (int i = 0; i < 4; ++i) {                            \
    ra[i] = *(const u32x4*)(ga + (size_t)(64 * i) * lda + (kt_) * 64);       \
    rb[i] = *(const u32x4*)(gb + (size_t)(64 * i) * ldb + (kt_) * 64);       \
  }
#define SWRITE(st_)                                                          \
  _Pragma("unroll") for (int i = 0; i < 4; ++i) {                            \
    *(u32x4*)((st_) + wofs + 64 * i * LS) = ra[i];                           \
    *(u32x4*)((st_) + 256 * LS + wofs + 64 * i * LS) = rb[i];                \
  }
#define FREAD(dst_, st_, kk_)                                                                      \
  _Pragma("unroll") for (int i = 0; i < 4; ++i) af[dst_][i] = *(const bf16x8*)((st_) + aofs + i * 32 * LS + (kk_) * 16); \
  _Pragma("unroll") for (int j = 0; j < 2; ++j) bfr[dst_][j] = *(const bf16x8*)((st_) + bofs + j * 32 * LS + (kk_) * 16);
#define MMAS(src_)                                                           \
  _Pragma("unroll") for (int i = 0; i < 4; ++i)                              \
  _Pragma("unroll") for (int j = 0; j < 2; ++j) acc[i][j] = MFMA(bfr[src_][j], af[src_][i], acc[i][j]);
  const int nk = K >> 6;
  bf16x8 af[2][4], bfr[2][2];
  GLOAD(0);
  __syncthreads();
  SWRITE(base);
  if (nk > 1) { GLOAD(1); }
  __syncthreads();
  FREAD(0, base, 0);
  for (int kt = 0; kt < nk; ++kt) {
    u16* cur = base + (kt & 1) * STAGE;
    u16* nxt = base + ((kt + 1) & 1) * STAGE;
    FREAD(1, cur, 1);
    if (kt + 1 < nk) { SWRITE(nxt); }
    MMAS(0);
    __builtin_amdgcn_sched_barrier(0);
    if (kt + 2 < nk) { GLOAD(kt + 2); }
    FREAD(0, cur, 2);
    MMAS(1);
    __builtin_amdgcn_sched_barrier(0);
    FREAD(1, cur, 3);
    MMAS(0);
    __builtin_amdgcn_sched_barrier(0);
    __syncthreads();
    if (kt + 1 < nk) { FREAD(0, nxt, 0); }
    MMAS(1);
    __builtin_amdgcn_sched_barrier(0);
  }
#undef GLOAD
#undef SWRITE
#undef FREAD
#undef MMAS
#pragma unroll
  for (int i = 0; i < 4; ++i)
#pragma unroll
    for (int j = 0; j < 2; ++j) elem(m0 + wm * 128 + i * 32, n0 + wn * 64 + j * 32, acc[i][j], r, h);
  u16* stg = base + wid * (128 * 72);
  if (HAS_T && useT(wn)) {
#pragma unroll
    for (int i = 0; i < 4; ++i)
#pragma unroll
      for (int j = 0; j < 2; ++j)
#pragma unroll
        for (int e = 0; e < 16; ++e) stg[(j * 32 + crow(e, h)) * 136 + i * 32 + r] = f2bf(acc[i][j][e]);
    __builtin_amdgcn_wave_barrier();
#pragma unroll 4
    for (int t = 0; t < 16; ++t) {
      const int id = lane + 64 * t, cl = id >> 4, cp = id & 15;
      u32x4 v = *(const u32x4*)(stg + cl * 136 + cp * 8);
      storeT(n0 + wn * 64 + cl, m0 + wm * 128 + cp * 8, v);
    }
  } else {
#pragma unroll
    for (int i = 0; i < 4; ++i)
#pragma unroll
      for (int j = 0; j < 2; ++j)
#pragma unroll
        for (int q4 = 0; q4 < 4; ++q4) {
          u32x2 w;
          w.x = pack2(acc[i][j][4 * q4], acc[i][j][4 * q4 + 1]);
          w.y = pack2(acc[i][j][4 * q4 + 2], acc[i][j][4 * q4 + 3]);
          *(u32x2*)(stg + (i * 32 + r) * 72 + j * 32 + 8 * q4 + 4 * h) = w;
        }
    __builtin_amdgcn_wave_barrier();
#pragma unroll 4
    for (int t = 0; t < 16; ++t) {
      const int id = lane + 64 * t, rl = id >> 3, cp = id & 7;
      u32x4 v = *(const u32x4*)(stg + rl * 72 + cp * 8);
      store(m0 + wm * 128 + rl, n0 + wn * 64 + cp * 8, v);
    }
  }
}

DI int xcd_tile(int it, int ntiles, int skip_tail = 0) {
  const int b = lbid(), g = gridDim.x;
  const int local = (b >> 3) + it * (g >> 3);
  const int per = ntiles >> 3;
  return local < per - skip_tail ? (b & 7) * per + local : -1;
}

DI void conv_tile(const float* __restrict__ src, int K, int N, u16* __restrict__ dst, const float* __restrict__ scale,
                  int tk, int tn, char* smem) {
  float* tile = (float*)smem;
  const int tid = ltid(), tx = tid & 63, ty = tid >> 6;
  const int k0 = tk * 64, n0 = tn * 64;
  __syncthreads();
#pragma unroll 4
  for (int i = 0; i < 8; ++i) {
    int kr = ty + 8 * i;
    float v = 0.f;
    if (n0 + tx < N) v = src[(size_t)(k0 + kr) * N + n0 + tx];
    if (scale) v *= scale[k0 + kr];
    tile[kr * 65 + tx] = v;
  }
  __syncthreads();
#pragma unroll 4
  for (int i = 0; i < 8; ++i) {
    int nr = ty + 8 * i;
    dst[(size_t)(n0 + nr) * K + k0 + tx] = f2bf(tile[tx * 65 + nr]);
  }
}

DI void convert_weights(const float* src, int K, int N, int Npad, u16* dst, const float* scale, char* smem) {
  const int tks = K / 64, tns = Npad / 64;
  for (int t = lbid(); t < tks * tns; t += gridDim.x) conv_tile(src, K, N, dst, scale, t / tns, t % tns, smem);
}

DI void prologue_phase(const Params& p, char* smem) {
  float* sc = (float*)smem;
  float* red = sc + 9 * 1024;
  const int tid = ltid();
  for (int i = tid; i < 9 * 1024; i += NTHR) {
    int j = i >> 10, k = i & 1023;
    float v = j < 8 ? p.c[j * 1024 + k] : p.c_ctx[k];
    sc[i] = v / (1.f + __expf(-v));
  }
  __syncthreads();
  for (int task = lbid(); task < DEPTH * 96; task += gridDim.x) {
    const int l = task / 96, n0 = (task % 96) * 64, nn = tid & 63, kq = tid >> 6;
    float acc[9];
#pragma unroll
    for (int j = 0; j < 9; ++j) acc[j] = 0.f;
    const float* w = p.w_ada + ((size_t)l * 1024 + kq * 128) * 6144 + n0 + nn;
    const float* scq = sc + kq * 128;
#pragma unroll 4
    for (int k = 0; k < 128; ++k) {
      float wv = w[(size_t)k * 6144];
#pragma unroll
      for (int j = 0; j < 9; ++j) acc[j] += scq[j * 1024 + k] * wv;
    }
#pragma unroll
    for (int j = 0; j < 9; ++j) red[(kq * 9 + j) * 64 + nn] = acc[j];
    __syncthreads();
    for (int idx = tid; idx < 576; idx += NTHR) {
      int j = idx >> 6, n2 = idx & 63;
      float s = p.b_ada[l * 6144 + n0 + n2];
#pragma unroll
      for (int q = 0; q < 8; ++q) s += red[(q * 9 + j) * 64 + n2];
      p.mod[(size_t)(l * 9 + j) * 6144 + n0 + n2] = s;
    }
    __syncthreads();
  }
  if (lbid() == gridDim.x - 1) {
    for (int i = tid; i < 64 * 16; i += NTHR) {
      int pos = i >> 4, j = i & 15;
      float inv_freq = exp2f(-(float)(2 * j) / 32.f * 13.287712379549449f);
      float ang = (float)pos * inv_freq;
      float k = rintf(ang * 0.15915494309189535f);
      float red2 = fmaf(-k, 6.2831854820251465f, ang);
      red2 = fmaf(-k, -1.7484555314695172e-07f, red2);
      p.ropetab[2 * i] = __cosf(red2);
      p.ropetab[2 * i + 1] = __sinf(red2);
    }
  }
}

DI void ew_phase(const Params& p, int layer, int kind) {
  const int tid = ltid(), lane = tid & 63, wid = __builtin_amdgcn_readfirstlane(tid >> 6);
  const bool has_branch = !(kind == 0 && layer == 0);
  const bool src_in = (layer == 0 && kind <= 1);
  const bool store_x = has_branch;
  const int blayer = (kind == 1) ? layer : (kind == 0 ? layer - 1 : DEPTH - 1);
  const float* gpost = (kind == 1) ? p.g_post_mix + blayer * D : p.g_post_ff + (blayer < 0 ? 0 : blayer) * D;
  const int gate_off = (kind == 1) ? 2 * D : 5 * D;
  const float* gpre = (kind == 0) ? p.g_pre_mix + layer * D : p.g_pre_ff + (kind == 1 ? layer : 0) * D;
  const int shift_off = (kind == 0) ? 0 : 3 * D, scale_off = (kind == 0) ? D : 4 * D;
  const float* xl = src_in ? p.x : p.out;
  const float* xc = src_in ? p.ctx : p.xctx;
  for (int rg = lbid(); rg < T / 8; rg += gridDim.x) {
    const int row = rg * 8 + wid;
    const int b = row / SP, s = row - b * SP;
    const bool lat = s < SEQ;
    if ((kind == 2 || (kind == 1 && layer == DEPTH - 1)) && !lat) continue;
    const size_t xoff = lat ? ((size_t)(b * SEQ + s) * D) : ((size_t)(b * CTX + s - SEQ) * D);
    const unsigned long long msk = lat ? ~0ull : 0ull;
    const float* xs = (const float*)(((unsigned long long)xl & msk) | ((unsigned long long)xc & ~msk)) + xoff;
    float* xd = (float*)(((unsigned long long)p.out & msk) | ((unsigned long long)p.xctx & ~msk)) + xoff;
    const int mi = lat ? b : 8;
    f32x4 xv[4];
#pragma unroll
    for (int i = 0; i < 4; ++i) xv[i] = *(const f32x4*)(xs + lane * 4 + 256 * i);
    if (has_branch) {
      const float* modb = p.mod + (size_t)(blayer * 9 + mi) * 6144 + gate_off;
      f32x4 yv[4];
      const u16* ysrc = (kind == 1) ? p.Y : p.F;
#pragma unroll
      for (int i = 0; i < 4; ++i) {
        u32x2 w = *(const u32x2*)(ysrc + (size_t)row * D + lane * 4 + 256 * i);
        yv[i] = f32x4{bflo(w.x), bfhi(w.x), bflo(w.y), bfhi(w.y)};
      }
      float ss = 0.f;
#pragma unroll
      for (int i = 0; i < 4; ++i) ss += yv[i].x * yv[i].x + yv[i].y * yv[i].y + yv[i].z * yv[i].z + yv[i].w * yv[i].w;
      ss = wave_sum(ss);
      const float rstd = rsqrtf(ss * (1.f / D) + EPS);
#pragma unroll
      for (int i = 0; i < 4; ++i) {
        const int col = lane * 4 + 256 * i;
        f32x4 g = *(const f32x4*)(gpost + col);
        f32x4 gt = *(const f32x4*)(modb + col);
        xv[i].x += gt.x * (yv[i].x * rstd * g.x);
        xv[i].y += gt.y * (yv[i].y * rstd * g.y);
        xv[i].z += gt.z * (yv[i].z * rstd * g.z);
        xv[i].w += gt.w * (yv[i].w * rstd * g.w);
      }
      if (store_x) {
#pragma unroll
        for (int i = 0; i < 4; ++i) *(f32x4*)(xd + lane * 4 + 256 * i) = xv[i];
      }
    }
    if (kind != 2) {
      const float* modl = p.mod + (size_t)(layer * 9 + mi) * 6144;
      float ss = 0.f;
#pragma unroll
      for (int i = 0; i < 4; ++i) ss += xv[i].x * xv[i].x + xv[i].y * xv[i].y + xv[i].z * xv[i].z + xv[i].w * xv[i].w;
      ss = wave_sum(ss);
      const float rstd = rsqrtf(ss * (1.f / D) + EPS);
#pragma unroll
      for (int i = 0; i < 4; ++i) {
        const int col = lane * 4 + 256 * i;
        f32x4 g = *(const f32x4*)(gpre + col);
        f32x4 sh = *(const f32x4*)(modl + shift_off + col);
        f32x4 sc = *(const f32x4*)(modl + scale_off + col);
        float h0 = xv[i].x * rstd * g.x * (1.f + sc.x) + sh.x;
        float h1 = xv[i].y * rstd * g.y * (1.f + sc.y) + sh.y;
        float h2 = xv[i].z * rstd * g.z * (1.f + sc.z) + sh.z;
        float h3 = xv[i].w * rstd * g.w * (1.f + sc.w) + sh.w;
        u32x2 w;
        w.x = pack2(h0, h1);
        w.y = pack2(h2, h3);
        *(u32x2*)(p.H + (size_t)row * D + col) = w;
      }
    }
  }
}

DI void row_rstd(const u16* __restrict__ base, int ld, int ncols, int m0, float* rs) {
  const int tid = ltid(), row = tid >> 1, half = tid & 1;
  const int per = ncols / 2;
  const u16* ptr = base + (size_t)(m0 + row) * ld + half * per;
  float ss = 0.f;
  for (int i = 0; i < per; i += 8) {
    u32x4 v = *(const u32x4*)(ptr + i);
#pragma unroll
    for (int e = 0; e < 8; ++e) {
      float f = uw(v, e);
      ss += f * f;
    }
  }
  ss += __shfl_xor(ss, 1);
  if (half == 0) rs[row] = rsqrtf(ss / (float)ncols + EPS);
}

DI void qkv_tasks(const Params& p, char* smem) {
  float* rs = (float*)(smem + 2 * 2 * 256 * 72 * 2);
  const int MT = T / 256;
  auto noT = [](int, int, u32x4) {};
  auto neverT = [](int) { return false; };
  for (int t = lbid(); t < MT * 3; t += gridDim.x) {
    const int tm = t / 3, tn = t % 3, m0 = tm * 256;
    __syncthreads();
    row_rstd(p.P, NINP, 256, m0, rs);
    const bool lat = (m0 % SP) < SEQ;
    const int s0 = m0 % SP;
    gemm_tile<false>(
        p.P, NINP, p.wt_uq, 256, 256, m0, tn * 256, smem,
        [&](int mb, int nb, f32x16& acc, int r, int h) {
          const int rowl = mb - m0 + r;
          const float sc = rs[rowl];
#pragma unroll
          for (int e = 0; e < 16; ++e) acc[e] *= sc;
          const int cb = nb % 192;
          if (lat && cb >= 128) {
            const int s = s0 + rowl;
            const int pos = (cb == 128) ? (s >> 6) : (s & 63);
#pragma unroll
            for (int e = 0; e < 8; ++e) {
              const int j = crow(e, h);
              const float cs = p.ropetab[2 * (pos * 16 + j)], sn = p.ropetab[2 * (pos * 16 + j) + 1];
              const float x1 = acc[e], x2 = acc[e + 8];
              acc[e] = x1 * cs - x2 * sn;
              acc[e + 8] = x1 * sn + x2 * cs;
            }
          }
        },
        [&](int row, int col, u32x4 v) { *(u32x4*)(p.Q + (size_t)row * 768 + col) = v; }, noT, neverT);
  }
  for (int t = lbid(); t < MT * 4; t += gridDim.x) {
    const int tm = t / 4, tn = t % 4, m0 = tm * 256;
    const int b = m0 / SP, s0 = m0 % SP;
    const bool lat = s0 < SEQ;
    __syncthreads();
    row_rstd(p.P + 256, NINP, 128, m0, rs);
    if (tn == 0) {
      for (int idx = ltid(); idx < 256 * 32; idx += NTHR) {
        const int rowl = idx >> 5, q = idx & 31, blk = q >> 4, j = q & 15;
        const u16* src = p.P + (size_t)(m0 + rowl) * NINP + 384 + blk * 32 + j;
        float x1 = bf2f(src[0]), x2 = bf2f(src[16]);
        float o1 = x1, o2 = x2;
        if (lat) {
          const int s = s0 + rowl;
          const int pos = blk == 0 ? (s >> 6) : (s & 63);
          const float cs = p.ropetab[2 * (pos * 16 + j)], sn = p.ropetab[2 * (pos * 16 + j) + 1];
          o1 = x1 * cs - x2 * sn;
          o2 = x1 * sn + x2 * cs;
        }
        u16* dst = p.Kr + (size_t)(m0 + rowl) * 64 + blk * 32 + j;
        dst[0] = f2bf(o1);
        dst[16] = f2bf(o2);
      }
    }
    const int n0 = tn * 256;
    u16* vbase = p.Vt + (size_t)(b * 4 + tn) * 128 * SP + s0;
    gemm_tile<true>(
        p.P + 256, NINP, p.wt_ukv, 128, 128, m0, n0, smem,
        [&](int mb, int nb, f32x16& acc, int r, int h) {
          const float sc = rs[mb - m0 + r];
#pragma unroll
          for (int e = 0; e < 16; ++e) acc[e] *= sc;
        },
        [&](int row, int col, u32x4 v) { *(u32x4*)(p.Kn + (size_t)row * 512 + tn * 128 + (col - n0)) = v; },
        [&](int col, int row, u32x4 v) { *(u32x4*)(vbase + (size_t)(col - n0 - 128) * SP + (row - m0)) = v; },
        [](int wn) { return wn >= 2; });
  }
}

DI void cm_tasks(const Params& p, int layer, char* smem) {
  const int ftid = ltid(), vb = ftid >> 8, tid = ftid & 255;
  u16* vnT = (u16*)(smem + vb * VSMEM);
  const int lane = tid & 63, wid = tid >> 6, r = lane & 31, h = lane >> 5;
  const float* gn = p.cm_norm_g + layer * 256;
  const float* bs = p.cm_b_s + layer * 512;
  for (int t0 = lbid() * 2; t0 < NB * NCH; t0 += gridDim.x * 2) {
    const int task = t0 + vb;
    const int row0 = task * 128;
    __syncthreads();
#pragma unroll 4
    for (int i = 0; i < 32; ++i) {
      const int s = wid * 32 + i;
      const u16* src = p.P + (size_t)(row0 + s) * NINP + 704;
      float v[4];
      float sum = 0.f;
#pragma unroll
      for (int q = 0; q < 4; ++q) {
        v[q] = gelu_f(bf2f(src[lane + 64 * q]));
        sum += v[q];
      }
      const float mean = wave_sum(sum) * (1.f / 256.f);
      float var = 0.f;
#pragma unroll
      for (int q = 0; q < 4; ++q) {
        v[q] -= mean;
        var += v[q] * v[q];
      }
      const float rstd = rsqrtf(wave_sum(var) * (1.f / 256.f) + EPS);
#pragma unroll
      for (int q = 0; q < 4; ++q) vnT[(lane + 64 * q) * 136 + s] = f2bf(v[q] * rstd * gn[lane + 64 * q]);
    }
    __syncthreads();
    const int t = wid * 32 + r;
    for (int g = 0; g < 4; ++g) {
      bf16x8 wf[8];
#pragma unroll
      for (int kk = 0; kk < 8; ++kk) wf[kk] = *(const bf16x8*)(p.wsb + ((size_t)(g * 128 + t)) * 128 + kk * 16 + h * 8);
      const float bias = bs[g * 128 + t];
#pragma unroll
      for (int cb = 0; cb < 2; ++cb) {
        f32x16 acc;
#pragma unroll
        for (int e = 0; e < 16; ++e) acc[e] = 0.f;
#pragma unroll
        for (int kk = 0; kk < 8; ++kk) {
          bf16x8 a = *(const bf16x8*)(vnT + (g * 64 + cb * 32 + r) * 136 + kk * 16 + h * 8);
          acc = MFMA(a, wf[kk], acc);
        }
#pragma unroll
        for (int q4 = 0; q4 < 4; ++q4) {
          const int ch0 = g * 64 + cb * 32 + 8 * q4 + 4 * h;
          u32x2 uwd = *(const u32x2*)(p.P + (size_t)(row0 + t) * NINP + 448 + ch0);
          float u0 = gelu_f(bflo(uwd.x)), u1 = gelu_f(bfhi(uwd.x)), u2 = gelu_f(bflo(uwd.y)), u3 = gelu_f(bfhi(uwd.y));
          u32x2 w;
          w.x = pack2(u0 * (acc[4 * q4] + bias), u1 * (acc[4 * q4 + 1] + bias));
          w.y = pack2(u2 * (acc[4 * q4 + 2] + bias), u3 * (acc[4 * q4 + 3] + bias));
          *(u32x2*)(p.H + (size_t)(row0 + t) * D + 512 + ch0) = w;
        }
      }
    }
  }
}

struct ConvW { f32x4 w0a, w0b, w1a, w1b, w2a, w2b, ba, bb; };
DI ConvW load_convw(const Params& p, int layer, int ch) {
  const float* cw = p.conv_w + (size_t)layer * 3 * 768 + ch;
  const float* cb = p.conv_b + layer * 768 + ch;
  ConvW c;
  c.w0a = *(const f32x4*)(cw); c.w0b = *(const f32x4*)(cw + 4);
  c.w1a = *(const f32x4*)(cw + 768); c.w1b = *(const f32x4*)(cw + 772);
  c.w2a = *(const f32x4*)(cw + 1536); c.w2b = *(const f32x4*)(cw + 1540);
  c.ba = *(const f32x4*)(cb); c.bb = *(const f32x4*)(cb + 4);
  return c;
}
DI float convw_get(const f32x4& a, const f32x4& b, int e) { return e < 4 ? a[e & 3] : b[e & 3]; }
DI void conv8(const Params& p, const ConvW& c, int row, int ch, bool hasPrev, bool hasNext, float out[8]) {
  const u16* base = p.P + (size_t)row * NINP + 1216 + ch;
  u32x4 cur = *(const u32x4*)base;
  u32x4 prv = *(const u32x4*)(base - (hasPrev ? NINP : 0));
  u32x4 nxt = *(const u32x4*)(base + (hasNext ? NINP : 0));
  const float mp = hasPrev ? 1.f : 0.f, mn = hasNext ? 1.f : 0.f;
#pragma unroll
  for (int e = 0; e < 8; ++e) {
    float y = convw_get(c.w0a, c.w0b, e) * (mp * uw(prv, e)) + convw_get(c.w1a, c.w1b, e) * uw(cur, e) +
              convw_get(c.w2a, c.w2b, e) * (mn * uw(nxt, e)) + convw_get(c.ba, c.bb, e);
    out[e] = silu_f(y);
  }
}

DI void ssd_dt_arrays(const Params& p, int layer, int row0, int hh, int t, float* arr) {
  float* dt0 = arr;
  float* dt1 = arr + 128;
  float* c0 = arr + 256;
  float* s1 = arr + 384;
  float* a0 = arr + 512;
  float* a1 = arr + 640;
  const float d0 = softplus_f(p.dtraw[(size_t)(row0 + t) * 8 + hh] + p.dt_bias[layer * 8 + hh]);
  const float d1 = softplus_f(p.dtraw[(size_t)(row0 + t) * 8 + 4 + hh] + p.dt_bias[layer * 8 + 4 + hh]);
  dt0[t] = d0;
  dt1[t] = d1;
  a0[t] = -d0 * __expf(p.a_log[layer * 8 + hh]);
  a1[t] = -d1 * __expf(p.a_log[layer * 8 + 4 + hh]);
}
DI float wave_incl_prefix(float x, int lane) {
#pragma unroll
  for (int o = 1; o < 64; o <<= 1) {
    float y = __shfl_up(x, o);
    if (lane >= o) x += y;
  }
  return x;
}
DI void ssd_cum_arrays(int t, float* arr) {
  float* c0 = arr + 256;
  float* s1 = arr + 384;
  const float* a0 = arr + 512;
  const float* a1 = arr + 640;
  const int lane = t & 63, w = t >> 6;
  const float x0 = a0[t], o0 = a0[t ^ 64], x1 = a1[t], o1 = a1[t ^ 64];
  const float tot_o0 = wave_sum(o0), tot_o1 = wave_sum(o1), tot_x1 = wave_sum(x1);
  float p0 = wave_incl_prefix(x0, lane);
  float p1 = wave_incl_prefix(x1, lane);
  if (w == 1) p0 += tot_o0;
  float sf = tot_x1 - p1 + x1;
  if (w == 0) sf += tot_o1;
  c0[t] = p0;
  s1[t] = sf;
}

DI void ssd_s1_tasks(const Params& p, int layer, char* smem) {
  const int ftid = ltid(), vb = ftid >> 8, tid = ftid & 255;
  u16* xsT0 = (u16*)(smem + vb * VSMEM);
  u16* xsT1 = xsT0 + 64 * 136;
  u16* BT = xsT1 + 64 * 136;
  float* arr = (float*)(BT + 128 * 136);
  float* w0 = arr + 768;
  float* w1 = w0 + 128;
  const int lane = tid & 63, wid = tid >> 6, r = lane & 31, h = lane >> 5;
  for (int t0 = lbid() * 2; t0 < NB * NCH * 4; t0 += gridDim.x * 2) {
    const int task = t0 + vb;
    const int hh = task & 3, bc = task >> 2, c = bc % NCH, b = bc / NCH;
    const int g = hh >> 1;
    const int row0 = bc * 128;
    const bool cPrev = (c != 0 && c != 32), cNext = (c != 31 && c != 33);
    __syncthreads();
    if (tid < 128) ssd_dt_arrays(p, layer, row0, hh, tid, arr);
    __syncthreads();
    if (tid < 128) ssd_cum_arrays(tid, arr);
    __syncthreads();
    if (tid < 128) {
      const float* dt0 = arr;
      const float* dt1 = arr + 128;
      const float* c0 = arr + 256;
      const float* s1 = arr + 384;
      w0[tid] = __expf(c0[127] - c0[tid]) * dt0[tid];
      w1[tid] = __expf(s1[0] - s1[tid]) * dt1[tid];
      if (tid == 0) {
        p.atot[((size_t)bc * 2 + 0) * 4 + hh] = c0[127];
        p.atot[((size_t)bc * 2 + 1) * 4 + hh] = s1[0];
      }
    }
    __syncthreads();
    const ConvW cwx = load_convw(p, layer, hh * 64 + (tid & 7) * 8);
#pragma unroll 4
    for (int i = 0; i < 4; ++i) {
      const int id = tid + VT * i, t = id >> 3, cp = id & 7;
      float v[8];
      conv8(p, cwx, row0 + t, hh * 64 + cp * 8, cPrev || t > 0, cNext || t < 127, v);
      const float f0 = w0[t], f1 = w1[t];
#pragma unroll
      for (int e = 0; e < 8; ++e) {
        xsT0[(cp * 8 + e) * 136 + t] = f2bf(v[e] * f0);
        xsT1[(cp * 8 + e) * 136 + t] = f2bf(v[e] * f1);
      }
    }
    const ConvW cwb = load_convw(p, layer, 256 + g * 128 + (tid & 15) * 8);
#pragma unroll 4
    for (int i = 0; i < 8; ++i) {
      const int id = tid + VT * i, t = id >> 4, cp = id & 15;
      float v[8];
      conv8(p, cwb, row0 + t, 256 + g * 128 + cp * 8, cPrev || t > 0, cNext || t < 127, v);
#pragma unroll
      for (int e = 0; e < 8; ++e) BT[(cp * 8 + e) * 136 + t] = f2bf(v[e]);
    }
    __syncthreads();
#pragma unroll
    for (int d = 0; d < 2; ++d) {
      const u16* xsT = d ? xsT1 : xsT0;
#pragma unroll
      for (int pb = 0; pb < 2; ++pb) {
        f32x16 acc;
#pragma unroll
        for (int e = 0; e < 16; ++e) acc[e] = 0.f;
#pragma unroll
        for (int kk = 0; kk < 8; ++kk) {
          bf16x8 a = *(const bf16x8*)(xsT + (pb * 32 + r) * 136 + kk * 16 + h * 8);
          bf16x8 bb = *(const bf16x8*)(BT + (wid * 32 + r) * 136 + kk * 16 + h * 8);
          acc = MFMA(a, bb, acc);
        }
        float* dst = p.CS + ((((size_t)bc * 2 + d) * 4 + hh) * 64 + pb * 32) * 128 + wid * 32 + r;
#pragma unroll
        for (int e = 0; e < 16; ++e) dst[(size_t)crow(e, h) * 128] = acc[e];
      }
    }
  }
}

DI void ssd_scan_phase(const Params& p) {
  const int total = NB * 2 * 4 * 8192;
  for (int idx = lbid() * NTHR + ltid(); idx < total; idx += gridDim.x * NTHR) {
    const int e = idx & 8191, hh = (idx >> 13) & 3, d = (idx >> 15) & 1, b = idx >> 16;
    float st = 0.f;
#pragma unroll 2
    for (int i = 0; i < NCH; ++i) {
      int c;
      if (d == 0) c = i < 2 ? 32 + i : i - 2;
      else c = i < 2 ? 33 - i : 33 - i;
      const size_t bc = (size_t)b * NCH + c;
      float* ptr = p.CS + ((bc * 2 + d) * 4 + hh) * 8192 + e;
      const float v = *ptr;
      const float dec = __expf(p.atot[(bc * 2 + d) * 4 + hh]);
      *ptr = st;
      st = dec * st + v;
    }
  }
}

template <int G>
DI float ssd_s3_group(const Params& p, int layer, int bc, bool cPrev, bool cNext, u16* Bg, u16* xsT, float* arr, int tid) {
  f32x16 y[4];
#pragma unroll
  for (int i = 0; i < 4; ++i)
#pragma unroll
    for (int e = 0; e < 16; ++e) y[i][e] = 0.f;
  const int lane = tid & 63, wid = tid >> 6, r = lane & 31, h = lane >> 5;
  const int l = wid * 32 + r;
  const int row0 = bc * 128;
  __syncthreads();
  ssd_dt_arrays(p, layer, row0, 2 * G + (tid >> 7), tid & 127, arr + (tid >> 7) * 768);
  const ConvW cwc = load_convw(p, layer, 512 + G * 128 + (tid & 15) * 8);
#pragma unroll 2
  for (int i = 0; i < 8; ++i) {
    const int id = tid + VT * i, t = id >> 4, cp = id & 15;
    float v[8];
    conv8(p, cwc, row0 + t, 512 + G * 128 + cp * 8, cPrev || t > 0, cNext || t < 127, v);
    *(bf16x8*)(Bg + t * 136 + cp * 8) = pack8(v[0], v[1], v[2], v[3], v[4], v[5], v[6], v[7]);
  }
  const ConvW cwx = load_convw(p, layer, G * 128 + (tid & 15) * 8);
#pragma unroll 2
  for (int i = 0; i < 8; ++i) {
    const int id = tid + VT * i, t = id >> 4, cp = id & 15;
    float v[8];
    conv8(p, cwx, row0 + t, G * 128 + cp * 8, cPrev || t > 0, cNext || t < 127, v);
#pragma unroll
    for (int e = 0; e < 8; ++e) xsT[(cp * 8 + e) * 136 + t] = f2bf(v[e]);
  }
  __syncthreads();
  ssd_cum_arrays(tid & 127, arr + (tid >> 7) * 768);
  bf16x8 cf[8];
#pragma unroll
  for (int kk = 0; kk < 8; ++kk) cf[kk] = *(const bf16x8*)(Bg + l * 136 + kk * 16 + h * 8);
  __syncthreads();
  const ConvW cwb = load_convw(p, layer, 256 + G * 128 + (tid & 15) * 8);
#pragma unroll 2
  for (int i = 0; i < 8; ++i) {
    const int id = tid + VT * i, t = id >> 4, cp = id & 15;
    float v[8];
    conv8(p, cwb, row0 + t, 256 + G * 128 + cp * 8, cPrev || t > 0, cNext || t < 127, v);
    *(bf16x8*)(Bg + t * 136 + cp * 8) = pack8(v[0], v[1], v[2], v[3], v[4], v[5], v[6], v[7]);
  }
  __syncthreads();
  float ss = 0.f;
#pragma unroll 1
  for (int hd2 = 0; hd2 < 2; ++hd2) {
    const int hh = 2 * G + hd2;
    const float* ah = arr + hd2 * 768;
    const float c0l = ah[256 + l], s1l = ah[384 + l];
    f32x16 y[2];
#pragma unroll
    for (int i = 0; i < 2; ++i)
#pragma unroll
      for (int e = 0; e < 16; ++e) y[i][e] = 0.f;
#pragma unroll 1
    for (int sb = 0; sb < 4; ++sb) {
      f32x16 gt;
#pragma unroll
      for (int e = 0; e < 16; ++e) gt[e] = 0.f;
#pragma unroll
      for (int kk = 0; kk < 8; ++kk) {
        bf16x8 a = *(const bf16x8*)(Bg + (sb * 32 + r) * 136 + kk * 16 + h * 8);
        gt = MFMA(a, cf[kk], gt);
      }
      f32x16 wv;
#pragma unroll
      for (int e = 0; e < 16; ++e) {
        const int s = sb * 32 + crow(e, h);
        const float a0 = (l >= s) ? (c0l - ah[256 + s]) : -1e30f;
        const float a1 = (l <= s) ? (s1l - ah[384 + s]) : -1e30f;
        const float f = __expf(a0) * ah[s] + __expf(a1) * ah[128 + s];
        wv[e] = gt[e] * f;
      }
      bf16x8 wp0 = pack8(wv[0], wv[1], wv[2], wv[3], wv[4], wv[5], wv[6], wv[7]);
      bf16x8 wp1 = pack8(wv[8], wv[9], wv[10], wv[11], wv[12], wv[13], wv[14], wv[15]);
#pragma unroll
      for (int pb = 0; pb < 2; ++pb) {
        const u16* xrow = xsT + (hd2 * 64 + pb * 32 + r) * 136 + sb * 32 + 4 * h;
        s16x4 lo0 = *(const s16x4*)(xrow), hi0 = *(const s16x4*)(xrow + 8);
        s16x4 lo1 = *(const s16x4*)(xrow + 16), hi1 = *(const s16x4*)(xrow + 24);
        bf16x8 a0 = __builtin_shufflevector(lo0, hi0, 0, 1, 2, 3, 4, 5, 6, 7);
        bf16x8 a1 = __builtin_shufflevector(lo1, hi1, 0, 1, 2, 3, 4, 5, 6, 7);
        y[pb] = MFMA(a0, wp0, y[pb]);
        y[pb] = MFMA(a1, wp1, y[pb]);
      }
    }
#pragma unroll 1
    for (int d = 0; d < 2; ++d) {
      const float el = __expf(d == 0 ? c0l : s1l);
#pragma unroll
      for (int pb = 0; pb < 2; ++pb) {
        const float* srow = p.CS + ((((size_t)bc * 2 + d) * 4 + hh) * 64 + pb * 32 + r) * 128 + h * 8;
        f32x16 tmp;
#pragma unroll
        for (int e = 0; e < 16; ++e) tmp[e] = 0.f;
#pragma unroll
        for (int kk = 0; kk < 8; ++kk) {
          f32x4 s0 = *(const f32x4*)(srow + kk * 16), s1 = *(const f32x4*)(srow + kk * 16 + 4);
          bf16x8 a = pack8(s0.x, s0.y, s0.z, s0.w, s1.x, s1.y, s1.z, s1.w);
          tmp = MFMA(a, cf[kk], tmp);
        }
#pragma unroll
        for (int e = 0; e < 16; ++e) y[pb][e] += el * tmp[e];
      }
    }
    const float dsk = p.ssd_d[layer * 8 + hh] + p.ssd_d[layer * 8 + 4 + hh];
#pragma unroll
    for (int pb = 0; pb < 2; ++pb) {
#pragma unroll
      for (int q4 = 0; q4 < 4; ++q4) {
        const int cl = hd2 * 64 + pb * 32 + 8 * q4 + 4 * h;
        const int ch0 = G * 128 + cl;
        u32x2 zw = *(const u32x2*)(p.P + (size_t)(row0 + l) * NINP + 960 + ch0);
        f32x4 o;
        o.x = (y[pb][4 * q4] + dsk * bf2f(xsT[(cl + 0) * 136 + l])) * silu_f(bflo(zw.x));
        o.y = (y[pb][4 * q4 + 1] + dsk * bf2f(xsT[(cl + 1) * 136 + l])) * silu_f(bfhi(zw.x));
        o.z = (y[pb][4 * q4 + 2] + dsk * bf2f(xsT[(cl + 2) * 136 + l])) * silu_f(bflo(zw.y));
        o.w = (y[pb][4 * q4 + 3] + dsk * bf2f(xsT[(cl + 3) * 136 + l])) * silu_f(bfhi(zw.y));
        ss += o.x * o.x + o.y * o.y + o.z * o.z + o.w * o.w;
        *(f32x4*)(p.ytmp + (size_t)(row0 + l) * 256 + ch0) = o;
      }
    }
  }
  return ss;
}

DI void ssd_s3_tasks(const Params& p, int layer, char* smem) {
  const int ftid = ltid(), vb = ftid >> 8, tid = ftid & 255;
  u16* Bg = (u16*)(smem + vb * VSMEM);
  u16* xsT = Bg + 128 * 136;
  float* arr = (float*)(xsT + 128 * 136);
  const int lane = tid & 63, wid = tid >> 6, r = lane & 31, h = lane >> 5;
  const int l = wid * 32 + r;
  for (int t0 = lbid() * 2; t0 < NB * NCH; t0 += gridDim.x * 2) {
    const int bc = t0 + vb, c = bc % NCH;
    const int row0 = bc * 128;
    const bool cPrev = (c != 0 && c != 32), cNext = (c != 31 && c != 33);
    float ss = ssd_s3_group<0>(p, layer, bc, cPrev, cNext, Bg, xsT, arr, tid);
    ss += ssd_s3_group<1>(p, layer, bc, cPrev, cNext, Bg, xsT, arr, tid);
    ss += __shfl_xor(ss, 32);
    const float rstd = rsqrtf(ss * (1.f / 256.f) + EPS);
    const float* gn = p.ssd_norm_g + layer * 256;
#pragma unroll 4
    for (int i = 0; i < 32; ++i) {
      const int ch0 = (i >> 2) * 32 + 8 * (i & 3) + 4 * h;
      f32x4 v = *(const f32x4*)(p.ytmp + (size_t)(row0 + l) * 256 + ch0);
      f32x4 gv = *(const f32x4*)(gn + ch0);
      u32x2 w;
      w.x = pack2(v.x * rstd * gv.x, v.y * rstd * gv.y);
      w.y = pack2(v.z * rstd * gv.z, v.w * rstd * gv.w);
      *(u32x2*)(p.H + (size_t)(row0 + l) * D + 768 + ch0) = w;
    }
  }
}

DI void attn_qk(const u16* Ks, const bf16x8 (&qf)[1], const u16* qs, f32x16 (&st)[2], int r, int h) {
#pragma unroll
  for (int kb = 0; kb < 2; ++kb)
#pragma unroll
    for (int e = 0; e < 16; ++e) st[kb][e] = 0.f;
  const u16* kp = Ks + r * 200 + h * 8;
#pragma unroll
  for (int kk = 0; kk < 12; ++kk) {
    bf16x8 k0 = *(const bf16x8*)(kp + kk * 16);
    bf16x8 k1 = *(const bf16x8*)(kp + 32 * 200 + kk * 16);
    bf16x8 q;
    if (kk < 1) q = qf[kk];
    else q = *(const bf16x8*)(qs + (kk - 1) * 512);
    st[0] = MFMA(k0, q, st[0]);
    st[1] = MFMA(k1, q, st[1]);
  }
}
DI void attn_softmax(f32x16 (&st)[2], f32x16 (&o)[4], bf16x8 (&pf)[4], float& m_run, float& l_run, float sc) {
  float mx = st[0][0];
#pragma unroll
  for (int kb = 0; kb < 2; ++kb)
#pragma unroll
    for (int e = 0; e < 16; ++e) mx = fmaxf(mx, st[kb][e]);
  mx = fmaxf(mx, __shfl_xor(mx, 32));
  const float m_new = fmaxf(m_run, mx * sc);
  const float alpha = __builtin_amdgcn_exp2f(m_run - m_new);
  m_run = m_new;
  float ls = 0.f;
#pragma unroll
  for (int kb = 0; kb < 2; ++kb)
#pragma unroll
    for (int e = 0; e < 16; ++e) {
      float pv = __builtin_amdgcn_exp2f(fmaf(st[kb][e], sc, -m_new));
      ls += pv;
      st[kb][e] = pv;
    }
  l_run = l_run * alpha + ls;
#pragma unroll
  for (int i = 0; i < 4; ++i)
#pragma unroll
    for (int e = 0; e < 16; ++e) o[i][e] *= alpha;
#pragma unroll
  for (int ks = 0; ks < 4; ++ks) {
    const int kb = ks >> 1, s2 = ks & 1;
    pf[ks] = pack8(st[kb][8 * s2], st[kb][8 * s2 + 1], st[kb][8 * s2 + 2], st[kb][8 * s2 + 3], st[kb][8 * s2 + 4],
                   st[kb][8 * s2 + 5], st[kb][8 * s2 + 6], st[kb][8 * s2 + 7]);
  }
}
DI void attn_pv(const u16* Vs, const bf16x8 (&pf)[4], f32x16 (&o)[4], int r, int h) {
#pragma unroll
  for (int ks = 0; ks < 4; ++ks) {
#pragma unroll
    for (int db = 0; db < 4; ++db) {
      const u16* vr = Vs + (db * 32 + r) * 68 + ks * 16 + 4 * h;
      s16x4 lo = *(const s16x4*)vr, hi = *(const s16x4*)(vr + 8);
      bf16x8 a = __builtin_shufflevector(lo, hi, 0, 1, 2, 3, 4, 5, 6, 7);
      o[db] = MFMA(a, pf[ks], o[db]);
    }
  }
}

DI void attn_tasks(const Params& p, char* smem) {
  u16* Ks = (u16*)smem;
  u16* Vs0 = Ks + 64 * 200;
  const int tid = ltid(), lane = tid & 63, wid = __builtin_amdgcn_readfirstlane(tid >> 6), r = lane & 31, h = lane >> 5;
  const bool late = wid >= 4;
  u16* qs = Vs0 + 2 * 128 * 68 + wid * (11 * 512) + lane * 8;
  const float sc = 0.07216878364870322f * 1.4426950408889634f;
  for (int task = lbid(); task < NB * 4 * 17; task += gridDim.x) {
    int b, hd, qt;
    if (task < 512) {
      qt = task & 15; hd = (task >> 4) & 3; b = task >> 6;
    } else {
      const int t2 = task - 512;
      qt = 16; hd = t2 & 3; b = t2 >> 2;
    }
    const int koff = (qt < 16) ? 0 : SEQ;
    const int nkt = ((qt < 16) ? SP : CTX) / 64;
    const int qrow = b * SP + qt * 256 + wid * 32 + r;
    bf16x8 qf[1];
#pragma unroll
    for (int kk = 0; kk < 1; ++kk) qf[kk] = *(const bf16x8*)(p.Q + (size_t)qrow * 768 + hd * 192 + kk * 16 + h * 8);
#pragma unroll
    for (int kk = 1; kk < 12; ++kk)
      *(bf16x8*)(qs + (kk - 1) * 512) = *(const bf16x8*)(p.Q + (size_t)qrow * 768 + hd * 192 + kk * 16 + h * 8);
    f32x16 o[4];
#pragma unroll
    for (int i = 0; i < 4; ++i)
#pragma unroll
      for (int e = 0; e < 16; ++e) o[i][e] = 0.f;
    bf16x8 pf[4];
#pragma unroll
    for (int i = 0; i < 4; ++i)
#pragma unroll
      for (int e = 0; e < 8; ++e) pf[i][e] = 0;
    float m_run = -1e30f, l_run = 0.f;
    u32x4 kn[2], kr[1], vv[2];
    const u16* knb = p.Kn + ((size_t)(b * SP + koff) + (tid >> 4)) * 512 + hd * 128 + (tid & 15) * 8;
    const u16* krb = p.Kr + ((size_t)(b * SP + koff) + (tid >> 3)) * 64 + (tid & 7) * 8;
    const u16* vb = p.Vt + ((size_t)(b * 4 + hd) * 128 + (tid >> 3)) * SP + koff + (tid & 7) * 8;
#pragma unroll
    for (int i = 0; i < 2; ++i) kn[i] = *(const u32x4*)(knb + (size_t)(32 * i) * 512);
    kr[0] = *(const u32x4*)(krb);
#pragma unroll
    for (int i = 0; i < 2; ++i) vv[i] = *(const u32x4*)(vb + (size_t)(64 * i) * SP);
    for (int kt = 0; kt < nkt; ++kt) {
      u16* Vs = Vs0 + (kt & 1) * (128 * 68);
      __syncthreads();
#pragma unroll
      for (int i = 0; i < 2; ++i) *(u32x4*)(Ks + ((tid >> 4) + 32 * i) * 200 + (tid & 15) * 8) = kn[i];
      *(u32x4*)(Ks + (tid >> 3) * 200 + 128 + (tid & 7) * 8) = kr[0];
#pragma unroll
      for (int i = 0; i < 2; ++i) {
        u16* dst = Vs + ((tid >> 3) + 64 * i) * 68 + (tid & 7) * 8;
        *(u32x2*)dst = u32x2{vv[i].x, vv[i].y};
        *(u32x2*)(dst + 4) = u32x2{vv[i].z, vv[i].w};
      }
      __syncthreads();
      {
        const size_t ko = (size_t)(kt + 1 < nkt ? kt + 1 : kt) * 64;
#pragma unroll
        for (int i = 0; i < 2; ++i) kn[i] = *(const u32x4*)(knb + (ko + 32 * i) * 512);
        kr[0] = *(const u32x4*)(krb + ko * 64);
#pragma unroll
        for (int i = 0; i < 2; ++i) vv[i] = *(const u32x4*)(vb + (size_t)(64 * i) * SP + ko);
      }
      __builtin_amdgcn_sched_barrier(0);
      if (late && kt > 0) attn_pv(Vs0 + ((kt - 1) & 1) * (128 * 68), pf, o, r, h);
      {
        f32x16 st[2];
        attn_qk(Ks, qf, qs, st, r, h);
        attn_softmax(st, o, pf, m_run, l_run, sc);
      }
      if (!late) attn_pv(Vs, pf, o, r, h);
    }
    if (late) attn_pv(Vs0 + ((nkt - 1) & 1) * (128 * 68), pf, o, r, h);
    const float ltot = l_run + __shfl_xor(l_run, 32);
    const float inv = 1.f / ltot;
    u16* orow = p.H + (size_t)qrow * D + hd * 128;
#pragma unroll
    for (int db = 0; db < 4; ++db)
#pragma unroll
      for (int q4 = 0; q4 < 4; ++q4) {
        u32x2 w;
        w.x = pack2(o[db][4 * q4] * inv, o[db][4 * q4 + 1] * inv);
        w.y = pack2(o[db][4 * q4 + 2] * inv, o[db][4 * q4 + 3] * inv);
        *(u32x2*)(orow + db * 32 + 8 * q4 + 4 * h) = w;
      }
  }
}

constexpr int NPHASE = 1 + DEPTH * 9 + 1;

DI void run_phase(const Params& p, int ph, char* smem) {
  if (ph == 0) { prologue_phase(p, smem); return; }
  if (ph == NPHASE - 1) { ew_phase(p, DEPTH, 2); return; }
  const int layer = (ph - 1) / 9, sub = (ph - 1) % 9;
  const bool last = layer == DEPTH - 1;
  const int MT = T / 256;
  auto noT = [](int, int, u32x4) {};
  auto neverT = [](int) { return false; };
  switch (sub) {
    case 0: {
      ew_phase(p, layer, 0);
      convert_weights(p.w_in + (size_t)layer * D * NIN, D, NIN, NINP, p.wt_in, nullptr, smem);
      convert_weights(p.w_uq + (size_t)layer * 256 * 768, 256, 768, 768, p.wt_uq, p.g_q + layer * 256, smem);
      convert_weights(p.w_ukv + (size_t)layer * 128 * 1024, 128, 1024, 1024, p.wt_ukv, p.g_kv + layer * 128, smem);
      convert_weights(p.w_out + (size_t)layer * D * D, D, D, D, p.wt_out, nullptr, smem);
      for (int i = lbid() * NTHR + ltid(); i < 4 * 128 * 128; i += gridDim.x * NTHR)
        p.wsb[i] = f2bf(p.cm_w_s[(size_t)layer * 65536 + i]);
    } break;
    case 1: {
      for (int it = 0;; ++it) {
        const int t = xcd_tile(it, MT * 8);
        if (t < 0) break;
        const int tm = t >> 3, tn = t & 7;
        gemm_tile<false>(
            p.H, D, p.wt_in, D, D, tm * 256, tn * 256, smem,
            [&](int mb, int nb, f32x16& acc, int r, int h) {
              if (nb == 1984) {
                f32x4 v = {acc[0], acc[1], acc[2], acc[3]};
                *(f32x4*)(p.dtraw + (size_t)(mb + r) * 8 + 4 * h) = v;
              }
            },
            [&](int row, int col, u32x4 v) { *(u32x4*)(p.P + (size_t)row * NINP + col) = v; }, noT, neverT);
      }
    } break;
    case 2: {
      qkv_tasks(p, smem);
      cm_tasks(p, layer, smem);
      ssd_s1_tasks(p, layer, smem);
    } break;
    case 3: ssd_scan_phase(p); break;
    case 4: {
      attn_tasks(p, smem);
#ifdef PROBE_ATTN
      __syncthreads();
      attn_tasks(p, smem);
#endif
      ssd_s3_tasks(p, layer, smem);
#ifdef PROBE_S3
      __syncthreads();
      ssd_s3_tasks(p, layer, smem);
#endif
    } break;
    case 5: {
      for (int it = 0;; ++it) {
        const int t = xcd_tile(it, MT * 4, last ? 4 : 0);
        if (t < 0) break;
        const int tm = t >> 2, tn = t & 3;
        gemm_tile<false>(
            p.H, D, p.wt_out, D, D, tm * 256, tn * 256, smem, [](int, int, f32x16&, int, int) {},
            [&](int row, int col, u32x4 v) { *(u32x4*)(p.Y + (size_t)row * D + col) = v; }, noT, neverT);
      }
    } break;
    case 6: {
      ew_phase(p, layer, 1);
      convert_weights(p.w_ff1 + (size_t)layer * D * DFF, D, DFF, DFF, p.wt_ff1, nullptr, smem);
      convert_weights(p.w_ff2 + (size_t)layer * DFF * D, DFF, D, D, p.wt_ff2, nullptr, smem);
    } break;
    case 7: {
      for (int it = 0;; ++it) {
        const int t = xcd_tile(it, MT * 16, last ? 16 : 0);
        if (t < 0) break;
        const int tm = t >> 4, tn = t & 15;
        gemm_tile<false>(
            p.H, D, p.wt_ff1, D, D, tm * 256, tn * 256, smem,
            [](int, int, f32x16& acc, int, int) {
#pragma unroll
              for (int e = 0; e < 16; ++e) {
                float v = fmaxf(acc[e], 0.f);
                acc[e] = v * v;
              }
            },
            [&](int row, int col, u32x4 v) { *(u32x4*)(p.Hd + (size_t)row * DFF + col) = v; }, noT, neverT);
      }
    } break;
    case 8: {
      for (int it = 0;; ++it) {
        const int t = xcd_tile(it, MT * 4, last ? 4 : 0);
        if (t < 0) break;
        const int tm = t >> 2, tn = t & 3;
        gemm_tile<false>(
            p.Hd, DFF, p.wt_ff2, DFF, DFF, tm * 256, tn * 256, smem, [](int, int, f32x16&, int, int) {},
            [&](int row, int col, u32x4 v) { *(u32x4*)(p.F + (size_t)row * D + col) = v; }, noT, neverT);
      }
    } break;
  }
}

__global__ void __launch_bounds__(NTHR, 2) mega_kernel(Params p, int ph_begin, int ph_end) {
  extern __shared__ __attribute__((aligned(16))) char smem[];
  cg::grid_group grid = cg::this_grid();
  for (int ph = ph_begin; ph < ph_end; ++ph) {
    run_phase(p, ph, smem);
#ifdef PROBE_MASK
    if (ph > 0 && ph < NPHASE - 1 && ((PROBE_MASK >> ((ph - 1) % 9)) & 1)) {
      grid.sync();
      run_phase(p, ph, smem);
    }
#endif
    if (ph + 1 < ph_end) grid.sync();
  }
}

extern "C" void kernel_launch(void* const* d_in, const int* in_sizes, int n_in, void* d_out, int out_size, void* d_ws,
                              size_t ws_size, hipStream_t stream) {
  Params p{};
  const float* const* in = (const float* const*)d_in;
  p.x = in[0]; p.c = in[1]; p.ctx = in[2]; p.c_ctx = in[3]; p.w_ada = in[4]; p.b_ada = in[5];
  p.g_pre_mix = in[6]; p.g_post_mix = in[7]; p.g_pre_ff = in[8]; p.g_post_ff = in[9]; p.w_in = in[10];
  p.g_q = in[11]; p.w_uq = in[12]; p.g_kv = in[13]; p.w_ukv = in[14]; p.cm_norm_g = in[15]; p.cm_w_s = in[16];
  p.cm_b_s = in[17]; p.conv_w = in[18]; p.conv_b = in[19]; p.dt_bias = in[20]; p.a_log = in[21]; p.ssd_d = in[22];
  p.ssd_norm_g = in[23]; p.w_out = in[24]; p.w_ff1 = in[25]; p.w_ff2 = in[26];
  p.out = (float*)d_out;
  char* ws = (char*)d_ws;
  size_t off = 0;
  auto take = [&](size_t bytes) { char* q = ws + off; off += (bytes + 255) & ~(size_t)255; return q; };
  p.wt_in = (u16*)take((size_t)NINP * D * 2);
  p.wt_uq = (u16*)take((size_t)768 * 256 * 2);
  p.wt_ukv = (u16*)take((size_t)1024 * 128 * 2);
  p.wt_out = (u16*)take((size_t)D * D * 2);
  p.wt_ff1 = (u16*)take((size_t)DFF * D * 2);
  p.wt_ff2 = (u16*)take((size_t)D * DFF * 2);
  p.wsb = (u16*)take((size_t)4 * 128 * 128 * 2);
  p.mod = (float*)take((size_t)DEPTH * 9 * 6144 * 4);
  p.ropetab = (float*)take((size_t)64 * 16 * 2 * 4);
  p.atot = (float*)take((size_t)NB * NCH * 2 * 4 * 4);
  p.xctx = (float*)take((size_t)NB * CTX * D * 4);
  char* r1 = take((size_t)T * DFF * 2);
  p.Hd = (u16*)r1;
  p.Y = (u16*)r1;
  {
    size_t o2 = 0;
    p.P = (u16*)(r1 + o2); o2 += (size_t)T * NINP * 2;
    p.Q = (u16*)(r1 + o2); o2 += (size_t)T * 768 * 2;
    p.Kn = (u16*)(r1 + o2); o2 += (size_t)T * 512 * 2;
    p.Kr = (u16*)(r1 + o2); o2 += (size_t)T * 64 * 2;
    p.Vt = (u16*)(r1 + o2); o2 += (size_t)NB * 4 * 128 * SP * 2;
    p.dtraw = (float*)(r1 + o2); o2 += (size_t)T * 8 * 4;
  }
  p.H = (u16*)take((size_t)T * D * 2);
  p.CS = (float*)take((size_t)NB * NCH * 2 * 4 * 8192 * 4);
  p.F = (u16*)p.CS;
  p.ytmp = (float*)take((size_t)T * 256 * 4);
  if (off > ws_size) {
    fprintf(stderr, "workspace too small: need %zu have %zu\n", off, ws_size);
    return;
  }
  static int grid_blocks = 0;
  if (!grid_blocks) {
    int dev = 0, cus = 0, per_cu = 0;
    hipGetDevice(&dev);
    hipDeviceGetAttribute(&cus, hipDeviceAttributeMultiprocessorCount, dev);
    hipFuncSetAttribute((const void*)mega_kernel, hipFuncAttributeMaxDynamicSharedMemorySize, SMEM_BYTES);
    hipOccupancyMaxActiveBlocksPerMultiprocessor(&per_cu, mega_kernel, NTHR, SMEM_BYTES);
    if (per_cu < 1) per_cu = 1;
    if (per_cu > 1) per_cu = 1;
    grid_blocks = cus * per_cu;
  }
  int pb = 0, pe = NPHASE;
  void* args[] = {&p, &pb, &pe};
  hipError_t e = hipLaunchCooperativeKernel((void*)mega_kernel, dim3(grid_blocks), dim3(NTHR), args, SMEM_BYTES, stream);
  if (e != hipSuccess) fprintf(stderr, "cooperative launch failed: %s (grid %d)\n", hipGetErrorString(e), grid_blocks);
}
```

```cpp
#include <hip/hip_runtime.h>
#include <hip/hip_cooperative_groups.h>
#include <cstdio>
namespace cg = cooperative_groups;

#define DI __device__ __forceinline__
typedef unsigned short u16;
using bf16x8 = __attribute__((ext_vector_type(8))) short;
using s16x4 = __attribute__((ext_vector_type(4))) short;
using f32x16 = __attribute__((ext_vector_type(16))) float;
using u32x4 = __attribute__((ext_vector_type(4))) unsigned;
using u32x2 = __attribute__((ext_vector_type(2))) unsigned;
using f32x4 = __attribute__((ext_vector_type(4))) float;
typedef __bf16 bf2_t __attribute__((ext_vector_type(2)));
typedef float f2_t __attribute__((ext_vector_type(2)));
#define MFMA(a, b, c) __builtin_amdgcn_mfma_f32_32x32x16_bf16((a), (b), (c), 0, 0, 0)

constexpr int NB = 8, SEQ = 4096, CTX = 256, SP = 4352, T = NB * SP, D = 1024, DFF = 4096;
constexpr int NIN = 1992, NINP = 2048, NCH = 34, DEPTH = 4;
constexpr int NTHR = 512;
constexpr int VT = 256;
constexpr int VSMEM = 75 * 1024;
constexpr int SMEM_BYTES = 2 * VSMEM;
constexpr float EPS = 1e-6f;

struct Params {
  const float *x, *c, *ctx, *c_ctx, *w_ada, *b_ada, *g_pre_mix, *g_post_mix, *g_pre_ff, *g_post_ff, *w_in, *g_q, *w_uq,
      *g_kv, *w_ukv, *cm_norm_g, *cm_w_s, *cm_b_s, *conv_w, *conv_b, *dt_bias, *a_log, *ssd_d, *ssd_norm_g, *w_out,
      *w_ff1, *w_ff2;
  float* out;
  u16 *wt_in, *wt_uq, *wt_ukv, *wt_out, *wt_ff1, *wt_ff2, *wsb;
  float *mod, *ropetab, *atot, *xctx;
  u16 *P, *Q, *Kn, *Kr, *Vt, *Hd;
  u16* Y;
  float* dtraw;
  u16* H;
  float* CS;
  u16* F;
  float* ytmp;
  int* cnt;
};

DI int ltid() { int t = threadIdx.x; asm volatile("" : "+v"(t)); return t; }
DI int lbid() { int t = blockIdx.x; asm volatile("" : "+s"(t)); return t; }
DI int crow(int e, int h) { return (e & 3) + 8 * (e >> 2) + 4 * h; }
DI unsigned pack2(float a, float b) {
  f2_t v = {a, b};
  bf2_t r = __builtin_convertvector(v, bf2_t);
  return __builtin_bit_cast(unsigned, r);
}
DI u16 f2bf(float a) { return (u16)(pack2(a, 0.f) & 0xffffu); }
DI float bf2f(u16 v) { return __uint_as_float(((unsigned)v) << 16); }
DI float bflo(unsigned w) { return __uint_as_float(w << 16); }
DI float bfhi(unsigned w) { return __uint_as_float(w & 0xffff0000u); }
DI bf16x8 pack8(float a0, float a1, float a2, float a3, float a4, float a5, float a6, float a7) {
  u32x4 u;
  u.x = pack2(a0, a1); u.y = pack2(a2, a3); u.z = pack2(a4, a5); u.w = pack2(a6, a7);
  return __builtin_bit_cast(bf16x8, u);
}
DI float wave_sum(float v) {
#pragma unroll
  for (int o = 32; o > 0; o >>= 1) v += __shfl_xor(v, o);
  return v;
}
DI float silu_f(float y) { return y * __builtin_amdgcn_rcpf(1.f + __expf(-y)); }
DI float gelu_f(float x) {
  float u = 0.7978845608028654f * (x + 0.044715f * x * x * x);
  float t = 1.f - 2.f * __builtin_amdgcn_rcpf(1.f + __expf(2.f * u));
  return 0.5f * x * (1.f + t);
}
DI float softplus_f(float x) { return x > 20.f ? x : log1pf(__expf(x)); }
DI float uw(const u32x4& v, int i) {
  unsigned w = (i >> 1) == 0 ? v.x : (i >> 1) == 1 ? v.y : (i >> 1) == 2 ? v.z : v.w;
  return (i & 1) ? bfhi(w) : bflo(w);
}

template <bool HAS_T, class ElemF, class StoreF, class StoreTF, class UseTF>
DI void gemm_tile(const u16* __restrict__ A, int lda, const u16* __restrict__ Bt, int ldb, int K, int m0, int n0,
                  char* smem, ElemF elem, StoreF store, StoreTF storeT, UseTF useT) {
  constexpr int LS = 72;
  constexpr int STAGE = 2 * 256 * LS;
  u16* base = (u16*)smem;
  const int tid = ltid(), lane = tid & 63, wid = tid >> 6, wm = wid >> 2, wn = wid & 3, r = lane & 31, h = lane >> 5;
  f32x16 acc[4][2];
#pragma unroll
  for (int i = 0; i < 4; ++i)
#pragma unroll
    for (int j = 0; j < 2; ++j)
#pragma unroll
      for (int e = 0; e < 16; ++e) acc[i][j][e] = 0.f;
  u32x4 ra[4], rb[4];
  const int lrow = tid >> 3, lcp = (tid & 7) * 8;
  const u16* ga = A + (size_t)(m0 + lrow) * lda + lcp;
  const u16* gb = Bt + (size_t)(n0 + lrow) * ldb + lcp;
  const int wofs = lrow * LS + lcp;
  const int aofs = (wm * 128 + r) * LS + h * 8;
  const int bofs = 256 * LS + (wn * 64 + r) * LS + h * 8;
#define GLOAD(kt_)                                                           \
  _Pragma("unroll") for (int i = 0; i < 4; ++i) {                            \
    ra[i] = *(const u32x4*)(ga + (size_t)(64 * i) * lda + (kt_) * 64);       \
    rb[i] = *(const u32x4*)(gb + (size_t)(64 * i) * ldb + (kt_) * 64);       \
  }
#define SWRITE(st_)                                                          \
  _Pragma("unroll") for (int i = 0; i < 4; ++i) {                            \
    *(u32x4*)((st_) + wofs + 64 * i * LS) = ra[i];                           \
    *(u32x4*)((st_) + 256 * LS + wofs + 64 * i * LS) = rb[i];                \
  }
#define FREAD(dst_, st_, kk_)                                                                      \
  _Pragma("unroll") for (int i = 0; i < 4; ++i) af[dst_][i] = *(const bf16x8*)((st_) + aofs + i * 32 * LS + (kk_) * 16); \
  _Pragma("unroll") for (int j = 0; j < 2; ++j) bfr[dst_][j] = *(const bf16x8*)((st_) + bofs + j * 32 * LS + (kk_) * 16);
#define MMAS(src_)                                                           \
  _Pragma("unroll") for (int i = 0; i < 4; ++i)                              \
  _Pragma("unroll") for (int j = 0; j < 2; ++j) acc[i][j] = MFMA(bfr[src_][j], af[src_][i], acc[i][j]);
  const int nk = K >> 6;
  bf16x8 af[2][4], bfr[2][2];
  GLOAD(0);
  __syncthreads();
  SWRITE(base);
  if (nk > 1) { GLOAD(1); }
  __syncthreads();
  FREAD(0, base, 0);
  for (int kt = 0; kt < nk; ++kt) {
    u16* cur = base + (kt & 1) * STAGE;
    u16* nxt = base + ((kt + 1) & 1) * STAGE;
    FREAD(1, cur, 1);
    if (kt + 1 < nk) { SWRITE(nxt); }
    MMAS(0);
    __builtin_amdgcn_sched_barrier(0);
    if (kt + 2 < nk) { GLOAD(kt + 2); }
    FREAD(0, cur, 2);
    MMAS(1);
    __builtin_amdgcn_sched_barrier(0);
    FREAD(1, cur, 3);
    MMAS(0);
    __builtin_amdgcn_sched_barrier(0);
    __syncthreads();
    if (kt + 1 < nk) { FREAD(0, nxt, 0); }
    MMAS(1);
    __builtin_amdgcn_sched_barrier(0);
  }
#undef GLOAD
#undef SWRITE
#undef FREAD
#undef MMAS
#pragma unroll
  for (int i = 0; i < 4; ++i)
#pragma unroll
    for (int j = 0; j < 2; ++j) elem(m0 + wm * 128 + i * 32, n0 + wn * 64 + j * 32, acc[i][j], r, h);
  u16* stg = base + wid * (128 * 72);
  if (HAS_T && useT(wn)) {
#pragma unroll
    for (int i = 0; i < 4; ++i)
#pragma unroll
      for (int j = 0; j < 2; ++j)
#pragma unroll
        for (int e = 0; e < 16; ++e) stg[(j * 32 + crow(e, h)) * 136 + i * 32 + r] = f2bf(acc[i][j][e]);
    __builtin_amdgcn_wave_barrier();
#pragma unroll 4
    for (int t = 0; t < 16; ++t) {
      const int id = lane + 64 * t, cl = id >> 4, cp = id & 15;
      u32x4 v = *(const u32x4*)(stg + cl * 136 + cp * 8);
      storeT(n0 + wn * 64 + cl, m0 + wm * 128 + cp * 8, v);
    }
  } else {
#pragma unroll
    for (int i = 0; i < 4; ++i)
#pragma unroll
      for (int j = 0; j < 2; ++j)
#pragma unroll
        for (int q4 = 0; q4 < 4; ++q4) {
          u32x2 w;
          w.x = pack2(acc[i][j][4 * q4], acc[i][j][4 * q4 + 1]);
          w.y = pack2(acc[i][j][4 * q4 + 2], acc[i][j][4 * q4 + 3]);
          *(u32x2*)(stg + (i * 32 + r) * 72 + j * 32 + 8 * q4 + 4 * h) = w;
        }
    __builtin_amdgcn_wave_barrier();
#pragma unroll 4
    for (int t = 0; t < 16; ++t) {
      const int id = lane + 64 * t, rl = id >> 3, cp = id & 7;
      u32x4 v = *(const u32x4*)(stg + rl * 72 + cp * 8);
      store(m0 + wm * 128 + rl, n0 + wn * 64 + cp * 8, v);
    }
  }
}

DI int xcd_tile(int it, int ntiles, int skip_tail = 0) {
  const int b = lbid(), g = gridDim.x;
  const int local = (b >> 3) + it * (g >> 3);
  const int per = ntiles >> 3;
  return local < per - skip_tail ? (b & 7) * per + local : -1;
}

DI void conv_tile(const float* __restrict__ src, int K, int N, u16* __restrict__ dst, const float* __restrict__ scale,
                  int tk, int tn, char* smem) {
  float* tile = (float*)smem;
  const int tid = ltid(), tx = tid & 63, ty = tid >> 6;
  const int k0 = tk * 64, n0 = tn * 64;
  __syncthreads();
#pragma unroll 4
  for (int i = 0; i < 8; ++i) {
    int kr = ty + 8 * i;
    float v = 0.f;
    if (n0 + tx < N) v = src[(size_t)(k0 + kr) * N + n0 + tx];
    if (scale) v *= scale[k0 + kr];
    tile[kr * 65 + tx] = v;
  }
  __syncthreads();
#pragma unroll 4
  for (int i = 0; i < 8; ++i) {
    int nr = ty + 8 * i;
    dst[(size_t)(n0 + nr) * K + k0 + tx] = f2bf(tile[tx * 65 + nr]);
  }
}

DI void convert_weights(const float* src, int K, int N, int Npad, u16* dst, const float* scale, char* smem) {
  const int tks = K / 64, tns = Npad / 64;
  for (int t = lbid(); t < tks * tns; t += gridDim.x) conv_tile(src, K, N, dst, scale, t / tns, t % tns, smem);
}

DI void prologue_phase(const Params& p, char* smem) {
  float* sc = (float*)smem;
  float* red = sc + 9 * 1024;
  const int tid = ltid();
  for (int i = tid; i < 9 * 1024; i += NTHR) {
    int j = i >> 10, k = i & 1023;
    float v = j < 8 ? p.c[j * 1024 + k] : p.c_ctx[k];
    sc[i] = v / (1.f + __expf(-v));
  }
  __syncthreads();
  for (int task = lbid(); task < DEPTH * 96; task += gridDim.x) {
    const int l = task / 96, n0 = (task % 96) * 64, nn = tid & 63, kq = tid >> 6;
    float acc[9];
#pragma unroll
    for (int j = 0; j < 9; ++j) acc[j] = 0.f;
    const float* w = p.w_ada + ((size_t)l * 1024 + kq * 128) * 6144 + n0 + nn;
    const float* scq = sc + kq * 128;
#pragma unroll 4
    for (int k = 0; k < 128; ++k) {
      float wv = w[(size_t)k * 6144];
#pragma unroll
      for (int j = 0; j < 9; ++j) acc[j] += scq[j * 1024 + k] * wv;
    }
#pragma unroll
    for (int j = 0; j < 9; ++j) red[(kq * 9 + j) * 64 + nn] = acc[j];
    __syncthreads();
    for (int idx = tid; idx < 576; idx += NTHR) {
      int j = idx >> 6, n2 = idx & 63;
      float s = p.b_ada[l * 6144 + n0 + n2];
#pragma unroll
      for (int q = 0; q < 8; ++q) s += red[(q * 9 + j) * 64 + n2];
      p.mod[(size_t)(l * 9 + j) * 6144 + n0 + n2] = s;
    }
    __syncthreads();
  }
  if (lbid() == gridDim.x - 1) {
    for (int i = tid; i < 64 * 16; i += NTHR) {
      int pos = i >> 4, j = i & 15;
      float inv_freq = exp2f(-(float)(2 * j) / 32.f * 13.287712379549449f);
      float ang = (float)pos * inv_freq;
      float k = rintf(ang * 0.15915494309189535f);
      float red2 = fmaf(-k, 6.2831854820251465f, ang);
      red2 = fmaf(-k, -1.7484555314695172e-07f, red2);
      p.ropetab[2 * i] = __cosf(red2);
      p.ropetab[2 * i + 1] = __sinf(red2);
    }
  }
}

DI void ew_row(const Params& p, int layer, int kind, int row, int lane) {
  const bool has_branch = !(kind == 0 && layer == 0);
  const bool src_in = (layer == 0 && kind <= 1);
  const bool store_x = has_branch;
  const int blayer = (kind == 1) ? layer : (kind == 0 ? layer - 1 : DEPTH - 1);
  const float* gpost = (kind == 1) ? p.g_post_mix + blayer * D : p.g_post_ff + (blayer < 0 ? 0 : blayer) * D;
  const int gate_off = (kind == 1) ? 2 * D : 5 * D;
  const float* gpre = (kind == 0) ? p.g_pre_mix + layer * D : p.g_pre_ff + (kind == 1 ? layer : 0) * D;
  const int shift_off = (kind == 0) ? 0 : 3 * D, scale_off = (kind == 0) ? D : 4 * D;
  const float* xl = src_in ? p.x : p.out;
  const float* xc = src_in ? p.ctx : p.xctx;
    const int b = row / SP, s = row - b * SP;
    const bool lat = s < SEQ;
    if ((kind == 2 || (kind == 1 && layer == DEPTH - 1)) && !lat) return;
    const size_t xoff = lat ? ((size_t)(b * SEQ + s) * D) : ((size_t)(b * CTX + s - SEQ) * D);
    const unsigned long long msk = lat ? ~0ull : 0ull;
    const float* xs = (const float*)(((unsigned long long)xl & msk) | ((unsigned long long)xc & ~msk)) + xoff;
    float* xd = (float*)(((unsigned long long)p.out & msk) | ((unsigned long long)p.xctx & ~msk)) + xoff;
    const int mi = lat ? b : 8;
    f32x4 xv[4];
#pragma unroll
    for (int i = 0; i < 4; ++i) xv[i] = *(const f32x4*)(xs + lane * 4 + 256 * i);
    if (has_branch) {
      const float* modb = p.mod + (size_t)(blayer * 9 + mi) * 6144 + gate_off;
      f32x4 yv[4];
      const u16* ysrc = (kind == 1) ? p.Y : p.F;
#pragma unroll
      for (int i = 0; i < 4; ++i) {
        u32x2 w = *(const u32x2*)(ysrc + (size_t)row * D + lane * 4 + 256 * i);
        yv[i] = f32x4{bflo(w.x), bfhi(w.x), bflo(w.y), bfhi(w.y)};
      }
      float ss = 0.f;
#pragma unroll
      for (int i = 0; i < 4; ++i) ss += yv[i].x * yv[i].x + yv[i].y * yv[i].y + yv[i].z * yv[i].z + yv[i].w * yv[i].w;
      ss = wave_sum(ss);
      const float rstd = rsqrtf(ss * (1.f / D) + EPS);
#pragma unroll
      for (int i = 0; i < 4; ++i) {
        const int col = lane * 4 + 256 * i;
        f32x4 g = *(const f32x4*)(gpost + col);
        f32x4 gt = *(const f32x4*)(modb + col);
        xv[i].x += gt.x * (yv[i].x * rstd * g.x);
        xv[i].y += gt.y * (yv[i].y * rstd * g.y);
        xv[i].z += gt.z * (yv[i].z * rstd * g.z);
        xv[i].w += gt.w * (yv[i].w * rstd * g.w);
      }
      if (store_x) {
#pragma unroll
        for (int i = 0; i < 4; ++i) *(f32x4*)(xd + lane * 4 + 256 * i) = xv[i];
      }
    }
    if (kind != 2) {
      const float* modl = p.mod + (size_t)(layer * 9 + mi) * 6144;
      float ss = 0.f;
#pragma unroll
      for (int i = 0; i < 4; ++i) ss += xv[i].x * xv[i].x + xv[i].y * xv[i].y + xv[i].z * xv[i].z + xv[i].w * xv[i].w;
      ss = wave_sum(ss);
      const float rstd = rsqrtf(ss * (1.f / D) + EPS);
#pragma unroll
      for (int i = 0; i < 4; ++i) {
        const int col = lane * 4 + 256 * i;
        f32x4 g = *(const f32x4*)(gpre + col);
        f32x4 sh = *(const f32x4*)(modl + shift_off + col);
        f32x4 sc = *(const f32x4*)(modl + scale_off + col);
        float h0 = xv[i].x * rstd * g.x * (1.f + sc.x) + sh.x;
        float h1 = xv[i].y * rstd * g.y * (1.f + sc.y) + sh.y;
        float h2 = xv[i].z * rstd * g.z * (1.f + sc.z) + sh.z;
        float h3 = xv[i].w * rstd * g.w * (1.f + sc.w) + sh.w;
        u32x2 w;
        w.x = pack2(h0, h1);
        w.y = pack2(h2, h3);
        *(u32x2*)(p.H + (size_t)row * D + col) = w;
      }
    }
}

DI void ew_phase(const Params& p, int layer, int kind) {
  const int tid = ltid(), lane = tid & 63, wid = __builtin_amdgcn_readfirstlane(tid >> 6);
  for (int rg = lbid(); rg < T / 8; rg += gridDim.x) ew_row(p, layer, kind, rg * 8 + wid, lane);
}

constexpr int CNT_STRIDE = 160;
DI void tile_done(int* cnt, int tm) {
  asm volatile("s_waitcnt vmcnt(0)" ::: "memory");
  __syncthreads();
  if (ltid() == 0) __hip_atomic_fetch_add(cnt + tm, 1, __ATOMIC_RELEASE, __HIP_MEMORY_SCOPE_AGENT);
}
template <class ConvF>
DI void ew_consume(const Params& p, int* cnt, int need, int layer, int kind, bool skip_ctx, int nconv, ConvF conv,
                   char* smem) {
  int* sh = (int*)(smem + SMEM_BYTES - 16);
  const int tid = ltid(), lane = tid & 63, wid = __builtin_amdgcn_readfirstlane(tid >> 6);
  for (;;) {
    __syncthreads();
    if (tid == 0) *sh = __hip_atomic_fetch_add(cnt + 136, 1, __ATOMIC_RELAXED, __HIP_MEMORY_SCOPE_AGENT);
    __syncthreads();
    const int q = *sh;
    if (q >= nconv + 544) break;
    if (q < nconv) { conv(q); continue; }
    const int c = q - nconv, mseq = c >> 2, j = mseq >> 3, bb = mseq & 7, tm = bb * 17 + j;
    if (skip_ctx && j == 16) continue;
    if (tid == 0) {
      while (__hip_atomic_load(cnt + tm, __ATOMIC_ACQUIRE, __HIP_MEMORY_SCOPE_AGENT) < need) __builtin_amdgcn_s_sleep(4);
    }
    __syncthreads();
    const int row0 = tm * 256 + (c & 3) * 64 + wid * 8;
#pragma unroll 1
    for (int i = 0; i < 8; ++i) ew_row(p, layer, kind, row0 + i, lane);
  }
}

DI void row_rstd(const u16* __restrict__ base, int ld, int ncols, int m0, float* rs) {
  const int tid = ltid(), row = tid >> 1, half = tid & 1;
  const int per = ncols / 2;
  const u16* ptr = base + (size_t)(m0 + row) * ld + half * per;
  float ss = 0.f;
  for (int i = 0; i < per; i += 8) {
    u32x4 v = *(const u32x4*)(ptr + i);
#pragma unroll
    for (int e = 0; e < 8; ++e) {
      float f = uw(v, e);
      ss += f * f;
    }
  }
  ss += __shfl_xor(ss, 1);
  if (half == 0) rs[row] = rsqrtf(ss / (float)ncols + EPS);
}

DI void qkv_tasks(const Params& p, char* smem) {
  float* rs = (float*)(smem + 2 * 2 * 256 * 72 * 2);
  const int MT = T / 256;
  auto noT = [](int, int, u32x4) {};
  auto neverT = [](int) { return false; };
  for (int t = lbid(); t < MT * 3; t += gridDim.x) {
    const int tm = t / 3, tn = t % 3, m0 = tm * 256;
    __syncthreads();
    row_rstd(p.P, NINP, 256, m0, rs);
    const bool lat = (m0 % SP) < SEQ;
    const int s0 = m0 % SP;
    gemm_tile<false>(
        p.P, NINP, p.wt_uq, 256, 256, m0, tn * 256, smem,
        [&](int mb, int nb, f32x16& acc, int r, int h) {
          const int rowl = mb - m0 + r;
          const float sc = rs[rowl];
#pragma unroll
          for (int e = 0; e < 16; ++e) acc[e] *= sc;
          const int cb = nb % 192;
          if (lat && cb >= 128) {
            const int s = s0 + rowl;
            const int pos = (cb == 128) ? (s >> 6) : (s & 63);
#pragma unroll
            for (int e = 0; e < 8; ++e) {
              const int j = crow(e, h);
              const float cs = p.ropetab[2 * (pos * 16 + j)], sn = p.ropetab[2 * (pos * 16 + j) + 1];
              const float x1 = acc[e], x2 = acc[e + 8];
              acc[e] = x1 * cs - x2 * sn;
              acc[e + 8] = x1 * sn + x2 * cs;
            }
          }
        },
        [&](int row, int col, u32x4 v) { *(u32x4*)(p.Q + (size_t)row * 768 + col) = v; }, noT, neverT);
  }
  for (int t = lbid(); t < MT * 4; t += gridDim.x) {
    const int tm = t / 4, tn = t % 4, m0 = tm * 256;
    const int b = m0 / SP, s0 = m0 % SP;
    const bool lat = s0 < SEQ;
    __syncthreads();
    row_rstd(p.P + 256, NINP, 128, m0, rs);
    if (tn == 0) {
      for (int idx = ltid(); idx < 256 * 32; idx += NTHR) {
        const int rowl = idx >> 5, q = idx & 31, blk = q >> 4, j = q & 15;
        const u16* src = p.P + (size_t)(m0 + rowl) * NINP + 384 + blk * 32 + j;
        float x1 = bf2f(src[0]), x2 = bf2f(src[16]);
        float o1 = x1, o2 = x2;
        if (lat) {
          const int s = s0 + rowl;
          const int pos = blk == 0 ? (s >> 6) : (s & 63);
          const float cs = p.ropetab[2 * (pos * 16 + j)], sn = p.ropetab[2 * (pos * 16 + j) + 1];
          o1 = x1 * cs - x2 * sn;
          o2 = x1 * sn + x2 * cs;
        }
        u16* dst = p.Kr + (size_t)(m0 + rowl) * 64 + blk * 32 + j;
        dst[0] = f2bf(o1);
        dst[16] = f2bf(o2);
      }
    }
    const int n0 = tn * 256;
    u16* vbase = p.Vt + (size_t)(b * 4 + tn) * 128 * SP + s0;
    gemm_tile<true>(
        p.P + 256, NINP, p.wt_ukv, 128, 128, m0, n0, smem,
        [&](int mb, int nb, f32x16& acc, int r, int h) {
          const float sc = rs[mb - m0 + r];
#pragma unroll
          for (int e = 0; e < 16; ++e) acc[e] *= sc;
        },
        [&](int row, int col, u32x4 v) { *(u32x4*)(p.Kn + (size_t)row * 512 + tn * 128 + (col - n0)) = v; },
        [&](int col, int row, u32x4 v) { *(u32x4*)(vbase + (size_t)(col - n0 - 128) * SP + (row - m0)) = v; },
        [](int wn) { return wn >= 2; });
  }
}

DI void cm_tasks(const Params& p, int layer, char* smem) {
  const int ftid = ltid(), vb = ftid >> 8, tid = ftid & 255;
  u16* vnT = (u16*)(smem + vb * VSMEM);
  const int lane = tid & 63, wid = tid >> 6, r = lane & 31, h = lane >> 5;
  const float* gn = p.cm_norm_g + layer * 256;
  const float* bs = p.cm_b_s + layer * 512;
  for (int t0 = lbid() * 2; t0 < NB * NCH; t0 += gridDim.x * 2) {
    const int task = t0 + vb;
    const int row0 = task * 128;
    __syncthreads();
#pragma unroll 4
    for (int i = 0; i < 32; ++i) {
      const int s = wid * 32 + i;
      const u16* src = p.P + (size_t)(row0 + s) * NINP + 704;
      float v[4];
      float sum = 0.f;
#pragma unroll
      for (int q = 0; q < 4; ++q) {
        v[q] = gelu_f(bf2f(src[lane + 64 * q]));
        sum += v[q];
      }
      const float mean = wave_sum(sum) * (1.f / 256.f);
      float var = 0.f;
#pragma unroll
      for (int q = 0; q < 4; ++q) {
        v[q] -= mean;
        var += v[q] * v[q];
      }
      const float rstd = rsqrtf(wave_sum(var) * (1.f / 256.f) + EPS);
#pragma unroll
      for (int q = 0; q < 4; ++q) vnT[(lane + 64 * q) * 136 + s] = f2bf(v[q] * rstd * gn[lane + 64 * q]);
    }
    __syncthreads();
    const int t = wid * 32 + r;
    for (int g = 0; g < 4; ++g) {
      bf16x8 wf[8];
#pragma unroll
      for (int kk = 0; kk < 8; ++kk) wf[kk] = *(const bf16x8*)(p.wsb + ((size_t)(g * 128 + t)) * 128 + kk * 16 + h * 8);
      const float bias = bs[g * 128 + t];
#pragma unroll
      for (int cb = 0; cb < 2; ++cb) {
        f32x16 acc;
#pragma unroll
        for (int e = 0; e < 16; ++e) acc[e] = 0.f;
#pragma unroll
        for (int kk = 0; kk < 8; ++kk) {
          bf16x8 a = *(const bf16x8*)(vnT + (g * 64 + cb * 32 + r) * 136 + kk * 16 + h * 8);
          acc = MFMA(a, wf[kk], acc);
        }
#pragma unroll
        for (int q4 = 0; q4 < 4; ++q4) {
          const int ch0 = g * 64 + cb * 32 + 8 * q4 + 4 * h;
          u32x2 uwd = *(const u32x2*)(p.P + (size_t)(row0 + t) * NINP + 448 + ch0);
          float u0 = gelu_f(bflo(uwd.x)), u1 = gelu_f(bfhi(uwd.x)), u2 = gelu_f(bflo(uwd.y)), u3 = gelu_f(bfhi(uwd.y));
          u32x2 w;
          w.x = pack2(u0 * (acc[4 * q4] + bias), u1 * (acc[4 * q4 + 1] + bias));
          w.y = pack2(u2 * (acc[4 * q4 + 2] + bias), u3 * (acc[4 * q4 + 3] + bias));
          *(u32x2*)(p.H + (size_t)(row0 + t) * D + 512 + ch0) = w;
        }
      }
    }
  }
}

struct ConvW { f32x4 w0a, w0b, w1a, w1b, w2a, w2b, ba, bb; };
DI ConvW load_convw(const Params& p, int layer, int ch) {
  const float* cw = p.conv_w + (size_t)layer * 3 * 768 + ch;
  const float* cb = p.conv_b + layer * 768 + ch;
  ConvW c;
  c.w0a = *(const f32x4*)(cw); c.w0b = *(const f32x4*)(cw + 4);
  c.w1a = *(const f32x4*)(cw + 768); c.w1b = *(const f32x4*)(cw + 772);
  c.w2a = *(const f32x4*)(cw + 1536); c.w2b = *(const f32x4*)(cw + 1540);
  c.ba = *(const f32x4*)(cb); c.bb = *(const f32x4*)(cb + 4);
  return c;
}
DI float convw_get(const f32x4& a, const f32x4& b, int e) { return e < 4 ? a[e & 3] : b[e & 3]; }
DI void conv8(const Params& p, const ConvW& c, int row, int ch, bool hasPrev, bool hasNext, float out[8]) {
  const u16* base = p.P + (size_t)row * NINP + 1216 + ch;
  u32x4 cur = *(const u32x4*)base;
  u32x4 prv = *(const u32x4*)(base - (hasPrev ? NINP : 0));
  u32x4 nxt = *(const u32x4*)(base + (hasNext ? NINP : 0));
  const float mp = hasPrev ? 1.f : 0.f, mn = hasNext ? 1.f : 0.f;
#pragma unroll
  for (int e = 0; e < 8; ++e) {
    float y = convw_get(c.w0a, c.w0b, e) * (mp * uw(prv, e)) + convw_get(c.w1a, c.w1b, e) * uw(cur, e) +
              convw_get(c.w2a, c.w2b, e) * (mn * uw(nxt, e)) + convw_get(c.ba, c.bb, e);
    out[e] = silu_f(y);
  }
}

DI void ssd_dt_arrays(const Params& p, int layer, int row0, int hh, int t, float* arr) {
  float* dt0 = arr;
  float* dt1 = arr + 128;
  float* c0 = arr + 256;
  float* s1 = arr + 384;
  float* a0 = arr + 512;
  float* a1 = arr + 640;
  const float d0 = softplus_f(p.dtraw[(size_t)(row0 + t) * 8 + hh] + p.dt_bias[layer * 8 + hh]);
  const float d1 = softplus_f(p.dtraw[(size_t)(row0 + t) * 8 + 4 + hh] + p.dt_bias[layer * 8 + 4 + hh]);
  dt0[t] = d0;
  dt1[t] = d1;
  a0[t] = -d0 * __expf(p.a_log[layer * 8 + hh]);
  a1[t] = -d1 * __expf(p.a_log[layer * 8 + 4 + hh]);
}
DI float wave_incl_prefix(float x, int lane) {
#pragma unroll
  for (int o = 1; o < 64; o <<= 1) {
    float y = __shfl_up(x, o);
    if (lane >= o) x += y;
  }
  return x;
}
DI void ssd_cum_arrays(int t, float* arr) {
  float* c0 = arr + 256;
  float* s1 = arr + 384;
  const float* a0 = arr + 512;
  const float* a1 = arr + 640;
  const int lane = t & 63, w = t >> 6;
  const float x0 = a0[t], o0 = a0[t ^ 64], x1 = a1[t], o1 = a1[t ^ 64];
  const float tot_o0 = wave_sum(o0), tot_o1 = wave_sum(o1), tot_x1 = wave_sum(x1);
  float p0 = wave_incl_prefix(x0, lane);
  float p1 = wave_incl_prefix(x1, lane);
  if (w == 1) p0 += tot_o0;
  float sf = tot_x1 - p1 + x1;
  if (w == 0) sf += tot_o1;
  c0[t] = p0;
  s1[t] = sf;
}

DI void ssd_s1_tasks(const Params& p, int layer, char* smem) {
  const int ftid = ltid(), vb = ftid >> 8, tid = ftid & 255;
  u16* xsT0 = (u16*)(smem + vb * VSMEM);
  u16* xsT1 = xsT0 + 64 * 136;
  u16* BT = xsT1 + 64 * 136;
  float* arr = (float*)(BT + 128 * 136);
  float* w0 = arr + 768;
  float* w1 = w0 + 128;
  const int lane = tid & 63, wid = tid >> 6, r = lane & 31, h = lane >> 5;
  for (int t0 = lbid() * 2; t0 < NB * NCH * 4; t0 += gridDim.x * 2) {
    const int task = t0 + vb;
    const int hh = task & 3, bc = task >> 2, c = bc % NCH, b = bc / NCH;
    const int g = hh >> 1;
    const int row0 = bc * 128;
    const bool cPrev = (c != 0 && c != 32), cNext = (c != 31 && c != 33);
    __syncthreads();
    if (tid < 128) ssd_dt_arrays(p, layer, row0, hh, tid, arr);
    __syncthreads();
    if (tid < 128) ssd_cum_arrays(tid, arr);
    __syncthreads();
    if (tid < 128) {
      const float* dt0 = arr;
      const float* dt1 = arr + 128;
      const float* c0 = arr + 256;
      const float* s1 = arr + 384;
      w0[tid] = __expf(c0[127] - c0[tid]) * dt0[tid];
      w1[tid] = __expf(s1[0] - s1[tid]) * dt1[tid];
      if (tid == 0) {
        p.atot[((size_t)bc * 2 + 0) * 4 + hh] = c0[127];
        p.atot[((size_t)bc * 2 + 1) * 4 + hh] = s1[0];
      }
    }
    __syncthreads();
    const ConvW cwx = load_convw(p, layer, hh * 64 + (tid & 7) * 8);
#pragma unroll 4
    for (int i = 0; i < 4; ++i) {
      const int id = tid + VT * i, t = id >> 3, cp = id & 7;
      float v[8];
      conv8(p, cwx, row0 + t, hh * 64 + cp * 8, cPrev || t > 0, cNext || t < 127, v);
      const float f0 = w0[t], f1 = w1[t];
#pragma unroll
      for (int e = 0; e < 8; ++e) {
        xsT0[(cp * 8 + e) * 136 + t] = f2bf(v[e] * f0);
        xsT1[(cp * 8 + e) * 136 + t] = f2bf(v[e] * f1);
      }
    }
    const ConvW cwb = load_convw(p, layer, 256 + g * 128 + (tid & 15) * 8);
#pragma unroll 4
    for (int i = 0; i < 8; ++i) {
      const int id = tid + VT * i, t = id >> 4, cp = id & 15;
      float v[8];
      conv8(p, cwb, row0 + t, 256 + g * 128 + cp * 8, cPrev || t > 0, cNext || t < 127, v);
#pragma unroll
      for (int e = 0; e < 8; ++e) BT[(cp * 8 + e) * 136 + t] = f2bf(v[e]);
    }
    __syncthreads();
#pragma unroll
    for (int d = 0; d < 2; ++d) {
      const u16* xsT = d ? xsT1 : xsT0;
#pragma unroll
      for (int pb = 0; pb < 2; ++pb) {
        f32x16 acc;
#pragma unroll
        for (int e = 0; e < 16; ++e) acc[e] = 0.f;
#pragma unroll
        for (int kk = 0; kk < 8; ++kk) {
          bf16x8 a = *(const bf16x8*)(xsT + (pb * 32 + r) * 136 + kk * 16 + h * 8);
          bf16x8 bb = *(const bf16x8*)(BT + (wid * 32 + r) * 136 + kk * 16 + h * 8);
          acc = MFMA(a, bb, acc);
        }
        float* dst = p.CS + ((((size_t)bc * 2 + d) * 4 + hh) * 64 + pb * 32) * 128 + wid * 32 + r;
#pragma unroll
        for (int e = 0; e < 16; ++e) dst[(size_t)crow(e, h) * 128] = acc[e];
      }
    }
  }
}

DI void ssd_scan_phase(const Params& p) {
  const int total = NB * 2 * 4 * 8192;
  for (int idx = lbid() * NTHR + ltid(); idx < total; idx += gridDim.x * NTHR) {
    const int e = idx & 8191, hh = (idx >> 13) & 3, d = (idx >> 15) & 1, b = idx >> 16;
    float st = 0.f;
#pragma unroll 2
    for (int i = 0; i < NCH; ++i) {
      int c;
      if (d == 0) c = i < 2 ? 32 + i : i - 2;
      else c = i < 2 ? 33 - i : 33 - i;
      const size_t bc = (size_t)b * NCH + c;
      float* ptr = p.CS + ((bc * 2 + d) * 4 + hh) * 8192 + e;
      const float v = *ptr;
      const float dec = __expf(p.atot[(bc * 2 + d) * 4 + hh]);
      *ptr = st;
      st = dec * st + v;
    }
  }
}

template <int G>
DI float ssd_s3_group(const Params& p, int layer, int bc, bool cPrev, bool cNext, u16* Bg, u16* xsT, float* arr, int tid) {
  f32x16 y[4];
#pragma unroll
  for (int i = 0; i < 4; ++i)
#pragma unroll
    for (int e = 0; e < 16; ++e) y[i][e] = 0.f;
  const int lane = tid & 63, wid = tid >> 6, r = lane & 31, h = lane >> 5;
  const int l = wid * 32 + r;
  const int row0 = bc * 128;
  __syncthreads();
  ssd_dt_arrays(p, layer, row0, 2 * G + (tid >> 7), tid & 127, arr + (tid >> 7) * 768);
  const ConvW cwc = load_convw(p, layer, 512 + G * 128 + (tid & 15) * 8);
#pragma unroll 1
  for (int i = 0; i < 8; ++i) {
    const int id = tid + VT * i, t = id >> 4, cp = id & 15;
    float v[8];
    conv8(p, cwc, row0 + t, 512 + G * 128 + cp * 8, cPrev || t > 0, cNext || t < 127, v);
    *(bf16x8*)(Bg + t * 136 + cp * 8) = pack8(v[0], v[1], v[2], v[3], v[4], v[5], v[6], v[7]);
  }
  const ConvW cwx = load_convw(p, layer, G * 128 + (tid & 15) * 8);
#pragma unroll 1
  for (int i = 0; i < 8; ++i) {
    const int id = tid + VT * i, t = id >> 4, cp = id & 15;
    float v[8];
    conv8(p, cwx, row0 + t, G * 128 + cp * 8, cPrev || t > 0, cNext || t < 127, v);
#pragma unroll
    for (int e = 0; e < 8; ++e) xsT[(cp * 8 + e) * 136 + t] = f2bf(v[e]);
  }
  __syncthreads();
  ssd_cum_arrays(tid & 127, arr + (tid >> 7) * 768);
  bf16x8 cf[8];
#pragma unroll
  for (int kk = 0; kk < 8; ++kk) cf[kk] = *(const bf16x8*)(Bg + l * 136 + kk * 16 + h * 8);
  __syncthreads();
  const ConvW cwb = load_convw(p, layer, 256 + G * 128 + (tid & 15) * 8);
#pragma unroll 1
  for (int i = 0; i < 8; ++i) {
    const int id = tid + VT * i, t = id >> 4, cp = id & 15;
    float v[8];
    conv8(p, cwb, row0 + t, 256 + G * 128 + cp * 8, cPrev || t > 0, cNext || t < 127, v);
    *(bf16x8*)(Bg + t * 136 + cp * 8) = pack8(v[0], v[1], v[2], v[3], v[4], v[5], v[6], v[7]);
  }
  __syncthreads();
  float ss = 0.f;
#pragma unroll 1
  for (int hd2 = 0; hd2 < 2; ++hd2) {
    const int hh = 2 * G + hd2;
    const float* ah = arr + hd2 * 768;
    const float c0l = ah[256 + l], s1l = ah[384 + l];
    f32x16 y[2];
#pragma unroll
    for (int i = 0; i < 2; ++i)
#pragma unroll
      for (int e = 0; e < 16; ++e) y[i][e] = 0.f;
#pragma unroll 1
    for (int sb = 0; sb < 4; ++sb) {
      f32x16 gt;
#pragma unroll
      for (int e = 0; e < 16; ++e) gt[e] = 0.f;
#pragma unroll
      for (int kk = 0; kk < 8; ++kk) {
        bf16x8 a = *(const bf16x8*)(Bg + (sb * 32 + r) * 136 + kk * 16 + h * 8);
        gt = MFMA(a, cf[kk], gt);
      }
      f32x16 wv;
#pragma unroll
      for (int e = 0; e < 16; ++e) {
        const int s = sb * 32 + crow(e, h);
        const float a0 = (l >= s) ? (c0l - ah[256 + s]) : -1e30f;
        const float a1 = (l <= s) ? (s1l - ah[384 + s]) : -1e30f;
        const float f = __expf(a0) * ah[s] + __expf(a1) * ah[128 + s];
        wv[e] = gt[e] * f;
      }
      bf16x8 wp0 = pack8(wv[0], wv[1], wv[2], wv[3], wv[4], wv[5], wv[6], wv[7]);
      bf16x8 wp1 = pack8(wv[8], wv[9], wv[10], wv[11], wv[12], wv[13], wv[14], wv[15]);
#pragma unroll
      for (int pb = 0; pb < 2; ++pb) {
        const u16* xrow = xsT + (hd2 * 64 + pb * 32 + r) * 136 + sb * 32 + 4 * h;
        s16x4 lo0 = *(const s16x4*)(xrow), hi0 = *(const s16x4*)(xrow + 8);
        s16x4 lo1 = *(const s16x4*)(xrow + 16), hi1 = *(const s16x4*)(xrow + 24);
        bf16x8 a0 = __builtin_shufflevector(lo0, hi0, 0, 1, 2, 3, 4, 5, 6, 7);
        bf16x8 a1 = __builtin_shufflevector(lo1, hi1, 0, 1, 2, 3, 4, 5, 6, 7);
        y[pb] = MFMA(a0, wp0, y[pb]);
        y[pb] = MFMA(a1, wp1, y[pb]);
      }
    }
#pragma unroll 1
    for (int d = 0; d < 2; ++d) {
      const float el = __expf(d == 0 ? c0l : s1l);
#pragma unroll
      for (int pb = 0; pb < 2; ++pb) {
        const float* srow = p.CS + ((((size_t)bc * 2 + d) * 4 + hh) * 64 + pb * 32 + r) * 128 + h * 8;
        f32x16 tmp;
#pragma unroll
        for (int e = 0; e < 16; ++e) tmp[e] = 0.f;
#pragma unroll
        for (int kk = 0; kk < 8; ++kk) {
          f32x4 s0 = *(const f32x4*)(srow + kk * 16), s1 = *(const f32x4*)(srow + kk * 16 + 4);
          bf16x8 a = pack8(s0.x, s0.y, s0.z, s0.w, s1.x, s1.y, s1.z, s1.w);
          tmp = MFMA(a, cf[kk], tmp);
        }
#pragma unroll
        for (int e = 0; e < 16; ++e) y[pb][e] += el * tmp[e];
      }
    }
    const float dsk = p.ssd_d[layer * 8 + hh] + p.ssd_d[layer * 8 + 4 + hh];
#pragma unroll
    for (int pb = 0; pb < 2; ++pb) {
#pragma unroll
      for (int q4 = 0; q4 < 4; ++q4) {
        const int cl = hd2 * 64 + pb * 32 + 8 * q4 + 4 * h;
        const int ch0 = G * 128 + cl;
        u32x2 zw = *(const u32x2*)(p.P + (size_t)(row0 + l) * NINP + 960 + ch0);
        f32x4 o;
        o.x = (y[pb][4 * q4] + dsk * bf2f(xsT[(cl + 0) * 136 + l])) * silu_f(bflo(zw.x));
        o.y = (y[pb][4 * q4 + 1] + dsk * bf2f(xsT[(cl + 1) * 136 + l])) * silu_f(bfhi(zw.x));
        o.z = (y[pb][4 * q4 + 2] + dsk * bf2f(xsT[(cl + 2) * 136 + l])) * silu_f(bflo(zw.y));
        o.w = (y[pb][4 * q4 + 3] + dsk * bf2f(xsT[(cl + 3) * 136 + l])) * silu_f(bfhi(zw.y));
        ss += o.x * o.x + o.y * o.y + o.z * o.z + o.w * o.w;
        *(f32x4*)(p.ytmp + (size_t)(row0 + l) * 256 + ch0) = o;
      }
    }
  }
  return ss;
}

DI void ssd_s3_tasks(const Params& p, int layer, char* smem) {
  const int ftid = ltid(), vb = ftid >> 8, tid = ftid & 255;
  u16* Bg = (u16*)(smem + vb * VSMEM);
  u16* xsT = Bg + 128 * 136;
  float* arr = (float*)(xsT + 128 * 136);
  const int lane = tid & 63, wid = tid >> 6, r = lane & 31, h = lane >> 5;
  const int l = wid * 32 + r;
  for (int t0 = lbid() * 2; t0 < NB * NCH; t0 += gridDim.x * 2) {
    const int bc = t0 + vb, c = bc % NCH;
    const int row0 = bc * 128;
    const bool cPrev = (c != 0 && c != 32), cNext = (c != 31 && c != 33);
    float ss = ssd_s3_group<0>(p, layer, bc, cPrev, cNext, Bg, xsT, arr, tid);
    ss += ssd_s3_group<1>(p, layer, bc, cPrev, cNext, Bg, xsT, arr, tid);
    ss += __shfl_xor(ss, 32);
    const float rstd = rsqrtf(ss * (1.f / 256.f) + EPS);
    const float* gn = p.ssd_norm_g + layer * 256;
#pragma unroll 4
    for (int i = 0; i < 32; ++i) {
      const int ch0 = (i >> 2) * 32 + 8 * (i & 3) + 4 * h;
      f32x4 v = *(const f32x4*)(p.ytmp + (size_t)(row0 + l) * 256 + ch0);
      f32x4 gv = *(const f32x4*)(gn + ch0);
      u32x2 w;
      w.x = pack2(v.x * rstd * gv.x, v.y * rstd * gv.y);
      w.y = pack2(v.z * rstd * gv.z, v.w * rstd * gv.w);
      *(u32x2*)(p.H + (size_t)(row0 + l) * D + 768 + ch0) = w;
    }
  }
}

DI void attn_qk(const u16* Ks, const bf16x8 (&qf)[1], const u16* qs, f32x16 (&st)[2], int r, int h) {
#pragma unroll
  for (int kb = 0; kb < 2; ++kb)
#pragma unroll
    for (int e = 0; e < 16; ++e) st[kb][e] = 0.f;
  const u16* kp = Ks + r * 200 + h * 8;
#pragma unroll
  for (int kk = 0; kk < 12; ++kk) {
    bf16x8 k0 = *(const bf16x8*)(kp + kk * 16);
    bf16x8 k1 = *(const bf16x8*)(kp + 32 * 200 + kk * 16);
    bf16x8 q;
    if (kk < 1) q = qf[kk];
    else q = *(const bf16x8*)(qs + (kk - 1) * 512);
    st[0] = MFMA(k0, q, st[0]);
    st[1] = MFMA(k1, q, st[1]);
  }
}
DI void attn_softmax(f32x16 (&st)[2], f32x16 (&o)[4], bf16x8 (&pf)[4], float& m_run, float& l_run, float sc) {
  float mx = st[0][0];
#pragma unroll
  for (int kb = 0; kb < 2; ++kb)
#pragma unroll
    for (int e = 0; e < 16; ++e) mx = fmaxf(mx, st[kb][e]);
  mx = fmaxf(mx, __shfl_xor(mx, 32));
  const float m_new = fmaxf(m_run, mx * sc);
  const float alpha = __builtin_amdgcn_exp2f(m_run - m_new);
  m_run = m_new;
  float ls = 0.f;
#pragma unroll
  for (int kb = 0; kb < 2; ++kb)
#pragma unroll
    for (int e = 0; e < 16; ++e) {
      float pv = __builtin_amdgcn_exp2f(fmaf(st[kb][e], sc, -m_new));
      ls += pv;
      st[kb][e] = pv;
    }
  l_run = l_run * alpha + ls;
#pragma unroll
  for (int i = 0; i < 4; ++i)
#pragma unroll
    for (int e = 0; e < 16; ++e) o[i][e] *= alpha;
#pragma unroll
  for (int ks = 0; ks < 4; ++ks) {
    const int kb = ks >> 1, s2 = ks & 1;
    pf[ks] = pack8(st[kb][8 * s2], st[kb][8 * s2 + 1], st[kb][8 * s2 + 2], st[kb][8 * s2 + 3], st[kb][8 * s2 + 4],
                   st[kb][8 * s2 + 5], st[kb][8 * s2 + 6], st[kb][8 * s2 + 7]);
  }
}
DI void attn_pv(const u16* Vs, const bf16x8 (&pf)[4], f32x16 (&o)[4], int r, int h) {
#pragma unroll
  for (int ks = 0; ks < 4; ++ks) {
#pragma unroll
    for (int db = 0; db < 4; ++db) {
      const u16* vr = Vs + (db * 32 + r) * 68 + ks * 16 + 4 * h;
      s16x4 lo = *(const s16x4*)vr, hi = *(const s16x4*)(vr + 8);
      bf16x8 a = __builtin_shufflevector(lo, hi, 0, 1, 2, 3, 4, 5, 6, 7);
      o[db] = MFMA(a, pf[ks], o[db]);
    }
  }
}

DI void attn_tasks(const Params& p, char* smem) {
  u16* Ks = (u16*)smem;
  u16* Vs0 = Ks + 64 * 200;
  const int tid = ltid(), lane = tid & 63, wid = __builtin_amdgcn_readfirstlane(tid >> 6), r = lane & 31, h = lane >> 5;
  const bool late = wid >= 4;
  u16* qs = Vs0 + 2 * 128 * 68 + wid * (11 * 512) + lane * 8;
  const float sc = 0.07216878364870322f * 1.4426950408889634f;
  for (int task = lbid(); task < NB * 4 * 17; task += gridDim.x) {
    int b, hd, qt;
    if (task < 512) {
      qt = task & 15; hd = (task >> 4) & 3; b = task >> 6;
    } else {
      const int t2 = task - 512;
      qt = 16; hd = t2 & 3; b = t2 >> 2;
    }
    const int koff = (qt < 16) ? 0 : SEQ;
    const int nkt = ((qt < 16) ? SP : CTX) / 64;
    const int qrow = b * SP + qt * 256 + wid * 32 + r;
    bf16x8 qf[1];
#pragma unroll
    for (int kk = 0; kk < 1; ++kk) qf[kk] = *(const bf16x8*)(p.Q + (size_t)qrow * 768 + hd * 192 + kk * 16 + h * 8);
#pragma unroll
    for (int kk = 1; kk < 12; ++kk)
      *(bf16x8*)(qs + (kk - 1) * 512) = *(const bf16x8*)(p.Q + (size_t)qrow * 768 + hd * 192 + kk * 16 + h * 8);
    f32x16 o[4];
#pragma unroll
    for (int i = 0; i < 4; ++i)
#pragma unroll
      for (int e = 0; e < 16; ++e) o[i][e] = 0.f;
    bf16x8 pf[4];
#pragma unroll
    for (int i = 0; i < 4; ++i)
#pragma unroll
      for (int e = 0; e < 8; ++e) pf[i][e] = 0;
    float m_run = -1e30f, l_run = 0.f;
    u32x4 kn[2], kr[1], vv[2];
    const u16* knb = p.Kn + ((size_t)(b * SP + koff) + (tid >> 4)) * 512 + hd * 128 + (tid & 15) * 8;
    const u16* krb = p.Kr + ((size_t)(b * SP + koff) + (tid >> 3)) * 64 + (tid & 7) * 8;
    const u16* vb = p.Vt + ((size_t)(b * 4 + hd) * 128 + (tid >> 3)) * SP + koff + (tid & 7) * 8;
#pragma unroll
    for (int i = 0; i < 2; ++i) kn[i] = *(const u32x4*)(knb + (size_t)(32 * i) * 512);
    kr[0] = *(const u32x4*)(krb);
#pragma unroll
    for (int i = 0; i < 2; ++i) vv[i] = *(const u32x4*)(vb + (size_t)(64 * i) * SP);
    for (int kt = 0; kt < nkt; ++kt) {
      u16* Vs = Vs0 + (kt & 1) * (128 * 68);
      __syncthreads();
#pragma unroll
      for (int i = 0; i < 2; ++i) *(u32x4*)(Ks + ((tid >> 4) + 32 * i) * 200 + (tid & 15) * 8) = kn[i];
      *(u32x4*)(Ks + (tid >> 3) * 200 + 128 + (tid & 7) * 8) = kr[0];
#pragma unroll
      for (int i = 0; i < 2; ++i) {
        u16* dst = Vs + ((tid >> 3) + 64 * i) * 68 + (tid & 7) * 8;
        *(u32x2*)dst = u32x2{vv[i].x, vv[i].y};
        *(u32x2*)(dst + 4) = u32x2{vv[i].z, vv[i].w};
      }
      __syncthreads();
      {
        const size_t ko = (size_t)(kt + 1 < nkt ? kt + 1 : kt) * 64;
#pragma unroll
        for (int i = 0; i < 2; ++i) kn[i] = *(const u32x4*)(knb + (ko + 32 * i) * 512);
        kr[0] = *(const u32x4*)(krb + ko * 64);
#pragma unroll
        for (int i = 0; i < 2; ++i) vv[i] = *(const u32x4*)(vb + (size_t)(64 * i) * SP + ko);
      }
      __builtin_amdgcn_sched_barrier(0);
      if (late && kt > 0) attn_pv(Vs0 + ((kt - 1) & 1) * (128 * 68), pf, o, r, h);
      {
        f32x16 st[2];
        attn_qk(Ks, qf, qs, st, r, h);
        attn_softmax(st, o, pf, m_run, l_run, sc);
      }
      if (!late) attn_pv(Vs, pf, o, r, h);
    }
    if (late) attn_pv(Vs0 + ((nkt - 1) & 1) * (128 * 68), pf, o, r, h);
    const float ltot = l_run + __shfl_xor(l_run, 32);
    const float inv = 1.f / ltot;
    u16* orow = p.H + (size_t)qrow * D + hd * 128;
#pragma unroll
    for (int db = 0; db < 4; ++db)
#pragma unroll
      for (int q4 = 0; q4 < 4; ++q4) {
        u32x2 w;
        w.x = pack2(o[db][4 * q4] * inv, o[db][4 * q4 + 1] * inv);
        w.y = pack2(o[db][4 * q4 + 2] * inv, o[db][4 * q4 + 3] * inv);
        *(u32x2*)(orow + db * 32 + 8 * q4 + 4 * h) = w;
      }
  }
}

constexpr int NPHASE = 2 + DEPTH * 7;

DI void conv_item_ffn(const Params& p, int layer, int q, char* smem) {
#pragma unroll 1
  for (int u = 0; u < 8; ++u) {
    const int tile = q * 8 + u;
    if (tile < 1024) conv_tile(p.w_ff1 + (size_t)layer * D * DFF, D, DFF, p.wt_ff1, nullptr, tile >> 6, tile & 63, smem);
    else conv_tile(p.w_ff2 + (size_t)layer * DFF * D, DFF, D, p.wt_ff2, nullptr, (tile - 1024) >> 4, (tile - 1024) & 15, smem);
  }
}
DI void conv_item_mix(const Params& p, int layer, int q, char* smem) {
#pragma unroll 1
  for (int u = 0; u < 8; ++u) {
    int tile = q * 8 + u;
    if (tile < 512) { conv_tile(p.w_in + (size_t)layer * D * NIN, D, NIN, p.wt_in, nullptr, tile >> 5, tile & 31, smem); continue; }
    tile -= 512;
    if (tile < 48) { conv_tile(p.w_uq + (size_t)layer * 256 * 768, 256, 768, p.wt_uq, p.g_q + layer * 256, tile / 12, tile % 12, smem); continue; }
    tile -= 48;
    if (tile < 32) { conv_tile(p.w_ukv + (size_t)layer * 128 * 1024, 128, 1024, p.wt_ukv, p.g_kv + layer * 128, tile >> 4, tile & 15, smem); continue; }
    tile -= 32;
    if (tile < 256) { conv_tile(p.w_out + (size_t)layer * D * D, D, D, p.wt_out, nullptr, tile >> 4, tile & 15, smem); continue; }
    tile -= 256;
    for (int i = ltid(); i < 4096; i += NTHR) p.wsb[tile * 4096 + i] = f2bf(p.cm_w_s[(size_t)layer * 65536 + tile * 4096 + i]);
  }
}

DI void run_phase(const Params& p, int ph, char* smem) {
  if (ph == 0) { prologue_phase(p, smem); return; }
  const int MT = T / 256;
  auto noT = [](int, int, u32x4) {};
  auto neverT = [](int) { return false; };
  if (ph == 1) {
    ew_phase(p, 0, 0);
    for (int q = lbid(); q < 108; q += gridDim.x) conv_item_mix(p, 0, q, smem);
    return;
  }
  const int layer = (ph - 2) / 7, sub = (ph - 2) % 7;
  const bool last = layer == DEPTH - 1;
  switch (sub) {
    case 0: {
      for (int it = 0;; ++it) {
        const int t = xcd_tile(it, MT * 8);
        if (t < 0) break;
        const int tm = t >> 3, tn = t & 7;
        gemm_tile<false>(
            p.H, D, p.wt_in, D, D, tm * 256, tn * 256, smem,
            [&](int mb, int nb, f32x16& acc, int r, int h) {
              if (nb == 1984) {
                f32x4 v = {acc[0], acc[1], acc[2], acc[3]};
                *(f32x4*)(p.dtraw + (size_t)(mb + r) * 8 + 4 * h) = v;
              }
            },
            [&](int row, int col, u32x4 v) { *(u32x4*)(p.P + (size_t)row * NINP + col) = v; }, noT, neverT);
      }
    } break;
    case 1: {
      qkv_tasks(p, smem);
      cm_tasks(p, layer, smem);
      ssd_s1_tasks(p, layer, smem);
    } break;
    case 2: ssd_scan_phase(p); break;
    case 3: {
      attn_tasks(p, smem);
      ssd_s3_tasks(p, layer, smem);
    } break;
    case 4: {
      int* cnt = p.cnt + (2 * layer) * CNT_STRIDE;
      for (int it = 0;; ++it) {
        const int t = xcd_tile(it, MT * 4, last ? 4 : 0);
        if (t < 0) break;
        const int tm = t >> 2, tn = t & 3;
        gemm_tile<false>(
            p.H, D, p.wt_out, D, D, tm * 256, tn * 256, smem, [](int, int, f32x16&, int, int) {},
            [&](int row, int col, u32x4 v) { *(u32x4*)(p.Y + (size_t)row * D + col) = v; }, noT, neverT);
        tile_done(cnt, tm);
      }
      ew_consume(p, cnt, 4, layer, 1, last, 256, [&](int q) { conv_item_ffn(p, layer, q, smem); }, smem);
    } break;
    case 5: {
      for (int it = 0;; ++it) {
        const int t = xcd_tile(it, MT * 16, last ? 16 : 0);
        if (t < 0) break;
        const int tm = t >> 4, tn = t & 15;
        gemm_tile<false>(
            p.H, D, p.wt_ff1, D, D, tm * 256, tn * 256, smem,
            [](int, int, f32x16& acc, int, int) {
#pragma unroll
              for (int e = 0; e < 16; ++e) {
                float v = fmaxf(acc[e], 0.f);
                acc[e] = v * v;
              }
            },
            [&](int row, int col, u32x4 v) { *(u32x4*)(p.Hd + (size_t)row * DFF + col) = v; }, noT, neverT);
      }
    } break;
    case 6: {
      int* cnt = p.cnt + (2 * layer + 1) * CNT_STRIDE;
      for (int it = 0;; ++it) {
        const int t = xcd_tile(it, MT * 4, last ? 4 : 0);
        if (t < 0) break;
        const int tm = t >> 2, tn = t & 3;
        gemm_tile<false>(
            p.Hd, DFF, p.wt_ff2, DFF, DFF, tm * 256, tn * 256, smem, [](int, int, f32x16&, int, int) {},
            [&](int row, int col, u32x4 v) { *(u32x4*)(p.F + (size_t)row * D + col) = v; }, noT, neverT);
        tile_done(cnt, tm);
      }
      if (last) ew_consume(p, cnt, 4, DEPTH, 2, true, 0, [](int) {}, smem);
      else ew_consume(p, cnt, 4, layer + 1, 0, false, 108, [&](int q) { conv_item_mix(p, layer + 1, q, smem); }, smem);
    } break;
  }
}

__global__ void __launch_bounds__(NTHR, 2) mega_kernel(Params p, int ph_begin, int ph_end) {
  extern __shared__ __attribute__((aligned(16))) char smem[];
  cg::grid_group grid = cg::this_grid();
  for (int ph = ph_begin; ph < ph_end; ++ph) {
    run_phase(p, ph, smem);
    if (ph + 1 < ph_end) grid.sync();
  }
}

extern "C" void kernel_launch(void* const* d_in, const int* in_sizes, int n_in, void* d_out, int out_size, void* d_ws,
                              size_t ws_size, hipStream_t stream) {
  Params p{};
  const float* const* in = (const float* const*)d_in;
  p.x = in[0]; p.c = in[1]; p.ctx = in[2]; p.c_ctx = in[3]; p.w_ada = in[4]; p.b_ada = in[5];
  p.g_pre_mix = in[6]; p.g_post_mix = in[7]; p.g_pre_ff = in[8]; p.g_post_ff = in[9]; p.w_in = in[10];
  p.g_q = in[11]; p.w_uq = in[12]; p.g_kv = in[13]; p.w_ukv = in[14]; p.cm_norm_g = in[15]; p.cm_w_s = in[16];
  p.cm_b_s = in[17]; p.conv_w = in[18]; p.conv_b = in[19]; p.dt_bias = in[20]; p.a_log = in[21]; p.ssd_d = in[22];
  p.ssd_norm_g = in[23]; p.w_out = in[24]; p.w_ff1 = in[25]; p.w_ff2 = in[26];
  p.out = (float*)d_out;
  char* ws = (char*)d_ws;
  size_t off = 0;
  auto take = [&](size_t bytes) { char* q = ws + off; off += (bytes + 255) & ~(size_t)255; return q; };
  p.wt_in = (u16*)take((size_t)NINP * D * 2);
  p.wt_uq = (u16*)take((size_t)768 * 256 * 2);
  p.wt_ukv = (u16*)take((size_t)1024 * 128 * 2);
  p.wt_out = (u16*)take((size_t)D * D * 2);
  p.wt_ff1 = (u16*)take((size_t)DFF * D * 2);
  p.wt_ff2 = (u16*)take((size_t)D * DFF * 2);
  p.wsb = (u16*)take((size_t)4 * 128 * 128 * 2);
  p.mod = (float*)take((size_t)DEPTH * 9 * 6144 * 4);
  p.ropetab = (float*)take((size_t)64 * 16 * 2 * 4);
  p.atot = (float*)take((size_t)NB * NCH * 2 * 4 * 4);
  p.xctx = (float*)take((size_t)NB * CTX * D * 4);
  char* r1 = take((size_t)T * DFF * 2);
  p.Hd = (u16*)r1;
  p.Y = (u16*)r1;
  {
    size_t o2 = 0;
    p.P = (u16*)(r1 + o2); o2 += (size_t)T * NINP * 2;
    p.Q = (u16*)(r1 + o2); o2 += (size_t)T * 768 * 2;
    p.Kn = (u16*)(r1 + o2); o2 += (size_t)T * 512 * 2;
    p.Kr = (u16*)(r1 + o2); o2 += (size_t)T * 64 * 2;
    p.Vt = (u16*)(r1 + o2); o2 += (size_t)NB * 4 * 128 * SP * 2;
    p.dtraw = (float*)(r1 + o2); o2 += (size_t)T * 8 * 4;
  }
  p.H = (u16*)take((size_t)T * D * 2);
  p.CS = (float*)take((size_t)NB * NCH * 2 * 4 * 8192 * 4);
  p.F = (u16*)p.CS;
  p.ytmp = (float*)take((size_t)T * 256 * 4);
  p.cnt = (int*)take((size_t)2 * DEPTH * CNT_STRIDE * 4);
  if (off > ws_size) {
    fprintf(stderr, "workspace too small: need %zu have %zu\n", off, ws_size);
    return;
  }
  static int grid_blocks = 0;
  if (!grid_blocks) {
    int dev = 0, cus = 0, per_cu = 0;
    hipGetDevice(&dev);
    hipDeviceGetAttribute(&cus, hipDeviceAttributeMultiprocessorCount, dev);
    hipFuncSetAttribute((const void*)mega_kernel, hipFuncAttributeMaxDynamicSharedMemorySize, SMEM_BYTES);
    hipOccupancyMaxActiveBlocksPerMultiprocessor(&per_cu, mega_kernel, NTHR, SMEM_BYTES);
    if (per_cu < 1) per_cu = 1;
    if (per_cu > 1) per_cu = 1;
    grid_blocks = cus * per_cu;
  }
  hipMemsetAsync(p.cnt, 0, (size_t)2 * DEPTH * CNT_STRIDE * 4, stream);
  int pb = 0, pe = NPHASE;
  void* args[] = {&p, &pb, &pe};
  hipError_t e = hipLaunchCooperativeKernel((void*)mega_kernel, dim3(grid_blocks), dim3(NTHR), args, SMEM_BYTES, stream);
  if (e != hipSuccess) fprintf(stderr, "cooperative launch failed: %s (grid %d)\n", hipGetErrorString(e), grid_blocks);
}
```

```cpp
#include <hip/hip_runtime.h>
#include <hip/hip_cooperative_groups.h>
#include <cstdio>
namespace cg = cooperative_groups;

#define DI __device__ __forceinline__
typedef unsigned short u16;
using bf16x8 = __attribute__((ext_vector_type(8))) short;
using s16x4 = __attribute__((ext_vector_type(4))) short;
using f32x16 = __attribute__((ext_vector_type(16))) float;
using u32x4 = __attribute__((ext_vector_type(4))) unsigned;
using u32x2 = __attribute__((ext_vector_type(2))) unsigned;
using f32x4 = __attribute__((ext_vector_type(4))) float;
typedef __bf16 bf2_t __attribute__((ext_vector_type(2)));
typedef float f2_t __attribute__((ext_vector_type(2)));
#define MFMA(a, b, c) __builtin_amdgcn_mfma_f32_32x32x16_bf16((a), (b), (c), 0, 0, 0)

constexpr int NB = 8, SEQ = 4096, CTX = 256, SP = 4352, T = NB * SP, D = 1024, DFF = 4096;
constexpr int NIN = 1992, NINP = 2048, NCH = 34, DEPTH = 4;
constexpr int NTHR = 512;
constexpr int VT = 256;
constexpr int VSMEM = 75 * 1024;
constexpr int SMEM_BYTES = 2 * VSMEM;
constexpr float EPS = 1e-6f;

struct Params {
  const float *x, *c, *ctx, *c_ctx, *w_ada, *b_ada, *g_pre_mix, *g_post_mix, *g_pre_ff, *g_post_ff, *w_in, *g_q, *w_uq,
      *g_kv, *w_ukv, *cm_norm_g, *cm_w_s, *cm_b_s, *conv_w, *conv_b, *dt_bias, *a_log, *ssd_d, *ssd_norm_g, *w_out,
      *w_ff1, *w_ff2;
  float* out;
  u16 *wt_in, *wt_uq, *wt_ukv, *wt_out, *wt_ff1, *wt_ff2, *wsb;
  float *mod, *ropetab, *atot, *xctx;
  u16 *P, *Q, *Kn, *Kr, *Vt, *Hd;
  u16* Y;
  float* dtraw;
  u16* H;
  float* CS;
  u16* F;
  float* ytmp;
  int* cnt;
};

DI int ltid() { int t = threadIdx.x; asm volatile("" : "+v"(t)); return t; }
DI int lbid() { int t = blockIdx.x; asm volatile("" : "+s"(t)); return t; }
DI void st_wt(void* ptr, u32x4 v) { asm volatile("global_store_dwordx4 %0, %1, off sc0 sc1" ::"v"(ptr), "v"(v) : "memory"); }
DI int crow(int e, int h) { return (e & 3) + 8 * (e >> 2) + 4 * h; }
DI unsigned pack2(float a, float b) {
  f2_t v = {a, b};
  bf2_t r = __builtin_convertvector(v, bf2_t);
  return __builtin_bit_cast(unsigned, r);
}
DI u16 f2bf(float a) { return (u16)(pack2(a, 0.f) & 0xffffu); }
DI float bf2f(u16 v) { return __uint_as_float(((unsigned)v) << 16); }
DI float bflo(unsigned w) { return __uint_as_float(w << 16); }
DI float bfhi(unsigned w) { return __uint_as_float(w & 0xffff0000u); }
DI bf16x8 pack8(float a0, float a1, float a2, float a3, float a4, float a5, float a6, float a7) {
  u32x4 u;
  u.x = pack2(a0, a1); u.y = pack2(a2, a3); u.z = pack2(a4, a5); u.w = pack2(a6, a7);
  return __builtin_bit_cast(bf16x8, u);
}
DI float wave_sum(float v) {
#pragma unroll
  for (int o = 32; o > 0; o >>= 1) v += __shfl_xor(v, o);
  return v;
}
DI float silu_f(float y) { return y * __builtin_amdgcn_rcpf(1.f + __expf(-y)); }
DI float gelu_f(float x) {
  float u = 0.7978845608028654f * (x + 0.044715f * x * x * x);
  float t = 1.f - 2.f * __builtin_amdgcn_rcpf(1.f + __expf(2.f * u));
  return 0.5f * x * (1.f + t);
}
DI float softplus_f(float x) { return x > 20.f ? x : log1pf(__expf(x)); }
DI float uw(const u32x4& v, int i) {
  unsigned w = (i >> 1) == 0 ? v.x : (i >> 1) == 1 ? v.y : (i >> 1) == 2 ? v.z : v.w;
  return (i & 1) ? bfhi(w) : bflo(w);
}

template <bool HAS_T, class ElemF, class StoreF, class StoreTF, class UseTF>
DI void gemm_tile(const u16* __restrict__ A, int lda, const u16* __restrict__ Bt, int ldb, int K, int m0, int n0,
                  char* smem, ElemF elem, StoreF store, StoreTF storeT, UseTF useT) {
  constexpr int LS = 72;
  constexpr int STAGE = 2 * 256 * LS;
  u16* base = (u16*)smem;
  const int tid = ltid(), lane = tid & 63, wid = tid >> 6, wm = wid >> 2, wn = wid & 3, r = lane & 31, h = lane >> 5;
  f32x16 acc[4][2];
#pragma unroll
  for (int i = 0; i < 4; ++i)
#pragma unroll
    for (int j = 0; j < 2; ++j)
#pragma unroll
      for (int e = 0; e < 16; ++e) acc[i][j][e] = 0.f;
  u32x4 ra[4], rb[4];
  const int lrow = tid >> 3, lcp = (tid & 7) * 8;
  const u16* ga = A + (size_t)(m0 + lrow) * lda + lcp;
  const u16* gb = Bt + (size_t)(n0 + lrow) * ldb + lcp;
  const int wofs = lrow * LS + lcp;
  const int aofs = (wm * 128 + r) * LS + h * 8;
  const int bofs = 256 * LS + (wn * 64 + r) * LS + h * 8;
#define GLOAD(kt_)                                                           \
  _Pragma("unroll") for (int i = 0; i < 4; ++i) {                            \
    ra[i] = *(const u32x4*)(ga + (size_t)(64 * i) * lda + (kt_) * 64);       \
    rb[i] = *(const u32x4*)(gb + (size_t)(64 * i) * ldb + (kt_) * 64);       \
  }
#define SWRITE(st_)                                                          \
  _Pragma("unroll") for (int i = 0; i < 4; ++i) {                            \
    *(u32x4*)((st_) + wofs + 64 * i * LS) = ra[i];                           \
    *(u32x4*)((st_) + 256 * LS + wofs + 64 * i * LS) = rb[i];                \
  }
#define FREAD(dst_, st_, kk_)                                                                      \
  _Pragma("unroll") for (int i = 0; i < 4; ++i) af[dst_][i] = *(const bf16x8*)((st_) + aofs + i * 32 * LS + (kk_) * 16); \
  _Pragma("unroll") for (int j = 0; j < 2; ++j) bfr[dst_][j] = *(const bf16x8*)((st_) + bofs + j * 32 * LS + (kk_) * 16);
#define MMAS(src_)                                                           \
  _Pragma("unroll") for (int i = 0; i < 4; ++i)                              \
  _Pragma("unroll") for (int j = 0; j < 2; ++j) acc[i][j] = MFMA(bfr[src_][j], af[src_][i], acc[i][j]);
#define ILV()                                                                   \
  __builtin_amdgcn_sched_group_barrier(0x008, 2, 0);                            \
  __builtin_amdgcn_sched_group_barrier(0x100, 2, 0);                            \
  __builtin_amdgcn_sched_group_barrier(0x008, 2, 0);                            \
  __builtin_amdgcn_sched_group_barrier(0x100, 2, 0);                            \
  __builtin_amdgcn_sched_group_barrier(0x008, 2, 0);                            \
  __builtin_amdgcn_sched_group_barrier(0x100, 2, 0);                            \
  __builtin_amdgcn_sched_group_barrier(0x008, 2, 0);
  const int nk = K >> 6;
  bf16x8 af[2][4], bfr[2][2];
  GLOAD(0);
  __syncthreads();
  SWRITE(base);
  if (nk > 1) { GLOAD(1); }
  __syncthreads();
  FREAD(0, base, 0);
  for (int kt = 0; kt < nk; ++kt) {
    u16* cur = base + (kt & 1) * STAGE;
    u16* nxt = base + ((kt + 1) & 1) * STAGE;
    FREAD(1, cur, 1);
    if (kt + 1 < nk) { SWRITE(nxt); }
    MMAS(0);
#pragma unroll
    for (int z = 0; z < 7; ++z) {
      __builtin_amdgcn_sched_group_barrier(0x008, 1, 0);
      __builtin_amdgcn_sched_group_barrier(0x080, 2, 0);
    }
    __builtin_amdgcn_sched_group_barrier(0x008, 1, 0);
    __builtin_amdgcn_sched_barrier(0);
    if (kt + 2 < nk) { GLOAD(kt + 2); }
    FREAD(0, cur, 2);
    MMAS(1);
    ILV();
    __builtin_amdgcn_sched_barrier(0);
    FREAD(1, cur, 3);
    MMAS(0);
    ILV();
    __builtin_amdgcn_sched_barrier(0);
    __syncthreads();
    if (kt + 1 < nk) { FREAD(0, nxt, 0); }
    MMAS(1);
    ILV();
    __builtin_amdgcn_sched_barrier(0);
  }
#undef ILV
#undef GLOAD
#undef SWRITE
#undef FREAD
#undef MMAS
#pragma unroll
  for (int i = 0; i < 4; ++i)
#pragma unroll
    for (int j = 0; j < 2; ++j) elem(m0 + wm * 128 + i * 32, n0 + wn * 64 + j * 32, acc[i][j], r, h);
  u16* stg = base + wid * (128 * 72);
  if (HAS_T && useT(wn)) {
#pragma unroll
    for (int i = 0; i < 4; ++i)
#pragma unroll
      for (int j = 0; j < 2; ++j)
#pragma unroll
        for (int e = 0; e < 16; ++e) stg[(j * 32 + crow(e, h)) * 136 + i * 32 + r] = f2bf(acc[i][j][e]);
    __builtin_amdgcn_wave_barrier();
#pragma unroll 4
    for (int t = 0; t < 16; ++t) {
      const int id = lane + 64 * t, cl = id >> 4, cp = id & 15;
      u32x4 v = *(const u32x4*)(stg + cl * 136 + cp * 8);
      storeT(n0 + wn * 64 + cl, m0 + wm * 128 + cp * 8, v);
    }
  } else {
#pragma unroll
    for (int i = 0; i < 4; ++i)
#pragma unroll
      for (int j = 0; j < 2; ++j)
#pragma unroll
        for (int q4 = 0; q4 < 4; ++q4) {
          u32x2 w;
          w.x = pack2(acc[i][j][4 * q4], acc[i][j][4 * q4 + 1]);
          w.y = pack2(acc[i][j][4 * q4 + 2], acc[i][j][4 * q4 + 3]);
          *(u32x2*)(stg + (i * 32 + r) * 72 + j * 32 + 8 * q4 + 4 * h) = w;
        }
    __builtin_amdgcn_wave_barrier();
#pragma unroll 4
    for (int t = 0; t < 16; ++t) {
      const int id = lane + 64 * t, rl = id >> 3, cp = id & 7;
      u32x4 v = *(const u32x4*)(stg + rl * 72 + cp * 8);
      store(m0 + wm * 128 + rl, n0 + wn * 64 + cp * 8, v);
    }
  }
}

DI int xcd_tile(int it, int ntiles, int skip_tail = 0) {
  const int b = lbid(), g = gridDim.x;
  const int local = (b >> 3) + it * (g >> 3);
  const int per = ntiles >> 3;
  return local < per - skip_tail ? (b & 7) * per + local : -1;
}

DI void conv_tile(const float* __restrict__ src, int K, int N, u16* __restrict__ dst, const float* __restrict__ scale,
                  int tk, int tn, char* smem) {
  float* tile = (float*)smem;
  const int tid = ltid(), tx = tid & 63, ty = tid >> 6;
  const int k0 = tk * 64, n0 = tn * 64;
  __syncthreads();
#pragma unroll 4
  for (int i = 0; i < 8; ++i) {
    int kr = ty + 8 * i;
    float v = 0.f;
    if (n0 + tx < N) v = src[(size_t)(k0 + kr) * N + n0 + tx];
    if (scale) v *= scale[k0 + kr];
    tile[kr * 65 + tx] = v;
  }
  __syncthreads();
#pragma unroll 4
  for (int i = 0; i < 8; ++i) {
    int nr = ty + 8 * i;
    dst[(size_t)(n0 + nr) * K + k0 + tx] = f2bf(tile[tx * 65 + nr]);
  }
}

DI void convert_weights(const float* src, int K, int N, int Npad, u16* dst, const float* scale, char* smem) {
  const int tks = K / 64, tns = Npad / 64;
  for (int t = lbid(); t < tks * tns; t += gridDim.x) conv_tile(src, K, N, dst, scale, t / tns, t % tns, smem);
}

DI void prologue_phase(const Params& p, char* smem) {
  float* sc = (float*)smem;
  float* red = sc + 9 * 1024;
  const int tid = ltid();
  for (int i = tid; i < 9 * 1024; i += NTHR) {
    int j = i >> 10, k = i & 1023;
    float v = j < 8 ? p.c[j * 1024 + k] : p.c_ctx[k];
    sc[i] = v / (1.f + __expf(-v));
  }
  __syncthreads();
  for (int task = lbid(); task < DEPTH * 96; task += gridDim.x) {
    const int l = task / 96, n0 = (task % 96) * 64, nn = tid & 63, kq = tid >> 6;
    float acc[9];
#pragma unroll
    for (int j = 0; j < 9; ++j) acc[j] = 0.f;
    const float* w = p.w_ada + ((size_t)l * 1024 + kq * 128) * 6144 + n0 + nn;
    const float* scq = sc + kq * 128;
#pragma unroll 4
    for (int k = 0; k < 128; ++k) {
      float wv = w[(size_t)k * 6144];
#pragma unroll
      for (int j = 0; j < 9; ++j) acc[j] += scq[j * 1024 + k] * wv;
    }
#pragma unroll
    for (int j = 0; j < 9; ++j) red[(kq * 9 + j) * 64 + nn] = acc[j];
    __syncthreads();
    for (int idx = tid; idx < 576; idx += NTHR) {
      int j = idx >> 6, n2 = idx & 63;
      float s = p.b_ada[l * 6144 + n0 + n2];
#pragma unroll
      for (int q = 0; q < 8; ++q) s += red[(q * 9 + j) * 64 + n2];
      p.mod[(size_t)(l * 9 + j) * 6144 + n0 + n2] = s;
    }
    __syncthreads();
  }
  if (lbid() == gridDim.x - 1) {
    for (int i = tid; i < 64 * 16; i += NTHR) {
      int pos = i >> 4, j = i & 15;
      float inv_freq = exp2f(-(float)(2 * j) / 32.f * 13.287712379549449f);
      float ang = (float)pos * inv_freq;
      float k = rintf(ang * 0.15915494309189535f);
      float red2 = fmaf(-k, 6.2831854820251465f, ang);
      red2 = fmaf(-k, -1.7484555314695172e-07f, red2);
      p.ropetab[2 * i] = __cosf(red2);
      p.ropetab[2 * i + 1] = __sinf(red2);
    }
  }
}

DI void ew_row(const Params& p, int layer, int kind, int row, int lane) {
  const bool has_branch = !(kind == 0 && layer == 0);
  const bool src_in = (layer == 0 && kind <= 1);
  const bool store_x = has_branch;
  const int blayer = (kind == 1) ? layer : (kind == 0 ? layer - 1 : DEPTH - 1);
  const float* gpost = (kind == 1) ? p.g_post_mix + blayer * D : p.g_post_ff + (blayer < 0 ? 0 : blayer) * D;
  const int gate_off = (kind == 1) ? 2 * D : 5 * D;
  const float* gpre = (kind == 0) ? p.g_pre_mix + layer * D : p.g_pre_ff + (kind == 1 ? layer : 0) * D;
  const int shift_off = (kind == 0) ? 0 : 3 * D, scale_off = (kind == 0) ? D : 4 * D;
  const float* xl = src_in ? p.x : p.out;
  const float* xc = src_in ? p.ctx : p.xctx;
    const int b = row / SP, s = row - b * SP;
    const bool lat = s < SEQ;
    if ((kind == 2 || (kind == 1 && layer == DEPTH - 1)) && !lat) return;
    const size_t xoff = lat ? ((size_t)(b * SEQ + s) * D) : ((size_t)(b * CTX + s - SEQ) * D);
    const unsigned long long msk = lat ? ~0ull : 0ull;
    const float* xs = (const float*)(((unsigned long long)xl & msk) | ((unsigned long long)xc & ~msk)) + xoff;
    float* xd = (float*)(((unsigned long long)p.out & msk) | ((unsigned long long)p.xctx & ~msk)) + xoff;
    const int mi = lat ? b : 8;
    f32x4 xv[4];
#pragma unroll
    for (int i = 0; i < 4; ++i) xv[i] = *(const f32x4*)(xs + lane * 4 + 256 * i);
    if (has_branch) {
      const float* modb = p.mod + (size_t)(blayer * 9 + mi) * 6144 + gate_off;
      f32x4 yv[4];
      const u16* ysrc = (kind == 1) ? p.Y : p.F;
#pragma unroll
      for (int i = 0; i < 4; ++i) {
        u32x2 w = *(const u32x2*)(ysrc + (size_t)row * D + lane * 4 + 256 * i);
        yv[i] = f32x4{bflo(w.x), bfhi(w.x), bflo(w.y), bfhi(w.y)};
      }
      float ss = 0.f;
#pragma unroll
      for (int i = 0; i < 4; ++i) ss += yv[i].x * yv[i].x + yv[i].y * yv[i].y + yv[i].z * yv[i].z + yv[i].w * yv[i].w;
      ss = wave_sum(ss);
      const float rstd = rsqrtf(ss * (1.f / D) + EPS);
#pragma unroll
      for (int i = 0; i < 4; ++i) {
        const int col = lane * 4 + 256 * i;
        f32x4 g = *(const f32x4*)(gpost + col);
        f32x4 gt = *(const f32x4*)(modb + col);
        xv[i].x += gt.x * (yv[i].x * rstd * g.x);
        xv[i].y += gt.y * (yv[i].y * rstd * g.y);
        xv[i].z += gt.z * (yv[i].z * rstd * g.z);
        xv[i].w += gt.w * (yv[i].w * rstd * g.w);
      }
      if (store_x) {
#pragma unroll
        for (int i = 0; i < 4; ++i) *(f32x4*)(xd + lane * 4 + 256 * i) = xv[i];
      }
    }
    if (kind != 2) {
      const float* modl = p.mod + (size_t)(layer * 9 + mi) * 6144;
      float ss = 0.f;
#pragma unroll
      for (int i = 0; i < 4; ++i) ss += xv[i].x * xv[i].x + xv[i].y * xv[i].y + xv[i].z * xv[i].z + xv[i].w * xv[i].w;
      ss = wave_sum(ss);
      const float rstd = rsqrtf(ss * (1.f / D) + EPS);
#pragma unroll
      for (int i = 0; i < 4; ++i) {
        const int col = lane * 4 + 256 * i;
        f32x4 g = *(const f32x4*)(gpre + col);
        f32x4 sh = *(const f32x4*)(modl + shift_off + col);
        f32x4 sc = *(const f32x4*)(modl + scale_off + col);
        float h0 = xv[i].x * rstd * g.x * (1.f + sc.x) + sh.x;
        float h1 = xv[i].y * rstd * g.y * (1.f + sc.y) + sh.y;
        float h2 = xv[i].z * rstd * g.z * (1.f + sc.z) + sh.z;
        float h3 = xv[i].w * rstd * g.w * (1.f + sc.w) + sh.w;
        u32x2 w;
        w.x = pack2(h0, h1);
        w.y = pack2(h2, h3);
        *(u32x2*)(p.H + (size_t)row * D + col) = w;
      }
    }
}

DI void ew_phase(const Params& p, int layer, int kind) {
  const int tid = ltid(), lane = tid & 63, wid = __builtin_amdgcn_readfirstlane(tid >> 6);
  for (int rg = lbid(); rg < T / 8; rg += gridDim.x) ew_row(p, layer, kind, rg * 8 + wid, lane);
}

constexpr int CNT_STRIDE = 160;
DI void tile_done(int* cnt, int tm) {
  asm volatile("s_waitcnt vmcnt(0)" ::: "memory");
  __syncthreads();
  if (ltid() == 0) __hip_atomic_fetch_add(cnt + tm, 1, __ATOMIC_RELAXED, __HIP_MEMORY_SCOPE_AGENT);
}
template <class ConvF>
DI void ew_consume(const Params& p, int* cnt, int need, int layer, int kind, bool skip_ctx, int nconv, ConvF conv,
                   char* smem) {
  int* sh = (int*)(smem + SMEM_BYTES - 16);
  const int tid = ltid(), lane = tid & 63, wid = __builtin_amdgcn_readfirstlane(tid >> 6);
  for (;;) {
    __syncthreads();
    if (tid == 0) *sh = __hip_atomic_fetch_add(cnt + 136, 1, __ATOMIC_RELAXED, __HIP_MEMORY_SCOPE_AGENT);
    __syncthreads();
    const int q = *sh;
    if (q >= nconv + 544) break;
    if (q < nconv) { conv(q); continue; }
    const int c = q - nconv, mseq = c >> 2, j = mseq >> 3, bb = mseq & 7, tm = bb * 17 + j;
    if (skip_ctx && j == 16) continue;
    if (tid == 0) {
      while (__hip_atomic_load(cnt + tm, __ATOMIC_ACQUIRE, __HIP_MEMORY_SCOPE_AGENT) < need) __builtin_amdgcn_s_sleep(4);
    }
    __syncthreads();
    const int row0 = tm * 256 + (c & 3) * 64 + wid * 8;
#pragma unroll 1
    for (int i = 0; i < 8; ++i) ew_row(p, layer, kind, row0 + i, lane);
  }
}

DI void row_rstd(const u16* __restrict__ base, int ld, int ncols, int m0, float* rs) {
  const int tid = ltid(), row = tid >> 1, half = tid & 1;
  const int per = ncols / 2;
  const u16* ptr = base + (size_t)(m0 + row) * ld + half * per;
  float ss = 0.f;
  for (int i = 0; i < per; i += 8) {
    u32x4 v = *(const u32x4*)(ptr + i);
#pragma unroll
    for (int e = 0; e < 8; ++e) {
      float f = uw(v, e);
      ss += f * f;
    }
  }
  ss += __shfl_xor(ss, 1);
  if (half == 0) rs[row] = rsqrtf(ss / (float)ncols + EPS);
}

DI void qkv_tasks(const Params& p, char* smem, int qb, int qe, int kb_, int ke, int stp) {
  float* rs = (float*)(smem + 2 * 2 * 256 * 72 * 2);
  const int MT = T / 256;
  auto noT = [](int, int, u32x4) {};
  auto neverT = [](int) { return false; };
  for (int t = qb; t < qe; t += stp) {
    const int tm = t / 3, tn = t % 3, m0 = tm * 256;
    __syncthreads();
    row_rstd(p.P, NINP, 256, m0, rs);
    const bool lat = (m0 % SP) < SEQ;
    const int s0 = m0 % SP;
    gemm_tile<false>(
        p.P, NINP, p.wt_uq, 256, 256, m0, tn * 256, smem,
        [&](int mb, int nb, f32x16& acc, int r, int h) {
          const int rowl = mb - m0 + r;
          const float sc = rs[rowl];
#pragma unroll
          for (int e = 0; e < 16; ++e) acc[e] *= sc;
          const int cb = nb % 192;
          if (lat && cb >= 128) {
            const int s = s0 + rowl;
            const int pos = (cb == 128) ? (s >> 6) : (s & 63);
#pragma unroll
            for (int e = 0; e < 8; ++e) {
              const int j = crow(e, h);
              const float cs = p.ropetab[2 * (pos * 16 + j)], sn = p.ropetab[2 * (pos * 16 + j) + 1];
              const float x1 = acc[e], x2 = acc[e + 8];
              acc[e] = x1 * cs - x2 * sn;
              acc[e + 8] = x1 * sn + x2 * cs;
            }
          }
        },
        [&](int row, int col, u32x4 v) { *(u32x4*)(p.Q + (size_t)row * 768 + col) = v; }, noT, neverT);
  }
  for (int t = kb_; t < ke; t += stp) {
    const int tm = t / 4, tn = t % 4, m0 = tm * 256;
    const int b = m0 / SP, s0 = m0 % SP;
    const bool lat = s0 < SEQ;
    __syncthreads();
    row_rstd(p.P + 256, NINP, 128, m0, rs);
    if (tn == 0) {
      for (int idx = ltid(); idx < 256 * 32; idx += NTHR) {
        const int rowl = idx >> 5, q = idx & 31, blk = q >> 4, j = q & 15;
        const u16* src = p.P + (size_t)(m0 + rowl) * NINP + 384 + blk * 32 + j;
        float x1 = bf2f(src[0]), x2 = bf2f(src[16]);
        float o1 = x1, o2 = x2;
        if (lat) {
          const int s = s0 + rowl;
          const int pos = blk == 0 ? (s >> 6) : (s & 63);
          const float cs = p.ropetab[2 * (pos * 16 + j)], sn = p.ropetab[2 * (pos * 16 + j) + 1];
          o1 = x1 * cs - x2 * sn;
          o2 = x1 * sn + x2 * cs;
        }
        u16* dst = p.Kr + (size_t)(m0 + rowl) * 64 + blk * 32 + j;
        dst[0] = f2bf(o1);
        dst[16] = f2bf(o2);
      }
    }
    const int n0 = tn * 256;
    u16* vbase = p.Vt + (size_t)(b * 4 + tn) * 128 * SP + s0;
    gemm_tile<true>(
        p.P + 256, NINP, p.wt_ukv, 128, 128, m0, n0, smem,
        [&](int mb, int nb, f32x16& acc, int r, int h) {
          const float sc = rs[mb - m0 + r];
#pragma unroll
          for (int e = 0; e < 16; ++e) acc[e] *= sc;
        },
        [&](int row, int col, u32x4 v) { *(u32x4*)(p.Kn + (size_t)row * 512 + tn * 128 + (col - n0)) = v; },
        [&](int col, int row, u32x4 v) { *(u32x4*)(vbase + (size_t)(col - n0 - 128) * SP + (row - m0)) = v; },
        [](int wn) { return wn >= 2; });
  }
}

DI void cm_tasks(const Params& p, int layer, char* smem, int tb, int te, int stp) {
  const int ftid = ltid(), vb = ftid >> 8, tid = ftid & 255;
  u16* vnT = (u16*)(smem + vb * VSMEM);
  const int lane = tid & 63, wid = tid >> 6, r = lane & 31, h = lane >> 5;
  const float* gn = p.cm_norm_g + layer * 256;
  const float* bs = p.cm_b_s + layer * 512;
  for (int t0 = tb; t0 < te; t0 += stp) {
    const int task = t0 + vb;
    const int row0 = task * 128;
    __syncthreads();
#pragma unroll 4
    for (int i = 0; i < 32; ++i) {
      const int s = wid * 32 + i;
      const u16* src = p.P + (size_t)(row0 + s) * NINP + 704;
      float v[4];
      float sum = 0.f;
#pragma unroll
      for (int q = 0; q < 4; ++q) {
        v[q] = gelu_f(bf2f(src[lane + 64 * q]));
        sum += v[q];
      }
      const float mean = wave_sum(sum) * (1.f / 256.f);
      float var = 0.f;
#pragma unroll
      for (int q = 0; q < 4; ++q) {
        v[q] -= mean;
        var += v[q] * v[q];
      }
      const float rstd = rsqrtf(wave_sum(var) * (1.f / 256.f) + EPS);
#pragma unroll
      for (int q = 0; q < 4; ++q) vnT[(lane + 64 * q) * 136 + s] = f2bf(v[q] * rstd * gn[lane + 64 * q]);
    }
    __syncthreads();
    const int t = wid * 32 + r;
    for (int g = 0; g < 4; ++g) {
      bf16x8 wf[8];
#pragma unroll
      for (int kk = 0; kk < 8; ++kk) wf[kk] = *(const bf16x8*)(p.wsb + ((size_t)(g * 128 + t)) * 128 + kk * 16 + h * 8);
      const float bias = bs[g * 128 + t];
#pragma unroll
      for (int cb = 0; cb < 2; ++cb) {
        f32x16 acc;
#pragma unroll
        for (int e = 0; e < 16; ++e) acc[e] = 0.f;
#pragma unroll
        for (int kk = 0; kk < 8; ++kk) {
          bf16x8 a = *(const bf16x8*)(vnT + (g * 64 + cb * 32 + r) * 136 + kk * 16 + h * 8);
          acc = MFMA(a, wf[kk], acc);
        }
#pragma unroll
        for (int q4 = 0; q4 < 4; ++q4) {
          const int ch0 = g * 64 + cb * 32 + 8 * q4 + 4 * h;
          u32x2 uwd = *(const u32x2*)(p.P + (size_t)(row0 + t) * NINP + 448 + ch0);
          float u0 = gelu_f(bflo(uwd.x)), u1 = gelu_f(bfhi(uwd.x)), u2 = gelu_f(bflo(uwd.y)), u3 = gelu_f(bfhi(uwd.y));
          u32x2 w;
          w.x = pack2(u0 * (acc[4 * q4] + bias), u1 * (acc[4 * q4 + 1] + bias));
          w.y = pack2(u2 * (acc[4 * q4 + 2] + bias), u3 * (acc[4 * q4 + 3] + bias));
          *(u32x2*)(p.H + (size_t)(row0 + t) * D + 512 + ch0) = w;
        }
      }
    }
  }
}

struct ConvW { f32x4 w0a, w0b, w1a, w1b, w2a, w2b, ba, bb; };
DI ConvW load_convw(const Params& p, int layer, int ch) {
  const float* cw = p.conv_w + (size_t)layer * 3 * 768 + ch;
  const float* cb = p.conv_b + layer * 768 + ch;
  ConvW c;
  c.w0a = *(const f32x4*)(cw); c.w0b = *(const f32x4*)(cw + 4);
  c.w1a = *(const f32x4*)(cw + 768); c.w1b = *(const f32x4*)(cw + 772);
  c.w2a = *(const f32x4*)(cw + 1536); c.w2b = *(const f32x4*)(cw + 1540);
  c.ba = *(const f32x4*)(cb); c.bb = *(const f32x4*)(cb + 4);
  return c;
}
DI float convw_get(const f32x4& a, const f32x4& b, int e) { return e < 4 ? a[e & 3] : b[e & 3]; }
DI void conv8(const Params& p, const ConvW& c, int row, int ch, bool hasPrev, bool hasNext, float out[8]) {
  const u16* base = p.P + (size_t)row * NINP + 1216 + ch;
  u32x4 cur = *(const u32x4*)base;
  u32x4 prv = *(const u32x4*)(base - (hasPrev ? NINP : 0));
  u32x4 nxt = *(const u32x4*)(base + (hasNext ? NINP : 0));
  const float mp = hasPrev ? 1.f : 0.f, mn = hasNext ? 1.f : 0.f;
#pragma unroll
  for (int e = 0; e < 8; ++e) {
    float y = convw_get(c.w0a, c.w0b, e) * (mp * uw(prv, e)) + convw_get(c.w1a, c.w1b, e) * uw(cur, e) +
              convw_get(c.w2a, c.w2b, e) * (mn * uw(nxt, e)) + convw_get(c.ba, c.bb, e);
    out[e] = silu_f(y);
  }
}

template <int RPT, class F>
DI void conv_stage(const Params& p, int layer, int row0, int chbase, int cp, int tb, bool cPrev, bool cNext, F emit) {
  const ConvW c = load_convw(p, layer, chbase + cp * 8);
  const int r0 = tb * RPT;
  const bool hp = cPrev || r0 > 0, hn = cNext || (r0 + RPT) < 128;
  const u16* base = p.P + (size_t)(row0 + r0) * NINP + 1216 + chbase + cp * 8;
  u32x4 raw[RPT + 2];
  raw[0] = *(const u32x4*)(base - (hp ? NINP : 0));
#pragma unroll
  for (int k = 0; k < RPT; ++k) raw[k + 1] = *(const u32x4*)(base + (size_t)k * NINP);
  raw[RPT + 1] = *(const u32x4*)(base + (size_t)(hn ? RPT : RPT - 1) * NINP);
  const float mp = hp ? 1.f : 0.f, mn = hn ? 1.f : 0.f;
#pragma unroll
  for (int i = 0; i < RPT; ++i) {
    const float fp = (i == 0) ? mp : 1.f, fn = (i == RPT - 1) ? mn : 1.f;
    float v[8];
#pragma unroll
    for (int e = 0; e < 8; ++e) {
      float y = convw_get(c.w0a, c.w0b, e) * (fp * uw(raw[i], e)) + convw_get(c.w1a, c.w1b, e) * uw(raw[i + 1], e) +
                convw_get(c.w2a, c.w2b, e) * (fn * uw(raw[i + 2], e)) + convw_get(c.ba, c.bb, e);
      v[e] = silu_f(y);
    }
    emit(r0 + i, v);
  }
}

DI void ssd_dt_arrays(const Params& p, int layer, int row0, int hh, int t, float* arr) {
  float* dt0 = arr;
  float* dt1 = arr + 128;
  float* c0 = arr + 256;
  float* s1 = arr + 384;
  float* a0 = arr + 512;
  float* a1 = arr + 640;
  const float d0 = softplus_f(p.dtraw[(size_t)(row0 + t) * 8 + hh] + p.dt_bias[layer * 8 + hh]);
  const float d1 = softplus_f(p.dtraw[(size_t)(row0 + t) * 8 + 4 + hh] + p.dt_bias[layer * 8 + 4 + hh]);
  dt0[t] = d0;
  dt1[t] = d1;
  a0[t] = -d0 * __expf(p.a_log[layer * 8 + hh]);
  a1[t] = -d1 * __expf(p.a_log[layer * 8 + 4 + hh]);
}
DI float wave_incl_prefix(float x, int lane) {
#pragma unroll
  for (int o = 1; o < 64; o <<= 1) {
    float y = __shfl_up(x, o);
    if (lane >= o) x += y;
  }
  return x;
}
DI void ssd_cum_arrays(int t, float* arr) {
  float* c0 = arr + 256;
  float* s1 = arr + 384;
  const float* a0 = arr + 512;
  const float* a1 = arr + 640;
  const int lane = t & 63, w = t >> 6;
  const float x0 = a0[t], o0 = a0[t ^ 64], x1 = a1[t], o1 = a1[t ^ 64];
  const float tot_o0 = wave_sum(o0), tot_o1 = wave_sum(o1), tot_x1 = wave_sum(x1);
  float p0 = wave_incl_prefix(x0, lane);
  float p1 = wave_incl_prefix(x1, lane);
  if (w == 1) p0 += tot_o0;
  float sf = tot_x1 - p1 + x1;
  if (w == 0) sf += tot_o1;
  c0[t] = p0;
  s1[t] = sf;
}

DI void ssd_s1_tasks(const Params& p, int layer, char* smem, int tb, int te, int stp) {
  const int ftid = ltid(), vb = ftid >> 8, tid = ftid & 255;
  u16* xsT0 = (u16*)(smem + vb * VSMEM);
  u16* xsT1 = xsT0 + 64 * 136;
  u16* BT = xsT1 + 64 * 136;
  float* arr = (float*)(BT + 128 * 136);
  float* w0 = arr + 768;
  float* w1 = w0 + 128;
  const int lane = tid & 63, wid = tid >> 6, r = lane & 31, h = lane >> 5;
  for (int t0 = tb; t0 < te; t0 += stp) {
    const int task = t0 + vb;
    const int hh = task & 3, bc = task >> 2, c = bc % NCH, b = bc / NCH;
    const int g = hh >> 1;
    const int row0 = bc * 128;
    const bool cPrev = (c != 0 && c != 32), cNext = (c != 31 && c != 33);
    __syncthreads();
    if (tid < 128) ssd_dt_arrays(p, layer, row0, hh, tid, arr);
    __syncthreads();
    if (tid < 128) ssd_cum_arrays(tid, arr);
    __syncthreads();
    if (tid < 128) {
      const float* dt0 = arr;
      const float* dt1 = arr + 128;
      const float* c0 = arr + 256;
      const float* s1 = arr + 384;
      w0[tid] = __expf(c0[127] - c0[tid]) * dt0[tid];
      w1[tid] = __expf(s1[0] - s1[tid]) * dt1[tid];
      if (tid == 0) {
        p.atot[((size_t)bc * 2 + 0) * 4 + hh] = c0[127];
        p.atot[((size_t)bc * 2 + 1) * 4 + hh] = s1[0];
      }
    }
    __syncthreads();
    conv_stage<4>(p, layer, row0, hh * 64, tid & 7, tid >> 3, cPrev, cNext, [&](int t, const float (&v)[8]) {
      const float f0 = w0[t], f1 = w1[t];
      const int cp = tid & 7;
#pragma unroll
      for (int e = 0; e < 8; ++e) {
        xsT0[(cp * 8 + e) * 136 + t] = f2bf(v[e] * f0);
        xsT1[(cp * 8 + e) * 136 + t] = f2bf(v[e] * f1);
      }
    });
    conv_stage<8>(p, layer, row0, 256 + g * 128, tid & 15, tid >> 4, cPrev, cNext, [&](int t, const float (&v)[8]) {
      const int cp = tid & 15;
#pragma unroll
      for (int e = 0; e < 8; ++e) BT[(cp * 8 + e) * 136 + t] = f2bf(v[e]);
    });
    __syncthreads();
#pragma unroll
    for (int d = 0; d < 2; ++d) {
      const u16* xsT = d ? xsT1 : xsT0;
#pragma unroll
      for (int pb = 0; pb < 2; ++pb) {
        f32x16 acc;
#pragma unroll
        for (int e = 0; e < 16; ++e) acc[e] = 0.f;
#pragma unroll
        for (int kk = 0; kk < 8; ++kk) {
          bf16x8 a = *(const bf16x8*)(xsT + (pb * 32 + r) * 136 + kk * 16 + h * 8);
          bf16x8 bb = *(const bf16x8*)(BT + (wid * 32 + r) * 136 + kk * 16 + h * 8);
          acc = MFMA(a, bb, acc);
        }
        float* dst = p.CS + ((((size_t)bc * 2 + d) * 4 + hh) * 64 + pb * 32) * 128 + wid * 32 + r;
#pragma unroll
        for (int e = 0; e < 16; ++e) dst[(size_t)crow(e, h) * 128] = acc[e];
      }
    }
  }
}

DI void ssd_scan_phase(const Params& p) {
  const int total = NB * 2 * 4 * 8192;
  for (int idx = lbid() * NTHR + ltid(); idx < total; idx += gridDim.x * NTHR) {
    const int e = idx & 8191, hh = (idx >> 13) & 3, d = (idx >> 15) & 1, b = idx >> 16;
    float st = 0.f;
#pragma unroll 2
    for (int i = 0; i < NCH; ++i) {
      int c;
      if (d == 0) c = i < 2 ? 32 + i : i - 2;
      else c = i < 2 ? 33 - i : 33 - i;
      const size_t bc = (size_t)b * NCH + c;
      float* ptr = p.CS + ((bc * 2 + d) * 4 + hh) * 8192 + e;
      const float v = *ptr;
      const float dec = __expf(p.atot[(bc * 2 + d) * 4 + hh]);
      *ptr = st;
      st = dec * st + v;
    }
  }
}

template <int G>
DI float ssd_s3_group(const Params& p, int layer, int bc, bool cPrev, bool cNext, u16* Bg, u16* xsT, float* arr, int tid) {
  f32x16 y[4];
#pragma unroll
  for (int i = 0; i < 4; ++i)
#pragma unroll
    for (int e = 0; e < 16; ++e) y[i][e] = 0.f;
  const int lane = tid & 63, wid = tid >> 6, r = lane & 31, h = lane >> 5;
  const int l = wid * 32 + r;
  const int row0 = bc * 128;
  __syncthreads();
  ssd_dt_arrays(p, layer, row0, 2 * G + (tid >> 7), tid & 127, arr + (tid >> 7) * 768);
  const ConvW cwc = load_convw(p, layer, 512 + G * 128 + (tid & 15) * 8);
#pragma unroll 1
  for (int i = 0; i < 8; ++i) {
    const int id = tid + VT * i, t = id >> 4, cp = id & 15;
    float v[8];
    conv8(p, cwc, row0 + t, 512 + G * 128 + cp * 8, cPrev || t > 0, cNext || t < 127, v);
    *(bf16x8*)(Bg + t * 136 + cp * 8) = pack8(v[0], v[1], v[2], v[3], v[4], v[5], v[6], v[7]);
  }
  const ConvW cwx = load_convw(p, layer, G * 128 + (tid & 15) * 8);
#pragma unroll 1
  for (int i = 0; i < 8; ++i) {
    const int id = tid + VT * i, t = id >> 4, cp = id & 15;
    float v[8];
    conv8(p, cwx, row0 + t, G * 128 + cp * 8, cPrev || t > 0, cNext || t < 127, v);
#pragma unroll
    for (int e = 0; e < 8; ++e) xsT[(cp * 8 + e) * 136 + t] = f2bf(v[e]);
  }
  __syncthreads();
  ssd_cum_arrays(tid & 127, arr + (tid >> 7) * 768);
  bf16x8 cf[8];
#pragma unroll
  for (int kk = 0; kk < 8; ++kk) cf[kk] = *(const bf16x8*)(Bg + l * 136 + kk * 16 + h * 8);
  __syncthreads();
  const ConvW cwb = load_convw(p, layer, 256 + G * 128 + (tid & 15) * 8);
#pragma unroll 1
  for (int i = 0; i < 8; ++i) {
    const int id = tid + VT * i, t = id >> 4, cp = id & 15;
    float v[8];
    conv8(p, cwb, row0 + t, 256 + G * 128 + cp * 8, cPrev || t > 0, cNext || t < 127, v);
    *(bf16x8*)(Bg + t * 136 + cp * 8) = pack8(v[0], v[1], v[2], v[3], v[4], v[5], v[6], v[7]);
  }
  __syncthreads();
  float ss = 0.f;
#pragma unroll 1
  for (int hd2 = 0; hd2 < 2; ++hd2) {
    const int hh = 2 * G + hd2;
    const float* ah = arr + hd2 * 768;
    const float c0l = ah[256 + l], s1l = ah[384 + l];
    f32x16 y[2];
#pragma unroll
    for (int i = 0; i < 2; ++i)
#pragma unroll
      for (int e = 0; e < 16; ++e) y[i][e] = 0.f;
#pragma unroll 1
    for (int sb = 0; sb < 4; ++sb) {
      f32x16 gt;
#pragma unroll
      for (int e = 0; e < 16; ++e) gt[e] = 0.f;
#pragma unroll
      for (int kk = 0; kk < 8; ++kk) {
        bf16x8 a = *(const bf16x8*)(Bg + (sb * 32 + r) * 136 + kk * 16 + h * 8);
        gt = MFMA(a, cf[kk], gt);
      }
      f32x16 wv;
      if (sb != wid) {
        const float ref = sb < wid ? c0l : s1l;
        const float* cumv = ah + (sb < wid ? 256 : 384) + sb * 32 + 4 * h;
        const float* dtv = ah + (sb < wid ? 0 : 128) + sb * 32 + 4 * h;
#pragma unroll
        for (int q4 = 0; q4 < 4; ++q4) {
          const f32x4 cv = *(const f32x4*)(cumv + 8 * q4), dv = *(const f32x4*)(dtv + 8 * q4);
#pragma unroll
          for (int k = 0; k < 4; ++k) wv[4 * q4 + k] = gt[4 * q4 + k] * (__expf(ref - cv[k]) * dv[k]);
        }
      } else {
#pragma unroll
        for (int q4 = 0; q4 < 4; ++q4) {
          const int s4 = sb * 32 + 8 * q4 + 4 * h;
          const f32x4 c0v = *(const f32x4*)(ah + 256 + s4), d0v = *(const f32x4*)(ah + s4);
          const f32x4 s1v = *(const f32x4*)(ah + 384 + s4), d1v = *(const f32x4*)(ah + 128 + s4);
#pragma unroll
          for (int k = 0; k < 4; ++k) {
            const int s = s4 + k;
            const float a0 = (l >= s) ? (c0l - c0v[k]) : -1e30f;
            const float a1 = (l <= s) ? (s1l - s1v[k]) : -1e30f;
            wv[4 * q4 + k] = gt[4 * q4 + k] * (__expf(a0) * d0v[k] + __expf(a1) * d1v[k]);
          }
          __builtin_amdgcn_sched_barrier(0);
        }
      }
      bf16x8 wp0 = pack8(wv[0], wv[1], wv[2], wv[3], wv[4], wv[5], wv[6], wv[7]);
      bf16x8 wp1 = pack8(wv[8], wv[9], wv[10], wv[11], wv[12], wv[13], wv[14], wv[15]);
#pragma unroll
      for (int pb = 0; pb < 2; ++pb) {
        const u16* xrow = xsT + (hd2 * 64 + pb * 32 + r) * 136 + sb * 32 + 4 * h;
        s16x4 lo0 = *(const s16x4*)(xrow), hi0 = *(const s16x4*)(xrow + 8);
        s16x4 lo1 = *(const s16x4*)(xrow + 16), hi1 = *(const s16x4*)(xrow + 24);
        bf16x8 a0 = __builtin_shufflevector(lo0, hi0, 0, 1, 2, 3, 4, 5, 6, 7);
        bf16x8 a1 = __builtin_shufflevector(lo1, hi1, 0, 1, 2, 3, 4, 5, 6, 7);
        y[pb] = MFMA(a0, wp0, y[pb]);
        y[pb] = MFMA(a1, wp1, y[pb]);
      }
    }
#pragma unroll 1
    for (int d = 0; d < 2; ++d) {
      const float el = __expf(d == 0 ? c0l : s1l);
#pragma unroll
      for (int pb = 0; pb < 2; ++pb) {
        const float* srow = p.CS + ((((size_t)bc * 2 + d) * 4 + hh) * 64 + pb * 32 + r) * 128 + h * 8;
        f32x16 tmp;
#pragma unroll
        for (int e = 0; e < 16; ++e) tmp[e] = 0.f;
#pragma unroll
        for (int kk = 0; kk < 8; ++kk) {
          f32x4 s0 = *(const f32x4*)(srow + kk * 16), s1 = *(const f32x4*)(srow + kk * 16 + 4);
          bf16x8 a = pack8(s0.x, s0.y, s0.z, s0.w, s1.x, s1.y, s1.z, s1.w);
          tmp = MFMA(a, cf[kk], tmp);
        }
#pragma unroll
        for (int e = 0; e < 16; ++e) y[pb][e] += el * tmp[e];
      }
    }
    const float dsk = p.ssd_d[layer * 8 + hh] + p.ssd_d[layer * 8 + 4 + hh];
#pragma unroll
    for (int pb = 0; pb < 2; ++pb) {
#pragma unroll
      for (int q4 = 0; q4 < 4; ++q4) {
        const int cl = hd2 * 64 + pb * 32 + 8 * q4 + 4 * h;
        const int ch0 = G * 128 + cl;
        u32x2 zw = *(const u32x2*)(p.P + (size_t)(row0 + l) * NINP + 960 + ch0);
        f32x4 o;
        o.x = (y[pb][4 * q4] + dsk * bf2f(xsT[(cl + 0) * 136 + l])) * silu_f(bflo(zw.x));
        o.y = (y[pb][4 * q4 + 1] + dsk * bf2f(xsT[(cl + 1) * 136 + l])) * silu_f(bfhi(zw.x));
        o.z = (y[pb][4 * q4 + 2] + dsk * bf2f(xsT[(cl + 2) * 136 + l])) * silu_f(bflo(zw.y));
        o.w = (y[pb][4 * q4 + 3] + dsk * bf2f(xsT[(cl + 3) * 136 + l])) * silu_f(bfhi(zw.y));
        ss += o.x * o.x + o.y * o.y + o.z * o.z + o.w * o.w;
        *(f32x4*)(p.ytmp + (size_t)(row0 + l) * 256 + ch0) = o;
      }
    }
  }
  return ss;
}

DI void ssd_s3_tasks(const Params& p, int layer, char* smem) {
  const int ftid = ltid(), vb = ftid >> 8, tid = ftid & 255;
  u16* Bg = (u16*)(smem + vb * VSMEM);
  u16* xsT = Bg + 128 * 136;
  float* arr = (float*)(xsT + 128 * 136);
  const int lane = tid & 63, wid = tid >> 6, r = lane & 31, h = lane >> 5;
  const int l = wid * 32 + r;
  for (int t0 = lbid() * 2; t0 < NB * NCH; t0 += gridDim.x * 2) {
    const int bc = t0 + vb, c = bc % NCH;
    const int row0 = bc * 128;
    const bool cPrev = (c != 0 && c != 32), cNext = (c != 31 && c != 33);
    float ss = ssd_s3_group<0>(p, layer, bc, cPrev, cNext, Bg, xsT, arr, tid);
    ss += ssd_s3_group<1>(p, layer, bc, cPrev, cNext, Bg, xsT, arr, tid);
    ss += __shfl_xor(ss, 32);
    const float rstd = rsqrtf(ss * (1.f / 256.f) + EPS);
    const float* gn = p.ssd_norm_g + layer * 256;
#pragma unroll 4
    for (int i = 0; i < 32; ++i) {
      const int ch0 = (i >> 2) * 32 + 8 * (i & 3) + 4 * h;
      f32x4 v = *(const f32x4*)(p.ytmp + (size_t)(row0 + l) * 256 + ch0);
      f32x4 gv = *(const f32x4*)(gn + ch0);
      u32x2 w;
      w.x = pack2(v.x * rstd * gv.x, v.y * rstd * gv.y);
      w.y = pack2(v.z * rstd * gv.z, v.w * rstd * gv.w);
      *(u32x2*)(p.H + (size_t)(row0 + l) * D + 768 + ch0) = w;
    }
  }
}

constexpr int QREG = 6;
DI void attn_qk(const u16* Ks, const bf16x8 (&qf)[QREG], const u16* qs, f32x16 (&st)[2], int r, int h) {
#pragma unroll
  for (int kb = 0; kb < 2; ++kb)
#pragma unroll
    for (int e = 0; e < 16; ++e) st[kb][e] = 0.f;
  const u16* kp = Ks + r * 200 + h * 8;
#pragma unroll
  for (int kk = 0; kk < 12; ++kk) {
    bf16x8 k0 = *(const bf16x8*)(kp + kk * 16);
    bf16x8 k1 = *(const bf16x8*)(kp + 32 * 200 + kk * 16);
    bf16x8 q;
    if (kk < QREG) q = qf[kk];
    else q = *(const bf16x8*)(qs + (kk - QREG) * 512);
    st[0] = MFMA(k0, q, st[0]);
    st[1] = MFMA(k1, q, st[1]);
  }
}
DI void attn_softmax(f32x16 (&st)[2], f32x16 (&o)[4], bf16x8 (&pf)[4], float& m_run, float& l_run, float sc) {
  float mx = st[0][0];
#pragma unroll
  for (int kb = 0; kb < 2; ++kb)
#pragma unroll
    for (int e = 0; e < 16; ++e) mx = fmaxf(mx, st[kb][e]);
  mx = fmaxf(mx, __shfl_xor(mx, 32));
  const float m_new = fmaxf(m_run, mx * sc);
  const float alpha = __builtin_amdgcn_exp2f(m_run - m_new);
  m_run = m_new;
  float ls = 0.f;
#pragma unroll
  for (int kb = 0; kb < 2; ++kb)
#pragma unroll
    for (int e = 0; e < 16; ++e) {
      float pv = __builtin_amdgcn_exp2f(fmaf(st[kb][e], sc, -m_new));
      ls += pv;
      st[kb][e] = pv;
    }
  l_run = l_run * alpha + ls;
  if (__builtin_amdgcn_ballot_w64(alpha != 1.f) != 0ull) {
#pragma unroll
    for (int i = 0; i < 4; ++i)
#pragma unroll
      for (int e = 0; e < 16; ++e) o[i][e] *= alpha;
  }
#pragma unroll
  for (int ks = 0; ks < 4; ++ks) {
    const int kb = ks >> 1, s2 = ks & 1;
    pf[ks] = pack8(st[kb][8 * s2], st[kb][8 * s2 + 1], st[kb][8 * s2 + 2], st[kb][8 * s2 + 3], st[kb][8 * s2 + 4],
                   st[kb][8 * s2 + 5], st[kb][8 * s2 + 6], st[kb][8 * s2 + 7]);
  }
}
DI void attn_pv(const u16* Vs, const bf16x8 (&pf)[4], f32x16 (&o)[4], int r, int h) {
#pragma unroll
  for (int ks = 0; ks < 4; ++ks) {
#pragma unroll
    for (int db = 0; db < 4; ++db) {
      const u16* vr = Vs + (db * 32 + r) * 68 + ks * 16 + 4 * h;
      s16x4 lo = *(const s16x4*)vr, hi = *(const s16x4*)(vr + 8);
      bf16x8 a = __builtin_shufflevector(lo, hi, 0, 1, 2, 3, 4, 5, 6, 7);
      o[db] = MFMA(a, pf[ks], o[db]);
    }
  }
}

DI void attn_tasks(const Params& p, char* smem) {
  u16* Ks = (u16*)smem;
  u16* Vs0 = Ks + 64 * 200;
  const int tid = ltid(), lane = tid & 63, wid = __builtin_amdgcn_readfirstlane(tid >> 6), r = lane & 31, h = lane >> 5;
  const bool late = wid >= 4;
  u16* qs = Vs0 + 2 * 128 * 68 + wid * (11 * 512) + lane * 8;
  const float sc = 0.07216878364870322f * 1.4426950408889634f;
  for (int task = lbid(); task < NB * 4 * 17; task += gridDim.x) {
    int b, hd, qt;
    if (task < 512) {
      qt = task & 15; hd = (task >> 4) & 3; b = task >> 6;
    } else {
      const int t2 = task - 512;
      qt = 16; hd = t2 & 3; b = t2 >> 2;
    }
    const int koff = (qt < 16) ? 0 : SEQ;
    const int nkt = ((qt < 16) ? SP : CTX) / 64;
    const int qrow = b * SP + qt * 256 + wid * 32 + r;
    bf16x8 qf[QREG];
#pragma unroll
    for (int kk = 0; kk < QREG; ++kk) qf[kk] = *(const bf16x8*)(p.Q + (size_t)qrow * 768 + hd * 192 + kk * 16 + h * 8);
#pragma unroll
    for (int kk = QREG; kk < 12; ++kk)
      *(bf16x8*)(qs + (kk - QREG) * 512) = *(const bf16x8*)(p.Q + (size_t)qrow * 768 + hd * 192 + kk * 16 + h * 8);
    f32x16 o[4];
#pragma unroll
    for (int i = 0; i < 4; ++i)
#pragma unroll
      for (int e = 0; e < 16; ++e) o[i][e] = 0.f;
    bf16x8 pf[4];
#pragma unroll
    for (int i = 0; i < 4; ++i)
#pragma unroll
      for (int e = 0; e < 8; ++e) pf[i][e] = 0;
    float m_run = -1e30f, l_run = 0.f;
    u32x4 kn[2], kr[1], vv[2];
    const u16* knb = p.Kn + ((size_t)(b * SP + koff) + (tid >> 4)) * 512 + hd * 128 + (tid & 15) * 8;
    const u16* krb = p.Kr + ((size_t)(b * SP + koff) + (tid >> 3)) * 64 + (tid & 7) * 8;
    const u16* vb = p.Vt + ((size_t)(b * 4 + hd) * 128 + (tid >> 3)) * SP + koff + (tid & 7) * 8;
#pragma unroll
    for (int i = 0; i < 2; ++i) kn[i] = *(const u32x4*)(knb + (size_t)(32 * i) * 512);
    kr[0] = *(const u32x4*)(krb);
#pragma unroll
    for (int i = 0; i < 2; ++i) vv[i] = *(const u32x4*)(vb + (size_t)(64 * i) * SP);
    for (int kt = 0; kt < nkt; ++kt) {
      u16* Vs = Vs0 + (kt & 1) * (128 * 68);
      __syncthreads();
#pragma unroll
      for (int i = 0; i < 2; ++i) *(u32x4*)(Ks + ((tid >> 4) + 32 * i) * 200 + (tid & 15) * 8) = kn[i];
      *(u32x4*)(Ks + (tid >> 3) * 200 + 128 + (tid & 7) * 8) = kr[0];
#pragma unroll
      for (int i = 0; i < 2; ++i) {
        u16* dst = Vs + ((tid >> 3) + 64 * i) * 68 + (tid & 7) * 8;
        *(u32x2*)dst = u32x2{vv[i].x, vv[i].y};
        *(u32x2*)(dst + 4) = u32x2{vv[i].z, vv[i].w};
      }
      __syncthreads();
      {
        const size_t ko = (size_t)(kt + 1 < nkt ? kt + 1 : kt) * 64;
#pragma unroll
        for (int i = 0; i < 2; ++i) kn[i] = *(const u32x4*)(knb + (ko + 32 * i) * 512);
        kr[0] = *(const u32x4*)(krb + ko * 64);
#pragma unroll
        for (int i = 0; i < 2; ++i) vv[i] = *(const u32x4*)(vb + (size_t)(64 * i) * SP + ko);
      }
      __builtin_amdgcn_sched_barrier(0);
      if (late && kt > 0) attn_pv(Vs0 + ((kt - 1) & 1) * (128 * 68), pf, o, r, h);
      {
        f32x16 st[2];
        attn_qk(Ks, qf, qs, st, r, h);
        attn_softmax(st, o, pf, m_run, l_run, sc);
      }
      if (!late) attn_pv(Vs, pf, o, r, h);
    }
    if (late) attn_pv(Vs0 + ((nkt - 1) & 1) * (128 * 68), pf, o, r, h);
    const float ltot = l_run + __shfl_xor(l_run, 32);
    const float inv = 1.f / ltot;
    u16* orow = p.H + (size_t)qrow * D + hd * 128;
#pragma unroll
    for (int db = 0; db < 4; ++db)
#pragma unroll
      for (int q4 = 0; q4 < 4; ++q4) {
        u32x2 w;
        w.x = pack2(o[db][4 * q4] * inv, o[db][4 * q4 + 1] * inv);
        w.y = pack2(o[db][4 * q4 + 2] * inv, o[db][4 * q4 + 3] * inv);
        *(u32x2*)(orow + db * 32 + 8 * q4 + 4 * h) = w;
      }
  }
}

constexpr int NPHASE = 2 + DEPTH * 6;

DI void conv_item_ffn(const Params& p, int layer, int q, char* smem) {
#pragma unroll 1
  for (int u = 0; u < 8; ++u) {
    const int tile = q * 8 + u;
    if (tile < 1024) conv_tile(p.w_ff1 + (size_t)layer * D * DFF, D, DFF, p.wt_ff1, nullptr, tile >> 6, tile & 63, smem);
    else conv_tile(p.w_ff2 + (size_t)layer * DFF * D, DFF, D, p.wt_ff2, nullptr, (tile - 1024) >> 4, (tile - 1024) & 15, smem);
  }
}
DI void conv_item_mix(const Params& p, int layer, int q, char* smem) {
#pragma unroll 1
  for (int u = 0; u < 8; ++u) {
    int tile = q * 8 + u;
    if (tile < 512) { conv_tile(p.w_in + (size_t)layer * D * NIN, D, NIN, p.wt_in, nullptr, tile >> 5, tile & 31, smem); continue; }
    tile -= 512;
    if (tile < 48) { conv_tile(p.w_uq + (size_t)layer * 256 * 768, 256, 768, p.wt_uq, p.g_q + layer * 256, tile / 12, tile % 12, smem); continue; }
    tile -= 48;
    if (tile < 32) { conv_tile(p.w_ukv + (size_t)layer * 128 * 1024, 128, 1024, p.wt_ukv, p.g_kv + layer * 128, tile >> 4, tile & 15, smem); continue; }
    tile -= 32;
    if (tile < 256) { conv_tile(p.w_out + (size_t)layer * D * D, D, D, p.wt_out, nullptr, tile >> 4, tile & 15, smem); continue; }
    tile -= 256;
    for (int i = ltid(); i < 4096; i += NTHR) p.wsb[tile * 4096 + i] = f2bf(p.cm_w_s[(size_t)layer * 65536 + tile * 4096 + i]);
  }
}

DI void run_phase(const Params& p, int ph, char* smem) {
  if (ph == 0) { prologue_phase(p, smem); return; }
  const int MT = T / 256;
  auto noT = [](int, int, u32x4) {};
  auto neverT = [](int) { return false; };
  if (ph == 1) {
    ew_phase(p, 0, 0);
    for (int q = lbid(); q < 108; q += gridDim.x) conv_item_mix(p, 0, q, smem);
    return;
  }
  const int layer = (ph - 2) / 6, sub = (ph - 2) % 6;
  const bool last = layer == DEPTH - 1;
  switch (sub) {
    case 0: {
      for (int it = 0;; ++it) {
        const int t = xcd_tile(it, MT * 8);
        if (t < 0) break;
        const int tm = t >> 3, tn = t & 7;
        gemm_tile<false>(
            p.H, D, p.wt_in, D, D, tm * 256, tn * 256, smem,
            [&](int mb, int nb, f32x16& acc, int r, int h) {
              if (nb == 1984) {
                f32x4 v = {acc[0], acc[1], acc[2], acc[3]};
                *(f32x4*)(p.dtraw + (size_t)(mb + r) * 8 + 4 * h) = v;
              }
            },
            [&](int row, int col, u32x4 v) { *(u32x4*)(p.P + (size_t)row * NINP + col) = v; }, noT, neverT);
      }
    } break;
    case 1: {
      int* wq = p.cnt + (2 * DEPTH + layer) * CNT_STRIDE;
      int* sh = (int*)(smem + SMEM_BYTES - 16);
      for (;;) {
        __syncthreads();
        if (ltid() == 0) *sh = __hip_atomic_fetch_add(wq, 1, __ATOMIC_RELAXED, __HIP_MEMORY_SCOPE_AGENT);
        __syncthreads();
        const int q = *sh;
        if (q >= 544 + 136 + 408 + 544) break;
        if (q < 544) ssd_s1_tasks(p, layer, smem, 2 * q, 2 * q + 1, 2);
        else if (q < 680) cm_tasks(p, layer, smem, 2 * (q - 544), 2 * (q - 544) + 1, 2);
        else if (q < 1088) qkv_tasks(p, smem, q - 680, q - 679, 0, 0, 1);
        else qkv_tasks(p, smem, 0, 0, q - 1088, q - 1087, 1);
      }
    } break;
    case 2: ssd_scan_phase(p); break;
    case 3: {
      attn_tasks(p, smem);
      ssd_s3_tasks(p, layer, smem);
    } break;
    case 4: {
      int* cnt = p.cnt + (2 * layer) * CNT_STRIDE;
      for (int it = 0;; ++it) {
        const int t = xcd_tile(it, MT * 4, last ? 4 : 0);
        if (t < 0) break;
        const int tm = t >> 2, tn = t & 3;
        gemm_tile<false>(
            p.H, D, p.wt_out, D, D, tm * 256, tn * 256, smem, [](int, int, f32x16&, int, int) {},
            [&](int row, int col, u32x4 v) { st_wt(p.Y + (size_t)row * D + col, v); }, noT, neverT);
        tile_done(cnt, tm);
      }
      ew_consume(p, cnt, 4, layer, 1, last, 256, [&](int q) { conv_item_ffn(p, layer, q, smem); }, smem);
    } break;
    case 5: {
      int* cnt1 = p.cnt + (3 * DEPTH + layer) * CNT_STRIDE;
      for (int it = 0;; ++it) {
        const int t = xcd_tile(it, MT * 16, last ? 16 : 0);
        if (t < 0) break;
        const int tm = t >> 4, tn = t & 15;
        gemm_tile<false>(
            p.H, D, p.wt_ff1, D, D, tm * 256, tn * 256, smem,
            [](int, int, f32x16& acc, int, int) {
#pragma unroll
              for (int e = 0; e < 16; ++e) {
                float v = fmaxf(acc[e], 0.f);
                acc[e] = v * v;
              }
            },
            [&](int row, int col, u32x4 v) { st_wt(p.Hd + (size_t)row * DFF + col, v); }, noT, neverT);
        tile_done(cnt1, tm);
      }
      int* cnt = p.cnt + (2 * layer + 1) * CNT_STRIDE;
      for (int it = 0;; ++it) {
        const int t = xcd_tile(it, MT * 4, last ? 4 : 0);
        if (t < 0) break;
        const int tm = t >> 2, tn = t & 3;
        if (ltid() == 0) {
          while (__hip_atomic_load(cnt1 + tm, __ATOMIC_ACQUIRE, __HIP_MEMORY_SCOPE_AGENT) < 16) __builtin_amdgcn_s_sleep(4);
        }
        __syncthreads();
        gemm_tile<false>(
            p.Hd, DFF, p.wt_ff2, DFF, DFF, tm * 256, tn * 256, smem, [](int, int, f32x16&, int, int) {},
            [&](int row, int col, u32x4 v) { st_wt(p.F + (size_t)row * D + col, v); }, noT, neverT);
        tile_done(cnt, tm);
      }
      if (last) ew_consume(p, cnt, 4, DEPTH, 2, true, 0, [](int) {}, smem);
      else ew_consume(p, cnt, 4, layer + 1, 0, false, 108, [&](int q) { conv_item_mix(p, layer + 1, q, smem); }, smem);
    } break;
  }
}

__global__ void __launch_bounds__(NTHR, 2) mega_kernel(Params p, int ph_begin, int ph_end) {
  extern __shared__ __attribute__((aligned(16))) char smem[];
  cg::grid_group grid = cg::this_grid();
  for (int ph = ph_begin; ph < ph_end; ++ph) {
    run_phase(p, ph, smem);
    if (ph + 1 < ph_end) grid.sync();
  }
}

extern "C" void kernel_launch(void* const* d_in, const int* in_sizes, int n_in, void* d_out, int out_size, void* d_ws,
                              size_t ws_size, hipStream_t stream) {
  Params p{};
  const float* const* in = (const float* const*)d_in;
  p.x = in[0]; p.c = in[1]; p.ctx = in[2]; p.c_ctx = in[3]; p.w_ada = in[4]; p.b_ada = in[5];
  p.g_pre_mix = in[6]; p.g_post_mix = in[7]; p.g_pre_ff = in[8]; p.g_post_ff = in[9]; p.w_in = in[10];
  p.g_q = in[11]; p.w_uq = in[12]; p.g_kv = in[13]; p.w_ukv = in[14]; p.cm_norm_g = in[15]; p.cm_w_s = in[16];
  p.cm_b_s = in[17]; p.conv_w = in[18]; p.conv_b = in[19]; p.dt_bias = in[20]; p.a_log = in[21]; p.ssd_d = in[22];
  p.ssd_norm_g = in[23]; p.w_out = in[24]; p.w_ff1 = in[25]; p.w_ff2 = in[26];
  p.out = (float*)d_out;
  char* ws = (char*)d_ws;
  size_t off = 0;
  auto take = [&](size_t bytes) { char* q = ws + off; off += (bytes + 255) & ~(size_t)255; return q; };
  p.wt_in = (u16*)take((size_t)NINP * D * 2);
  p.wt_uq = (u16*)take((size_t)768 * 256 * 2);
  p.wt_ukv = (u16*)take((size_t)1024 * 128 * 2);
  p.wt_out = (u16*)take((size_t)D * D * 2);
  p.wt_ff1 = (u16*)take((size_t)DFF * D * 2);
  p.wt_ff2 = (u16*)take((size_t)D * DFF * 2);
  p.wsb = (u16*)take((size_t)4 * 128 * 128 * 2);
  p.mod = (float*)take((size_t)DEPTH * 9 * 6144 * 4);
  p.ropetab = (float*)take((size_t)64 * 16 * 2 * 4);
  p.atot = (float*)take((size_t)NB * NCH * 2 * 4 * 4);
  p.xctx = (float*)take((size_t)NB * CTX * D * 4);
  char* r1 = take((size_t)T * DFF * 2);
  p.Hd = (u16*)r1;
  p.Y = (u16*)r1;
  {
    size_t o2 = 0;
    p.P = (u16*)(r1 + o2); o2 += (size_t)T * NINP * 2;
    p.Q = (u16*)(r1 + o2); o2 += (size_t)T * 768 * 2;
    p.Kn = (u16*)(r1 + o2); o2 += (size_t)T * 512 * 2;
    p.Kr = (u16*)(r1 + o2); o2 += (size_t)T * 64 * 2;
    p.Vt = (u16*)(r1 + o2); o2 += (size_t)NB * 4 * 128 * SP * 2;
    p.dtraw = (float*)(r1 + o2); o2 += (size_t)T * 8 * 4;
  }
  p.H = (u16*)take((size_t)T * D * 2);
  p.CS = (float*)take((size_t)NB * NCH * 2 * 4 * 8192 * 4);
  p.F = (u16*)p.CS;
  p.ytmp = (float*)take((size_t)T * 256 * 4);
  p.cnt = (int*)take((size_t)4 * DEPTH * CNT_STRIDE * 4);
  if (off > ws_size) {
    fprintf(stderr, "workspace too small: need %zu have %zu\n", off, ws_size);
    return;
  }
  static int grid_blocks = 0;
  if (!grid_blocks) {
    int dev = 0, cus = 0, per_cu = 0;
    hipGetDevice(&dev);
    hipDeviceGetAttribute(&cus, hipDeviceAttributeMultiprocessorCount, dev);
    hipFuncSetAttribute((const void*)mega_kernel, hipFuncAttributeMaxDynamicSharedMemorySize, SMEM_BYTES);
    hipOccupancyMaxActiveBlocksPerMultiprocessor(&per_cu, mega_kernel, NTHR, SMEM_BYTES);
    if (per_cu < 1) per_cu = 1;
    if (per_cu > 1) per_cu = 1;
    grid_blocks = cus * per_cu;
  }
  hipMemsetAsync(p.cnt, 0, (size_t)4 * DEPTH * CNT_STRIDE * 4, stream);
  int pb = 0, pe = NPHASE;
  void* args[] = {&p, &pb, &pe};
  hipError_t e = hipLaunchCooperativeKernel((void*)mega_kernel, dim3(grid_blocks), dim3(NTHR), args, SMEM_BYTES, stream);
  if (e != hipSuccess) fprintf(stderr, "cooperative launch failed: %s (grid %d)\n", hipGetErrorString(e), grid_blocks);
}
```

```cpp
#include <hip/hip_runtime.h>
#include <hip/hip_cooperative_groups.h>
#include <cstdio>
namespace cg = cooperative_groups;

#define DI __device__ __forceinline__
typedef unsigned short u16;
using bf16x8 = __attribute__((ext_vector_type(8))) short;
using s16x4 = __attribute__((ext_vector_type(4))) short;
using f32x16 = __attribute__((ext_vector_type(16))) float;
using u32x4 = __attribute__((ext_vector_type(4))) unsigned;
using u32x2 = __attribute__((ext_vector_type(2))) unsigned;
using f32x4 = __attribute__((ext_vector_type(4))) float;
typedef __bf16 bf2_t __attribute__((ext_vector_type(2)));
typedef float f2_t __attribute__((ext_vector_type(2)));
#define MFMA(a, b, c) __builtin_amdgcn_mfma_f32_32x32x16_bf16((a), (b), (c), 0, 0, 0)

constexpr int NB = 8, SEQ = 4096, CTX = 256, SP = 4352, T = NB * SP, D = 1024, DFF = 4096;
constexpr int NIN = 1992, NINP = 2048, NCH = 34, DEPTH = 4;
constexpr int NTHR = 512;
constexpr int VT = 256;
constexpr int VSMEM = 75 * 1024;
constexpr int SMEM_BYTES = 2 * VSMEM;
constexpr float EPS = 1e-6f;

struct Params {
  const float *x, *c, *ctx, *c_ctx, *w_ada, *b_ada, *g_pre_mix, *g_post_mix, *g_pre_ff, *g_post_ff, *w_in, *g_q, *w_uq,
      *g_kv, *w_ukv, *cm_norm_g, *cm_w_s, *cm_b_s, *conv_w, *conv_b, *dt_bias, *a_log, *ssd_d, *ssd_norm_g, *w_out,
      *w_ff1, *w_ff2;
  float* out;
  u16 *wt_in, *wt_uq, *wt_ukv, *wt_out, *wt_ff1, *wt_ff2, *wsb;
  float *mod, *ropetab, *atot, *xctx;
  u16 *P, *Q, *Kn, *Kr, *Vt, *Hd;
  u16* Y;
  float* dtraw;
  u16* H;
  float* CS;
  u16* F;
  float* ytmp;
  int* cnt;
};

DI int ltid() { int t = threadIdx.x; asm volatile("" : "+v"(t)); return t; }
DI int lbid() { int t = blockIdx.x; asm volatile("" : "+s"(t)); return t; }
DI void st_wt(void* ptr, u32x4 v) { asm volatile("global_store_dwordx4 %0, %1, off sc0 sc1" ::"v"(ptr), "v"(v) : "memory"); }
DI int crow(int e, int h) { return (e & 3) + 8 * (e >> 2) + 4 * h; }
DI unsigned pack2(float a, float b) {
  f2_t v = {a, b};
  bf2_t r = __builtin_convertvector(v, bf2_t);
  return __builtin_bit_cast(unsigned, r);
}
DI u16 f2bf(float a) { return (u16)(pack2(a, 0.f) & 0xffffu); }
DI float bf2f(u16 v) { return __uint_as_float(((unsigned)v) << 16); }
DI float bflo(unsigned w) { return __uint_as_float(w << 16); }
DI float bfhi(unsigned w) { return __uint_as_float(w & 0xffff0000u); }
DI bf16x8 pack8(float a0, float a1, float a2, float a3, float a4, float a5, float a6, float a7) {
  u32x4 u;
  u.x = pack2(a0, a1); u.y = pack2(a2, a3); u.z = pack2(a4, a5); u.w = pack2(a6, a7);
  return __builtin_bit_cast(bf16x8, u);
}
DI float wave_sum(float v) {
#pragma unroll
  for (int o = 32; o > 0; o >>= 1) v += __shfl_xor(v, o);
  return v;
}
DI float silu_f(float y) { return y * __builtin_amdgcn_rcpf(1.f + __expf(-y)); }
DI float gelu_f(float x) {
  float u = 0.7978845608028654f * (x + 0.044715f * x * x * x);
  float t = 1.f - 2.f * __builtin_amdgcn_rcpf(1.f + __expf(2.f * u));
  return 0.5f * x * (1.f + t);
}
DI float softplus_f(float x) { return x > 20.f ? x : log1pf(__expf(x)); }
DI float uw(const u32x4& v, int i) {
  unsigned w = (i >> 1) == 0 ? v.x : (i >> 1) == 1 ? v.y : (i >> 1) == 2 ? v.z : v.w;
  return (i & 1) ? bfhi(w) : bflo(w);
}

template <bool HAS_T, class ElemF, class StoreF, class StoreTF, class UseTF>
DI void gemm_tile(const u16* __restrict__ A, int lda, const u16* __restrict__ Bt, int ldb, int K, int m0, int n0,
                  char* smem, ElemF elem, StoreF store, StoreTF storeT, UseTF useT) {
  constexpr int LS = 72;
  constexpr int STAGE = 2 * 256 * LS;
  u16* base = (u16*)smem;
  const int tid = ltid(), lane = tid & 63, wid = tid >> 6, wm = wid >> 2, wn = wid & 3, r = lane & 31, h = lane >> 5;
  f32x16 acc[4][2];
#pragma unroll
  for (int i = 0; i < 4; ++i)
#pragma unroll
    for (int j = 0; j < 2; ++j)
#pragma unroll
      for (int e = 0; e < 16; ++e) acc[i][j][e] = 0.f;
  u32x4 ra[4], rb[4];
  const int lrow = tid >> 3, lcp = (tid & 7) * 8;
  const u16* ga = A + (size_t)(m0 + lrow) * lda + lcp;
  const u16* gb = Bt + (size_t)(n0 + lrow) * ldb + lcp;
  const int wofs = lrow * LS + lcp;
  const int aofs = (wm * 128 + r) * LS + h * 8;
  const int bofs = 256 * LS + (wn * 64 + r) * LS + h * 8;
#define GLOAD(kt_)                                                           \
  _Pragma("unroll") for (int i = 0; i < 4; ++i) {                            \
    ra[i] = *(const u32x4*)(ga + (size_t)(64 * i) * lda + (kt_) * 64);       \
    rb[i] = *(const u32x4*)(gb + (size_t)(64 * i) * ldb + (kt_) * 64);       \
  }
#define SWRITE(st_)                                                          \
  _Pragma("unroll") for (int i = 0; i < 4; ++i) {                            \
    *(u32x4*)((st_) + wofs + 64 * i * LS) = ra[i];                           \
    *(u32x4*)((st_) + 256 * LS + wofs + 64 * i * LS) = rb[i];                \
  }
#define FREAD(dst_, st_, kk_)                                                                      \
  _Pragma("unroll") for (int i = 0; i < 4; ++i) af[dst_][i] = *(const bf16x8*)((st_) + aofs + i * 32 * LS + (kk_) * 16); \
  _Pragma("unroll") for (int j = 0; j < 2; ++j) bfr[dst_][j] = *(const bf16x8*)((st_) + bofs + j * 32 * LS + (kk_) * 16);
#define MMAS(src_)                                                           \
  _Pragma("unroll") for (int i = 0; i < 4; ++i)                              \
  _Pragma("unroll") for (int j = 0; j < 2; ++j) acc[i][j] = MFMA(bfr[src_][j], af[src_][i], acc[i][j]);
#define ILV()                                                                   \
  __builtin_amdgcn_sched_group_barrier(0x008, 2, 0);                            \
  __builtin_amdgcn_sched_group_barrier(0x100, 2, 0);                            \
  __builtin_amdgcn_sched_group_barrier(0x008, 2, 0);                            \
  __builtin_amdgcn_sched_group_barrier(0x100, 2, 0);                            \
  __builtin_amdgcn_sched_group_barrier(0x008, 2, 0);                            \
  __builtin_amdgcn_sched_group_barrier(0x100, 2, 0);                            \
  __builtin_amdgcn_sched_group_barrier(0x008, 2, 0);
  const int nk = K >> 6;
  bf16x8 af[2][4], bfr[2][2];
  GLOAD(0);
  __syncthreads();
  SWRITE(base);
  if (nk > 1) { GLOAD(1); }
  __syncthreads();
  FREAD(0, base, 0);
  for (int kt = 0; kt < nk; ++kt) {
    u16* cur = base + (kt & 1) * STAGE;
    u16* nxt = base + ((kt + 1) & 1) * STAGE;
    FREAD(1, cur, 1);
    if (kt + 1 < nk) { SWRITE(nxt); }
    MMAS(0);
#pragma unroll
    for (int z = 0; z < 7; ++z) {
      __builtin_amdgcn_sched_group_barrier(0x008, 1, 0);
      __builtin_amdgcn_sched_group_barrier(0x080, 2, 0);
    }
    __builtin_amdgcn_sched_group_barrier(0x008, 1, 0);
    __builtin_amdgcn_sched_barrier(0);
    if (kt + 2 < nk) { GLOAD(kt + 2); }
    FREAD(0, cur, 2);
    MMAS(1);
    ILV();
    __builtin_amdgcn_sched_barrier(0);
    FREAD(1, cur, 3);
    MMAS(0);
    ILV();
    __builtin_amdgcn_sched_barrier(0);
    __syncthreads();
    if (kt + 1 < nk) { FREAD(0, nxt, 0); }
    MMAS(1);
    ILV();
    __builtin_amdgcn_sched_barrier(0);
  }
#undef ILV
#undef GLOAD
#undef SWRITE
#undef FREAD
#undef MMAS
#pragma unroll
  for (int i = 0; i < 4; ++i)
#pragma unroll
    for (int j = 0; j < 2; ++j) elem(m0 + wm * 128 + i * 32, n0 + wn * 64 + j * 32, acc[i][j], r, h);
  u16* stg = base + wid * (128 * 72);
  if (HAS_T && useT(wn)) {
#pragma unroll
    for (int i = 0; i < 4; ++i)
#pragma unroll
      for (int j = 0; j < 2; ++j)
#pragma unroll
        for (int e = 0; e < 16; ++e) stg[(j * 32 + crow(e, h)) * 136 + i * 32 + r] = f2bf(acc[i][j][e]);
    __builtin_amdgcn_wave_barrier();
#pragma unroll 4
    for (int t = 0; t < 16; ++t) {
      const int id = lane + 64 * t, cl = id >> 4, cp = id & 15;
      u32x4 v = *(const u32x4*)(stg + cl * 136 + cp * 8);
      storeT(n0 + wn * 64 + cl, m0 + wm * 128 + cp * 8, v);
    }
  } else {
#pragma unroll
    for (int i = 0; i < 4; ++i)
#pragma unroll
      for (int j = 0; j < 2; ++j)
#pragma unroll
        for (int q4 = 0; q4 < 4; ++q4) {
          u32x2 w;
          w.x = pack2(acc[i][j][4 * q4], acc[i][j][4 * q4 + 1]);
          w.y = pack2(acc[i][j][4 * q4 + 2], acc[i][j][4 * q4 + 3]);
          *(u32x2*)(stg + (i * 32 + r) * 72 + j * 32 + 8 * q4 + 4 * h) = w;
        }
    __builtin_amdgcn_wave_barrier();
#pragma unroll 4
    for (int t = 0; t < 16; ++t) {
      const int id = lane + 64 * t, rl = id >> 3, cp = id & 7;
      u32x4 v = *(const u32x4*)(stg + rl * 72 + cp * 8);
      store(m0 + wm * 128 + rl, n0 + wn * 64 + cp * 8, v);
    }
  }
}

DI int xcd_tile(int it, int ntiles, int skip_tail = 0) {
  const int b = lbid(), g = gridDim.x;
  const int local = (b >> 3) + it * (g >> 3);
  const int per = ntiles >> 3;
  return local < per - skip_tail ? (b & 7) * per + local : -1;
}

DI void conv_tile(const float* __restrict__ src, int K, int N, u16* __restrict__ dst, const float* __restrict__ scale,
                  int tk, int tn, char* smem) {
  float* tile = (float*)smem;
  const int tid = ltid(), tx = tid & 63, ty = tid >> 6;
  const int k0 = tk * 64, n0 = tn * 64;
  __syncthreads();
#pragma unroll 4
  for (int i = 0; i < 8; ++i) {
    int kr = ty + 8 * i;
    float v = 0.f;
    if (n0 + tx < N) v = src[(size_t)(k0 + kr) * N + n0 + tx];
    if (scale) v *= scale[k0 + kr];
    tile[kr * 65 + tx] = v;
  }
  __syncthreads();
#pragma unroll 4
  for (int i = 0; i < 8; ++i) {
    int nr = ty + 8 * i;
    dst[(size_t)(n0 + nr) * K + k0 + tx] = f2bf(tile[tx * 65 + nr]);
  }
}

DI void convert_weights(const float* src, int K, int N, int Npad, u16* dst, const float* scale, char* smem) {
  const int tks = K / 64, tns = Npad / 64;
  for (int t = lbid(); t < tks * tns; t += gridDim.x) conv_tile(src, K, N, dst, scale, t / tns, t % tns, smem);
}

DI void prologue_phase(const Params& p, char* smem) {
  float* sc = (float*)smem;
  float* red = sc + 9 * 1024;
  const int tid = ltid();
  for (int i = tid; i < 9 * 1024; i += NTHR) {
    int j = i >> 10, k = i & 1023;
    float v = j < 8 ? p.c[j * 1024 + k] : p.c_ctx[k];
    sc[i] = v / (1.f + __expf(-v));
  }
  __syncthreads();
  for (int task = lbid(); task < DEPTH * 96; task += gridDim.x) {
    const int l = task / 96, n0 = (task % 96) * 64, nn = tid & 63, kq = tid >> 6;
    float acc[9];
#pragma unroll
    for (int j = 0; j < 9; ++j) acc[j] = 0.f;
    const float* w = p.w_ada + ((size_t)l * 1024 + kq * 128) * 6144 + n0 + nn;
    const float* scq = sc + kq * 128;
#pragma unroll 4
    for (int k = 0; k < 128; ++k) {
      float wv = w[(size_t)k * 6144];
#pragma unroll
      for (int j = 0; j < 9; ++j) acc[j] += scq[j * 1024 + k] * wv;
    }
#pragma unroll
    for (int j = 0; j < 9; ++j) red[(kq * 9 + j) * 64 + nn] = acc[j];
    __syncthreads();
    for (int idx = tid; idx < 576; idx += NTHR) {
      int j = idx >> 6, n2 = idx & 63;
      float s = p.b_ada[l * 6144 + n0 + n2];
#pragma unroll
      for (int q = 0; q < 8; ++q) s += red[(q * 9 + j) * 64 + n2];
      p.mod[(size_t)(l * 9 + j) * 6144 + n0 + n2] = s;
    }
    __syncthreads();
  }
  if (lbid() == gridDim.x - 1) {
    for (int i = tid; i < 64 * 16; i += NTHR) {
      int pos = i >> 4, j = i & 15;
      float inv_freq = exp2f(-(float)(2 * j) / 32.f * 13.287712379549449f);
      float ang = (float)pos * inv_freq;
      float k = rintf(ang * 0.15915494309189535f);
      float red2 = fmaf(-k, 6.2831854820251465f, ang);
      red2 = fmaf(-k, -1.7484555314695172e-07f, red2);
      p.ropetab[2 * i] = __cosf(red2);
      p.ropetab[2 * i + 1] = __sinf(red2);
    }
  }
}

DI void ew_row(const Params& p, int layer, int kind, int row, int lane) {
  const bool has_branch = !(kind == 0 && layer == 0);
  const bool src_in = (layer == 0 && kind <= 1);
  const bool store_x = has_branch;
  const int blayer = (kind == 1) ? layer : (kind == 0 ? layer - 1 : DEPTH - 1);
  const float* gpost = (kind == 1) ? p.g_post_mix + blayer * D : p.g_post_ff + (blayer < 0 ? 0 : blayer) * D;
  const int gate_off = (kind == 1) ? 2 * D : 5 * D;
  const float* gpre = (kind == 0) ? p.g_pre_mix + layer * D : p.g_pre_ff + (kind == 1 ? layer : 0) * D;
  const int shift_off = (kind == 0) ? 0 : 3 * D, scale_off = (kind == 0) ? D : 4 * D;
  const float* xl = src_in ? p.x : p.out;
  const float* xc = src_in ? p.ctx : p.xctx;
    const int b = row / SP, s = row - b * SP;
    const bool lat = s < SEQ;
    if ((kind == 2 || (kind == 1 && layer == DEPTH - 1)) && !lat) return;
    const size_t xoff = lat ? ((size_t)(b * SEQ + s) * D) : ((size_t)(b * CTX + s - SEQ) * D);
    const unsigned long long msk = lat ? ~0ull : 0ull;
    const float* xs = (const float*)(((unsigned long long)xl & msk) | ((unsigned long long)xc & ~msk)) + xoff;
    float* xd = (float*)(((unsigned long long)p.out & msk) | ((unsigned long long)p.xctx & ~msk)) + xoff;
    const int mi = lat ? b : 8;
    f32x4 xv[4];
#pragma unroll
    for (int i = 0; i < 4; ++i) xv[i] = *(const f32x4*)(xs + lane * 4 + 256 * i);
    if (has_branch) {
      const float* modb = p.mod + (size_t)(blayer * 9 + mi) * 6144 + gate_off;
      f32x4 yv[4];
      const u16* ysrc = (kind == 1) ? p.Y : p.F;
#pragma unroll
      for (int i = 0; i < 4; ++i) {
        u32x2 w = *(const u32x2*)(ysrc + (size_t)row * D + lane * 4 + 256 * i);
        yv[i] = f32x4{bflo(w.x), bfhi(w.x), bflo(w.y), bfhi(w.y)};
      }
      float ss = 0.f;
#pragma unroll
      for (int i = 0; i < 4; ++i) ss += yv[i].x * yv[i].x + yv[i].y * yv[i].y + yv[i].z * yv[i].z + yv[i].w * yv[i].w;
      ss = wave_sum(ss);
      const float rstd = rsqrtf(ss * (1.f / D) + EPS);
#pragma unroll
      for (int i = 0; i < 4; ++i) {
        const int col = lane * 4 + 256 * i;
        f32x4 g = *(const f32x4*)(gpost + col);
        f32x4 gt = *(const f32x4*)(modb + col);
        xv[i].x += gt.x * (yv[i].x * rstd * g.x);
        xv[i].y += gt.y * (yv[i].y * rstd * g.y);
        xv[i].z += gt.z * (yv[i].z * rstd * g.z);
        xv[i].w += gt.w * (yv[i].w * rstd * g.w);
      }
      if (store_x) {
#pragma unroll
        for (int i = 0; i < 4; ++i) *(f32x4*)(xd + lane * 4 + 256 * i) = xv[i];
      }
    }
    if (kind != 2) {
      const float* modl = p.mod + (size_t)(layer * 9 + mi) * 6144;
      float ss = 0.f;
#pragma unroll
      for (int i = 0; i < 4; ++i) ss += xv[i].x * xv[i].x + xv[i].y * xv[i].y + xv[i].z * xv[i].z + xv[i].w * xv[i].w;
      ss = wave_sum(ss);
      const float rstd = rsqrtf(ss * (1.f / D) + EPS);
#pragma unroll
      for (int i = 0; i < 4; ++i) {
        const int col = lane * 4 + 256 * i;
        f32x4 g = *(const f32x4*)(gpre + col);
        f32x4 sh = *(const f32x4*)(modl + shift_off + col);
        f32x4 sc = *(const f32x4*)(modl + scale_off + col);
        float h0 = xv[i].x * rstd * g.x * (1.f + sc.x) + sh.x;
        float h1 = xv[i].y * rstd * g.y * (1.f + sc.y) + sh.y;
        float h2 = xv[i].z * rstd * g.z * (1.f + sc.z) + sh.z;
        float h3 = xv[i].w * rstd * g.w * (1.f + sc.w) + sh.w;
        u32x2 w;
        w.x = pack2(h0, h1);
        w.y = pack2(h2, h3);
        *(u32x2*)(p.H + (size_t)row * D + col) = w;
      }
    }
}

DI void ew_phase(const Params& p, int layer, int kind) {
  const int tid = ltid(), lane = tid & 63, wid = __builtin_amdgcn_readfirstlane(tid >> 6);
  for (int rg = lbid(); rg < T / 8; rg += gridDim.x) ew_row(p, layer, kind, rg * 8 + wid, lane);
}

constexpr int CNT_STRIDE = 160;
DI void tile_done(int* cnt, int tm) {
  asm volatile("s_waitcnt vmcnt(0)" ::: "memory");
  __syncthreads();
  if (ltid() == 0) __hip_atomic_fetch_add(cnt + tm, 1, __ATOMIC_RELAXED, __HIP_MEMORY_SCOPE_AGENT);
}
template <class ConvF>
DI void ew_consume(const Params& p, int* cnt, int need, int layer, int kind, bool skip_ctx, int nconv, ConvF conv,
                   char* smem) {
  int* sh = (int*)(smem + SMEM_BYTES - 16);
  const int tid = ltid(), lane = tid & 63, wid = __builtin_amdgcn_readfirstlane(tid >> 6);
  for (;;) {
    __syncthreads();
    if (tid == 0) *sh = __hip_atomic_fetch_add(cnt + 136, 1, __ATOMIC_RELAXED, __HIP_MEMORY_SCOPE_AGENT);
    __syncthreads();
    const int q = *sh;
    if (q >= nconv + 544) break;
    if (q < nconv) { conv(q); continue; }
    const int c = q - nconv, mseq = c >> 2, j = mseq >> 3, bb = mseq & 7, tm = bb * 17 + j;
    if (skip_ctx && j == 16) continue;
    if (tid == 0) {
      while (__hip_atomic_load(cnt + tm, __ATOMIC_ACQUIRE, __HIP_MEMORY_SCOPE_AGENT) < need) __builtin_amdgcn_s_sleep(4);
    }
    __syncthreads();
    const int row0 = tm * 256 + (c & 3) * 64 + wid * 8;
#pragma unroll 1
    for (int i = 0; i < 8; ++i) ew_row(p, layer, kind, row0 + i, lane);
  }
}

DI void row_rstd(const u16* __restrict__ base, int ld, int ncols, int m0, float* rs) {
  const int tid = ltid(), row = tid >> 1, half = tid & 1;
  const int per = ncols / 2;
  const u16* ptr = base + (size_t)(m0 + row) * ld + half * per;
  float ss = 0.f;
  for (int i = 0; i < per; i += 8) {
    u32x4 v = *(const u32x4*)(ptr + i);
#pragma unroll
    for (int e = 0; e < 8; ++e) {
      float f = uw(v, e);
      ss += f * f;
    }
  }
  ss += __shfl_xor(ss, 1);
  if (half == 0) rs[row] = rsqrtf(ss / (float)ncols + EPS);
}

DI void qkv_tasks(const Params& p, char* smem, int qb, int qe, int kb_, int ke, int stp) {
  float* rs = (float*)(smem + 2 * 2 * 256 * 72 * 2);
  const int MT = T / 256;
  auto noT = [](int, int, u32x4) {};
  auto neverT = [](int) { return false; };
  for (int t = qb; t < qe; t += stp) {
    const int tm = t / 3, tn = t % 3, m0 = tm * 256;
    __syncthreads();
    row_rstd(p.P, NINP, 256, m0, rs);
    const bool lat = (m0 % SP) < SEQ;
    const int s0 = m0 % SP;
    gemm_tile<false>(
        p.P, NINP, p.wt_uq, 256, 256, m0, tn * 256, smem,
        [&](int mb, int nb, f32x16& acc, int r, int h) {
          const int rowl = mb - m0 + r;
          const float sc = rs[rowl];
#pragma unroll
          for (int e = 0; e < 16; ++e) acc[e] *= sc;
          const int cb = nb % 192;
          if (lat && cb >= 128) {
            const int s = s0 + rowl;
            const int pos = (cb == 128) ? (s >> 6) : (s & 63);
#pragma unroll
            for (int e = 0; e < 8; ++e) {
              const int j = crow(e, h);
              const float cs = p.ropetab[2 * (pos * 16 + j)], sn = p.ropetab[2 * (pos * 16 + j) + 1];
              const float x1 = acc[e], x2 = acc[e + 8];
              acc[e] = x1 * cs - x2 * sn;
              acc[e + 8] = x1 * sn + x2 * cs;
            }
          }
        },
        [&](int row, int col, u32x4 v) { *(u32x4*)(p.Q + (size_t)row * 768 + col) = v; }, noT, neverT);
  }
  for (int t = kb_; t < ke; t += stp) {
    const int tm = t / 4, tn = t % 4, m0 = tm * 256;
    const int b = m0 / SP, s0 = m0 % SP;
    const bool lat = s0 < SEQ;
    __syncthreads();
    row_rstd(p.P + 256, NINP, 128, m0, rs);
    if (tn == 0) {
      for (int idx = ltid(); idx < 256 * 32; idx += NTHR) {
        const int rowl = idx >> 5, q = idx & 31, blk = q >> 4, j = q & 15;
        const u16* src = p.P + (size_t)(m0 + rowl) * NINP + 384 + blk * 32 + j;
        float x1 = bf2f(src[0]), x2 = bf2f(src[16]);
        float o1 = x1, o2 = x2;
        if (lat) {
          const int s = s0 + rowl;
          const int pos = blk == 0 ? (s >> 6) : (s & 63);
          const float cs = p.ropetab[2 * (pos * 16 + j)], sn = p.ropetab[2 * (pos * 16 + j) + 1];
          o1 = x1 * cs - x2 * sn;
          o2 = x1 * sn + x2 * cs;
        }
        u16* dst = p.Kr + (size_t)(m0 + rowl) * 64 + blk * 32 + j;
        dst[0] = f2bf(o1);
        dst[16] = f2bf(o2);
      }
    }
    const int n0 = tn * 256;
    u16* vbase = p.Vt + (size_t)(b * 4 + tn) * 128 * SP + s0;
    gemm_tile<true>(
        p.P + 256, NINP, p.wt_ukv, 128, 128, m0, n0, smem,
        [&](int mb, int nb, f32x16& acc, int r, int h) {
          const float sc = rs[mb - m0 + r];
#pragma unroll
          for (int e = 0; e < 16; ++e) acc[e] *= sc;
        },
        [&](int row, int col, u32x4 v) { *(u32x4*)(p.Kn + (size_t)row * 512 + tn * 128 + (col - n0)) = v; },
        [&](int col, int row, u32x4 v) { *(u32x4*)(vbase + (size_t)(col - n0 - 128) * SP + (row - m0)) = v; },
        [](int wn) { return wn >= 2; });
  }
}

DI void cm_tasks(const Params& p, int layer, char* smem, int tb, int te, int stp) {
  const int ftid = ltid(), vb = ftid >> 8, tid = ftid & 255;
  u16* vnT = (u16*)(smem + vb * VSMEM);
  const int lane = tid & 63, wid = tid >> 6, r = lane & 31, h = lane >> 5;
  const float* gn = p.cm_norm_g + layer * 256;
  const float* bs = p.cm_b_s + layer * 512;
  for (int t0 = tb; t0 < te; t0 += stp) {
    const int task = t0 + vb;
    const int row0 = task * 128;
    __syncthreads();
#pragma unroll 4
    for (int i = 0; i < 32; ++i) {
      const int s = wid * 32 + i;
      const u16* src = p.P + (size_t)(row0 + s) * NINP + 704;
      float v[4];
      float sum = 0.f;
#pragma unroll
      for (int q = 0; q < 4; ++q) {
        v[q] = gelu_f(bf2f(src[lane + 64 * q]));
        sum += v[q];
      }
      const float mean = wave_sum(sum) * (1.f / 256.f);
      float var = 0.f;
#pragma unroll
      for (int q = 0; q < 4; ++q) {
        v[q] -= mean;
        var += v[q] * v[q];
      }
      const float rstd = rsqrtf(wave_sum(var) * (1.f / 256.f) + EPS);
#pragma unroll
      for (int q = 0; q < 4; ++q) vnT[(lane + 64 * q) * 136 + s] = f2bf(v[q] * rstd * gn[lane + 64 * q]);
    }
    __syncthreads();
    const int t = wid * 32 + r;
    for (int g = 0; g < 4; ++g) {
      bf16x8 wf[8];
#pragma unroll
      for (int kk = 0; kk < 8; ++kk) wf[kk] = *(const bf16x8*)(p.wsb + ((size_t)(g * 128 + t)) * 128 + kk * 16 + h * 8);
      const float bias = bs[g * 128 + t];
#pragma unroll
      for (int cb = 0; cb < 2; ++cb) {
        f32x16 acc;
#pragma unroll
        for (int e = 0; e < 16; ++e) acc[e] = 0.f;
#pragma unroll
        for (int kk = 0; kk < 8; ++kk) {
          bf16x8 a = *(const bf16x8*)(vnT + (g * 64 + cb * 32 + r) * 136 + kk * 16 + h * 8);
          acc = MFMA(a, wf[kk], acc);
        }
#pragma unroll
        for (int q4 = 0; q4 < 4; ++q4) {
          const int ch0 = g * 64 + cb * 32 + 8 * q4 + 4 * h;
          u32x2 uwd = *(const u32x2*)(p.P + (size_t)(row0 + t) * NINP + 448 + ch0);
          float u0 = gelu_f(bflo(uwd.x)), u1 = gelu_f(bfhi(uwd.x)), u2 = gelu_f(bflo(uwd.y)), u3 = gelu_f(bfhi(uwd.y));
          u32x2 w;
          w.x = pack2(u0 * (acc[4 * q4] + bias), u1 * (acc[4 * q4 + 1] + bias));
          w.y = pack2(u2 * (acc[4 * q4 + 2] + bias), u3 * (acc[4 * q4 + 3] + bias));
          *(u32x2*)(p.H + (size_t)(row0 + t) * D + 512 + ch0) = w;
        }
      }
    }
  }
}

struct ConvW { f32x4 w0a, w0b, w1a, w1b, w2a, w2b, ba, bb; };
DI ConvW load_convw(const Params& p, int layer, int ch) {
  const float* cw = p.conv_w + (size_t)layer * 3 * 768 + ch;
  const float* cb = p.conv_b + layer * 768 + ch;
  ConvW c;
  c.w0a = *(const f32x4*)(cw); c.w0b = *(const f32x4*)(cw + 4);
  c.w1a = *(const f32x4*)(cw + 768); c.w1b = *(const f32x4*)(cw + 772);
  c.w2a = *(const f32x4*)(cw + 1536); c.w2b = *(const f32x4*)(cw + 1540);
  c.ba = *(const f32x4*)(cb); c.bb = *(const f32x4*)(cb + 4);
  return c;
}
DI float convw_get(const f32x4& a, const f32x4& b, int e) { return e < 4 ? a[e & 3] : b[e & 3]; }
DI void conv8(const Params& p, const ConvW& c, int row, int ch, bool hasPrev, bool hasNext, float out[8]) {
  const u16* base = p.P + (size_t)row * NINP + 1216 + ch;
  u32x4 cur = *(const u32x4*)base;
  u32x4 prv = *(const u32x4*)(base - (hasPrev ? NINP : 0));
  u32x4 nxt = *(const u32x4*)(base + (hasNext ? NINP : 0));
  const float mp = hasPrev ? 1.f : 0.f, mn = hasNext ? 1.f : 0.f;
#pragma unroll
  for (int e = 0; e < 8; ++e) {
    float y = convw_get(c.w0a, c.w0b, e) * (mp * uw(prv, e)) + convw_get(c.w1a, c.w1b, e) * uw(cur, e) +
              convw_get(c.w2a, c.w2b, e) * (mn * uw(nxt, e)) + convw_get(c.ba, c.bb, e);
    out[e] = silu_f(y);
  }
}

template <int RPT, class F>
DI void conv_stage(const Params& p, int layer, int row0, int chbase, int cp, int tb, bool cPrev, bool cNext, F emit) {
  const ConvW c = load_convw(p, layer, chbase + cp * 8);
  const int r0 = tb * RPT;
  const bool hp = cPrev || r0 > 0, hn = cNext || (r0 + RPT) < 128;
  const u16* base = p.P + (size_t)(row0 + r0) * NINP + 1216 + chbase + cp * 8;
  u32x4 raw[RPT + 2];
  raw[0] = *(const u32x4*)(base - (hp ? NINP : 0));
#pragma unroll
  for (int k = 0; k < RPT; ++k) raw[k + 1] = *(const u32x4*)(base + (size_t)k * NINP);
  raw[RPT + 1] = *(const u32x4*)(base + (size_t)(hn ? RPT : RPT - 1) * NINP);
  const float mp = hp ? 1.f : 0.f, mn = hn ? 1.f : 0.f;
#pragma unroll
  for (int i = 0; i < RPT; ++i) {
    const float fp = (i == 0) ? mp : 1.f, fn = (i == RPT - 1) ? mn : 1.f;
    float v[8];
#pragma unroll
    for (int e = 0; e < 8; ++e) {
      float y = convw_get(c.w0a, c.w0b, e) * (fp * uw(raw[i], e)) + convw_get(c.w1a, c.w1b, e) * uw(raw[i + 1], e) +
                convw_get(c.w2a, c.w2b, e) * (fn * uw(raw[i + 2], e)) + convw_get(c.ba, c.bb, e);
      v[e] = silu_f(y);
    }
    emit(r0 + i, v);
  }
}

DI void ssd_dt_arrays(const Params& p, int layer, int row0, int hh, int t, float* arr) {
  float* dt0 = arr;
  float* dt1 = arr + 128;
  float* c0 = arr + 256;
  float* s1 = arr + 384;
  float* a0 = arr + 512;
  float* a1 = arr + 640;
  const float d0 = softplus_f(p.dtraw[(size_t)(row0 + t) * 8 + hh] + p.dt_bias[layer * 8 + hh]);
  const float d1 = softplus_f(p.dtraw[(size_t)(row0 + t) * 8 + 4 + hh] + p.dt_bias[layer * 8 + 4 + hh]);
  dt0[t] = d0;
  dt1[t] = d1;
  a0[t] = -d0 * __expf(p.a_log[layer * 8 + hh]);
  a1[t] = -d1 * __expf(p.a_log[layer * 8 + 4 + hh]);
}
DI float wave_incl_prefix(float x, int lane) {
#pragma unroll
  for (int o = 1; o < 64; o <<= 1) {
    float y = __shfl_up(x, o);
    if (lane >= o) x += y;
  }
  return x;
}
DI void ssd_cum_arrays(int t, float* arr) {
  float* c0 = arr + 256;
  float* s1 = arr + 384;
  const float* a0 = arr + 512;
  const float* a1 = arr + 640;
  const int lane = t & 63, w = t >> 6;
  const float x0 = a0[t], o0 = a0[t ^ 64], x1 = a1[t], o1 = a1[t ^ 64];
  const float tot_o0 = wave_sum(o0), tot_o1 = wave_sum(o1), tot_x1 = wave_sum(x1);
  float p0 = wave_incl_prefix(x0, lane);
  float p1 = wave_incl_prefix(x1, lane);
  if (w == 1) p0 += tot_o0;
  float sf = tot_x1 - p1 + x1;
  if (w == 0) sf += tot_o1;
  c0[t] = p0;
  s1[t] = sf;
}

DI void ssd_s1_tasks(const Params& p, int layer, char* smem, int tb, int te, int stp) {
  const int ftid = ltid(), vb = ftid >> 8, tid = ftid & 255;
  u16* xsT0 = (u16*)(smem + vb * VSMEM);
  u16* xsT1 = xsT0 + 64 * 136;
  u16* BT = xsT1 + 64 * 136;
  float* arr = (float*)(BT + 128 * 136);
  float* w0 = arr + 768;
  float* w1 = w0 + 128;
  const int lane = tid & 63, wid = tid >> 6, r = lane & 31, h = lane >> 5;
  for (int t0 = tb; t0 < te; t0 += stp) {
    const int task = t0 + vb;
    const int hh = task & 3, bc = task >> 2, c = bc % NCH, b = bc / NCH;
    const int g = hh >> 1;
    const int row0 = bc * 128;
    const bool cPrev = (c != 0 && c != 32), cNext = (c != 31 && c != 33);
    __syncthreads();
    if (tid < 128) ssd_dt_arrays(p, layer, row0, hh, tid, arr);
    __syncthreads();
    if (tid < 128) ssd_cum_arrays(tid, arr);
    __syncthreads();
    if (tid < 128) {
      const float* dt0 = arr;
      const float* dt1 = arr + 128;
      const float* c0 = arr + 256;
      const float* s1 = arr + 384;
      w0[tid] = __expf(c0[127] - c0[tid]) * dt0[tid];
      w1[tid] = __expf(s1[0] - s1[tid]) * dt1[tid];
      if (tid == 0) {
        p.atot[((size_t)bc * 2 + 0) * 4 + hh] = c0[127];
        p.atot[((size_t)bc * 2 + 1) * 4 + hh] = s1[0];
      }
    }
    __syncthreads();
    conv_stage<4>(p, layer, row0, hh * 64, tid & 7, tid >> 3, cPrev, cNext, [&](int t, const float (&v)[8]) {
      const float f0 = w0[t], f1 = w1[t];
      const int cp = tid & 7;
#pragma unroll
      for (int e = 0; e < 8; ++e) {
        xsT0[(cp * 8 + e) * 136 + t] = f2bf(v[e] * f0);
        xsT1[(cp * 8 + e) * 136 + t] = f2bf(v[e] * f1);
      }
    });
    conv_stage<8>(p, layer, row0, 256 + g * 128, tid & 15, tid >> 4, cPrev, cNext, [&](int t, const float (&v)[8]) {
      const int cp = tid & 15;
#pragma unroll
      for (int e = 0; e < 8; ++e) BT[(cp * 8 + e) * 136 + t] = f2bf(v[e]);
    });
    __syncthreads();
#pragma unroll
    for (int d = 0; d < 2; ++d) {
      const u16* xsT = d ? xsT1 : xsT0;
#pragma unroll
      for (int pb = 0; pb < 2; ++pb) {
        f32x16 acc;
#pragma unroll
        for (int e = 0; e < 16; ++e) acc[e] = 0.f;
#pragma unroll
        for (int kk = 0; kk < 8; ++kk) {
          bf16x8 a = *(const bf16x8*)(xsT + (pb * 32 + r) * 136 + kk * 16 + h * 8);
          bf16x8 bb = *(const bf16x8*)(BT + (wid * 32 + r) * 136 + kk * 16 + h * 8);
          acc = MFMA(a, bb, acc);
        }
        float* dst = p.CS + ((((size_t)bc * 2 + d) * 4 + hh) * 64 + pb * 32) * 128 + wid * 32 + r;
#pragma unroll
        for (int e = 0; e < 16; ++e) dst[(size_t)crow(e, h) * 128] = acc[e];
      }
    }
  }
}

DI void ssd_scan_phase(const Params& p) {
  const int total = NB * 2 * 4 * 8192;
  for (int idx = lbid() * NTHR + ltid(); idx < total; idx += gridDim.x * NTHR) {
    const int e = idx & 8191, hh = (idx >> 13) & 3, d = (idx >> 15) & 1, b = idx >> 16;
    float st = 0.f;
#pragma unroll 2
    for (int i = 0; i < NCH; ++i) {
      int c;
      if (d == 0) c = i < 2 ? 32 + i : i - 2;
      else c = i < 2 ? 33 - i : 33 - i;
      const size_t bc = (size_t)b * NCH + c;
      float* ptr = p.CS + ((bc * 2 + d) * 4 + hh) * 8192 + e;
      const float v = *ptr;
      const float dec = __expf(p.atot[(bc * 2 + d) * 4 + hh]);
      *ptr = st;
      st = dec * st + v;
    }
  }
}

template <int G>
DI float ssd_s3_group(const Params& p, int layer, int bc, bool cPrev, bool cNext, u16* Bg, u16* xsT, float* arr, int tid) {
  f32x16 y[4];
#pragma unroll
  for (int i = 0; i < 4; ++i)
#pragma unroll
    for (int e = 0; e < 16; ++e) y[i][e] = 0.f;
  const int lane = tid & 63, wid = tid >> 6, r = lane & 31, h = lane >> 5;
  const int l = wid * 32 + r;
  const int row0 = bc * 128;
  __syncthreads();
  ssd_dt_arrays(p, layer, row0, 2 * G + (tid >> 7), tid & 127, arr + (tid >> 7) * 768);
  const ConvW cwc = load_convw(p, layer, 512 + G * 128 + (tid & 15) * 8);
#pragma unroll 1
  for (int i = 0; i < 8; ++i) {
    const int id = tid + VT * i, t = id >> 4, cp = id & 15;
    float v[8];
    conv8(p, cwc, row0 + t, 512 + G * 128 + cp * 8, cPrev || t > 0, cNext || t < 127, v);
    *(bf16x8*)(Bg + t * 136 + cp * 8) = pack8(v[0], v[1], v[2], v[3], v[4], v[5], v[6], v[7]);
  }
  const ConvW cwx = load_convw(p, layer, G * 128 + (tid & 15) * 8);
#pragma unroll 1
  for (int i = 0; i < 8; ++i) {
    const int id = tid + VT * i, t = id >> 4, cp = id & 15;
    float v[8];
    conv8(p, cwx, row0 + t, G * 128 + cp * 8, cPrev || t > 0, cNext || t < 127, v);
#pragma unroll
    for (int e = 0; e < 8; ++e) xsT[(cp * 8 + e) * 136 + t] = f2bf(v[e]);
  }
  __syncthreads();
  ssd_cum_arrays(tid & 127, arr + (tid >> 7) * 768);
  bf16x8 cf[8];
#pragma unroll
  for (int kk = 0; kk < 8; ++kk) cf[kk] = *(const bf16x8*)(Bg + l * 136 + kk * 16 + h * 8);
  __syncthreads();
  const ConvW cwb = load_convw(p, layer, 256 + G * 128 + (tid & 15) * 8);
#pragma unroll 1
  for (int i = 0; i < 8; ++i) {
    const int id = tid + VT * i, t = id >> 4, cp = id & 15;
    float v[8];
    conv8(p, cwb, row0 + t, 256 + G * 128 + cp * 8, cPrev || t > 0, cNext || t < 127, v);
    *(bf16x8*)(Bg + t * 136 + cp * 8) = pack8(v[0], v[1], v[2], v[3], v[4], v[5], v[6], v[7]);
  }
  __syncthreads();
  float ss = 0.f;
#pragma unroll 1
  for (int hd2 = 0; hd2 < 2; ++hd2) {
    const int hh = 2 * G + hd2;
    const float* ah = arr + hd2 * 768;
    const float c0l = ah[256 + l], s1l = ah[384 + l];
    f32x16 y[2];
#pragma unroll
    for (int i = 0; i < 2; ++i)
#pragma unroll
      for (int e = 0; e < 16; ++e) y[i][e] = 0.f;
#pragma unroll 1
    for (int sb = 0; sb < 4; ++sb) {
      f32x16 gt;
#pragma unroll
      for (int e = 0; e < 16; ++e) gt[e] = 0.f;
#pragma unroll
      for (int kk = 0; kk < 8; ++kk) {
        bf16x8 a = *(const bf16x8*)(Bg + (sb * 32 + r) * 136 + kk * 16 + h * 8);
        gt = MFMA(a, cf[kk], gt);
      }
      f32x16 wv;
      if (sb != wid) {
        const float ref = sb < wid ? c0l : s1l;
        const float* cumv = ah + (sb < wid ? 256 : 384) + sb * 32 + 4 * h;
        const float* dtv = ah + (sb < wid ? 0 : 128) + sb * 32 + 4 * h;
#pragma unroll
        for (int q4 = 0; q4 < 4; ++q4) {
          const f32x4 cv = *(const f32x4*)(cumv + 8 * q4), dv = *(const f32x4*)(dtv + 8 * q4);
#pragma unroll
          for (int k = 0; k < 4; ++k) wv[4 * q4 + k] = gt[4 * q4 + k] * (__expf(ref - cv[k]) * dv[k]);
        }
      } else {
#pragma unroll
        for (int q4 = 0; q4 < 4; ++q4) {
          const int s4 = sb * 32 + 8 * q4 + 4 * h;
          const f32x4 c0v = *(const f32x4*)(ah + 256 + s4), d0v = *(const f32x4*)(ah + s4);
          const f32x4 s1v = *(const f32x4*)(ah + 384 + s4), d1v = *(const f32x4*)(ah + 128 + s4);
#pragma unroll
          for (int k = 0; k < 4; ++k) {
            const int s = s4 + k;
            const float a0 = (l >= s) ? (c0l - c0v[k]) : -1e30f;
            const float a1 = (l <= s) ? (s1l - s1v[k]) : -1e30f;
            wv[4 * q4 + k] = gt[4 * q4 + k] * (__expf(a0) * d0v[k] + __expf(a1) * d1v[k]);
          }
          __builtin_amdgcn_sched_barrier(0);
        }
      }
      bf16x8 wp0 = pack8(wv[0], wv[1], wv[2], wv[3], wv[4], wv[5], wv[6], wv[7]);
      bf16x8 wp1 = pack8(wv[8], wv[9], wv[10], wv[11], wv[12], wv[13], wv[14], wv[15]);
#pragma unroll
      for (int pb = 0; pb < 2; ++pb) {
        const u16* xrow = xsT + (hd2 * 64 + pb * 32 + r) * 136 + sb * 32 + 4 * h;
        s16x4 lo0 = *(const s16x4*)(xrow), hi0 = *(const s16x4*)(xrow + 8);
        s16x4 lo1 = *(const s16x4*)(xrow + 16), hi1 = *(const s16x4*)(xrow + 24);
        bf16x8 a0 = __builtin_shufflevector(lo0, hi0, 0, 1, 2, 3, 4, 5, 6, 7);
        bf16x8 a1 = __builtin_shufflevector(lo1, hi1, 0, 1, 2, 3, 4, 5, 6, 7);
        y[pb] = MFMA(a0, wp0, y[pb]);
        y[pb] = MFMA(a1, wp1, y[pb]);
      }
    }
#pragma unroll 1
    for (int d = 0; d < 2; ++d) {
      const float el = __expf(d == 0 ? c0l : s1l);
#pragma unroll
      for (int pb = 0; pb < 2; ++pb) {
        const float* srow = p.CS + ((((size_t)bc * 2 + d) * 4 + hh) * 64 + pb * 32 + r) * 128 + h * 8;
        f32x16 tmp;
#pragma unroll
        for (int e = 0; e < 16; ++e) tmp[e] = 0.f;
#pragma unroll
        for (int kk = 0; kk < 8; ++kk) {
          f32x4 s0 = *(const f32x4*)(srow + kk * 16), s1 = *(const f32x4*)(srow + kk * 16 + 4);
          bf16x8 a = pack8(s0.x, s0.y, s0.z, s0.w, s1.x, s1.y, s1.z, s1.w);
          tmp = MFMA(a, cf[kk], tmp);
        }
#pragma unroll
        for (int e = 0; e < 16; ++e) y[pb][e] += el * tmp[e];
      }
    }
    const float dsk = p.ssd_d[layer * 8 + hh] + p.ssd_d[layer * 8 + 4 + hh];
#pragma unroll
    for (int pb = 0; pb < 2; ++pb) {
#pragma unroll
      for (int q4 = 0; q4 < 4; ++q4) {
        const int cl = hd2 * 64 + pb * 32 + 8 * q4 + 4 * h;
        const int ch0 = G * 128 + cl;
        u32x2 zw = *(const u32x2*)(p.P + (size_t)(row0 + l) * NINP + 960 + ch0);
        f32x4 o;
        o.x = (y[pb][4 * q4] + dsk * bf2f(xsT[(cl + 0) * 136 + l])) * silu_f(bflo(zw.x));
        o.y = (y[pb][4 * q4 + 1] + dsk * bf2f(xsT[(cl + 1) * 136 + l])) * silu_f(bfhi(zw.x));
        o.z = (y[pb][4 * q4 + 2] + dsk * bf2f(xsT[(cl + 2) * 136 + l])) * silu_f(bflo(zw.y));
        o.w = (y[pb][4 * q4 + 3] + dsk * bf2f(xsT[(cl + 3) * 136 + l])) * silu_f(bfhi(zw.y));
        ss += o.x * o.x + o.y * o.y + o.z * o.z + o.w * o.w;
        *(f32x4*)(p.ytmp + (size_t)(row0 + l) * 256 + ch0) = o;
      }
    }
  }
  return ss;
}

DI void ssd_s3_tasks(const Params& p, int layer, char* smem) {
  const int ftid = ltid(), vb = ftid >> 8, tid = ftid & 255;
  u16* Bg = (u16*)(smem + vb * VSMEM);
  u16* xsT = Bg + 128 * 136;
  float* arr = (float*)(xsT + 128 * 136);
  const int lane = tid & 63, wid = tid >> 6, r = lane & 31, h = lane >> 5;
  const int l = wid * 32 + r;
  for (int t0 = lbid() * 2; t0 < NB * NCH; t0 += gridDim.x * 2) {
    const int bc = t0 + vb, c = bc % NCH;
    const int row0 = bc * 128;
    const bool cPrev = (c != 0 && c != 32), cNext = (c != 31 && c != 33);
    float ss = ssd_s3_group<0>(p, layer, bc, cPrev, cNext, Bg, xsT, arr, tid);
    ss += ssd_s3_group<1>(p, layer, bc, cPrev, cNext, Bg, xsT, arr, tid);
    ss += __shfl_xor(ss, 32);
    const float rstd = rsqrtf(ss * (1.f / 256.f) + EPS);
    const float* gn = p.ssd_norm_g + layer * 256;
#pragma unroll 4
    for (int i = 0; i < 32; ++i) {
      const int ch0 = (i >> 2) * 32 + 8 * (i & 3) + 4 * h;
      f32x4 v = *(const f32x4*)(p.ytmp + (size_t)(row0 + l) * 256 + ch0);
      f32x4 gv = *(const f32x4*)(gn + ch0);
      u32x2 w;
      w.x = pack2(v.x * rstd * gv.x, v.y * rstd * gv.y);
      w.y = pack2(v.z * rstd * gv.z, v.w * rstd * gv.w);
      *(u32x2*)(p.H + (size_t)(row0 + l) * D + 768 + ch0) = w;
    }
  }
}

constexpr int QREG = 6;
DI void attn_qk(const u16* Ks, const bf16x8 (&qf)[QREG], const u16* qs, f32x16 (&st)[2], int r, int h) {
#pragma unroll
  for (int kb = 0; kb < 2; ++kb)
#pragma unroll
    for (int e = 0; e < 16; ++e) st[kb][e] = 0.f;
  const u16* kp = Ks + r * 200 + h * 8;
#pragma unroll
  for (int kk = 0; kk < 12; ++kk) {
    bf16x8 k0 = *(const bf16x8*)(kp + kk * 16);
    bf16x8 k1 = *(const bf16x8*)(kp + 32 * 200 + kk * 16);
    bf16x8 q;
    if (kk < QREG) q = qf[kk];
    else q = *(const bf16x8*)(qs + (kk - QREG) * 512);
    st[0] = MFMA(k0, q, st[0]);
    st[1] = MFMA(k1, q, st[1]);
  }
}
DI void attn_softmax(f32x16 (&st)[2], f32x16 (&o)[4], bf16x8 (&pf)[4], float& m_run, float& l_run, float sc) {
  float mx = st[0][0];
#pragma unroll
  for (int kb = 0; kb < 2; ++kb)
#pragma unroll
    for (int e = 0; e < 16; ++e) mx = fmaxf(mx, st[kb][e]);
  mx = fmaxf(mx, __shfl_xor(mx, 32));
  const float m_new = fmaxf(m_run, mx * sc);
  const float alpha = __builtin_amdgcn_exp2f(m_run - m_new);
  m_run = m_new;
  float ls = 0.f;
#pragma unroll
  for (int kb = 0; kb < 2; ++kb)
#pragma unroll
    for (int e = 0; e < 16; ++e) {
      float pv = __builtin_amdgcn_exp2f(fmaf(st[kb][e], sc, -m_new));
      ls += pv;
      st[kb][e] = pv;
    }
  l_run = l_run * alpha + ls;
  if (__builtin_amdgcn_ballot_w64(alpha != 1.f) != 0ull) {
#pragma unroll
    for (int i = 0; i < 4; ++i)
#pragma unroll
      for (int e = 0; e < 16; ++e) o[i][e] *= alpha;
  }
#pragma unroll
  for (int ks = 0; ks < 4; ++ks) {
    const int kb = ks >> 1, s2 = ks & 1;
    pf[ks] = pack8(st[kb][8 * s2], st[kb][8 * s2 + 1], st[kb][8 * s2 + 2], st[kb][8 * s2 + 3], st[kb][8 * s2 + 4],
                   st[kb][8 * s2 + 5], st[kb][8 * s2 + 6], st[kb][8 * s2 + 7]);
  }
}
DI void attn_pv(const u16* Vs, const bf16x8 (&pf)[4], f32x16 (&o)[4], int r, int h) {
#pragma unroll
  for (int ks = 0; ks < 4; ++ks) {
#pragma unroll
    for (int db = 0; db < 4; ++db) {
      bf16x8 a = *(const bf16x8*)(Vs + (db * 32 + r) * 72 + ks * 16 + 8 * h);
      o[db] = MFMA(a, pf[ks], o[db]);
    }
  }
}

DI void attn_tasks(const Params& p, char* smem) {
  u16* Ks = (u16*)smem;
  u16* Vs0 = Ks + 64 * 200;
  const int tid = ltid(), lane = tid & 63, wid = __builtin_amdgcn_readfirstlane(tid >> 6), r = lane & 31, h = lane >> 5;
  const bool late = wid >= 4;
  u16* qs = Vs0 + 2 * 128 * 72 + wid * (11 * 512) + lane * 8;
  const float sc = 0.07216878364870322f * 1.4426950408889634f;
  for (int task = lbid(); task < NB * 4 * 17; task += gridDim.x) {
    int b, hd, qt;
    if (task < 512) {
      qt = task & 15; hd = (task >> 4) & 3; b = task >> 6;
    } else {
      const int t2 = task - 512;
      qt = 16; hd = t2 & 3; b = t2 >> 2;
    }
    const int koff = (qt < 16) ? 0 : SEQ;
    const int nkt = ((qt < 16) ? SP : CTX) / 64;
    const int qrow = b * SP + qt * 256 + wid * 32 + r;
    bf16x8 qf[QREG];
#pragma unroll
    for (int kk = 0; kk < QREG; ++kk) qf[kk] = *(const bf16x8*)(p.Q + (size_t)qrow * 768 + hd * 192 + kk * 16 + h * 8);
#pragma unroll
    for (int kk = QREG; kk < 12; ++kk)
      *(bf16x8*)(qs + (kk - QREG) * 512) = *(const bf16x8*)(p.Q + (size_t)qrow * 768 + hd * 192 + kk * 16 + h * 8);
    f32x16 o[4];
#pragma unroll
    for (int i = 0; i < 4; ++i)
#pragma unroll
      for (int e = 0; e < 16; ++e) o[i][e] = 0.f;
    bf16x8 pf[4];
#pragma unroll
    for (int i = 0; i < 4; ++i)
#pragma unroll
      for (int e = 0; e < 8; ++e) pf[i][e] = 0;
    float m_run = -1e30f, l_run = 0.f;
    u32x4 kn[2], kr[1], vv[2];
    const u16* knb = p.Kn + ((size_t)(b * SP + koff) + (tid >> 4)) * 512 + hd * 128 + (tid & 15) * 8;
    const u16* krb = p.Kr + ((size_t)(b * SP + koff) + (tid >> 3)) * 64 + (tid & 7) * 8;
    const u16* vb = p.Vt + ((size_t)(b * 4 + hd) * 128 + (tid >> 3)) * SP + koff + (tid & 7) * 8;
#pragma unroll
    for (int i = 0; i < 2; ++i) kn[i] = *(const u32x4*)(knb + (size_t)(32 * i) * 512);
    kr[0] = *(const u32x4*)(krb);
#pragma unroll
    for (int i = 0; i < 2; ++i) vv[i] = *(const u32x4*)(vb + (size_t)(64 * i) * SP);
    for (int kt = 0; kt < nkt; ++kt) {
      u16* Vs = Vs0 + (kt & 1) * (128 * 72);
      __syncthreads();
#pragma unroll
      for (int i = 0; i < 2; ++i) *(u32x4*)(Ks + ((tid >> 4) + 32 * i) * 200 + (tid & 15) * 8) = kn[i];
      *(u32x4*)(Ks + (tid >> 3) * 200 + 128 + (tid & 7) * 8) = kr[0];
#pragma unroll
      for (int i = 0; i < 2; ++i) {
        u16* dst = Vs + ((tid >> 3) + 64 * i) * 72 + ((tid & 7) >> 1) * 16 + ((tid & 7) & 1) * 4;
        *(u32x2*)dst = u32x2{vv[i].x, vv[i].y};
        *(u32x2*)(dst + 8) = u32x2{vv[i].z, vv[i].w};
      }
      __syncthreads();
      {
        const size_t ko = (size_t)(kt + 1 < nkt ? kt + 1 : kt) * 64;
#pragma unroll
        for (int i = 0; i < 2; ++i) kn[i] = *(const u32x4*)(knb + (ko + 32 * i) * 512);
        kr[0] = *(const u32x4*)(krb + ko * 64);
#pragma unroll
        for (int i = 0; i < 2; ++i) vv[i] = *(const u32x4*)(vb + (size_t)(64 * i) * SP + ko);
      }
      __builtin_amdgcn_sched_barrier(0);
      if (late && kt > 0) attn_pv(Vs0 + ((kt - 1) & 1) * (128 * 72), pf, o, r, h);
      {
        f32x16 st[2];
        attn_qk(Ks, qf, qs, st, r, h);
        attn_softmax(st, o, pf, m_run, l_run, sc);
      }
      if (!late) attn_pv(Vs, pf, o, r, h);
    }
    if (late) attn_pv(Vs0 + ((nkt - 1) & 1) * (128 * 72), pf, o, r, h);
    const float ltot = l_run + __shfl_xor(l_run, 32);
    const float inv = 1.f / ltot;
    u16* orow = p.H + (size_t)qrow * D + hd * 128;
#pragma unroll
    for (int db = 0; db < 4; ++db)
#pragma unroll
      for (int q4 = 0; q4 < 4; ++q4) {
        u32x2 w;
        w.x = pack2(o[db][4 * q4] * inv, o[db][4 * q4 + 1] * inv);
        w.y = pack2(o[db][4 * q4 + 2] * inv, o[db][4 * q4 + 3] * inv);
        *(u32x2*)(orow + db * 32 + 8 * q4 + 4 * h) = w;
      }
  }
}

constexpr int NPHASE = 2 + DEPTH * 6;

DI void conv_item_ffn(const Params& p, int layer, int q, char* smem) {
#pragma unroll 1
  for (int u = 0; u < 8; ++u) {
    const int tile = q * 8 + u;
    if (tile < 1024) conv_tile(p.w_ff1 + (size_t)layer * D * DFF, D, DFF, p.wt_ff1, nullptr, tile >> 6, tile & 63, smem);
    else conv_tile(p.w_ff2 + (size_t)layer * DFF * D, DFF, D, p.wt_ff2, nullptr, (tile - 1024) >> 4, (tile - 1024) & 15, smem);
  }
}
DI void conv_item_mix(const Params& p, int layer, int q, char* smem) {
#pragma unroll 1
  for (int u = 0; u < 8; ++u) {
    int tile = q * 8 + u;
    if (tile < 512) { conv_tile(p.w_in + (size_t)layer * D * NIN, D, NIN, p.wt_in, nullptr, tile >> 5, tile & 31, smem); continue; }
    tile -= 512;
    if (tile < 48) { conv_tile(p.w_uq + (size_t)layer * 256 * 768, 256, 768, p.wt_uq, p.g_q + layer * 256, tile / 12, tile % 12, smem); continue; }
    tile -= 48;
    if (tile < 32) { conv_tile(p.w_ukv + (size_t)layer * 128 * 1024, 128, 1024, p.wt_ukv, p.g_kv + layer * 128, tile >> 4, tile & 15, smem); continue; }
    tile -= 32;
    if (tile < 256) { conv_tile(p.w_out + (size_t)layer * D * D, D, D, p.wt_out, nullptr, tile >> 4, tile & 15, smem); continue; }
    tile -= 256;
    for (int i = ltid(); i < 4096; i += NTHR) p.wsb[tile * 4096 + i] = f2bf(p.cm_w_s[(size_t)layer * 65536 + tile * 4096 + i]);
  }
}

DI void run_phase(const Params& p, int ph, char* smem) {
  if (ph == 0) { prologue_phase(p, smem); return; }
  const int MT = T / 256;
  auto noT = [](int, int, u32x4) {};
  auto neverT = [](int) { return false; };
  if (ph == 1) {
    ew_phase(p, 0, 0);
    for (int q = lbid(); q < 108; q += gridDim.x) conv_item_mix(p, 0, q, smem);
    return;
  }
  const int layer = (ph - 2) / 6, sub = (ph - 2) % 6;
  const bool last = layer == DEPTH - 1;
  switch (sub) {
    case 0: {
      for (int it = 0;; ++it) {
        const int t = xcd_tile(it, MT * 8);
        if (t < 0) break;
        const int tm = t >> 3, tn = t & 7;
        gemm_tile<false>(
            p.H, D, p.wt_in, D, D, tm * 256, tn * 256, smem,
            [&](int mb, int nb, f32x16& acc, int r, int h) {
              if (nb == 1984) {
                f32x4 v = {acc[0], acc[1], acc[2], acc[3]};
                *(f32x4*)(p.dtraw + (size_t)(mb + r) * 8 + 4 * h) = v;
              }
            },
            [&](int row, int col, u32x4 v) { *(u32x4*)(p.P + (size_t)row * NINP + col) = v; }, noT, neverT);
      }
    } break;
    case 1: {
      int* wq = p.cnt + (2 * DEPTH + layer) * CNT_STRIDE;
      int* sh = (int*)(smem + SMEM_BYTES - 16);
      for (;;) {
        __syncthreads();
        if (ltid() == 0) *sh = __hip_atomic_fetch_add(wq, 1, __ATOMIC_RELAXED, __HIP_MEMORY_SCOPE_AGENT);
        __syncthreads();
        const int q = *sh;
        if (q >= 544 + 136 + 408 + 544) break;
        if (q < 544) ssd_s1_tasks(p, layer, smem, 2 * q, 2 * q + 1, 2);
        else if (q < 680) cm_tasks(p, layer, smem, 2 * (q - 544), 2 * (q - 544) + 1, 2);
        else if (q < 1088) qkv_tasks(p, smem, q - 680, q - 679, 0, 0, 1);
        else qkv_tasks(p, smem, 0, 0, q - 1088, q - 1087, 1);
      }
    } break;
    case 2: ssd_scan_phase(p); break;
    case 3: {
      attn_tasks(p, smem);
      ssd_s3_tasks(p, layer, smem);
    } break;
    case 4: {
      int* cnt = p.cnt + (2 * layer) * CNT_STRIDE;
      for (int it = 0;; ++it) {
        const int t = xcd_tile(it, MT * 4, last ? 4 : 0);
        if (t < 0) break;
        const int tm = t >> 2, tn = t & 3;
        gemm_tile<false>(
            p.H, D, p.wt_out, D, D, tm * 256, tn * 256, smem, [](int, int, f32x16&, int, int) {},
            [&](int row, int col, u32x4 v) { st_wt(p.Y + (size_t)row * D + col, v); }, noT, neverT);
        tile_done(cnt, tm);
      }
      ew_consume(p, cnt, 4, layer, 1, last, 256, [&](int q) { conv_item_ffn(p, layer, q, smem); }, smem);
    } break;
    case 5: {
      int* cnt1 = p.cnt + (3 * DEPTH + layer) * CNT_STRIDE;
      for (int it = 0;; ++it) {
        const int t = xcd_tile(it, MT * 16, last ? 16 : 0);
        if (t < 0) break;
        const int tm = t >> 4, tn = t & 15;
        gemm_tile<false>(
            p.H, D, p.wt_ff1, D, D, tm * 256, tn * 256, smem,
            [](int, int, f32x16& acc, int, int) {
#pragma unroll
              for (int e = 0; e < 16; ++e) {
                float v = fmaxf(acc[e], 0.f);
                acc[e] = v * v;
              }
            },
            [&](int row, int col, u32x4 v) { st_wt(p.Hd + (size_t)row * DFF + col, v); }, noT, neverT);
        tile_done(cnt1, tm);
      }
      int* cnt = p.cnt + (2 * layer + 1) * CNT_STRIDE;
      for (int it = 0;; ++it) {
        const int t = xcd_tile(it, MT * 4, last ? 4 : 0);
        if (t < 0) break;
        const int tm = t >> 2, tn = t & 3;
        if (ltid() == 0) {
          while (__hip_atomic_load(cnt1 + tm, __ATOMIC_ACQUIRE, __HIP_MEMORY_SCOPE_AGENT) < 16) __builtin_amdgcn_s_sleep(4);
        }
        __syncthreads();
        gemm_tile<false>(
            p.Hd, DFF, p.wt_ff2, DFF, DFF, tm * 256, tn * 256, smem, [](int, int, f32x16&, int, int) {},
            [&](int row, int col, u32x4 v) { st_wt(p.F + (size_t)row * D + col, v); }, noT, neverT);
        tile_done(cnt, tm);
      }
      if (last) ew_consume(p, cnt, 4, DEPTH, 2, true, 0, [](int) {}, smem);
      else ew_consume(p, cnt, 4, layer + 1, 0, false, 108, [&](int q) { conv_item_mix(p, layer + 1, q, smem); }, smem);
    } break;
  }
}

__global__ void __launch_bounds__(NTHR, 2) mega_kernel(Params p, int ph_begin, int ph_end) {
  extern __shared__ __attribute__((aligned(16))) char smem[];
  cg::grid_group grid = cg::this_grid();
  for (int ph = ph_begin; ph < ph_end; ++ph) {
    run_phase(p, ph, smem);
    if (ph + 1 < ph_end) grid.sync();
  }
}

extern "C" void kernel_launch(void* const* d_in, const int* in_sizes, int n_in, void* d_out, int out_size, void* d_ws,
                              size_t ws_size, hipStream_t stream) {
  Params p{};
  const float* const* in = (const float* const*)d_in;
  p.x = in[0]; p.c = in[1]; p.ctx = in[2]; p.c_ctx = in[3]; p.w_ada = in[4]; p.b_ada = in[5];
  p.g_pre_mix = in[6]; p.g_post_mix = in[7]; p.g_pre_ff = in[8]; p.g_post_ff = in[9]; p.w_in = in[10];
  p.g_q = in[11]; p.w_uq = in[12]; p.g_kv = in[13]; p.w_ukv = in[14]; p.cm_norm_g = in[15]; p.cm_w_s = in[16];
  p.cm_b_s = in[17]; p.conv_w = in[18]; p.conv_b = in[19]; p.dt_bias = in[20]; p.a_log = in[21]; p.ssd_d = in[22];
  p.ssd_norm_g = in[23]; p.w_out = in[24]; p.w_ff1 = in[25]; p.w_ff2 = in[26];
  p.out = (float*)d_out;
  char* ws = (char*)d_ws;
  size_t off = 0;
  auto take = [&](size_t bytes) { char* q = ws + off; off += (bytes + 255) & ~(size_t)255; return q; };
  p.wt_in = (u16*)take((size_t)NINP * D * 2);
  p.wt_uq = (u16*)take((size_t)768 * 256 * 2);
  p.wt_ukv = (u16*)take((size_t)1024 * 128 * 2);
  p.wt_out = (u16*)take((size_t)D * D * 2);
  p.wt_ff1 = (u16*)take((size_t)DFF * D * 2);
  p.wt_ff2 = (u16*)take((size_t)D * DFF * 2);
  p.wsb = (u16*)take((size_t)4 * 128 * 128 * 2);
  p.mod = (float*)take((size_t)DEPTH * 9 * 6144 * 4);
  p.ropetab = (float*)take((size_t)64 * 16 * 2 * 4);
  p.atot = (float*)take((size_t)NB * NCH * 2 * 4 * 4);
  p.xctx = (float*)take((size_t)NB * CTX * D * 4);
  char* r1 = take((size_t)T * DFF * 2);
  p.Hd = (u16*)r1;
  p.Y = (u16*)r1;
  {
    size_t o2 = 0;
    p.P = (u16*)(r1 + o2); o2 += (size_t)T * NINP * 2;
    p.Q = (u16*)(r1 + o2); o2 += (size_t)T * 768 * 2;
    p.Kn = (u16*)(r1 + o2); o2 += (size_t)T * 512 * 2;
    p.Kr = (u16*)(r1 + o2); o2 += (size_t)T * 64 * 2;
    p.Vt = (u16*)(r1 + o2); o2 += (size_t)NB * 4 * 128 * SP * 2;
    p.dtraw = (float*)(r1 + o2); o2 += (size_t)T * 8 * 4;
  }
  p.H = (u16*)take((size_t)T * D * 2);
  p.CS = (float*)take((size_t)NB * NCH * 2 * 4 * 8192 * 4);
  p.F = (u16*)p.CS;
  p.ytmp = (float*)take((size_t)T * 256 * 4);
  p.cnt = (int*)take((size_t)4 * DEPTH * CNT_STRIDE * 4);
  if (off > ws_size) {
    fprintf(stderr, "workspace too small: need %zu have %zu\n", off, ws_size);
    return;
  }
  static int grid_blocks = 0;
  if (!grid_blocks) {
    int dev = 0, cus = 0, per_cu = 0;
    hipGetDevice(&dev);
    hipDeviceGetAttribute(&cus, hipDeviceAttributeMultiprocessorCount, dev);
    hipFuncSetAttribute((const void*)mega_kernel, hipFuncAttributeMaxDynamicSharedMemorySize, SMEM_BYTES);
    hipOccupancyMaxActiveBlocksPerMultiprocessor(&per_cu, mega_kernel, NTHR, SMEM_BYTES);
    if (per_cu < 1) per_cu = 1;
    if (per_cu > 1) per_cu = 1;
    grid_blocks = cus * per_cu;
  }
  hipMemsetAsync(p.cnt, 0, (size_t)4 * DEPTH * CNT_STRIDE * 4, stream);
  int pb = 0, pe = NPHASE;
  void* args[] = {&p, &pb, &pe};
  hipError_t e = hipLaunchCooperativeKernel((void*)mega_kernel, dim3(grid_blocks), dim3(NTHR), args, SMEM_BYTES, stream);
  if (e != hipSuccess) fprintf(stderr, "cooperative launch failed: %s (grid %d)\n", hipGetErrorString(e), grid_blocks);
}
```

```cpp
#include <hip/hip_runtime.h>
#include <hip/hip_cooperative_groups.h>
#include <cstdio>
namespace cg = cooperative_groups;

#define DI __device__ __forceinline__
typedef unsigned short u16;
using bf16x8 = __attribute__((ext_vector_type(8))) short;
using s16x4 = __attribute__((ext_vector_type(4))) short;
using f32x16 = __attribute__((ext_vector_type(16))) float;
using u32x4 = __attribute__((ext_vector_type(4))) unsigned;
using u32x2 = __attribute__((ext_vector_type(2))) unsigned;
using f32x4 = __attribute__((ext_vector_type(4))) float;
typedef __bf16 bf2_t __attribute__((ext_vector_type(2)));
typedef float f2_t __attribute__((ext_vector_type(2)));
#define MFMA(a, b, c) __builtin_amdgcn_mfma_f32_32x32x16_bf16((a), (b), (c), 0, 0, 0)

constexpr int NB = 8, SEQ = 4096, CTX = 256, SP = 4352, T = NB * SP, D = 1024, DFF = 4096;
constexpr int NIN = 1992, NINP = 2048, NCH = 34, DEPTH = 4;
constexpr int NTHR = 512;
constexpr int VT = 256;
constexpr int VSMEM = 75 * 1024;
constexpr int SMEM_BYTES = 2 * VSMEM;
constexpr float EPS = 1e-6f;
constexpr int CNT_STRIDE = 160;

struct Params {
  const float *x, *c, *ctx, *c_ctx, *w_ada, *b_ada, *g_pre_mix, *g_post_mix, *g_pre_ff, *g_post_ff, *w_in, *g_q, *w_uq,
      *g_kv, *w_ukv, *cm_norm_g, *cm_w_s, *cm_b_s, *conv_w, *conv_b, *dt_bias, *a_log, *ssd_d, *ssd_norm_g, *w_out,
      *w_ff1, *w_ff2;
  float* out;
  u16 *wt_in, *wt_uq, *wt_ukv, *wt_out, *wt_ff1, *wt_ff2, *wsb;
  float *mod, *ropetab, *atot, *xctx;
  u16 *P, *Q, *Kn, *Kr, *Vt, *Hd;
  u16* Y;
  float* dtraw;
  u16* H;
  float* CS;
  u16* F;
  float* ytmp;
  int* cnt;
};

DI int ltid() { int t = threadIdx.x; asm volatile("" : "+v"(t)); return t; }
DI int lbid() { int t = blockIdx.x; asm volatile("" : "+s"(t)); return t; }
DI void st_wt(void* ptr, u32x4 v) { asm volatile("global_store_dwordx4 %0, %1, off sc0 sc1" ::"v"(ptr), "v"(v) : "memory"); }
DI int crow(int e, int h) { return (e & 3) + 8 * (e >> 2) + 4 * h; }
DI unsigned pack2(float a, float b) {
  f2_t v = {a, b};
  bf2_t r = __builtin_convertvector(v, bf2_t);
  return __builtin_bit_cast(unsigned, r);
}
DI u16 f2bf(float a) { return (u16)(pack2(a, 0.f) & 0xffffu); }
DI float bf2f(u16 v) { return __uint_as_float(((unsigned)v) << 16); }
DI float bflo(unsigned w) { return __uint_as_float(w << 16); }
DI float bfhi(unsigned w) { return __uint_as_float(w & 0xffff0000u); }
DI bf16x8 pack8(float a0, float a1, float a2, float a3, float a4, float a5, float a6, float a7) {
  u32x4 u;
  u.x = pack2(a0, a1); u.y = pack2(a2, a3); u.z = pack2(a4, a5); u.w = pack2(a6, a7);
  return __builtin_bit_cast(bf16x8, u);
}
DI float wave_sum(float v) {
#pragma unroll
  for (int o = 32; o > 0; o >>= 1) v += __shfl_xor(v, o);
  return v;
}
DI float silu_f(float y) { return y * __builtin_amdgcn_rcpf(1.f + __expf(-y)); }
DI float gelu_f(float x) {
  float u = 0.7978845608028654f * (x + 0.044715f * x * x * x);
  float t = 1.f - 2.f * __builtin_amdgcn_rcpf(1.f + __expf(2.f * u));
  return 0.5f * x * (1.f + t);
}
DI float softplus_f(float x) { return x > 20.f ? x : log1pf(__expf(x)); }
DI float uw(const u32x4& v, int i) {
  unsigned w = (i >> 1) == 0 ? v.x : (i >> 1) == 1 ? v.y : (i >> 1) == 2 ? v.z : v.w;
  return (i & 1) ? bfhi(w) : bflo(w);
}

template <bool HAS_T, class ElemF, class StoreF, class StoreTF, class UseTF>
DI void gemm_tile(const u16* __restrict__ A, int lda, const u16* __restrict__ Bt, int ldb, int K, int m0, int n0,
                  char* smem, ElemF elem, StoreF store, StoreTF storeT, UseTF useT) {
  constexpr int LS = 72;
  constexpr int STAGE = 2 * 256 * LS;
  u16* base = (u16*)smem;
  const int tid = ltid(), lane = tid & 63, wid = tid >> 6, wm = wid >> 2, wn = wid & 3, r = lane & 31, h = lane >> 5;
  f32x16 acc[4][2];
#pragma unroll
  for (int i = 0; i < 4; ++i)
#pragma unroll
    for (int j = 0; j < 2; ++j)
#pragma unroll
      for (int e = 0; e < 16; ++e) acc[i][j][e] = 0.f;
  u32x4 ra[4], rb[4];
  const int lrow = tid >> 3, lcp = (tid & 7) * 8;
  const u16* ga = A + (size_t)(m0 + lrow) * lda + lcp;
  const u16* gb = Bt + (size_t)(n0 + lrow) * ldb + lcp;
  const int wofs = lrow * LS + lcp;
  const int aofs = (wm * 128 + r) * LS + h * 8;
  const int bofs = 256 * LS + (wn * 64 + r) * LS + h * 8;
#define GLOAD(kt_)                                                           \
  _Pragma("unroll") for (int i = 0; i < 4; ++i) {                            \
    ra[i] = *(const u32x4*)(ga + (size_t)(64 * i) * lda + (kt_) * 64);       \
    rb[i] = *(const u32x4*)(gb + (size_t)(64 * i) * ldb + (kt_) * 64);       \
  }
#define SWRITE(st_)                                                          \
  _Pragma("unroll") for (int i = 0; i < 4; ++i) {                            \
    *(u32x4*)((st_) + wofs + 64 * i * LS) = ra[i];                           \
    *(u32x4*)((st_) + 256 * LS + wofs + 64 * i * LS) = rb[i];                \
  }
#define FREAD(dst_, st_, kk_)                                                                      \
  _Pragma("unroll") for (int i = 0; i < 4; ++i) af[dst_][i] = *(const bf16x8*)((st_) + aofs + i * 32 * LS + (kk_) * 16); \
  _Pragma("unroll") for (int j = 0; j < 2; ++j) bfr[dst_][j] = *(const bf16x8*)((st_) + bofs + j * 32 * LS + (kk_) * 16);
#define MMAS(src_)                                                           \
  _Pragma("unroll") for (int i = 0; i < 4; ++i)                              \
  _Pragma("unroll") for (int j = 0; j < 2; ++j) acc[i][j] = MFMA(bfr[src_][j], af[src_][i], acc[i][j]);
#define ILV()                                                                   \
  __builtin_amdgcn_sched_group_barrier(0x008, 2, 0);                            \
  __builtin_amdgcn_sched_group_barrier(0x100, 2, 0);                            \
  __builtin_amdgcn_sched_group_barrier(0x008, 2, 0);                            \
  __builtin_amdgcn_sched_group_barrier(0x100, 2, 0);                            \
  __builtin_amdgcn_sched_group_barrier(0x008, 2, 0);                            \
  __builtin_amdgcn_sched_group_barrier(0x100, 2, 0);                            \
  __builtin_amdgcn_sched_group_barrier(0x008, 2, 0);
  const int nk = K >> 6;
  bf16x8 af[2][4], bfr[2][2];
  GLOAD(0);
  __syncthreads();
  SWRITE(base);
  if (nk > 1) { GLOAD(1); }
  __syncthreads();
  FREAD(0, base, 0);
  for (int kt = 0; kt < nk; ++kt) {
    u16* cur = base + (kt & 1) * STAGE;
    u16* nxt = base + ((kt + 1) & 1) * STAGE;
    FREAD(1, cur, 1);
    if (kt + 1 < nk) { SWRITE(nxt); }
    MMAS(0);
#pragma unroll
    for (int z = 0; z < 7; ++z) {
      __builtin_amdgcn_sched_group_barrier(0x008, 1, 0);
      __builtin_amdgcn_sched_group_barrier(0x080, 2, 0);
    }
    __builtin_amdgcn_sched_group_barrier(0x008, 1, 0);
    __builtin_amdgcn_sched_barrier(0);
    if (kt + 2 < nk) { GLOAD(kt + 2); }
    FREAD(0, cur, 2);
    MMAS(1);
    ILV();
    __builtin_amdgcn_sched_barrier(0);
    FREAD(1, cur, 3);
    MMAS(0);
    ILV();
    __builtin_amdgcn_sched_barrier(0);
    __syncthreads();
    if (kt + 1 < nk) { FREAD(0, nxt, 0); }
    MMAS(1);
    ILV();
    __builtin_amdgcn_sched_barrier(0);
  }
#undef ILV
#undef GLOAD
#undef SWRITE
#undef FREAD
#undef MMAS
#pragma unroll
  for (int i = 0; i < 4; ++i)
#pragma unroll
    for (int j = 0; j < 2; ++j) elem(m0 + wm * 128 + i * 32, n0 + wn * 64 + j * 32, acc[i][j], r, h);
  u16* stg = base + wid * (128 * 72);
  if (HAS_T && useT(wn)) {
#pragma unroll
    for (int i = 0; i < 4; ++i)
#pragma unroll
      for (int j = 0; j < 2; ++j)
#pragma unroll
        for (int e = 0; e < 16; ++e) stg[(j * 32 + crow(e, h)) * 136 + i * 32 + r] = f2bf(acc[i][j][e]);
    __builtin_amdgcn_wave_barrier();
#pragma unroll 4
    for (int t = 0; t < 16; ++t) {
      const int id = lane + 64 * t, cl = id >> 4, cp = id & 15;
      u32x4 v = *(const u32x4*)(stg + cl * 136 + cp * 8);
      storeT(n0 + wn * 64 + cl, m0 + wm * 128 + cp * 8, v);
    }
  } else {
#pragma unroll
    for (int i = 0; i < 4; ++i)
#pragma unroll
      for (int j = 0; j < 2; ++j)
#pragma unroll
        for (int q4 = 0; q4 < 4; ++q4) {
          u32x2 w;
          w.x = pack2(acc[i][j][4 * q4], acc[i][j][4 * q4 + 1]);
          w.y = pack2(acc[i][j][4 * q4 + 2], acc[i][j][4 * q4 + 3]);
          *(u32x2*)(stg + (i * 32 + r) * 72 + j * 32 + 8 * q4 + 4 * h) = w;
        }
    __builtin_amdgcn_wave_barrier();
#pragma unroll 4
    for (int t = 0; t < 16; ++t) {
      const int id = lane + 64 * t, rl = id >> 3, cp = id & 7;
      u32x4 v = *(const u32x4*)(stg + rl * 72 + cp * 8);
      store(m0 + wm * 128 + rl, n0 + wn * 64 + cp * 8, v);
    }
  }
}

DI int xcd_tile(int it, int ntiles, int skip_tail = 0) {
  const int b = lbid(), g = gridDim.x;
  const int local = (b >> 3) + it * (g >> 3);
  const int per = ntiles >> 3;
  return local < per - skip_tail ? (b & 7) * per + local : -1;
}

DI void conv_tile(const float* __restrict__ src, int K, int N, u16* __restrict__ dst, const float* __restrict__ scale,
                  int tk, int tn, char* smem) {
  float* tile = (float*)smem;
  const int tid = ltid(), tx = tid & 63, ty = tid >> 6;
  const int k0 = tk * 64, n0 = tn * 64;
  __syncthreads();
#pragma unroll 4
  for (int i = 0; i < 8; ++i) {
    int kr = ty + 8 * i;
    float v = 0.f;
    if (n0 + tx < N) v = src[(size_t)(k0 + kr) * N + n0 + tx];
    if (scale) v *= scale[k0 + kr];
    tile[kr * 65 + tx] = v;
  }
  __syncthreads();
#pragma unroll 4
  for (int i = 0; i < 8; ++i) {
    int nr = ty + 8 * i;
    dst[(size_t)(n0 + nr) * K + k0 + tx] = f2bf(tile[tx * 65 + nr]);
  }
}

DI void convert_weights(const float* src, int K, int N, int Npad, u16* dst, const float* scale, char* smem) {
  const int tks = K / 64, tns = Npad / 64;
  for (int t = lbid(); t < tks * tns; t += gridDim.x) conv_tile(src, K, N, dst, scale, t / tns, t % tns, smem);
}

DI void prologue_phase(const Params& p, char* smem) {
  float* sc = (float*)smem;
  float* red = sc + 9 * 1024;
  const int tid = ltid();
  for (int i = tid; i < 9 * 1024; i += NTHR) {
    int j = i >> 10, k = i & 1023;
    float v = j < 8 ? p.c[j * 1024 + k] : p.c_ctx[k];
    sc[i] = v / (1.f + __expf(-v));
  }
  __syncthreads();
  for (int task = lbid(); task < DEPTH * 96; task += gridDim.x) {
    const int l = task / 96, n0 = (task % 96) * 64, nn = tid & 63, kq = tid >> 6;
    float acc[9];
#pragma unroll
    for (int j = 0; j < 9; ++j) acc[j] = 0.f;
    const float* w = p.w_ada + ((size_t)l * 1024 + kq * 128) * 6144 + n0 + nn;
    const float* scq = sc + kq * 128;
#pragma unroll 4
    for (int k = 0; k < 128; ++k) {
      float wv = w[(size_t)k * 6144];
#pragma unroll
      for (int j = 0; j < 9; ++j) acc[j] += scq[j * 1024 + k] * wv;
    }
#pragma unroll
    for (int j = 0; j < 9; ++j) red[(kq * 9 + j) * 64 + nn] = acc[j];
    __syncthreads();
    for (int idx = tid; idx < 576; idx += NTHR) {
      int j = idx >> 6, n2 = idx & 63;
      float s = p.b_ada[l * 6144 + n0 + n2];
#pragma unroll
      for (int q = 0; q < 8; ++q) s += red[(q * 9 + j) * 64 + n2];
      p.mod[(size_t)(l * 9 + j) * 6144 + n0 + n2] = s;
    }
    __syncthreads();
  }
  for (int i = lbid() * NTHR + tid; i < 4 * DEPTH * CNT_STRIDE; i += gridDim.x * NTHR) p.cnt[i] = 0;
  if (lbid() == gridDim.x - 1) {
    for (int i = tid; i < 64 * 16; i += NTHR) {
      int pos = i >> 4, j = i & 15;
      float inv_freq = exp2f(-(float)(2 * j) / 32.f * 13.287712379549449f);
      float ang = (float)pos * inv_freq;
      float k = rintf(ang * 0.15915494309189535f);
      float red2 = fmaf(-k, 6.2831854820251465f, ang);
      red2 = fmaf(-k, -1.7484555314695172e-07f, red2);
      p.ropetab[2 * i] = __cosf(red2);
      p.ropetab[2 * i + 1] = __sinf(red2);
    }
  }
}

DI void ew_row(const Params& p, int layer, int kind, int row, int lane) {
  const bool has_branch = !(kind == 0 && layer == 0);
  const bool src_in = (layer == 0 && kind <= 1);
  const bool store_x = has_branch;
  const int blayer = (kind == 1) ? layer : (kind == 0 ? layer - 1 : DEPTH - 1);
  const float* gpost = (kind == 1) ? p.g_post_mix + blayer * D : p.g_post_ff + (blayer < 0 ? 0 : blayer) * D;
  const int gate_off = (kind == 1) ? 2 * D : 5 * D;
  const float* gpre = (kind == 0) ? p.g_pre_mix + layer * D : p.g_pre_ff + (kind == 1 ? layer : 0) * D;
  const int shift_off = (kind == 0) ? 0 : 3 * D, scale_off = (kind == 0) ? D : 4 * D;
  const float* xl = src_in ? p.x : p.out;
  const float* xc = src_in ? p.ctx : p.xctx;
    const int b = row / SP, s = row - b * SP;
    const bool lat = s < SEQ;
    if ((kind == 2 || (kind == 1 && layer == DEPTH - 1)) && !lat) return;
    const size_t xoff = lat ? ((size_t)(b * SEQ + s) * D) : ((size_t)(b * CTX + s - SEQ) * D);
    const unsigned long long msk = lat ? ~0ull : 0ull;
    const float* xs = (const float*)(((unsigned long long)xl & msk) | ((unsigned long long)xc & ~msk)) + xoff;
    float* xd = (float*)(((unsigned long long)p.out & msk) | ((unsigned long long)p.xctx & ~msk)) + xoff;
    const int mi = lat ? b : 8;
    f32x4 xv[4];
#pragma unroll
    for (int i = 0; i < 4; ++i) xv[i] = *(const f32x4*)(xs + lane * 4 + 256 * i);
    if (has_branch) {
      const float* modb = p.mod + (size_t)(blayer * 9 + mi) * 6144 + gate_off;
      f32x4 yv[4];
      const u16* ysrc = (kind == 1) ? p.Y : p.F;
#pragma unroll
      for (int i = 0; i < 4; ++i) {
        u32x2 w = *(const u32x2*)(ysrc + (size_t)row * D + lane * 4 + 256 * i);
        yv[i] = f32x4{bflo(w.x), bfhi(w.x), bflo(w.y), bfhi(w.y)};
      }
      float ss = 0.f;
#pragma unroll
      for (int i = 0; i < 4; ++i) ss += yv[i].x * yv[i].x + yv[i].y * yv[i].y + yv[i].z * yv[i].z + yv[i].w * yv[i].w;
      ss = wave_sum(ss);
      const float rstd = rsqrtf(ss * (1.f / D) + EPS);
#pragma unroll
      for (int i = 0; i < 4; ++i) {
        const int col = lane * 4 + 256 * i;
        f32x4 g = *(const f32x4*)(gpost + col);
        f32x4 gt = *(const f32x4*)(modb + col);
        xv[i].x += gt.x * (yv[i].x * rstd * g.x);
        xv[i].y += gt.y * (yv[i].y * rstd * g.y);
        xv[i].z += gt.z * (yv[i].z * rstd * g.z);
        xv[i].w += gt.w * (yv[i].w * rstd * g.w);
      }
      if (store_x) {
#pragma unroll
        for (int i = 0; i < 4; ++i) *(f32x4*)(xd + lane * 4 + 256 * i) = xv[i];
      }
    }
    if (kind != 2) {
      const float* modl = p.mod + (size_t)(layer * 9 + mi) * 6144;
      float ss = 0.f;
#pragma unroll
      for (int i = 0; i < 4; ++i) ss += xv[i].x * xv[i].x + xv[i].y * xv[i].y + xv[i].z * xv[i].z + xv[i].w * xv[i].w;
      ss = wave_sum(ss);
      const float rstd = rsqrtf(ss * (1.f / D) + EPS);
#pragma unroll
      for (int i = 0; i < 4; ++i) {
        const int col = lane * 4 + 256 * i;
        f32x4 g = *(const f32x4*)(gpre + col);
        f32x4 sh = *(const f32x4*)(modl + shift_off + col);
        f32x4 sc = *(const f32x4*)(modl + scale_off + col);
        float h0 = xv[i].x * rstd * g.x * (1.f + sc.x) + sh.x;
        float h1 = xv[i].y * rstd * g.y * (1.f + sc.y) + sh.y;
        float h2 = xv[i].z * rstd * g.z * (1.f + sc.z) + sh.z;
        float h3 = xv[i].w * rstd * g.w * (1.f + sc.w) + sh.w;
        u32x2 w;
        w.x = pack2(h0, h1);
        w.y = pack2(h2, h3);
        *(u32x2*)(p.H + (size_t)row * D + col) = w;
      }
    }
}

DI void ew_phase(const Params& p, int layer, int kind) {
  const int tid = ltid(), lane = tid & 63, wid = __builtin_amdgcn_readfirstlane(tid >> 6);
  for (int rg = lbid(); rg < T / 8; rg += gridDim.x) ew_row(p, layer, kind, rg * 8 + wid, lane);
}

DI void tile_done(int* cnt, int tm) {
  asm volatile("s_waitcnt vmcnt(0)" ::: "memory");
  __syncthreads();
  if (ltid() == 0) __hip_atomic_fetch_add(cnt + tm, 1, __ATOMIC_RELAXED, __HIP_MEMORY_SCOPE_AGENT);
}
template <class ConvF>
DI void ew_consume(const Params& p, int* cnt, int need, int layer, int kind, bool skip_ctx, int nconv, ConvF conv,
                   char* smem) {
  int* sh = (int*)(smem + SMEM_BYTES - 16);
  const int tid = ltid(), lane = tid & 63, wid = __builtin_amdgcn_readfirstlane(tid >> 6);
  for (;;) {
    __syncthreads();
    if (tid == 0) *sh = __hip_atomic_fetch_add(cnt + 136, 1, __ATOMIC_RELAXED, __HIP_MEMORY_SCOPE_AGENT);
    __syncthreads();
    const int q = *sh;
    if (q >= nconv + 544) break;
    if (q < nconv) { conv(q); continue; }
    const int c = q - nconv, mseq = c >> 2, j = mseq >> 3, bb = mseq & 7, tm = bb * 17 + j;
    if (skip_ctx && j == 16) continue;
    if (tid == 0) {
      while (__hip_atomic_load(cnt + tm, __ATOMIC_ACQUIRE, __HIP_MEMORY_SCOPE_AGENT) < need) __builtin_amdgcn_s_sleep(4);
    }
    __syncthreads();
    const int row0 = tm * 256 + (c & 3) * 64 + wid * 8;
#pragma unroll 1
    for (int i = 0; i < 8; ++i) ew_row(p, layer, kind, row0 + i, lane);
  }
}

DI void row_rstd(const u16* __restrict__ base, int ld, int ncols, int m0, float* rs) {
  const int tid = ltid(), row = tid >> 1, half = tid & 1;
  const int per = ncols / 2;
  const u16* ptr = base + (size_t)(m0 + row) * ld + half * per;
  float ss = 0.f;
  for (int i = 0; i < per; i += 8) {
    u32x4 v = *(const u32x4*)(ptr + i);
#pragma unroll
    for (int e = 0; e < 8; ++e) {
      float f = uw(v, e);
      ss += f * f;
    }
  }
  ss += __shfl_xor(ss, 1);
  if (half == 0) rs[row] = rsqrtf(ss / (float)ncols + EPS);
}

DI void qkv_tasks(const Params& p, char* smem, int qb, int qe, int kb_, int ke, int stp) {
  float* rs = (float*)(smem + 2 * 2 * 256 * 72 * 2);
  const int MT = T / 256;
  auto noT = [](int, int, u32x4) {};
  auto neverT = [](int) { return false; };
  for (int t = qb; t < qe; t += stp) {
    const int tm = t / 3, tn = t % 3, m0 = tm * 256;
    __syncthreads();
    row_rstd(p.P, NINP, 256, m0, rs);
    const bool lat = (m0 % SP) < SEQ;
    const int s0 = m0 % SP;
    gemm_tile<false>(
        p.P, NINP, p.wt_uq, 256, 256, m0, tn * 256, smem,
        [&](int mb, int nb, f32x16& acc, int r, int h) {
          const int rowl = mb - m0 + r;
          const float sc = rs[rowl];
#pragma unroll
          for (int e = 0; e < 16; ++e) acc[e] *= sc;
          const int cb = nb % 192;
          if (lat && cb >= 128) {
            const int s = s0 + rowl;
            const int pos = (cb == 128) ? (s >> 6) : (s & 63);
#pragma unroll
            for (int e = 0; e < 8; ++e) {
              const int j = crow(e, h);
              const float cs = p.ropetab[2 * (pos * 16 + j)], sn = p.ropetab[2 * (pos * 16 + j) + 1];
              const float x1 = acc[e], x2 = acc[e + 8];
              acc[e] = x1 * cs - x2 * sn;
              acc[e + 8] = x1 * sn + x2 * cs;
            }
          }
        },
        [&](int row, int col, u32x4 v) { *(u32x4*)(p.Q + (size_t)row * 768 + col) = v; }, noT, neverT);
  }
  for (int t = kb_; t < ke; t += stp) {
    const int tm = t / 4, tn = t % 4, m0 = tm * 256;
    const int b = m0 / SP, s0 = m0 % SP;
    const bool lat = s0 < SEQ;
    __syncthreads();
    row_rstd(p.P + 256, NINP, 128, m0, rs);
    if (tn == 0) {
      for (int idx = ltid(); idx < 256 * 32; idx += NTHR) {
        const int rowl = idx >> 5, q = idx & 31, blk = q >> 4, j = q & 15;
        const u16* src = p.P + (size_t)(m0 + rowl) * NINP + 384 + blk * 32 + j;
        float x1 = bf2f(src[0]), x2 = bf2f(src[16]);
        float o1 = x1, o2 = x2;
        if (lat) {
          const int s = s0 + rowl;
          const int pos = blk == 0 ? (s >> 6) : (s & 63);
          const float cs = p.ropetab[2 * (pos * 16 + j)], sn = p.ropetab[2 * (pos * 16 + j) + 1];
          o1 = x1 * cs - x2 * sn;
          o2 = x1 * sn + x2 * cs;
        }
        u16* dst = p.Kr + (size_t)(m0 + rowl) * 64 + blk * 32 + j;
        dst[0] = f2bf(o1);
        dst[16] = f2bf(o2);
      }
    }
    const int n0 = tn * 256;
    u16* vbase = p.Vt + (size_t)(b * 4 + tn) * 128 * SP + s0;
    gemm_tile<true>(
        p.P + 256, NINP, p.wt_ukv, 128, 128, m0, n0, smem,
        [&](int mb, int nb, f32x16& acc, int r, int h) {
          const float sc = rs[mb - m0 + r];
#pragma unroll
          for (int e = 0; e < 16; ++e) acc[e] *= sc;
        },
        [&](int row, int col, u32x4 v) { *(u32x4*)(p.Kn + (size_t)row * 512 + tn * 128 + (col - n0)) = v; },
        [&](int col, int row, u32x4 v) { *(u32x4*)(vbase + (size_t)(col - n0 - 128) * SP + (row - m0)) = v; },
        [](int wn) { return wn >= 2; });
  }
}

DI void cm_tasks(const Params& p, int layer, char* smem, int tb, int te, int stp) {
  const int ftid = ltid(), vb = ftid >> 8, tid = ftid & 255;
  u16* vnT = (u16*)(smem + vb * VSMEM);
  const int lane = tid & 63, wid = tid >> 6, r = lane & 31, h = lane >> 5;
  const float* gn = p.cm_norm_g + layer * 256;
  const float* bs = p.cm_b_s + layer * 512;
  for (int t0 = tb; t0 < te; t0 += stp) {
    const int task = t0 + vb;
    const int row0 = task * 128;
    __syncthreads();
#pragma unroll 4
    for (int i = 0; i < 32; ++i) {
      const int s = wid * 32 + i;
      const u16* src = p.P + (size_t)(row0 + s) * NINP + 704;
      float v[4];
      float sum = 0.f;
#pragma unroll
      for (int q = 0; q < 4; ++q) {
        v[q] = gelu_f(bf2f(src[lane + 64 * q]));
        sum += v[q];
      }
      const float mean = wave_sum(sum) * (1.f / 256.f);
      float var = 0.f;
#pragma unroll
      for (int q = 0; q < 4; ++q) {
        v[q] -= mean;
        var += v[q] * v[q];
      }
      const float rstd = rsqrtf(wave_sum(var) * (1.f / 256.f) + EPS);
#pragma unroll
      for (int q = 0; q < 4; ++q) vnT[(lane + 64 * q) * 136 + s] = f2bf(v[q] * rstd * gn[lane + 64 * q]);
    }
    __syncthreads();
    const int t = wid * 32 + r;
    for (int g = 0; g < 4; ++g) {
      bf16x8 wf[8];
#pragma unroll
      for (int kk = 0; kk < 8; ++kk) wf[kk] = *(const bf16x8*)(p.wsb + ((size_t)(g * 128 + t)) * 128 + kk * 16 + h * 8);
      const float bias = bs[g * 128 + t];
#pragma unroll
      for (int cb = 0; cb < 2; ++cb) {
        f32x16 acc;
#pragma unroll
        for (int e = 0; e < 16; ++e) acc[e] = 0.f;
#pragma unroll
        for (int kk = 0; kk < 8; ++kk) {
          bf16x8 a = *(const bf16x8*)(vnT + (g * 64 + cb * 32 + r) * 136 + kk * 16 + h * 8);
          acc = MFMA(a, wf[kk], acc);
        }
#pragma unroll
        for (int q4 = 0; q4 < 4; ++q4) {
          const int ch0 = g * 64 + cb * 32 + 8 * q4 + 4 * h;
          u32x2 uwd = *(const u32x2*)(p.P + (size_t)(row0 + t) * NINP + 448 + ch0);
          float u0 = gelu_f(bflo(uwd.x)), u1 = gelu_f(bfhi(uwd.x)), u2 = gelu_f(bflo(uwd.y)), u3 = gelu_f(bfhi(uwd.y));
          u32x2 w;
          w.x = pack2(u0 * (acc[4 * q4] + bias), u1 * (acc[4 * q4 + 1] + bias));
          w.y = pack2(u2 * (acc[4 * q4 + 2] + bias), u3 * (acc[4 * q4 + 3] + bias));
          *(u32x2*)(p.H + (size_t)(row0 + t) * D + 512 + ch0) = w;
        }
      }
    }
  }
}

struct ConvW { f32x4 w0a, w0b, w1a, w1b, w2a, w2b, ba, bb; };
DI ConvW load_convw(const Params& p, int layer, int ch) {
  const float* cw = p.conv_w + (size_t)layer * 3 * 768 + ch;
  const float* cb = p.conv_b + layer * 768 + ch;
  ConvW c;
  c.w0a = *(const f32x4*)(cw); c.w0b = *(const f32x4*)(cw + 4);
  c.w1a = *(const f32x4*)(cw + 768); c.w1b = *(const f32x4*)(cw + 772);
  c.w2a = *(const f32x4*)(cw + 1536); c.w2b = *(const f32x4*)(cw + 1540);
  c.ba = *(const f32x4*)(cb); c.bb = *(const f32x4*)(cb + 4);
  return c;
}
DI float convw_get(const f32x4& a, const f32x4& b, int e) { return e < 4 ? a[e & 3] : b[e & 3]; }
DI void conv8(const Params& p, const ConvW& c, int row, int ch, bool hasPrev, bool hasNext, float out[8]) {
  const u16* base = p.P + (size_t)row * NINP + 1216 + ch;
  u32x4 cur = *(const u32x4*)base;
  u32x4 prv = *(const u32x4*)(base - (hasPrev ? NINP : 0));
  u32x4 nxt = *(const u32x4*)(base + (hasNext ? NINP : 0));
  const float mp = hasPrev ? 1.f : 0.f, mn = hasNext ? 1.f : 0.f;
#pragma unroll
  for (int e = 0; e < 8; ++e) {
    float y = convw_get(c.w0a, c.w0b, e) * (mp * uw(prv, e)) + convw_get(c.w1a, c.w1b, e) * uw(cur, e) +
              convw_get(c.w2a, c.w2b, e) * (mn * uw(nxt, e)) + convw_get(c.ba, c.bb, e);
    out[e] = silu_f(y);
  }
}

template <int RPT, class F>
DI void conv_stage(const Params& p, int layer, int row0, int chbase, int cp, int tb, bool cPrev, bool cNext, F emit) {
  const ConvW c = load_convw(p, layer, chbase + cp * 8);
  const int r0 = tb * RPT;
  const bool hp = cPrev || r0 > 0, hn = cNext || (r0 + RPT) < 128;
  const u16* base = p.P + (size_t)(row0 + r0) * NINP + 1216 + chbase + cp * 8;
  u32x4 raw[RPT + 2];
  raw[0] = *(const u32x4*)(base - (hp ? NINP : 0));
#pragma unroll
  for (int k = 0; k < RPT; ++k) raw[k + 1] = *(const u32x4*)(base + (size_t)k * NINP);
  raw[RPT + 1] = *(const u32x4*)(base + (size_t)(hn ? RPT : RPT - 1) * NINP);
  const float mp = hp ? 1.f : 0.f, mn = hn ? 1.f : 0.f;
#pragma unroll
  for (int i = 0; i < RPT; ++i) {
    const float fp = (i == 0) ? mp : 1.f, fn = (i == RPT - 1) ? mn : 1.f;
    float v[8];
#pragma unroll
    for (int e = 0; e < 8; ++e) {
      float y = convw_get(c.w0a, c.w0b, e) * (fp * uw(raw[i], e)) + convw_get(c.w1a, c.w1b, e) * uw(raw[i + 1], e) +
                convw_get(c.w2a, c.w2b, e) * (fn * uw(raw[i + 2], e)) + convw_get(c.ba, c.bb, e);
      v[e] = silu_f(y);
    }
    emit(r0 + i, v);
  }
}

DI void ssd_dt_arrays(const Params& p, int layer, int row0, int hh, int t, float* arr) {
  float* dt0 = arr;
  float* dt1 = arr + 128;
  float* c0 = arr + 256;
  float* s1 = arr + 384;
  float* a0 = arr + 512;
  float* a1 = arr + 640;
  const float d0 = softplus_f(p.dtraw[(size_t)(row0 + t) * 8 + hh] + p.dt_bias[layer * 8 + hh]);
  const float d1 = softplus_f(p.dtraw[(size_t)(row0 + t) * 8 + 4 + hh] + p.dt_bias[layer * 8 + 4 + hh]);
  dt0[t] = d0;
  dt1[t] = d1;
  a0[t] = -d0 * __expf(p.a_log[layer * 8 + hh]);
  a1[t] = -d1 * __expf(p.a_log[layer * 8 + 4 + hh]);
}
DI float wave_incl_prefix(float x, int lane) {
#pragma unroll
  for (int o = 1; o < 64; o <<= 1) {
    float y = __shfl_up(x, o);
    if (lane >= o) x += y;
  }
  return x;
}
DI void ssd_cum_arrays(int t, float* arr) {
  float* c0 = arr + 256;
  float* s1 = arr + 384;
  const float* a0 = arr + 512;
  const float* a1 = arr + 640;
  const int lane = t & 63, w = t >> 6;
  const float x0 = a0[t], o0 = a0[t ^ 64], x1 = a1[t], o1 = a1[t ^ 64];
  const float tot_o0 = wave_sum(o0), tot_o1 = wave_sum(o1), tot_x1 = wave_sum(x1);
  float p0 = wave_incl_prefix(x0, lane);
  float p1 = wave_incl_prefix(x1, lane);
  if (w == 1) p0 += tot_o0;
  float sf = tot_x1 - p1 + x1;
  if (w == 0) sf += tot_o1;
  c0[t] = p0;
  s1[t] = sf;
}

DI void ssd_s1_tasks(const Params& p, int layer, char* smem, int tb, int te, int stp) {
  const int ftid = ltid(), vb = ftid >> 8, tid = ftid & 255;
  u16* xsT0 = (u16*)(smem + vb * VSMEM);
  u16* xsT1 = xsT0 + 64 * 136;
  u16* BT = xsT1 + 64 * 136;
  float* arr = (float*)(BT + 128 * 136);
  float* w0 = arr + 768;
  float* w1 = w0 + 128;
  const int lane = tid & 63, wid = tid >> 6, r = lane & 31, h = lane >> 5;
  for (int t0 = tb; t0 < te; t0 += stp) {
    const int task = t0 + vb;
    const int hh = task & 3, bc = task >> 2, c = bc % NCH, b = bc / NCH;
    const int g = hh >> 1;
    const int row0 = bc * 128;
    const bool cPrev = (c != 0 && c != 32), cNext = (c != 31 && c != 33);
    __syncthreads();
    if (tid < 128) ssd_dt_arrays(p, layer, row0, hh, tid, arr);
    __syncthreads();
    if (tid < 128) ssd_cum_arrays(tid, arr);
    __syncthreads();
    if (tid < 128) {
      const float* dt0 = arr;
      const float* dt1 = arr + 128;
      const float* c0 = arr + 256;
      const float* s1 = arr + 384;
      w0[tid] = __expf(c0[127] - c0[tid]) * dt0[tid];
      w1[tid] = __expf(s1[0] - s1[tid]) * dt1[tid];
      if (tid == 0) {
        p.atot[((size_t)bc * 2 + 0) * 4 + hh] = c0[127];
        p.atot[((size_t)bc * 2 + 1) * 4 + hh] = s1[0];
      }
    }
    __syncthreads();
    conv_stage<4>(p, layer, row0, hh * 64, tid & 7, tid >> 3, cPrev, cNext, [&](int t, const float (&v)[8]) {
      const float f0 = w0[t], f1 = w1[t];
      const int cp = tid & 7;
#pragma unroll
      for (int e = 0; e < 8; ++e) {
        xsT0[(cp * 8 + e) * 136 + t] = f2bf(v[e] * f0);
        xsT1[(cp * 8 + e) * 136 + t] = f2bf(v[e] * f1);
      }
    });
    conv_stage<8>(p, layer, row0, 256 + g * 128, tid & 15, tid >> 4, cPrev, cNext, [&](int t, const float (&v)[8]) {
      const int cp = tid & 15;
#pragma unroll
      for (int e = 0; e < 8; ++e) BT[(cp * 8 + e) * 136 + t] = f2bf(v[e]);
    });
    __syncthreads();
#pragma unroll
    for (int d = 0; d < 2; ++d) {
      const u16* xsT = d ? xsT1 : xsT0;
#pragma unroll
      for (int pb = 0; pb < 2; ++pb) {
        f32x16 acc;
#pragma unroll
        for (int e = 0; e < 16; ++e) acc[e] = 0.f;
#pragma unroll
        for (int kk = 0; kk < 8; ++kk) {
          bf16x8 a = *(const bf16x8*)(xsT + (pb * 32 + r) * 136 + kk * 16 + h * 8);
          bf16x8 bb = *(const bf16x8*)(BT + (wid * 32 + r) * 136 + kk * 16 + h * 8);
          acc = MFMA(a, bb, acc);
        }
        float* dst = p.CS + ((((size_t)bc * 2 + d) * 4 + hh) * 64 + pb * 32) * 128 + wid * 32 + r;
#pragma unroll
        for (int e = 0; e < 16; ++e) dst[(size_t)crow(e, h) * 128] = acc[e];
      }
    }
  }
}

DI void ssd_scan_phase(const Params& p) {
  const int total = NB * 2 * 4 * 8192;
  for (int idx = lbid() * NTHR + ltid(); idx < total; idx += gridDim.x * NTHR) {
    const int e = idx & 8191, hh = (idx >> 13) & 3, d = (idx >> 15) & 1, b = idx >> 16;
    float st = 0.f;
#pragma unroll 2
    for (int i = 0; i < NCH; ++i) {
      int c;
      if (d == 0) c = i < 2 ? 32 + i : i - 2;
      else c = i < 2 ? 33 - i : 33 - i;
      const size_t bc = (size_t)b * NCH + c;
      float* ptr = p.CS + ((bc * 2 + d) * 4 + hh) * 8192 + e;
      const float v = *ptr;
      const float dec = __expf(p.atot[(bc * 2 + d) * 4 + hh]);
      *ptr = st;
      st = dec * st + v;
    }
  }
}

template <int G>
DI float ssd_s3_group(const Params& p, int layer, int bc, bool cPrev, bool cNext, u16* Bg, u16* xsT, float* arr, int tid) {
  f32x16 y[4];
#pragma unroll
  for (int i = 0; i < 4; ++i)
#pragma unroll
    for (int e = 0; e < 16; ++e) y[i][e] = 0.f;
  const int lane = tid & 63, wid = tid >> 6, r = lane & 31, h = lane >> 5;
  const int l = wid * 32 + r;
  const int row0 = bc * 128;
  __syncthreads();
  ssd_dt_arrays(p, layer, row0, 2 * G + (tid >> 7), tid & 127, arr + (tid >> 7) * 768);
  const ConvW cwc = load_convw(p, layer, 512 + G * 128 + (tid & 15) * 8);
#pragma unroll 1
  for (int i = 0; i < 8; ++i) {
    const int id = tid + VT * i, t = id >> 4, cp = id & 15;
    float v[8];
    conv8(p, cwc, row0 + t, 512 + G * 128 + cp * 8, cPrev || t > 0, cNext || t < 127, v);
    *(bf16x8*)(Bg + t * 136 + cp * 8) = pack8(v[0], v[1], v[2], v[3], v[4], v[5], v[6], v[7]);
  }
  const ConvW cwx = load_convw(p, layer, G * 128 + (tid & 15) * 8);
#pragma unroll 1
  for (int i = 0; i < 8; ++i) {
    const int id = tid + VT * i, t = id >> 4, cp = id & 15;
    float v[8];
    conv8(p, cwx, row0 + t, G * 128 + cp * 8, cPrev || t > 0, cNext || t < 127, v);
#pragma unroll
    for (int e = 0; e < 8; ++e) xsT[(cp * 8 + e) * 136 + t] = f2bf(v[e]);
  }
  __syncthreads();
  ssd_cum_arrays(tid & 127, arr + (tid >> 7) * 768);
  bf16x8 cf[8];
#pragma unroll
  for (int kk = 0; kk < 8; ++kk) cf[kk] = *(const bf16x8*)(Bg + l * 136 + kk * 16 + h * 8);
  __syncthreads();
  const ConvW cwb = load_convw(p, layer, 256 + G * 128 + (tid & 15) * 8);
#pragma unroll 1
  for (int i = 0; i < 8; ++i) {
    const int id = tid + VT * i, t = id >> 4, cp = id & 15;
    float v[8];
    conv8(p, cwb, row0 + t, 256 + G * 128 + cp * 8, cPrev || t > 0, cNext || t < 127, v);
    *(bf16x8*)(Bg + t * 136 + cp * 8) = pack8(v[0], v[1], v[2], v[3], v[4], v[5], v[6], v[7]);
  }
  __syncthreads();
  float ss = 0.f;
#pragma unroll 1
  for (int hd2 = 0; hd2 < 2; ++hd2) {
    const int hh = 2 * G + hd2;
    const float* ah = arr + hd2 * 768;
    const float c0l = ah[256 + l], s1l = ah[384 + l];
    f32x16 y[2];
#pragma unroll
    for (int i = 0; i < 2; ++i)
#pragma unroll
      for (int e = 0; e < 16; ++e) y[i][e] = 0.f;
#pragma unroll 1
    for (int sb = 0; sb < 4; ++sb) {
      f32x16 gt;
#pragma unroll
      for (int e = 0; e < 16; ++e) gt[e] = 0.f;
#pragma unroll
      for (int kk = 0; kk < 8; ++kk) {
        bf16x8 a = *(const bf16x8*)(Bg + (sb * 32 + r) * 136 + kk * 16 + h * 8);
        gt = MFMA(a, cf[kk], gt);
      }
      f32x16 wv;
      if (sb != wid) {
        const float ref = sb < wid ? c0l : s1l;
        const float* cumv = ah + (sb < wid ? 256 : 384) + sb * 32 + 4 * h;
        const float* dtv = ah + (sb < wid ? 0 : 128) + sb * 32 + 4 * h;
#pragma unroll
        for (int q4 = 0; q4 < 4; ++q4) {
          const f32x4 cv = *(const f32x4*)(cumv + 8 * q4), dv = *(const f32x4*)(dtv + 8 * q4);
#pragma unroll
          for (int k = 0; k < 4; ++k) wv[4 * q4 + k] = gt[4 * q4 + k] * (__expf(ref - cv[k]) * dv[k]);
        }
      } else {
#pragma unroll
        for (int q4 = 0; q4 < 4; ++q4) {
          const int s4 = sb * 32 + 8 * q4 + 4 * h;
          const f32x4 c0v = *(const f32x4*)(ah + 256 + s4), d0v = *(const f32x4*)(ah + s4);
          const f32x4 s1v = *(const f32x4*)(ah + 384 + s4), d1v = *(const f32x4*)(ah + 128 + s4);
#pragma unroll
          for (int k = 0; k < 4; ++k) {
            const int s = s4 + k;
            const float a0 = (l >= s) ? (c0l - c0v[k]) : -1e30f;
            const float a1 = (l <= s) ? (s1l - s1v[k]) : -1e30f;
            wv[4 * q4 + k] = gt[4 * q4 + k] * (__expf(a0) * d0v[k] + __expf(a1) * d1v[k]);
          }
          __builtin_amdgcn_sched_barrier(0);
        }
      }
      bf16x8 wp0 = pack8(wv[0], wv[1], wv[2], wv[3], wv[4], wv[5], wv[6], wv[7]);
      bf16x8 wp1 = pack8(wv[8], wv[9], wv[10], wv[11], wv[12], wv[13], wv[14], wv[15]);
#pragma unroll
      for (int pb = 0; pb < 2; ++pb) {
        const u16* xrow = xsT + (hd2 * 64 + pb * 32 + r) * 136 + sb * 32 + 4 * h;
        s16x4 lo0 = *(const s16x4*)(xrow), hi0 = *(const s16x4*)(xrow + 8);
        s16x4 lo1 = *(const s16x4*)(xrow + 16), hi1 = *(const s16x4*)(xrow + 24);
        bf16x8 a0 = __builtin_shufflevector(lo0, hi0, 0, 1, 2, 3, 4, 5, 6, 7);
        bf16x8 a1 = __builtin_shufflevector(lo1, hi1, 0, 1, 2, 3, 4, 5, 6, 7);
        y[pb] = MFMA(a0, wp0, y[pb]);
        y[pb] = MFMA(a1, wp1, y[pb]);
      }
    }
#pragma unroll 1
    for (int d = 0; d < 2; ++d) {
      const float el = __expf(d == 0 ? c0l : s1l);
#pragma unroll
      for (int pb = 0; pb < 2; ++pb) {
        const float* srow = p.CS + ((((size_t)bc * 2 + d) * 4 + hh) * 64 + pb * 32 + r) * 128 + h * 8;
        f32x16 tmp;
#pragma unroll
        for (int e = 0; e < 16; ++e) tmp[e] = 0.f;
#pragma unroll
        for (int kk = 0; kk < 8; ++kk) {
          f32x4 s0 = *(const f32x4*)(srow + kk * 16), s1 = *(const f32x4*)(srow + kk * 16 + 4);
          bf16x8 a = pack8(s0.x, s0.y, s0.z, s0.w, s1.x, s1.y, s1.z, s1.w);
          tmp = MFMA(a, cf[kk], tmp);
        }
#pragma unroll
        for (int e = 0; e < 16; ++e) y[pb][e] += el * tmp[e];
      }
    }
    const float dsk = p.ssd_d[layer * 8 + hh] + p.ssd_d[layer * 8 + 4 + hh];
#pragma unroll
    for (int pb = 0; pb < 2; ++pb) {
#pragma unroll
      for (int q4 = 0; q4 < 4; ++q4) {
        const int cl = hd2 * 64 + pb * 32 + 8 * q4 + 4 * h;
        const int ch0 = G * 128 + cl;
        u32x2 zw = *(const u32x2*)(p.P + (size_t)(row0 + l) * NINP + 960 + ch0);
        f32x4 o;
        o.x = (y[pb][4 * q4] + dsk * bf2f(xsT[(cl + 0) * 136 + l])) * silu_f(bflo(zw.x));
        o.y = (y[pb][4 * q4 + 1] + dsk * bf2f(xsT[(cl + 1) * 136 + l])) * silu_f(bfhi(zw.x));
        o.z = (y[pb][4 * q4 + 2] + dsk * bf2f(xsT[(cl + 2) * 136 + l])) * silu_f(bflo(zw.y));
        o.w = (y[pb][4 * q4 + 3] + dsk * bf2f(xsT[(cl + 3) * 136 + l])) * silu_f(bfhi(zw.y));
        ss += o.x * o.x + o.y * o.y + o.z * o.z + o.w * o.w;
        *(f32x4*)(p.ytmp + (size_t)(row0 + l) * 256 + ch0) = o;
      }
    }
  }
  return ss;
}

DI void ssd_s3_tasks(const Params& p, int layer, char* smem) {
  const int ftid = ltid(), vb = ftid >> 8, tid = ftid & 255;
  u16* Bg = (u16*)(smem + vb * VSMEM);
  u16* xsT = Bg + 128 * 136;
  float* arr = (float*)(xsT + 128 * 136);
  const int lane = tid & 63, wid = tid >> 6, r = lane & 31, h = lane >> 5;
  const int l = wid * 32 + r;
  for (int t0 = lbid() * 2; t0 < NB * NCH; t0 += gridDim.x * 2) {
    const int bc = t0 + vb, c = bc % NCH;
    const int row0 = bc * 128;
    const bool cPrev = (c != 0 && c != 32), cNext = (c != 31 && c != 33);
    float ss = ssd_s3_group<0>(p, layer, bc, cPrev, cNext, Bg, xsT, arr, tid);
    ss += ssd_s3_group<1>(p, layer, bc, cPrev, cNext, Bg, xsT, arr, tid);
    ss += __shfl_xor(ss, 32);
    const float rstd = rsqrtf(ss * (1.f / 256.f) + EPS);
    const float* gn = p.ssd_norm_g + layer * 256;
#pragma unroll 4
    for (int i = 0; i < 32; ++i) {
      const int ch0 = (i >> 2) * 32 + 8 * (i & 3) + 4 * h;
      f32x4 v = *(const f32x4*)(p.ytmp + (size_t)(row0 + l) * 256 + ch0);
      f32x4 gv = *(const f32x4*)(gn + ch0);
      u32x2 w;
      w.x = pack2(v.x * rstd * gv.x, v.y * rstd * gv.y);
      w.y = pack2(v.z * rstd * gv.z, v.w * rstd * gv.w);
      *(u32x2*)(p.H + (size_t)(row0 + l) * D + 768 + ch0) = w;
    }
  }
}

constexpr int QREG = 6;
DI void attn_qk(const u16* Ks, const bf16x8 (&qf)[QREG], const u16* qs, f32x16 (&st)[2], int r, int h) {
#pragma unroll
  for (int kb = 0; kb < 2; ++kb)
#pragma unroll
    for (int e = 0; e < 16; ++e) st[kb][e] = 0.f;
  const u16* kp = Ks + r * 200 + h * 8;
#pragma unroll
  for (int kk = 0; kk < 12; ++kk) {
    bf16x8 k0 = *(const bf16x8*)(kp + kk * 16);
    bf16x8 k1 = *(const bf16x8*)(kp + 32 * 200 + kk * 16);
    bf16x8 q;
    if (kk < QREG) q = qf[kk];
    else q = *(const bf16x8*)(qs + (kk - QREG) * 512);
    st[0] = MFMA(k0, q, st[0]);
    st[1] = MFMA(k1, q, st[1]);
  }
}
DI void attn_softmax(f32x16 (&st)[2], f32x16 (&o)[4], bf16x8 (&pf)[4], float& m_run, float& l_run, float sc) {
  float mx = st[0][0];
#pragma unroll
  for (int kb = 0; kb < 2; ++kb)
#pragma unroll
    for (int e = 0; e < 16; ++e) mx = fmaxf(mx, st[kb][e]);
  mx = fmaxf(mx, __shfl_xor(mx, 32));
  const float m_new = fmaxf(m_run, mx * sc);
  const float alpha = __builtin_amdgcn_exp2f(m_run - m_new);
  m_run = m_new;
  float ls = 0.f;
#pragma unroll
  for (int kb = 0; kb < 2; ++kb)
#pragma unroll
    for (int e = 0; e < 16; ++e) {
      float pv = __builtin_amdgcn_exp2f(fmaf(st[kb][e], sc, -m_new));
      ls += pv;
      st[kb][e] = pv;
    }
  l_run = l_run * alpha + ls;
  if (__builtin_amdgcn_ballot_w64(alpha != 1.f) != 0ull) {
#pragma unroll
    for (int i = 0; i < 4; ++i)
#pragma unroll
      for (int e = 0; e < 16; ++e) o[i][e] *= alpha;
  }
#pragma unroll
  for (int ks = 0; ks < 4; ++ks) {
    const int kb = ks >> 1, s2 = ks & 1;
    pf[ks] = pack8(st[kb][8 * s2], st[kb][8 * s2 + 1], st[kb][8 * s2 + 2], st[kb][8 * s2 + 3], st[kb][8 * s2 + 4],
                   st[kb][8 * s2 + 5], st[kb][8 * s2 + 6], st[kb][8 * s2 + 7]);
  }
}
DI void attn_pv(const u16* Vs, const bf16x8 (&pf)[4], f32x16 (&o)[4], int r, int h) {
#pragma unroll
  for (int ks = 0; ks < 4; ++ks) {
#pragma unroll
    for (int db = 0; db < 4; ++db) {
      bf16x8 a = *(const bf16x8*)(Vs + (db * 32 + r) * 72 + ks * 16 + 8 * h);
      o[db] = MFMA(a, pf[ks], o[db]);
    }
  }
}

DI void attn_tasks(const Params& p, char* smem) {
  u16* Ks = (u16*)smem;
  u16* Vs0 = Ks + 64 * 200;
  const int tid = ltid(), lane = tid & 63, wid = __builtin_amdgcn_readfirstlane(tid >> 6), r = lane & 31, h = lane >> 5;
  const bool late = wid >= 4;
  u16* qs = Vs0 + 2 * 128 * 72 + wid * (11 * 512) + lane * 8;
  const float sc = 0.07216878364870322f * 1.4426950408889634f;
  for (int task = lbid(); task < NB * 4 * 17; task += gridDim.x) {
    int b, hd, qt;
    if (task < 512) {
      qt = task & 15; hd = (task >> 4) & 3; b = task >> 6;
    } else {
      const int t2 = task - 512;
      qt = 16; hd = t2 & 3; b = t2 >> 2;
    }
    const int koff = (qt < 16) ? 0 : SEQ;
    const int nkt = ((qt < 16) ? SP : CTX) / 64;
    const int qrow = b * SP + qt * 256 + wid * 32 + r;
    bf16x8 qf[QREG];
#pragma unroll
    for (int kk = 0; kk < QREG; ++kk) qf[kk] = *(const bf16x8*)(p.Q + (size_t)qrow * 768 + hd * 192 + kk * 16 + h * 8);
#pragma unroll
    for (int kk = QREG; kk < 12; ++kk)
      *(bf16x8*)(qs + (kk - QREG) * 512) = *(const bf16x8*)(p.Q + (size_t)qrow * 768 + hd * 192 + kk * 16 + h * 8);
    f32x16 o[4];
#pragma unroll
    for (int i = 0; i < 4; ++i)
#pragma unroll
      for (int e = 0; e < 16; ++e) o[i][e] = 0.f;
    bf16x8 pf[4];
#pragma unroll
    for (int i = 0; i < 4; ++i)
#pragma unroll
      for (int e = 0; e < 8; ++e) pf[i][e] = 0;
    float m_run = -1e30f, l_run = 0.f;
    u32x4 kn[2], kr[1], vv[2];
    const u16* knb = p.Kn + ((size_t)(b * SP + koff) + (tid >> 4)) * 512 + hd * 128 + (tid & 15) * 8;
    const u16* krb = p.Kr + ((size_t)(b * SP + koff) + (tid >> 3)) * 64 + (tid & 7) * 8;
    const u16* vb = p.Vt + ((size_t)(b * 4 + hd) * 128 + (tid >> 3)) * SP + koff + (tid & 7) * 8;
#pragma unroll
    for (int i = 0; i < 2; ++i) kn[i] = *(const u32x4*)(knb + (size_t)(32 * i) * 512);
    kr[0] = *(const u32x4*)(krb);
#pragma unroll
    for (int i = 0; i < 2; ++i) vv[i] = *(const u32x4*)(vb + (size_t)(64 * i) * SP);
    for (int kt = 0; kt < nkt; ++kt) {
      u16* Vs = Vs0 + (kt & 1) * (128 * 72);
      __syncthreads();
#pragma unroll
      for (int i = 0; i < 2; ++i) *(u32x4*)(Ks + ((tid >> 4) + 32 * i) * 200 + (tid & 15) * 8) = kn[i];
      *(u32x4*)(Ks + (tid >> 3) * 200 + 128 + (tid & 7) * 8) = kr[0];
#pragma unroll
      for (int i = 0; i < 2; ++i) {
        u16* dst = Vs + ((tid >> 3) + 64 * i) * 72 + ((tid & 7) >> 1) * 16 + ((tid & 7) & 1) * 4;
        *(u32x2*)dst = u32x2{vv[i].x, vv[i].y};
        *(u32x2*)(dst + 8) = u32x2{vv[i].z, vv[i].w};
      }
      __syncthreads();
      {
        const size_t ko = (size_t)(kt + 1 < nkt ? kt + 1 : kt) * 64;
#pragma unroll
        for (int i = 0; i < 2; ++i) kn[i] = *(const u32x4*)(knb + (ko + 32 * i) * 512);
        kr[0] = *(const u32x4*)(krb + ko * 64);
#pragma unroll
        for (int i = 0; i < 2; ++i) vv[i] = *(const u32x4*)(vb + (size_t)(64 * i) * SP + ko);
      }
      __builtin_amdgcn_sched_barrier(0);
      if (late && kt > 0) attn_pv(Vs0 + ((kt - 1) & 1) * (128 * 72), pf, o, r, h);
      {
        f32x16 st[2];
        attn_qk(Ks, qf, qs, st, r, h);
        attn_softmax(st, o, pf, m_run, l_run, sc);
      }
      if (!late) attn_pv(Vs, pf, o, r, h);
    }
    if (late) attn_pv(Vs0 + ((nkt - 1) & 1) * (128 * 72), pf, o, r, h);
    const float ltot = l_run + __shfl_xor(l_run, 32);
    const float inv = 1.f / ltot;
    u16* orow = p.H + (size_t)qrow * D + hd * 128;
#pragma unroll
    for (int db = 0; db < 4; ++db)
#pragma unroll
      for (int q4 = 0; q4 < 4; ++q4) {
        u32x2 w;
        w.x = pack2(o[db][4 * q4] * inv, o[db][4 * q4 + 1] * inv);
        w.y = pack2(o[db][4 * q4 + 2] * inv, o[db][4 * q4 + 3] * inv);
        *(u32x2*)(orow + db * 32 + 8 * q4 + 4 * h) = w;
      }
  }
}

constexpr int NPHASE = 2 + DEPTH * 6;

DI void conv_item_ffn(const Params& p, int layer, int q, char* smem) {
#pragma unroll 1
  for (int u = 0; u < 8; ++u) {
    const int tile = q * 8 + u;
    if (tile < 1024) conv_tile(p.w_ff1 + (size_t)layer * D * DFF, D, DFF, p.wt_ff1, nullptr, tile >> 6, tile & 63, smem);
    else conv_tile(p.w_ff2 + (size_t)layer * DFF * D, DFF, D, p.wt_ff2, nullptr, (tile - 1024) >> 4, (tile - 1024) & 15, smem);
  }
}
DI void conv_item_mix(const Params& p, int layer, int q, char* smem) {
#pragma unroll 1
  for (int u = 0; u < 8; ++u) {
    int tile = q * 8 + u;
    if (tile < 512) { conv_tile(p.w_in + (size_t)layer * D * NIN, D, NIN, p.wt_in, nullptr, tile >> 5, tile & 31, smem); continue; }
    tile -= 512;
    if (tile < 48) { conv_tile(p.w_uq + (size_t)layer * 256 * 768, 256, 768, p.wt_uq, p.g_q + layer * 256, tile / 12, tile % 12, smem); continue; }
    tile -= 48;
    if (tile < 32) { conv_tile(p.w_ukv + (size_t)layer * 128 * 1024, 128, 1024, p.wt_ukv, p.g_kv + layer * 128, tile >> 4, tile & 15, smem); continue; }
    tile -= 32;
    if (tile < 256) { conv_tile(p.w_out + (size_t)layer * D * D, D, D, p.wt_out, nullptr, tile >> 4, tile & 15, smem); continue; }
    tile -= 256;
    for (int i = ltid(); i < 4096; i += NTHR) p.wsb[tile * 4096 + i] = f2bf(p.cm_w_s[(size_t)layer * 65536 + tile * 4096 + i]);
  }
}

DI void run_phase(const Params& p, int ph, char* smem) {
  if (ph == 0) { prologue_phase(p, smem); return; }
  const int MT = T / 256;
  auto noT = [](int, int, u32x4) {};
  auto neverT = [](int) { return false; };
  if (ph == 1) {
    ew_phase(p, 0, 0);
    for (int q = lbid(); q < 108; q += gridDim.x) conv_item_mix(p, 0, q, smem);
    return;
  }
  const int layer = (ph - 2) / 6, sub = (ph - 2) % 6;
  const bool last = layer == DEPTH - 1;
  switch (sub) {
    case 0: {
      for (int it = 0;; ++it) {
        const int t = xcd_tile(it, MT * 8);
        if (t < 0) break;
        const int tm = t >> 3, tn = t & 7;
        gemm_tile<false>(
            p.H, D, p.wt_in, D, D, tm * 256, tn * 256, smem,
            [&](int mb, int nb, f32x16& acc, int r, int h) {
              if (nb == 1984) {
                f32x4 v = {acc[0], acc[1], acc[2], acc[3]};
                *(f32x4*)(p.dtraw + (size_t)(mb + r) * 8 + 4 * h) = v;
              }
            },
            [&](int row, int col, u32x4 v) { *(u32x4*)(p.P + (size_t)row * NINP + col) = v; }, noT, neverT);
      }
    } break;
    case 1: {
      int* wq = p.cnt + (2 * DEPTH + layer) * CNT_STRIDE;
      int* sh = (int*)(smem + SMEM_BYTES - 16);
      for (;;) {
        __syncthreads();
        if (ltid() == 0) *sh = __hip_atomic_fetch_add(wq, 1, __ATOMIC_RELAXED, __HIP_MEMORY_SCOPE_AGENT);
        __syncthreads();
        const int q = *sh;
        if (q >= 544 + 136 + 408 + 544) break;
        if (q < 544) ssd_s1_tasks(p, layer, smem, 2 * q, 2 * q + 1, 2);
        else if (q < 680) cm_tasks(p, layer, smem, 2 * (q - 544), 2 * (q - 544) + 1, 2);
        else if (q < 1088) qkv_tasks(p, smem, q - 680, q - 679, 0, 0, 1);
        else qkv_tasks(p, smem, 0, 0, q - 1088, q - 1087, 1);
      }
    } break;
    case 2: ssd_scan_phase(p); break;
    case 3: {
      attn_tasks(p, smem);
      ssd_s3_tasks(p, layer, smem);
    } break;
    case 4: {
      int* cnt = p.cnt + (2 * layer) * CNT_STRIDE;
      for (int it = 0;; ++it) {
        const int t = xcd_tile(it, MT * 4, last ? 4 : 0);
        if (t < 0) break;
        const int tm = t >> 2, tn = t & 3;
        gemm_tile<false>(
            p.H, D, p.wt_out, D, D, tm * 256, tn * 256, smem, [](int, int, f32x16&, int, int) {},
            [&](int row, int col, u32x4 v) { st_wt(p.Y + (size_t)row * D + col, v); }, noT, neverT);
        tile_done(cnt, tm);
      }
      ew_consume(p, cnt, 4, layer, 1, last, 256, [&](int q) { conv_item_ffn(p, layer, q, smem); }, smem);
    } break;
    case 5: {
      int* cnt1 = p.cnt + (3 * DEPTH + layer) * CNT_STRIDE;
      for (int it = 0;; ++it) {
        const int t = xcd_tile(it, MT * 16, last ? 16 : 0);
        if (t < 0) break;
        const int tm = t >> 4, tn = t & 15;
        gemm_tile<false>(
            p.H, D, p.wt_ff1, D, D, tm * 256, tn * 256, smem,
            [](int, int, f32x16& acc, int, int) {
#pragma unroll
              for (int e = 0; e < 16; ++e) {
                float v = fmaxf(acc[e], 0.f);
                acc[e] = v * v;
              }
            },
            [&](int row, int col, u32x4 v) { st_wt(p.Hd + (size_t)row * DFF + col, v); }, noT, neverT);
        tile_done(cnt1, tm);
      }
      int* cnt = p.cnt + (2 * layer + 1) * CNT_STRIDE;
      for (int it = 0;; ++it) {
        const int t = xcd_tile(it, MT * 4, last ? 4 : 0);
        if (t < 0) break;
        const int tm = t >> 2, tn = t & 3;
        if (ltid() == 0) {
          while (__hip_atomic_load(cnt1 + tm, __ATOMIC_ACQUIRE, __HIP_MEMORY_SCOPE_AGENT) < 16) __builtin_amdgcn_s_sleep(4);
        }
        __syncthreads();
        gemm_tile<false>(
            p.Hd, DFF, p.wt_ff2, DFF, DFF, tm * 256, tn * 256, smem, [](int, int, f32x16&, int, int) {},
            [&](int row, int col, u32x4 v) { st_wt(p.F + (size_t)row * D + col, v); }, noT, neverT);
        tile_done(cnt, tm);
      }
      if (last) ew_consume(p, cnt, 4, DEPTH, 2, true, 0, [](int) {}, smem);
      else ew_consume(p, cnt, 4, layer + 1, 0, false, 108, [&](int q) { conv_item_mix(p, layer + 1, q, smem); }, smem);
    } break;
  }
}

__global__ void __launch_bounds__(NTHR, 2) mega_kernel(Params p, int ph_begin, int ph_end) {
  extern __shared__ __attribute__((aligned(16))) char smem[];
  cg::grid_group grid = cg::this_grid();
  for (int ph = ph_begin; ph < ph_end; ++ph) {
    run_phase(p, ph, smem);
    if (ph + 1 < ph_end) grid.sync();
  }
}

extern "C" void kernel_launch(void* const* d_in, const int* in_sizes, int n_in, void* d_out, int out_size, void* d_ws,
                              size_t ws_size, hipStream_t stream) {
  Params p{};
  const float* const* in = (const float* const*)d_in;
  p.x = in[0]; p.c = in[1]; p.ctx = in[2]; p.c_ctx = in[3]; p.w_ada = in[4]; p.b_ada = in[5];
  p.g_pre_mix = in[6]; p.g_post_mix = in[7]; p.g_pre_ff = in[8]; p.g_post_ff = in[9]; p.w_in = in[10];
  p.g_q = in[11]; p.w_uq = in[12]; p.g_kv = in[13]; p.w_ukv = in[14]; p.cm_norm_g = in[15]; p.cm_w_s = in[16];
  p.cm_b_s = in[17]; p.conv_w = in[18]; p.conv_b = in[19]; p.dt_bias = in[20]; p.a_log = in[21]; p.ssd_d = in[22];
  p.ssd_norm_g = in[23]; p.w_out = in[24]; p.w_ff1 = in[25]; p.w_ff2 = in[26];
  p.out = (float*)d_out;
  char* ws = (char*)d_ws;
  size_t off = 0;
  auto take = [&](size_t bytes) { char* q = ws + off; off += (bytes + 255) & ~(size_t)255; return q; };
  p.wt_in = (u16*)take((size_t)NINP * D * 2);
  p.wt_uq = (u16*)take((size_t)768 * 256 * 2);
  p.wt_ukv = (u16*)take((size_t)1024 * 128 * 2);
  p.wt_out = (u16*)take((size_t)D * D * 2);
  p.wt_ff1 = (u16*)take((size_t)DFF * D * 2);
  p.wt_ff2 = (u16*)take((size_t)D * DFF * 2);
  p.wsb = (u16*)take((size_t)4 * 128 * 128 * 2);
  p.mod = (float*)take((size_t)DEPTH * 9 * 6144 * 4);
  p.ropetab = (float*)take((size_t)64 * 16 * 2 * 4);
  p.atot = (float*)take((size_t)NB * NCH * 2 * 4 * 4);
  p.xctx = (float*)take((size_t)NB * CTX * D * 4);
  char* r1 = take((size_t)T * DFF * 2);
  p.Hd = (u16*)r1;
  p.Y = (u16*)r1;
  {
    size_t o2 = 0;
    p.P = (u16*)(r1 + o2); o2 += (size_t)T * NINP * 2;
    p.Q = (u16*)(r1 + o2); o2 += (size_t)T * 768 * 2;
    p.Kn = (u16*)(r1 + o2); o2 += (size_t)T * 512 * 2;
    p.Kr = (u16*)(r1 + o2); o2 += (size_t)T * 64 * 2;
    p.Vt = (u16*)(r1 + o2); o2 += (size_t)NB * 4 * 128 * SP * 2;
    p.dtraw = (float*)(r1 + o2); o2 += (size_t)T * 8 * 4;
  }
  p.H = (u16*)take((size_t)T * D * 2);
  p.CS = (float*)take((size_t)NB * NCH * 2 * 4 * 8192 * 4);
  p.F = (u16*)p.CS;
  p.ytmp = (float*)take((size_t)T * 256 * 4);
  p.cnt = (int*)take((size_t)4 * DEPTH * CNT_STRIDE * 4);
  if (off > ws_size) {
    fprintf(stderr, "workspace too small: need %zu have %zu\n", off, ws_size);
    return;
  }
  static int grid_blocks = 0;
  if (!grid_blocks) {
    int dev = 0, cus = 0, per_cu = 0;
    hipGetDevice(&dev);
    hipDeviceGetAttribute(&cus, hipDeviceAttributeMultiprocessorCount, dev);
    hipFuncSetAttribute((const void*)mega_kernel, hipFuncAttributeMaxDynamicSharedMemorySize, SMEM_BYTES);
    hipOccupancyMaxActiveBlocksPerMultiprocessor(&per_cu, mega_kernel, NTHR, SMEM_BYTES);
    if (per_cu < 1) per_cu = 1;
    if (per_cu > 1) per_cu = 1;
    grid_blocks = cus * per_cu;
  }
  int pb = 0, pe = NPHASE;
  void* args[] = {&p, &pb, &pe};
  hipError_t e = hipLaunchCooperativeKernel((void*)mega_kernel, dim3(grid_blocks), dim3(NTHR), args, SMEM_BYTES, stream);
  if (e != hipSuccess) fprintf(stderr, "cooperative launch failed: %s (grid %d)\n", hipGetErrorString(e), grid_blocks);
}
```

```cpp
#include <hip/hip_runtime.h>
#include <hip/hip_cooperative_groups.h>
#include <cstdio>
namespace cg = cooperative_groups;

#define DI __device__ __forceinline__
typedef unsigned short u16;
using bf16x8 = __attribute__((ext_vector_type(8))) short;
using s16x4 = __attribute__((ext_vector_type(4))) short;
using f32x16 = __attribute__((ext_vector_type(16))) float;
using u32x4 = __attribute__((ext_vector_type(4))) unsigned;
using u32x2 = __attribute__((ext_vector_type(2))) unsigned;
using f32x4 = __attribute__((ext_vector_type(4))) float;
typedef __bf16 bf2_t __attribute__((ext_vector_type(2)));
typedef float f2_t __attribute__((ext_vector_type(2)));
#define MFMA(a, b, c) __builtin_amdgcn_mfma_f32_32x32x16_bf16((a), (b), (c), 0, 0, 0)

constexpr int NB = 8, SEQ = 4096, CTX = 256, SP = 4352, T = NB * SP, D = 1024, DFF = 4096;
constexpr int NIN = 1992, NINP = 2048, NCH = 34, DEPTH = 4;
constexpr int NTHR = 512;
constexpr int VT = 256;
constexpr int VSMEM = 75 * 1024;
constexpr int SMEM_BYTES = 2 * VSMEM;
constexpr float EPS = 1e-6f;
constexpr int CNT_STRIDE = 160;

struct Params {
  const float *x, *c, *ctx, *c_ctx, *w_ada, *b_ada, *g_pre_mix, *g_post_mix, *g_pre_ff, *g_post_ff, *w_in, *g_q, *w_uq,
      *g_kv, *w_ukv, *cm_norm_g, *cm_w_s, *cm_b_s, *conv_w, *conv_b, *dt_bias, *a_log, *ssd_d, *ssd_norm_g, *w_out,
      *w_ff1, *w_ff2;
  float* out;
  u16 *wt_in, *wt_uq, *wt_ukv, *wt_out, *wt_ff1, *wt_ff2, *wsb;
  float *mod, *ropetab, *atot, *xctx;
  u16 *P, *Q, *Kn, *Kr, *Vt, *Hd;
  u16* Y;
  float* dtraw;
  u16* H;
  float* CS;
  u16* F;
  float* ytmp;
  int* cnt;
};

DI int ltid() { int t = threadIdx.x; asm volatile("" : "+v"(t)); return t; }
DI int lbid() { int t = blockIdx.x; asm volatile("" : "+s"(t)); return t; }
DI void st_wt(void* ptr, u32x4 v) { asm volatile("global_store_dwordx4 %0, %1, off sc0 sc1" ::"v"(ptr), "v"(v) : "memory"); }
DI int crow(int e, int h) { return (e & 3) + 8 * (e >> 2) + 4 * h; }
DI unsigned pack2(float a, float b) {
  f2_t v = {a, b};
  bf2_t r = __builtin_convertvector(v, bf2_t);
  return __builtin_bit_cast(unsigned, r);
}
DI u16 f2bf(float a) { return (u16)(pack2(a, 0.f) & 0xffffu); }
DI float bf2f(u16 v) { return __uint_as_float(((unsigned)v) << 16); }
DI float bflo(unsigned w) { return __uint_as_float(w << 16); }
DI float bfhi(unsigned w) { return __uint_as_float(w & 0xffff0000u); }
DI bf16x8 pack8(float a0, float a1, float a2, float a3, float a4, float a5, float a6, float a7) {
  u32x4 u;
  u.x = pack2(a0, a1); u.y = pack2(a2, a3); u.z = pack2(a4, a5); u.w = pack2(a6, a7);
  return __builtin_bit_cast(bf16x8, u);
}
DI float wave_sum(float v) {
#pragma unroll
  for (int o = 32; o > 0; o >>= 1) v += __shfl_xor(v, o);
  return v;
}
DI float silu_f(float y) { return y * __builtin_amdgcn_rcpf(1.f + __expf(-y)); }
DI float gelu_f(float x) {
  float u = 0.7978845608028654f * (x + 0.044715f * x * x * x);
  float t = 1.f - 2.f * __builtin_amdgcn_rcpf(1.f + __expf(2.f * u));
  return 0.5f * x * (1.f + t);
}
DI float softplus_f(float x) { return x > 20.f ? x : log1pf(__expf(x)); }
DI float uw(const u32x4& v, int i) {
  unsigned w = (i >> 1) == 0 ? v.x : (i >> 1) == 1 ? v.y : (i >> 1) == 2 ? v.z : v.w;
  return (i & 1) ? bfhi(w) : bflo(w);
}

template <bool HAS_T, class ElemF, class StoreF, class StoreTF, class UseTF>
DI void gemm_tile(const u16* __restrict__ A, int lda, const u16* __restrict__ Bt, int ldb, int K, int m0, int n0,
                  char* smem, ElemF elem, StoreF store, StoreTF storeT, UseTF useT) {
  constexpr int LS = 72;
  constexpr int STAGE = 2 * 256 * LS;
  u16* base = (u16*)smem;
  const int tid = ltid(), lane = tid & 63, wid = tid >> 6, wm = wid >> 2, wn = wid & 3, r = lane & 31, h = lane >> 5;
  f32x16 acc[4][2];
#pragma unroll
  for (int i = 0; i < 4; ++i)
#pragma unroll
    for (int j = 0; j < 2; ++j)
#pragma unroll
      for (int e = 0; e < 16; ++e) acc[i][j][e] = 0.f;
  u32x4 ra[4], rb[4];
  const int lrow = tid >> 3, lcp = (tid & 7) * 8;
  const u16* ga = A + (size_t)(m0 + lrow) * lda + lcp;
  const u16* gb = Bt + (size_t)(n0 + lrow) * ldb + lcp;
  const int wofs = lrow * LS + lcp;
  const int aofs = (wm * 128 + r) * LS + h * 8;
  const int bofs = 256 * LS + (wn * 64 + r) * LS + h * 8;
#define GLOAD(kt_)                                                           \
  _Pragma("unroll") for (int i = 0; i < 4; ++i) {                            \
    ra[i] = *(const u32x4*)(ga + (size_t)(64 * i) * lda + (kt_) * 64);       \
    rb[i] = *(const u32x4*)(gb + (size_t)(64 * i) * ldb + (kt_) * 64);       \
  }
#define SWRITE(st_)                                                          \
  _Pragma("unroll") for (int i = 0; i < 4; ++i) {                            \
    *(u32x4*)((st_) + wofs + 64 * i * LS) = ra[i];                           \
    *(u32x4*)((st_) + 256 * LS + wofs + 64 * i * LS) = rb[i];                \
  }
#define FREAD(dst_, st_, kk_)                                                                      \
  _Pragma("unroll") for (int i = 0; i < 4; ++i) af[dst_][i] = *(const bf16x8*)((st_) + aofs + i * 32 * LS + (kk_) * 16); \
  _Pragma("unroll") for (int j = 0; j < 2; ++j) bfr[dst_][j] = *(const bf16x8*)((st_) + bofs + j * 32 * LS + (kk_) * 16);
#define MMAS(src_)                                                           \
  _Pragma("unroll") for (int i = 0; i < 4; ++i)                              \
  _Pragma("unroll") for (int j = 0; j < 2; ++j) acc[i][j] = MFMA(bfr[src_][j], af[src_][i], acc[i][j]);
#define ILV()                                                                   \
  __builtin_amdgcn_sched_group_barrier(0x008, 2, 0);                            \
  __builtin_amdgcn_sched_group_barrier(0x100, 2, 0);                            \
  __builtin_amdgcn_sched_group_barrier(0x008, 2, 0);                            \
  __builtin_amdgcn_sched_group_barrier(0x100, 2, 0);                            \
  __builtin_amdgcn_sched_group_barrier(0x008, 2, 0);                            \
  __builtin_amdgcn_sched_group_barrier(0x100, 2, 0);                            \
  __builtin_amdgcn_sched_group_barrier(0x008, 2, 0);
  const int nk = K >> 6;
  bf16x8 af[2][4], bfr[2][2];
  GLOAD(0);
  __syncthreads();
  SWRITE(base);
  if (nk > 1) { GLOAD(1); }
  __syncthreads();
  FREAD(0, base, 0);
  for (int kt = 0; kt < nk; ++kt) {
    u16* cur = base + (kt & 1) * STAGE;
    u16* nxt = base + ((kt + 1) & 1) * STAGE;
    FREAD(1, cur, 1);
    if (kt + 1 < nk) { SWRITE(nxt); }
    MMAS(0);
#pragma unroll
    for (int z = 0; z < 7; ++z) {
      __builtin_amdgcn_sched_group_barrier(0x008, 1, 0);
      __builtin_amdgcn_sched_group_barrier(0x080, 2, 0);
    }
    __builtin_amdgcn_sched_group_barrier(0x008, 1, 0);
    __builtin_amdgcn_sched_barrier(0);
    if (kt + 2 < nk) { GLOAD(kt + 2); }
    FREAD(0, cur, 2);
    MMAS(1);
    ILV();
    __builtin_amdgcn_sched_barrier(0);
    FREAD(1, cur, 3);
    MMAS(0);
    ILV();
    __builtin_amdgcn_sched_barrier(0);
    __syncthreads();
    if (kt + 1 < nk) { FREAD(0, nxt, 0); }
    MMAS(1);
    ILV();
    __builtin_amdgcn_sched_barrier(0);
  }
#undef ILV
#undef GLOAD
#undef SWRITE
#undef FREAD
#undef MMAS
#pragma unroll
  for (int i = 0; i < 4; ++i)
#pragma unroll
    for (int j = 0; j < 2; ++j) elem(m0 + wm * 128 + i * 32, n0 + wn * 64 + j * 32, acc[i][j], r, h);
  u16* stg = base + wid * (128 * 72);
  if (HAS_T && useT(wn)) {
#pragma unroll
    for (int i = 0; i < 4; ++i)
#pragma unroll
      for (int j = 0; j < 2; ++j)
#pragma unroll
        for (int e = 0; e < 16; ++e) stg[(j * 32 + crow(e, h)) * 136 + i * 32 + r] = f2bf(acc[i][j][e]);
    __builtin_amdgcn_wave_barrier();
#pragma unroll 4
    for (int t = 0; t < 16; ++t) {
      const int id = lane + 64 * t, cl = id >> 4, cp = id & 15;
      u32x4 v = *(const u32x4*)(stg + cl * 136 + cp * 8);
      storeT(n0 + wn * 64 + cl, m0 + wm * 128 + cp * 8, v);
    }
  } else {
#pragma unroll
    for (int i = 0; i < 4; ++i)
#pragma unroll
      for (int j = 0; j < 2; ++j)
#pragma unroll
        for (int q4 = 0; q4 < 4; ++q4) {
          u32x2 w;
          w.x = pack2(acc[i][j][4 * q4], acc[i][j][4 * q4 + 1]);
          w.y = pack2(acc[i][j][4 * q4 + 2], acc[i][j][4 * q4 + 3]);
          *(u32x2*)(stg + (i * 32 + r) * 72 + j * 32 + 8 * q4 + 4 * h) = w;
        }
    __builtin_amdgcn_wave_barrier();
#pragma unroll 4
    for (int t = 0; t < 16; ++t) {
      const int id = lane + 64 * t, rl = id >> 3, cp = id & 7;
      u32x4 v = *(const u32x4*)(stg + rl * 72 + cp * 8);
      store(m0 + wm * 128 + rl, n0 + wn * 64 + cp * 8, v);
    }
  }
}

DI int xcd_tile(int it, int ntiles, int skip_tail = 0) {
  const int b = lbid(), g = gridDim.x;
  const int local = (b >> 3) + it * (g >> 3);
  const int per = ntiles >> 3;
  return local < per - skip_tail ? (b & 7) * per + local : -1;
}

DI void conv_tile(const float* __restrict__ src, int K, int N, u16* __restrict__ dst, const float* __restrict__ scale,
                  int tk, int tn, char* smem) {
  float* tile = (float*)smem;
  const int tid = ltid(), tx = tid & 63, ty = tid >> 6;
  const int k0 = tk * 64, n0 = tn * 64;
  __syncthreads();
#pragma unroll 4
  for (int i = 0; i < 8; ++i) {
    int kr = ty + 8 * i;
    float v = 0.f;
    if (n0 + tx < N) v = src[(size_t)(k0 + kr) * N + n0 + tx];
    if (scale) v *= scale[k0 + kr];
    tile[kr * 65 + tx] = v;
  }
  __syncthreads();
#pragma unroll 4
  for (int i = 0; i < 8; ++i) {
    int nr = ty + 8 * i;
    dst[(size_t)(n0 + nr) * K + k0 + tx] = f2bf(tile[tx * 65 + nr]);
  }
}

DI void convert_weights(const float* src, int K, int N, int Npad, u16* dst, const float* scale, char* smem) {
  const int tks = K / 64, tns = Npad / 64;
  for (int t = lbid(); t < tks * tns; t += gridDim.x) conv_tile(src, K, N, dst, scale, t / tns, t % tns, smem);
}

DI void prologue_phase(const Params& p, char* smem) {
  float* sc = (float*)smem;
  float* red = sc + 9 * 1024;
  const int tid = ltid();
  for (int i = tid; i < 9 * 1024; i += NTHR) {
    int j = i >> 10, k = i & 1023;
    float v = j < 8 ? p.c[j * 1024 + k] : p.c_ctx[k];
    sc[i] = v / (1.f + __expf(-v));
  }
  __syncthreads();
  for (int task = lbid(); task < DEPTH * 96; task += gridDim.x) {
    const int l = task / 96, n0 = (task % 96) * 64, nn = tid & 63, kq = tid >> 6;
    float acc[9];
#pragma unroll
    for (int j = 0; j < 9; ++j) acc[j] = 0.f;
    const float* w = p.w_ada + ((size_t)l * 1024 + kq * 128) * 6144 + n0 + nn;
    const float* scq = sc + kq * 128;
#pragma unroll 4
    for (int k = 0; k < 128; ++k) {
      float wv = w[(size_t)k * 6144];
#pragma unroll
      for (int j = 0; j < 9; ++j) acc[j] += scq[j * 1024 + k] * wv;
    }
#pragma unroll
    for (int j = 0; j < 9; ++j) red[(kq * 9 + j) * 64 + nn] = acc[j];
    __syncthreads();
    for (int idx = tid; idx < 576; idx += NTHR) {
      int j = idx >> 6, n2 = idx & 63;
      float s = p.b_ada[l * 6144 + n0 + n2];
#pragma unroll
      for (int q = 0; q < 8; ++q) s += red[(q * 9 + j) * 64 + n2];
      p.mod[(size_t)(l * 9 + j) * 6144 + n0 + n2] = s;
    }
    __syncthreads();
  }
  for (int i = lbid() * NTHR + tid; i < 4 * DEPTH * CNT_STRIDE; i += gridDim.x * NTHR) p.cnt[i] = 0;
  if (lbid() == gridDim.x - 1) {
    for (int i = tid; i < 64 * 16; i += NTHR) {
      int pos = i >> 4, j = i & 15;
      float inv_freq = exp2f(-(float)(2 * j) / 32.f * 13.287712379549449f);
      float ang = (float)pos * inv_freq;
      float k = rintf(ang * 0.15915494309189535f);
      float red2 = fmaf(-k, 6.2831854820251465f, ang);
      red2 = fmaf(-k, -1.7484555314695172e-07f, red2);
      p.ropetab[2 * i] = __cosf(red2);
      p.ropetab[2 * i + 1] = __sinf(red2);
    }
  }
}

DI void ew_row(const Params& p, int layer, int kind, int row, int lane) {
  const bool has_branch = !(kind == 0 && layer == 0);
  const bool src_in = (layer == 0 && kind <= 1);
  const bool store_x = has_branch;
  const int blayer = (kind == 1) ? layer : (kind == 0 ? layer - 1 : DEPTH - 1);
  const float* gpost = (kind == 1) ? p.g_post_mix + blayer * D : p.g_post_ff + (blayer < 0 ? 0 : blayer) * D;
  const int gate_off = (kind == 1) ? 2 * D : 5 * D;
  const float* gpre = (kind == 0) ? p.g_pre_mix + layer * D : p.g_pre_ff + (kind == 1 ? layer : 0) * D;
  const int shift_off = (kind == 0) ? 0 : 3 * D, scale_off = (kind == 0) ? D : 4 * D;
  const float* xl = src_in ? p.x : p.out;
  const float* xc = src_in ? p.ctx : p.xctx;
    const int b = row / SP, s = row - b * SP;
    const bool lat = s < SEQ;
    if ((kind == 2 || (kind == 1 && layer == DEPTH - 1)) && !lat) return;
    const size_t xoff = lat ? ((size_t)(b * SEQ + s) * D) : ((size_t)(b * CTX + s - SEQ) * D);
    const unsigned long long msk = lat ? ~0ull : 0ull;
    const float* xs = (const float*)(((unsigned long long)xl & msk) | ((unsigned long long)xc & ~msk)) + xoff;
    float* xd = (float*)(((unsigned long long)p.out & msk) | ((unsigned long long)p.xctx & ~msk)) + xoff;
    const int mi = lat ? b : 8;
    f32x4 xv[4];
#pragma unroll
    for (int i = 0; i < 4; ++i) xv[i] = *(const f32x4*)(xs + lane * 4 + 256 * i);
    if (has_branch) {
      const float* modb = p.mod + (size_t)(blayer * 9 + mi) * 6144 + gate_off;
      f32x4 yv[4];
      const u16* ysrc = (kind == 1) ? p.Y : p.F;
#pragma unroll
      for (int i = 0; i < 4; ++i) {
        u32x2 w = *(const u32x2*)(ysrc + (size_t)row * D + lane * 4 + 256 * i);
        yv[i] = f32x4{bflo(w.x), bfhi(w.x), bflo(w.y), bfhi(w.y)};
      }
      float ss = 0.f;
#pragma unroll
      for (int i = 0; i < 4; ++i) ss += yv[i].x * yv[i].x + yv[i].y * yv[i].y + yv[i].z * yv[i].z + yv[i].w * yv[i].w;
      ss = wave_sum(ss);
      const float rstd = rsqrtf(ss * (1.f / D) + EPS);
#pragma unroll
      for (int i = 0; i < 4; ++i) {
        const int col = lane * 4 + 256 * i;
        f32x4 g = *(const f32x4*)(gpost + col);
        f32x4 gt = *(const f32x4*)(modb + col);
        xv[i].x += gt.x * (yv[i].x * rstd * g.x);
        xv[i].y += gt.y * (yv[i].y * rstd * g.y);
        xv[i].z += gt.z * (yv[i].z * rstd * g.z);
        xv[i].w += gt.w * (yv[i].w * rstd * g.w);
      }
      if (store_x) {
#pragma unroll
        for (int i = 0; i < 4; ++i) *(f32x4*)(xd + lane * 4 + 256 * i) = xv[i];
      }
    }
    if (kind != 2) {
      const float* modl = p.mod + (size_t)(layer * 9 + mi) * 6144;
      float ss = 0.f;
#pragma unroll
      for (int i = 0; i < 4; ++i) ss += xv[i].x * xv[i].x + xv[i].y * xv[i].y + xv[i].z * xv[i].z + xv[i].w * xv[i].w;
      ss = wave_sum(ss);
      const float rstd = rsqrtf(ss * (1.f / D) + EPS);
#pragma unroll
      for (int i = 0; i < 4; ++i) {
        const int col = lane * 4 + 256 * i;
        f32x4 g = *(const f32x4*)(gpre + col);
        f32x4 sh = *(const f32x4*)(modl + shift_off + col);
        f32x4 sc = *(const f32x4*)(modl + scale_off + col);
        float h0 = xv[i].x * rstd * g.x * (1.f + sc.x) + sh.x;
        float h1 = xv[i].y * rstd * g.y * (1.f + sc.y) + sh.y;
        float h2 = xv[i].z * rstd * g.z * (1.f + sc.z) + sh.z;
        float h3 = xv[i].w * rstd * g.w * (1.f + sc.w) + sh.w;
        u32x2 w;
        w.x = pack2(h0, h1);
        w.y = pack2(h2, h3);
        *(u32x2*)(p.H + (size_t)row * D + col) = w;
      }
    }
}

DI void ew_phase(const Params& p, int layer, int kind) {
  const int tid = ltid(), lane = tid & 63, wid = __builtin_amdgcn_readfirstlane(tid >> 6);
  for (int rg = lbid(); rg < T / 8; rg += gridDim.x) ew_row(p, layer, kind, rg * 8 + wid, lane);
}

DI void tile_done(int* cnt, int tm) {
  asm volatile("s_waitcnt vmcnt(0)" ::: "memory");
  __syncthreads();
  if (ltid() == 0) __hip_atomic_fetch_add(cnt + tm, 1, __ATOMIC_RELAXED, __HIP_MEMORY_SCOPE_AGENT);
}
template <class ConvF>
DI void ew_consume(const Params& p, int* cnt, int need, int layer, int kind, bool skip_ctx, int nconv, ConvF conv,
                   char* smem) {
  int* sh = (int*)(smem + SMEM_BYTES - 16);
  const int tid = ltid(), lane = tid & 63, wid = __builtin_amdgcn_readfirstlane(tid >> 6);
  for (;;) {
    __syncthreads();
    if (tid == 0) *sh = __hip_atomic_fetch_add(cnt + 136, 1, __ATOMIC_RELAXED, __HIP_MEMORY_SCOPE_AGENT);
    __syncthreads();
    const int q = *sh;
    if (q >= nconv + 544) break;
    if (q < nconv) { conv(q); continue; }
    const int c = q - nconv, mseq = c >> 2, j = mseq >> 3, bb = mseq & 7, tm = bb * 17 + j;
    if (skip_ctx && j == 16) continue;
    if (tid == 0) {
      while (__hip_atomic_load(cnt + tm, __ATOMIC_ACQUIRE, __HIP_MEMORY_SCOPE_AGENT) < need) __builtin_amdgcn_s_sleep(4);
    }
    __syncthreads();
    const int row0 = tm * 256 + (c & 3) * 64 + wid * 8;
#pragma unroll 1
    for (int i = 0; i < 8; ++i) ew_row(p, layer, kind, row0 + i, lane);
  }
}

DI void row_rstd(const u16* __restrict__ base, int ld, int ncols, int m0, float* rs) {
  const int tid = ltid(), row = tid >> 1, half = tid & 1;
  const int per = ncols / 2;
  const u16* ptr = base + (size_t)(m0 + row) * ld + half * per;
  float ss = 0.f;
  for (int i = 0; i < per; i += 8) {
    u32x4 v = *(const u32x4*)(ptr + i);
#pragma unroll
    for (int e = 0; e < 8; ++e) {
      float f = uw(v, e);
      ss += f * f;
    }
  }
  ss += __shfl_xor(ss, 1);
  if (half == 0) rs[row] = rsqrtf(ss / (float)ncols + EPS);
}

DI void qkv_tasks(const Params& p, char* smem, int qb, int qe, int kb_, int ke, int stp) {
  float* rs = (float*)(smem + 2 * 2 * 256 * 72 * 2);
  const int MT = T / 256;
  auto noT = [](int, int, u32x4) {};
  auto neverT = [](int) { return false; };
  for (int t = qb; t < qe; t += stp) {
    const int tm = t / 3, tn = t % 3, m0 = tm * 256;
    __syncthreads();
    row_rstd(p.P, NINP, 256, m0, rs);
    const bool lat = (m0 % SP) < SEQ;
    const int s0 = m0 % SP;
    gemm_tile<false>(
        p.P, NINP, p.wt_uq, 256, 256, m0, tn * 256, smem,
        [&](int mb, int nb, f32x16& acc, int r, int h) {
          const int rowl = mb - m0 + r;
          const float sc = rs[rowl];
#pragma unroll
          for (int e = 0; e < 16; ++e) acc[e] *= sc;
          const int cb = nb % 192;
          if (lat && cb >= 128) {
            const int s = s0 + rowl;
            const int pos = (cb == 128) ? (s >> 6) : (s & 63);
#pragma unroll
            for (int e = 0; e < 8; ++e) {
              const int j = crow(e, h);
              const float cs = p.ropetab[2 * (pos * 16 + j)], sn = p.ropetab[2 * (pos * 16 + j) + 1];
              const float x1 = acc[e], x2 = acc[e + 8];
              acc[e] = x1 * cs - x2 * sn;
              acc[e + 8] = x1 * sn + x2 * cs;
            }
          }
        },
        [&](int row, int col, u32x4 v) { *(u32x4*)(p.Q + (size_t)row * 768 + col) = v; }, noT, neverT);
  }
  for (int t = kb_; t < ke; t += stp) {
    const int tm = t / 4, tn = t % 4, m0 = tm * 256;
    const int b = m0 / SP, s0 = m0 % SP;
    const bool lat = s0 < SEQ;
    __syncthreads();
    row_rstd(p.P + 256, NINP, 128, m0, rs);
    if (tn == 0) {
      for (int idx = ltid(); idx < 256 * 32; idx += NTHR) {
        const int rowl = idx >> 5, q = idx & 31, blk = q >> 4, j = q & 15;
        const u16* src = p.P + (size_t)(m0 + rowl) * NINP + 384 + blk * 32 + j;
        float x1 = bf2f(src[0]), x2 = bf2f(src[16]);
        float o1 = x1, o2 = x2;
        if (lat) {
          const int s = s0 + rowl;
          const int pos = blk == 0 ? (s >> 6) : (s & 63);
          const float cs = p.ropetab[2 * (pos * 16 + j)], sn = p.ropetab[2 * (pos * 16 + j) + 1];
          o1 = x1 * cs - x2 * sn;
          o2 = x1 * sn + x2 * cs;
        }
        u16* dst = p.Kr + (size_t)(m0 + rowl) * 64 + blk * 32 + j;
        dst[0] = f2bf(o1);
        dst[16] = f2bf(o2);
      }
    }
    const int n0 = tn * 256;
    u16* vbase = p.Vt + (size_t)(b * 4 + tn) * 128 * SP + s0;
    gemm_tile<true>(
        p.P + 256, NINP, p.wt_ukv, 128, 128, m0, n0, smem,
        [&](int mb, int nb, f32x16& acc, int r, int h) {
          const float sc = rs[mb - m0 + r];
#pragma unroll
          for (int e = 0; e < 16; ++e) acc[e] *= sc;
        },
        [&](int row, int col, u32x4 v) { *(u32x4*)(p.Kn + (size_t)row * 512 + tn * 128 + (col - n0)) = v; },
        [&](int col, int row, u32x4 v) { *(u32x4*)(vbase + (size_t)(col - n0 - 128) * SP + (row - m0)) = v; },
        [](int wn) { return wn >= 2; });
  }
}

DI void cm_tasks(const Params& p, int layer, char* smem, int tb, int te, int stp) {
  const int ftid = ltid(), vb = ftid >> 8, tid = ftid & 255;
  u16* vnT = (u16*)(smem + vb * VSMEM);
  const int lane = tid & 63, wid = tid >> 6, r = lane & 31, h = lane >> 5;
  const float* gn = p.cm_norm_g + layer * 256;
  const float* bs = p.cm_b_s + layer * 512;
  for (int t0 = tb; t0 < te; t0 += stp) {
    const int task = t0 + vb;
    const int row0 = task * 128;
    __syncthreads();
#pragma unroll 4
    for (int i = 0; i < 32; ++i) {
      const int s = wid * 32 + i;
      const u16* src = p.P + (size_t)(row0 + s) * NINP + 704;
      float v[4];
      float sum = 0.f;
#pragma unroll
      for (int q = 0; q < 4; ++q) {
        v[q] = gelu_f(bf2f(src[lane + 64 * q]));
        sum += v[q];
      }
      const float mean = wave_sum(sum) * (1.f / 256.f);
      float var = 0.f;
#pragma unroll
      for (int q = 0; q < 4; ++q) {
        v[q] -= mean;
        var += v[q] * v[q];
      }
      const float rstd = rsqrtf(wave_sum(var) * (1.f / 256.f) + EPS);
#pragma unroll
      for (int q = 0; q < 4; ++q) vnT[(lane + 64 * q) * 136 + s] = f2bf(v[q] * rstd * gn[lane + 64 * q]);
    }
    __syncthreads();
    const int t = wid * 32 + r;
    for (int g = 0; g < 4; ++g) {
      bf16x8 wf[8];
#pragma unroll
      for (int kk = 0; kk < 8; ++kk) wf[kk] = *(const bf16x8*)(p.wsb + ((size_t)(g * 128 + t)) * 128 + kk * 16 + h * 8);
      const float bias = bs[g * 128 + t];
#pragma unroll
      for (int cb = 0; cb < 2; ++cb) {
        f32x16 acc;
#pragma unroll
        for (int e = 0; e < 16; ++e) acc[e] = 0.f;
#pragma unroll
        for (int kk = 0; kk < 8; ++kk) {
          bf16x8 a = *(const bf16x8*)(vnT + (g * 64 + cb * 32 + r) * 136 + kk * 16 + h * 8);
          acc = MFMA(a, wf[kk], acc);
        }
#pragma unroll
        for (int q4 = 0; q4 < 4; ++q4) {
          const int ch0 = g * 64 + cb * 32 + 8 * q4 + 4 * h;
          u32x2 uwd = *(const u32x2*)(p.P + (size_t)(row0 + t) * NINP + 448 + ch0);
          float u0 = gelu_f(bflo(uwd.x)), u1 = gelu_f(bfhi(uwd.x)), u2 = gelu_f(bflo(uwd.y)), u3 = gelu_f(bfhi(uwd.y));
          u32x2 w;
          w.x = pack2(u0 * (acc[4 * q4] + bias), u1 * (acc[4 * q4 + 1] + bias));
          w.y = pack2(u2 * (acc[4 * q4 + 2] + bias), u3 * (acc[4 * q4 + 3] + bias));
          *(u32x2*)(p.H + (size_t)(row0 + t) * D + 512 + ch0) = w;
        }
      }
    }
  }
}

struct ConvW { f32x4 w0a, w0b, w1a, w1b, w2a, w2b, ba, bb; };
DI ConvW load_convw(const Params& p, int layer, int ch) {
  const float* cw = p.conv_w + (size_t)layer * 3 * 768 + ch;
  const float* cb = p.conv_b + layer * 768 + ch;
  ConvW c;
  c.w0a = *(const f32x4*)(cw); c.w0b = *(const f32x4*)(cw + 4);
  c.w1a = *(const f32x4*)(cw + 768); c.w1b = *(const f32x4*)(cw + 772);
  c.w2a = *(const f32x4*)(cw + 1536); c.w2b = *(const f32x4*)(cw + 1540);
  c.ba = *(const f32x4*)(cb); c.bb = *(const f32x4*)(cb + 4);
  return c;
}
DI float convw_get(const f32x4& a, const f32x4& b, int e) { return e < 4 ? a[e & 3] : b[e & 3]; }
DI void conv8(const Params& p, const ConvW& c, int row, int ch, bool hasPrev, bool hasNext, float out[8]) {
  const u16* base = p.P + (size_t)row * NINP + 1216 + ch;
  u32x4 cur = *(const u32x4*)base;
  u32x4 prv = *(const u32x4*)(base - (hasPrev ? NINP : 0));
  u32x4 nxt = *(const u32x4*)(base + (hasNext ? NINP : 0));
  const float mp = hasPrev ? 1.f : 0.f, mn = hasNext ? 1.f : 0.f;
#pragma unroll
  for (int e = 0; e < 8; ++e) {
    float y = convw_get(c.w0a, c.w0b, e) * (mp * uw(prv, e)) + convw_get(c.w1a, c.w1b, e) * uw(cur, e) +
              convw_get(c.w2a, c.w2b, e) * (mn * uw(nxt, e)) + convw_get(c.ba, c.bb, e);
    out[e] = silu_f(y);
  }
}

template <int RPT, class F>
DI void conv_stage(const Params& p, int layer, int row0, int chbase, int cp, int tb, bool cPrev, bool cNext, F emit) {
  const ConvW c = load_convw(p, layer, chbase + cp * 8);
  const int r0 = tb * RPT;
  const bool hp = cPrev || r0 > 0, hn = cNext || (r0 + RPT) < 128;
  const u16* base = p.P + (size_t)(row0 + r0) * NINP + 1216 + chbase + cp * 8;
  u32x4 raw[RPT + 2];
  raw[0] = *(const u32x4*)(base - (hp ? NINP : 0));
#pragma unroll
  for (int k = 0; k < RPT; ++k) raw[k + 1] = *(const u32x4*)(base + (size_t)k * NINP);
  raw[RPT + 1] = *(const u32x4*)(base + (size_t)(hn ? RPT : RPT - 1) * NINP);
  const float mp = hp ? 1.f : 0.f, mn = hn ? 1.f : 0.f;
#pragma unroll
  for (int i = 0; i < RPT; ++i) {
    const float fp = (i == 0) ? mp : 1.f, fn = (i == RPT - 1) ? mn : 1.f;
    float v[8];
#pragma unroll
    for (int e = 0; e < 8; ++e) {
      float y = convw_get(c.w0a, c.w0b, e) * (fp * uw(raw[i], e)) + convw_get(c.w1a, c.w1b, e) * uw(raw[i + 1], e) +
                convw_get(c.w2a, c.w2b, e) * (fn * uw(raw[i + 2], e)) + convw_get(c.ba, c.bb, e);
      v[e] = silu_f(y);
    }
    emit(r0 + i, v);
  }
}

DI void ssd_dt_arrays(const Params& p, int layer, int row0, int hh, int t, float* arr) {
  float* dt0 = arr;
  float* dt1 = arr + 128;
  float* c0 = arr + 256;
  float* s1 = arr + 384;
  float* a0 = arr + 512;
  float* a1 = arr + 640;
  const float d0 = softplus_f(p.dtraw[(size_t)(row0 + t) * 8 + hh] + p.dt_bias[layer * 8 + hh]);
  const float d1 = softplus_f(p.dtraw[(size_t)(row0 + t) * 8 + 4 + hh] + p.dt_bias[layer * 8 + 4 + hh]);
  dt0[t] = d0;
  dt1[t] = d1;
  a0[t] = -d0 * __expf(p.a_log[layer * 8 + hh]);
  a1[t] = -d1 * __expf(p.a_log[layer * 8 + 4 + hh]);
}
DI float wave_incl_prefix(float x, int lane) {
#pragma unroll
  for (int o = 1; o < 64; o <<= 1) {
    float y = __shfl_up(x, o);
    if (lane >= o) x += y;
  }
  return x;
}
DI void ssd_cum_arrays(int t, float* arr) {
  float* c0 = arr + 256;
  float* s1 = arr + 384;
  const float* a0 = arr + 512;
  const float* a1 = arr + 640;
  const int lane = t & 63, w = t >> 6;
  const float x0 = a0[t], o0 = a0[t ^ 64], x1 = a1[t], o1 = a1[t ^ 64];
  const float tot_o0 = wave_sum(o0), tot_o1 = wave_sum(o1), tot_x1 = wave_sum(x1);
  float p0 = wave_incl_prefix(x0, lane);
  float p1 = wave_incl_prefix(x1, lane);
  if (w == 1) p0 += tot_o0;
  float sf = tot_x1 - p1 + x1;
  if (w == 0) sf += tot_o1;
  c0[t] = p0;
  s1[t] = sf;
}

DI void ssd_s1_tasks(const Params& p, int layer, char* smem, int tb, int te, int stp) {
  const int ftid = ltid(), vb = ftid >> 8, tid = ftid & 255;
  u16* xsT0 = (u16*)(smem + vb * VSMEM);
  u16* xsT1 = xsT0 + 64 * 136;
  u16* BT = xsT1 + 64 * 136;
  float* arr = (float*)(BT + 128 * 136);
  float* w0 = arr + 768;
  float* w1 = w0 + 128;
  const int lane = tid & 63, wid = tid >> 6, r = lane & 31, h = lane >> 5;
  for (int t0 = tb; t0 < te; t0 += stp) {
    const int task = t0 + vb;
    const int hh = task & 3, bc = task >> 2, c = bc % NCH, b = bc / NCH;
    const int g = hh >> 1;
    const int row0 = bc * 128;
    const bool cPrev = (c != 0 && c != 32), cNext = (c != 31 && c != 33);
    __syncthreads();
    if (tid < 128) ssd_dt_arrays(p, layer, row0, hh, tid, arr);
    __syncthreads();
    if (tid < 128) ssd_cum_arrays(tid, arr);
    __syncthreads();
    if (tid < 128) {
      const float* dt0 = arr;
      const float* dt1 = arr + 128;
      const float* c0 = arr + 256;
      const float* s1 = arr + 384;
      w0[tid] = __expf(c0[127] - c0[tid]) * dt0[tid];
      w1[tid] = __expf(s1[0] - s1[tid]) * dt1[tid];
      if (tid == 0) {
        p.atot[((size_t)bc * 2 + 0) * 4 + hh] = c0[127];
        p.atot[((size_t)bc * 2 + 1) * 4 + hh] = s1[0];
      }
    }
    __syncthreads();
    conv_stage<4>(p, layer, row0, hh * 64, tid & 7, tid >> 3, cPrev, cNext, [&](int t, const float (&v)[8]) {
      const float f0 = w0[t], f1 = w1[t];
      const int cp = tid & 7;
#pragma unroll
      for (int e = 0; e < 8; ++e) {
        xsT0[(cp * 8 + e) * 136 + t] = f2bf(v[e] * f0);
        xsT1[(cp * 8 + e) * 136 + t] = f2bf(v[e] * f1);
      }
    });
    conv_stage<8>(p, layer, row0, 256 + g * 128, tid & 15, tid >> 4, cPrev, cNext, [&](int t, const float (&v)[8]) {
      const int cp = tid & 15;
#pragma unroll
      for (int e = 0; e < 8; ++e) BT[(cp * 8 + e) * 136 + t] = f2bf(v[e]);
    });
    __syncthreads();
#pragma unroll
    for (int d = 0; d < 2; ++d) {
      const u16* xsT = d ? xsT1 : xsT0;
#pragma unroll
      for (int pb = 0; pb < 2; ++pb) {
        f32x16 acc;
#pragma unroll
        for (int e = 0; e < 16; ++e) acc[e] = 0.f;
#pragma unroll
        for (int kk = 0; kk < 8; ++kk) {
          bf16x8 a = *(const bf16x8*)(xsT + (pb * 32 + r) * 136 + kk * 16 + h * 8);
          bf16x8 bb = *(const bf16x8*)(BT + (wid * 32 + r) * 136 + kk * 16 + h * 8);
          acc = MFMA(a, bb, acc);
        }
        float* dst = p.CS + ((((size_t)bc * 2 + d) * 4 + hh) * 64 + pb * 32) * 128 + wid * 32 + r;
#pragma unroll
        for (int e = 0; e < 16; ++e) dst[(size_t)crow(e, h) * 128] = acc[e];
      }
    }
  }
}

DI void ssd_scan_phase(const Params& p) {
  const int total = NB * 2 * 4 * 8192;
  for (int idx = lbid() * NTHR + ltid(); idx < total; idx += gridDim.x * NTHR) {
    const int e = idx & 8191, hh = (idx >> 13) & 3, d = (idx >> 15) & 1, b = idx >> 16;
    float st = 0.f;
#pragma unroll 2
    for (int i = 0; i < NCH; ++i) {
      int c;
      if (d == 0) c = i < 2 ? 32 + i : i - 2;
      else c = i < 2 ? 33 - i : 33 - i;
      const size_t bc = (size_t)b * NCH + c;
      float* ptr = p.CS + ((bc * 2 + d) * 4 + hh) * 8192 + e;
      const float v = *ptr;
      const float dec = __expf(p.atot[(bc * 2 + d) * 4 + hh]);
      *ptr = st;
      st = dec * st + v;
    }
  }
}

template <int G>
DI float ssd_s3_group(const Params& p, int layer, int bc, bool cPrev, bool cNext, u16* Bg, u16* xsT, float* arr, int tid) {
  f32x16 y[4];
#pragma unroll
  for (int i = 0; i < 4; ++i)
#pragma unroll
    for (int e = 0; e < 16; ++e) y[i][e] = 0.f;
  const int lane = tid & 63, wid = tid >> 6, r = lane & 31, h = lane >> 5;
  const int l = wid * 32 + r;
  const int row0 = bc * 128;
  __syncthreads();
  ssd_dt_arrays(p, layer, row0, 2 * G + (tid >> 7), tid & 127, arr + (tid >> 7) * 768);
  const ConvW cwc = load_convw(p, layer, 512 + G * 128 + (tid & 15) * 8);
#pragma unroll 1
  for (int i = 0; i < 8; ++i) {
    const int id = tid + VT * i, t = id >> 4, cp = id & 15;
    float v[8];
    conv8(p, cwc, row0 + t, 512 + G * 128 + cp * 8, cPrev || t > 0, cNext || t < 127, v);
    *(bf16x8*)(Bg + t * 136 + cp * 8) = pack8(v[0], v[1], v[2], v[3], v[4], v[5], v[6], v[7]);
  }
  const ConvW cwx = load_convw(p, layer, G * 128 + (tid & 15) * 8);
#pragma unroll 1
  for (int i = 0; i < 8; ++i) {
    const int id = tid + VT * i, t = id >> 4, cp = id & 15;
    float v[8];
    conv8(p, cwx, row0 + t, G * 128 + cp * 8, cPrev || t > 0, cNext || t < 127, v);
#pragma unroll
    for (int e = 0; e < 8; ++e) xsT[(cp * 8 + e) * 136 + t] = f2bf(v[e]);
  }
  __syncthreads();
  ssd_cum_arrays(tid & 127, arr + (tid >> 7) * 768);
  bf16x8 cf[8];
#pragma unroll
  for (int kk = 0; kk < 8; ++kk) cf[kk] = *(const bf16x8*)(Bg + l * 136 + kk * 16 + h * 8);
  __syncthreads();
  const ConvW cwb = load_convw(p, layer, 256 + G * 128 + (tid & 15) * 8);
#pragma unroll 1
  for (int i = 0; i < 8; ++i) {
    const int id = tid + VT * i, t = id >> 4, cp = id & 15;
    float v[8];
    conv8(p, cwb, row0 + t, 256 + G * 128 + cp * 8, cPrev || t > 0, cNext || t < 127, v);
    *(bf16x8*)(Bg + t * 136 + cp * 8) = pack8(v[0], v[1], v[2], v[3], v[4], v[5], v[6], v[7]);
  }
  __syncthreads();
  float ss = 0.f;
#pragma unroll 1
  for (int hd2 = 0; hd2 < 2; ++hd2) {
    const int hh = 2 * G + hd2;
    const float* ah = arr + hd2 * 768;
    const float c0l = ah[256 + l], s1l = ah[384 + l];
    f32x16 y[2];
#pragma unroll
    for (int i = 0; i < 2; ++i)
#pragma unroll
      for (int e = 0; e < 16; ++e) y[i][e] = 0.f;
#pragma unroll 1
    for (int sb = 0; sb < 4; ++sb) {
      f32x16 gt;
#pragma unroll
      for (int e = 0; e < 16; ++e) gt[e] = 0.f;
#pragma unroll
      for (int kk = 0; kk < 8; ++kk) {
        bf16x8 a = *(const bf16x8*)(Bg + (sb * 32 + r) * 136 + kk * 16 + h * 8);
        gt = MFMA(a, cf[kk], gt);
      }
      f32x16 wv;
      if (sb != wid) {
        const float ref = sb < wid ? c0l : s1l;
        const float* cumv = ah + (sb < wid ? 256 : 384) + sb * 32 + 4 * h;
        const float* dtv = ah + (sb < wid ? 0 : 128) + sb * 32 + 4 * h;
#pragma unroll
        for (int q4 = 0; q4 < 4; ++q4) {
          const f32x4 cv = *(const f32x4*)(cumv + 8 * q4), dv = *(const f32x4*)(dtv + 8 * q4);
#pragma unroll
          for (int k = 0; k < 4; ++k) wv[4 * q4 + k] = gt[4 * q4 + k] * (__expf(ref - cv[k]) * dv[k]);
        }
      } else {
#pragma unroll
        for (int q4 = 0; q4 < 4; ++q4) {
          const int s4 = sb * 32 + 8 * q4 + 4 * h;
          const f32x4 c0v = *(const f32x4*)(ah + 256 + s4), d0v = *(const f32x4*)(ah + s4);
          const f32x4 s1v = *(const f32x4*)(ah + 384 + s4), d1v = *(const f32x4*)(ah + 128 + s4);
#pragma unroll
          for (int k = 0; k < 4; ++k) {
            const int s = s4 + k;
            const float a0 = (l >= s) ? (c0l - c0v[k]) : -1e30f;
            const float a1 = (l <= s) ? (s1l - s1v[k]) : -1e30f;
            wv[4 * q4 + k] = gt[4 * q4 + k] * (__expf(a0) * d0v[k] + __expf(a1) * d1v[k]);
          }
          __builtin_amdgcn_sched_barrier(0);
        }
      }
      bf16x8 wp0 = pack8(wv[0], wv[1], wv[2], wv[3], wv[4], wv[5], wv[6], wv[7]);
      bf16x8 wp1 = pack8(wv[8], wv[9], wv[10], wv[11], wv[12], wv[13], wv[14], wv[15]);
#pragma unroll
      for (int pb = 0; pb < 2; ++pb) {
        const u16* xrow = xsT + (hd2 * 64 + pb * 32 + r) * 136 + sb * 32 + 4 * h;
        s16x4 lo0 = *(const s16x4*)(xrow), hi0 = *(const s16x4*)(xrow + 8);
        s16x4 lo1 = *(const s16x4*)(xrow + 16), hi1 = *(const s16x4*)(xrow + 24);
        bf16x8 a0 = __builtin_shufflevector(lo0, hi0, 0, 1, 2, 3, 4, 5, 6, 7);
        bf16x8 a1 = __builtin_shufflevector(lo1, hi1, 0, 1, 2, 3, 4, 5, 6, 7);
        y[pb] = MFMA(a0, wp0, y[pb]);
        y[pb] = MFMA(a1, wp1, y[pb]);
      }
    }
#pragma unroll 1
    for (int d = 0; d < 2; ++d) {
      const float el = __expf(d == 0 ? c0l : s1l);
#pragma unroll
      for (int pb = 0; pb < 2; ++pb) {
        const float* srow = p.CS + ((((size_t)bc * 2 + d) * 4 + hh) * 64 + pb * 32 + r) * 128 + h * 8;
        f32x16 tmp;
#pragma unroll
        for (int e = 0; e < 16; ++e) tmp[e] = 0.f;
#pragma unroll
        for (int kk = 0; kk < 8; ++kk) {
          f32x4 s0 = *(const f32x4*)(srow + kk * 16), s1 = *(const f32x4*)(srow + kk * 16 + 4);
          bf16x8 a = pack8(s0.x, s0.y, s0.z, s0.w, s1.x, s1.y, s1.z, s1.w);
          tmp = MFMA(a, cf[kk], tmp);
        }
#pragma unroll
        for (int e = 0; e < 16; ++e) y[pb][e] += el * tmp[e];
      }
    }
    const float dsk = p.ssd_d[layer * 8 + hh] + p.ssd_d[layer * 8 + 4 + hh];
#pragma unroll
    for (int pb = 0; pb < 2; ++pb) {
#pragma unroll
      for (int q4 = 0; q4 < 4; ++q4) {
        const int cl = hd2 * 64 + pb * 32 + 8 * q4 + 4 * h;
        const int ch0 = G * 128 + cl;
        u32x2 zw = *(const u32x2*)(p.P + (size_t)(row0 + l) * NINP + 960 + ch0);
        f32x4 o;
        o.x = (y[pb][4 * q4] + dsk * bf2f(xsT[(cl + 0) * 136 + l])) * silu_f(bflo(zw.x));
        o.y = (y[pb][4 * q4 + 1] + dsk * bf2f(xsT[(cl + 1) * 136 + l])) * silu_f(bfhi(zw.x));
        o.z = (y[pb][4 * q4 + 2] + dsk * bf2f(xsT[(cl + 2) * 136 + l])) * silu_f(bflo(zw.y));
        o.w = (y[pb][4 * q4 + 3] + dsk * bf2f(xsT[(cl + 3) * 136 + l])) * silu_f(bfhi(zw.y));
        ss += o.x * o.x + o.y * o.y + o.z * o.z + o.w * o.w;
        *(f32x4*)(p.ytmp + (size_t)(row0 + l) * 256 + ch0) = o;
      }
    }
  }
  return ss;
}

DI void ssd_s3_tasks(const Params& p, int layer, char* smem) {
  const int ftid = ltid(), vb = ftid >> 8, tid = ftid & 255;
  u16* Bg = (u16*)(smem + vb * VSMEM);
  u16* xsT = Bg + 128 * 136;
  float* arr = (float*)(xsT + 128 * 136);
  const int lane = tid & 63, wid = tid >> 6, r = lane & 31, h = lane >> 5;
  const int l = wid * 32 + r;
  for (int t0 = lbid() * 2; t0 < NB * NCH; t0 += gridDim.x * 2) {
    const int bc = t0 + vb, c = bc % NCH;
    const int row0 = bc * 128;
    const bool cPrev = (c != 0 && c != 32), cNext = (c != 31 && c != 33);
    float ss = ssd_s3_group<0>(p, layer, bc, cPrev, cNext, Bg, xsT, arr, tid);
    ss += ssd_s3_group<1>(p, layer, bc, cPrev, cNext, Bg, xsT, arr, tid);
    ss += __shfl_xor(ss, 32);
    const float rstd = rsqrtf(ss * (1.f / 256.f) + EPS);
    const float* gn = p.ssd_norm_g + layer * 256;
#pragma unroll 4
    for (int i = 0; i < 32; ++i) {
      const int ch0 = (i >> 2) * 32 + 8 * (i & 3) + 4 * h;
      f32x4 v = *(const f32x4*)(p.ytmp + (size_t)(row0 + l) * 256 + ch0);
      f32x4 gv = *(const f32x4*)(gn + ch0);
      u32x2 w;
      w.x = pack2(v.x * rstd * gv.x, v.y * rstd * gv.y);
      w.y = pack2(v.z * rstd * gv.z, v.w * rstd * gv.w);
      *(u32x2*)(p.H + (size_t)(row0 + l) * D + 768 + ch0) = w;
    }
  }
}

constexpr int QREG = 12;
DI void attn_qk(const u16* Ks, const bf16x8 (&qf)[QREG], const u16* qs, f32x16 (&st)[2], int r, int h) {
#pragma unroll
  for (int kb = 0; kb < 2; ++kb)
#pragma unroll
    for (int e = 0; e < 16; ++e) st[kb][e] = 0.f;
  const u16* kp = Ks + r * 200 + h * 8;
#pragma unroll
  for (int kk = 0; kk < 12; ++kk) {
    bf16x8 k0 = *(const bf16x8*)(kp + kk * 16);
    bf16x8 k1 = *(const bf16x8*)(kp + 32 * 200 + kk * 16);
    bf16x8 q;
    if (kk < QREG) q = qf[kk];
    else q = *(const bf16x8*)(qs + (kk - QREG) * 512);
    st[0] = MFMA(k0, q, st[0]);
    st[1] = MFMA(k1, q, st[1]);
  }
}
DI void attn_softmax(f32x16 (&st)[2], f32x16 (&o)[4], bf16x8 (&pf)[4], float& m_run, float& l_run, float sc) {
  float mx = st[0][0];
#pragma unroll
  for (int kb = 0; kb < 2; ++kb)
#pragma unroll
    for (int e = 0; e < 16; ++e) mx = fmaxf(mx, st[kb][e]);
  mx = fmaxf(mx, __shfl_xor(mx, 32));
  const float m_new = fmaxf(m_run, mx * sc);
  const float alpha = __builtin_amdgcn_exp2f(m_run - m_new);
  m_run = m_new;
  float ls = 0.f;
#pragma unroll
  for (int kb = 0; kb < 2; ++kb)
#pragma unroll
    for (int e = 0; e < 16; ++e) {
      float pv = __builtin_amdgcn_exp2f(fmaf(st[kb][e], sc, -m_new));
      ls += pv;
      st[kb][e] = pv;
    }
  l_run = l_run * alpha + ls;
  if (__builtin_amdgcn_ballot_w64(alpha != 1.f) != 0ull) {
#pragma unroll
    for (int i = 0; i < 4; ++i)
#pragma unroll
      for (int e = 0; e < 16; ++e) o[i][e] *= alpha;
  }
#pragma unroll
  for (int ks = 0; ks < 4; ++ks) {
    const int kb = ks >> 1, s2 = ks & 1;
    pf[ks] = pack8(st[kb][8 * s2], st[kb][8 * s2 + 1], st[kb][8 * s2 + 2], st[kb][8 * s2 + 3], st[kb][8 * s2 + 4],
                   st[kb][8 * s2 + 5], st[kb][8 * s2 + 6], st[kb][8 * s2 + 7]);
  }
}
DI void attn_pv(const u16* Vs, const bf16x8 (&pf)[4], f32x16 (&o)[4], int r, int h) {
#pragma unroll
  for (int ks = 0; ks < 4; ++ks) {
#pragma unroll
    for (int db = 0; db < 4; ++db) {
      bf16x8 a = *(const bf16x8*)(Vs + (db * 32 + r) * 72 + ks * 16 + 8 * h);
      o[db] = MFMA(a, pf[ks], o[db]);
    }
  }
}

DI void attn_tasks(const Params& p, char* smem) {
  u16* Ks0 = (u16*)smem;
  u16* Vs0 = Ks0 + 2 * 64 * 200;
  const int tid = ltid(), lane = tid & 63, wid = __builtin_amdgcn_readfirstlane(tid >> 6), r = lane & 31, h = lane >> 5;
  u16* qs = Vs0 + 2 * 128 * 72 + wid * ((12 - QREG) * 512) + lane * 8;
  const float sc = 0.07216878364870322f * 1.4426950408889634f;
  for (int task = lbid(); task < NB * 4 * 17; task += gridDim.x) {
    int b, hd, qt;
    if (task < 512) {
      qt = task & 15; hd = (task >> 4) & 3; b = task >> 6;
    } else {
      const int t2 = task - 512;
      qt = 16; hd = t2 & 3; b = t2 >> 2;
    }
    const int koff = (qt < 16) ? 0 : SEQ;
    const int nkt = ((qt < 16) ? SP : CTX) / 64;
    const int qrow = b * SP + qt * 256 + wid * 32 + r;
    bf16x8 qf[QREG];
#pragma unroll
    for (int kk = 0; kk < QREG; ++kk) qf[kk] = *(const bf16x8*)(p.Q + (size_t)qrow * 768 + hd * 192 + kk * 16 + h * 8);
#pragma unroll
    for (int kk = QREG; kk < 12; ++kk)
      *(bf16x8*)(qs + (kk - QREG) * 512) = *(const bf16x8*)(p.Q + (size_t)qrow * 768 + hd * 192 + kk * 16 + h * 8);
    f32x16 o[4];
#pragma unroll
    for (int i = 0; i < 4; ++i)
#pragma unroll
      for (int e = 0; e < 16; ++e) o[i][e] = 0.f;
    float m_run = -1e30f, l_run = 0.f;
    u32x4 kn[2], kr[1], vv[2];
    const u16* knb = p.Kn + ((size_t)(b * SP + koff) + (tid >> 4)) * 512 + hd * 128 + (tid & 15) * 8;
    const u16* krb = p.Kr + ((size_t)(b * SP + koff) + (tid >> 3)) * 64 + (tid & 7) * 8;
    const u16* vb = p.Vt + ((size_t)(b * 4 + hd) * 128 + (tid >> 3)) * SP + koff + (tid & 7) * 8;
#define ALOAD(ko_)                                                                               \
  {                                                                                              \
    _Pragma("unroll") for (int i = 0; i < 2; ++i) kn[i] = *(const u32x4*)(knb + ((ko_) + 32 * i) * 512); \
    kr[0] = *(const u32x4*)(krb + (ko_) * 64);                                                   \
    _Pragma("unroll") for (int i = 0; i < 2; ++i) vv[i] = *(const u32x4*)(vb + (size_t)(64 * i) * SP + (ko_)); \
  }
#define AWRITE(buf_)                                                                             \
  {                                                                                              \
    u16* Kw = Ks0 + (buf_) * (64 * 200);                                                         \
    u16* Vw = Vs0 + (buf_) * (128 * 72);                                                         \
    _Pragma("unroll") for (int i = 0; i < 2; ++i) *(u32x4*)(Kw + ((tid >> 4) + 32 * i) * 200 + (tid & 15) * 8) = kn[i]; \
    *(u32x4*)(Kw + (tid >> 3) * 200 + 128 + (tid & 7) * 8) = kr[0];                              \
    _Pragma("unroll") for (int i = 0; i < 2; ++i) {                                              \
      u16* dst = Vw + ((tid >> 3) + 64 * i) * 72 + ((tid & 7) >> 1) * 16 + ((tid & 7) & 1) * 4;  \
      *(u32x2*)dst = u32x2{vv[i].x, vv[i].y};                                                    \
      *(u32x2*)(dst + 8) = u32x2{vv[i].z, vv[i].w};                                              \
    }                                                                                            \
  }
    ALOAD((size_t)0);
    AWRITE(0);
    ALOAD((size_t)64);
    for (int kt = 0; kt < nkt; ++kt) {
      __syncthreads();
      if (kt + 1 < nkt) AWRITE((kt + 1) & 1);
      {
        const size_t ko = (size_t)(kt + 2 < nkt ? kt + 2 : nkt - 1) * 64;
        ALOAD(ko);
      }
      __builtin_amdgcn_sched_barrier(0);
      f32x16 st[2];
      bf16x8 pf[4];
      attn_qk(Ks0 + (kt & 1) * (64 * 200), qf, qs, st, r, h);
      attn_softmax(st, o, pf, m_run, l_run, sc);
      attn_pv(Vs0 + (kt & 1) * (128 * 72), pf, o, r, h);
    }
#undef ALOAD
#undef AWRITE
    const float ltot = l_run + __shfl_xor(l_run, 32);
    const float inv = 1.f / ltot;
    u16* orow = p.H + (size_t)qrow * D + hd * 128;
#pragma unroll
    for (int db = 0; db < 4; ++db)
#pragma unroll
      for (int q4 = 0; q4 < 4; ++q4) {
        u32x2 w;
        w.x = pack2(o[db][4 * q4] * inv, o[db][4 * q4 + 1] * inv);
        w.y = pack2(o[db][4 * q4 + 2] * inv, o[db][4 * q4 + 3] * inv);
        *(u32x2*)(orow + db * 32 + 8 * q4 + 4 * h) = w;
      }
  }
}

constexpr int NPHASE = 2 + DEPTH * 6;

DI void conv_item_ffn(const Params& p, int layer, int q, char* smem) {
#pragma unroll 1
  for (int u = 0; u < 8; ++u) {
    const int tile = q * 8 + u;
    if (tile < 1024) conv_tile(p.w_ff1 + (size_t)layer * D * DFF, D, DFF, p.wt_ff1, nullptr, tile >> 6, tile & 63, smem);
    else conv_tile(p.w_ff2 + (size_t)layer * DFF * D, DFF, D, p.wt_ff2, nullptr, (tile - 1024) >> 4, (tile - 1024) & 15, smem);
  }
}
DI void conv_item_mix(const Params& p, int layer, int q, char* smem) {
#pragma unroll 1
  for (int u = 0; u < 8; ++u) {
    int tile = q * 8 + u;
    if (tile < 512) { conv_tile(p.w_in + (size_t)layer * D * NIN, D, NIN, p.wt_in, nullptr, tile >> 5, tile & 31, smem); continue; }
    tile -= 512;
    if (tile < 48) { conv_tile(p.w_uq + (size_t)layer * 256 * 768, 256, 768, p.wt_uq, p.g_q + layer * 256, tile / 12, tile % 12, smem); continue; }
    tile -= 48;
    if (tile < 32) { conv_tile(p.w_ukv + (size_t)layer * 128 * 1024, 128, 1024, p.wt_ukv, p.g_kv + layer * 128, tile >> 4, tile & 15, smem); continue; }
    tile -= 32;
    if (tile < 256) { conv_tile(p.w_out + (size_t)layer * D * D, D, D, p.wt_out, nullptr, tile >> 4, tile & 15, smem); continue; }
    tile -= 256;
    for (int i = ltid(); i < 4096; i += NTHR) p.wsb[tile * 4096 + i] = f2bf(p.cm_w_s[(size_t)layer * 65536 + tile * 4096 + i]);
  }
}

DI void run_phase(const Params& p, int ph, char* smem) {
  if (ph == 0) { prologue_phase(p, smem); return; }
  const int MT = T / 256;
  auto noT = [](int, int, u32x4) {};
  auto neverT = [](int) { return false; };
  if (ph == 1) {
    ew_phase(p, 0, 0);
    for (int q = lbid(); q < 108; q += gridDim.x) conv_item_mix(p, 0, q, smem);
    return;
  }
  const int layer = (ph - 2) / 6, sub = (ph - 2) % 6;
  const bool last = layer == DEPTH - 1;
  switch (sub) {
    case 0: {
      for (int it = 0;; ++it) {
        const int t = xcd_tile(it, MT * 8);
        if (t < 0) break;
        const int tm = t >> 3, tn = t & 7;
        gemm_tile<false>(
            p.H, D, p.wt_in, D, D, tm * 256, tn * 256, smem,
            [&](int mb, int nb, f32x16& acc, int r, int h) {
              if (nb == 1984) {
                f32x4 v = {acc[0], acc[1], acc[2], acc[3]};
                *(f32x4*)(p.dtraw + (size_t)(mb + r) * 8 + 4 * h) = v;
              }
            },
            [&](int row, int col, u32x4 v) { *(u32x4*)(p.P + (size_t)row * NINP + col) = v; }, noT, neverT);
      }
    } break;
    case 1: {
      int* wq = p.cnt + (2 * DEPTH + layer) * CNT_STRIDE;
      int* sh = (int*)(smem + SMEM_BYTES - 16);
      for (;;) {
        __syncthreads();
        if (ltid() == 0) *sh = __hip_atomic_fetch_add(wq, 1, __ATOMIC_RELAXED, __HIP_MEMORY_SCOPE_AGENT);
        __syncthreads();
        const int q = *sh;
        if (q >= 544 + 136 + 408 + 544) break;
        if (q < 544) ssd_s1_tasks(p, layer, smem, 2 * q, 2 * q + 1, 2);
        else if (q < 680) cm_tasks(p, layer, smem, 2 * (q - 544), 2 * (q - 544) + 1, 2);
        else if (q < 1088) qkv_tasks(p, smem, q - 680, q - 679, 0, 0, 1);
        else qkv_tasks(p, smem, 0, 0, q - 1088, q - 1087, 1);
      }
    } break;
    case 2: ssd_scan_phase(p); break;
    case 3: {
      attn_tasks(p, smem);
      ssd_s3_tasks(p, layer, smem);
    } break;
    case 4: {
      int* cnt = p.cnt + (2 * layer) * CNT_STRIDE;
      for (int it = 0;; ++it) {
        const int t = xcd_tile(it, MT * 4, last ? 4 : 0);
        if (t < 0) break;
        const int tm = t >> 2, tn = t & 3;
        gemm_tile<false>(
            p.H, D, p.wt_out, D, D, tm * 256, tn * 256, smem, [](int, int, f32x16&, int, int) {},
            [&](int row, int col, u32x4 v) { st_wt(p.Y + (size_t)row * D + col, v); }, noT, neverT);
        tile_done(cnt, tm);
      }
      ew_consume(p, cnt, 4, layer, 1, last, 256, [&](int q) { conv_item_ffn(p, layer, q, smem); }, smem);
    } break;
    case 5: {
      int* cnt1 = p.cnt + (3 * DEPTH + layer) * CNT_STRIDE;
      for (int it = 0;; ++it) {
        const int t = xcd_tile(it, MT * 16, last ? 16 : 0);
        if (t < 0) break;
        const int tm = t >> 4, tn = t & 15;
        gemm_tile<false>(
            p.H, D, p.wt_ff1, D, D, tm * 256, tn * 256, smem,
            [](int, int, f32x16& acc, int, int) {
#pragma unroll
              for (int e = 0; e < 16; ++e) {
                float v = fmaxf(acc[e], 0.f);
                acc[e] = v * v;
              }
            },
            [&](int row, int col, u32x4 v) { st_wt(p.Hd + (size_t)row * DFF + col, v); }, noT, neverT);
        tile_done(cnt1, tm);
      }
      int* cnt = p.cnt + (2 * layer + 1) * CNT_STRIDE;
      for (int it = 0;; ++it) {
        const int t = xcd_tile(it, MT * 4, last ? 4 : 0);
        if (t < 0) break;
        const int tm = t >> 2, tn = t & 3;
        if (ltid() == 0) {
          while (__hip_atomic_load(cnt1 + tm, __ATOMIC_ACQUIRE, __HIP_MEMORY_SCOPE_AGENT) < 16) __builtin_amdgcn_s_sleep(4);
        }
        __syncthreads();
        gemm_tile<false>(
            p.Hd, DFF, p.wt_ff2, DFF, DFF, tm * 256, tn * 256, smem, [](int, int, f32x16&, int, int) {},
            [&](int row, int col, u32x4 v) { st_wt(p.F + (size_t)row * D + col, v); }, noT, neverT);
        tile_done(cnt, tm);
      }
      if (last) ew_consume(p, cnt, 4, DEPTH, 2, true, 0, [](int) {}, smem);
      else ew_consume(p, cnt, 4, layer + 1, 0, false, 108, [&](int q) { conv_item_mix(p, layer + 1, q, smem); }, smem);
    } break;
  }
}

__global__ void __launch_bounds__(NTHR, 2) mega_kernel(Params p, int ph_begin, int ph_end) {
  extern __shared__ __attribute__((aligned(16))) char smem[];
  cg::grid_group grid = cg::this_grid();
  for (int ph = ph_begin; ph < ph_end; ++ph) {
    run_phase(p, ph, smem);
    if (ph + 1 < ph_end) grid.sync();
  }
}

extern "C" void kernel_launch(void* const* d_in, const int* in_sizes, int n_in, void* d_out, int out_size, void* d_ws,
                              size_t ws_size, hipStream_t stream) {
  Params p{};
  const float* const* in = (const float* const*)d_in;
  p.x = in[0]; p.c = in[1]; p.ctx = in[2]; p.c_ctx = in[3]; p.w_ada = in[4]; p.b_ada = in[5];
  p.g_pre_mix = in[6]; p.g_post_mix = in[7]; p.g_pre_ff = in[8]; p.g_post_ff = in[9]; p.w_in = in[10];
  p.g_q = in[11]; p.w_uq = in[12]; p.g_kv = in[13]; p.w_ukv = in[14]; p.cm_norm_g = in[15]; p.cm_w_s = in[16];
  p.cm_b_s = in[17]; p.conv_w = in[18]; p.conv_b = in[19]; p.dt_bias = in[20]; p.a_log = in[21]; p.ssd_d = in[22];
  p.ssd_norm_g = in[23]; p.w_out = in[24]; p.w_ff1 = in[25]; p.w_ff2 = in[26];
  p.out = (float*)d_out;
  char* ws = (char*)d_ws;
  size_t off = 0;
  auto take = [&](size_t bytes) { char* q = ws + off; off += (bytes + 255) & ~(size_t)255; return q; };
  p.wt_in = (u16*)take((size_t)NINP * D * 2);
  p.wt_uq = (u16*)take((size_t)768 * 256 * 2);
  p.wt_ukv = (u16*)take((size_t)1024 * 128 * 2);
  p.wt_out = (u16*)take((size_t)D * D * 2);
  p.wt_ff1 = (u16*)take((size_t)DFF * D * 2);
  p.wt_ff2 = (u16*)take((size_t)D * DFF * 2);
  p.wsb = (u16*)take((size_t)4 * 128 * 128 * 2);
  p.mod = (float*)take((size_t)DEPTH * 9 * 6144 * 4);
  p.ropetab = (float*)take((size_t)64 * 16 * 2 * 4);
  p.atot = (float*)take((size_t)NB * NCH * 2 * 4 * 4);
  p.xctx = (float*)take((size_t)NB * CTX * D * 4);
  char* r1 = take((size_t)T * DFF * 2);
  p.Hd = (u16*)r1;
  p.Y = (u16*)r1;
  {
    size_t o2 = 0;
    p.P = (u16*)(r1 + o2); o2 += (size_t)T * NINP * 2;
    p.Q = (u16*)(r1 + o2); o2 += (size_t)T * 768 * 2;
    p.Kn = (u16*)(r1 + o2); o2 += (size_t)T * 512 * 2;
    p.Kr = (u16*)(r1 + o2); o2 += (size_t)T * 64 * 2;
    p.Vt = (u16*)(r1 + o2); o2 += (size_t)NB * 4 * 128 * SP * 2;
    p.dtraw = (float*)(r1 + o2); o2 += (size_t)T * 8 * 4;
  }
  p.H = (u16*)take((size_t)T * D * 2);
  p.CS = (float*)take((size_t)NB * NCH * 2 * 4 * 8192 * 4);
  p.F = (u16*)p.CS;
  p.ytmp = (float*)take((size_t)T * 256 * 4);
  p.cnt = (int*)take((size_t)4 * DEPTH * CNT_STRIDE * 4);
  if (off > ws_size) {
    fprintf(stderr, "workspace too small: need %zu have %zu\n", off, ws_size);
    return;
  }
  static int grid_blocks = 0;
  if (!grid_blocks) {
    int dev = 0, cus = 0, per_cu = 0;
    hipGetDevice(&dev);
    hipDeviceGetAttribute(&cus, hipDeviceAttributeMultiprocessorCount, dev);
    hipFuncSetAttribute((const void*)mega_kernel, hipFuncAttributeMaxDynamicSharedMemorySize, SMEM_BYTES);
    hipOccupancyMaxActiveBlocksPerMultiprocessor(&per_cu, mega_kernel, NTHR, SMEM_BYTES);
    if (per_cu < 1) per_cu = 1;
    if (per_cu > 1) per_cu = 1;
    grid_blocks = cus * per_cu;
  }
  int pb = 0, pe = NPHASE;
  void* args[] = {&p, &pb, &pe};
  hipError_t e = hipLaunchCooperativeKernel((void*)mega_kernel, dim3(grid_blocks), dim3(NTHR), args, SMEM_BYTES, stream);
  if (e != hipSuccess) fprintf(stderr, "cooperative launch failed: %s (grid %d)\n", hipGetErrorString(e), grid_blocks);
}
```

```cpp
#include <hip/hip_runtime.h>
#include <hip/hip_cooperative_groups.h>
#include <cstdio>
namespace cg = cooperative_groups;

#define DI __device__ __forceinline__
typedef unsigned short u16;
using bf16x8 = __attribute__((ext_vector_type(8))) short;
using s16x4 = __attribute__((ext_vector_type(4))) short;
using f32x16 = __attribute__((ext_vector_type(16))) float;
using u32x4 = __attribute__((ext_vector_type(4))) unsigned;
using u32x2 = __attribute__((ext_vector_type(2))) unsigned;
using f32x4 = __attribute__((ext_vector_type(4))) float;
typedef __bf16 bf2_t __attribute__((ext_vector_type(2)));
typedef float f2_t __attribute__((ext_vector_type(2)));
#define MFMA(a, b, c) __builtin_amdgcn_mfma_f32_32x32x16_bf16((a), (b), (c), 0, 0, 0)

constexpr int NB = 8, SEQ = 4096, CTX = 256, SP = 4352, T = NB * SP, D = 1024, DFF = 4096;
constexpr int NIN = 1992, NINP = 2048, NCH = 34, DEPTH = 4;
constexpr int NTHR = 512;
constexpr int VT = 256;
constexpr int VSMEM = 75 * 1024;
constexpr int SMEM_BYTES = 2 * VSMEM;
constexpr float EPS = 1e-6f;
constexpr int CNT_STRIDE = 160;

struct Params {
  const float *x, *c, *ctx, *c_ctx, *w_ada, *b_ada, *g_pre_mix, *g_post_mix, *g_pre_ff, *g_post_ff, *w_in, *g_q, *w_uq,
      *g_kv, *w_ukv, *cm_norm_g, *cm_w_s, *cm_b_s, *conv_w, *conv_b, *dt_bias, *a_log, *ssd_d, *ssd_norm_g, *w_out,
      *w_ff1, *w_ff2;
  float* out;
  u16 *wt_in, *wt_uq, *wt_ukv, *wt_out, *wt_ff1, *wt_ff2, *wsb;
  float *mod, *ropetab, *atot, *xctx;
  u16 *P, *Q, *Kn, *Kr, *Vt, *Hd;
  u16* Y;
  float* dtraw;
  u16* H;
  float* CS;
  u16* F;
  float* ytmp;
  int* cnt;
};

DI int ltid() { int t = threadIdx.x; asm volatile("" : "+v"(t)); return t; }
DI int lbid() { int t = blockIdx.x; asm volatile("" : "+s"(t)); return t; }
DI void st_wt(void* ptr, u32x4 v) { asm volatile("global_store_dwordx4 %0, %1, off sc0 sc1" ::"v"(ptr), "v"(v) : "memory"); }
DI int crow(int e, int h) { return (e & 3) + 8 * (e >> 2) + 4 * h; }
DI unsigned pack2(float a, float b) {
  f2_t v = {a, b};
  bf2_t r = __builtin_convertvector(v, bf2_t);
  return __builtin_bit_cast(unsigned, r);
}
DI u16 f2bf(float a) { return (u16)(pack2(a, 0.f) & 0xffffu); }
DI float bf2f(u16 v) { return __uint_as_float(((unsigned)v) << 16); }
DI float bflo(unsigned w) { return __uint_as_float(w << 16); }
DI float bfhi(unsigned w) { return __uint_as_float(w & 0xffff0000u); }
DI bf16x8 pack8(float a0, float a1, float a2, float a3, float a4, float a5, float a6, float a7) {
  u32x4 u;
  u.x = pack2(a0, a1); u.y = pack2(a2, a3); u.z = pack2(a4, a5); u.w = pack2(a6, a7);
  return __builtin_bit_cast(bf16x8, u);
}
DI float wave_sum(float v) {
#pragma unroll
  for (int o = 32; o > 0; o >>= 1) v += __shfl_xor(v, o);
  return v;
}
DI float silu_f(float y) { return y * __builtin_amdgcn_rcpf(1.f + __expf(-y)); }
DI float gelu_f(float x) {
  float u = 0.7978845608028654f * (x + 0.044715f * x * x * x);
  float t = 1.f - 2.f * __builtin_amdgcn_rcpf(1.f + __expf(2.f * u));
  return 0.5f * x * (1.f + t);
}
DI float softplus_f(float x) { return x > 20.f ? x : log1pf(__expf(x)); }
DI float uw(const u32x4& v, int i) {
  unsigned w = (i >> 1) == 0 ? v.x : (i >> 1) == 1 ? v.y : (i >> 1) == 2 ? v.z : v.w;
  return (i & 1) ? bfhi(w) : bflo(w);
}

template <bool HAS_T, class ElemF, class StoreF, class StoreTF, class UseTF>
DI void gemm_tile(const u16* __restrict__ A, int lda, const u16* __restrict__ Bt, int ldb, int K, int m0, int n0,
                  char* smem, ElemF elem, StoreF store, StoreTF storeT, UseTF useT) {
  constexpr int LS = 72;
  constexpr int STAGE = 2 * 256 * LS;
  u16* base = (u16*)smem;
  const int tid = ltid(), lane = tid & 63, wid = tid >> 6, wm = wid >> 2, wn = wid & 3, r = lane & 31, h = lane >> 5;
  f32x16 acc[4][2];
#pragma unroll
  for (int i = 0; i < 4; ++i)
#pragma unroll
    for (int j = 0; j < 2; ++j)
#pragma unroll
      for (int e = 0; e < 16; ++e) acc[i][j][e] = 0.f;
  u32x4 ra[4], rb[4];
  const int lrow = tid >> 3, lcp = (tid & 7) * 8;
  const u16* ga = A + (size_t)(m0 + lrow) * lda + lcp;
  const u16* gb = Bt + (size_t)(n0 + lrow) * ldb + lcp;
  const int wofs = lrow * LS + lcp;
  const int aofs = (wm * 128 + r) * LS + h * 8;
  const int bofs = 256 * LS + (wn * 64 + r) * LS + h * 8;
#define GLOAD(kt_)                                                           \
  _Pragma("unroll") for (int i = 0; i < 4; ++i) {                            \
    ra[i] = *(const u32x4*)(ga + (size_t)(64 * i) * lda + (kt_) * 64);       \
    rb[i] = *(const u32x4*)(gb + (size_t)(64 * i) * ldb + (kt_) * 64);       \
  }
#define SWRITE(st_)                                                          \
  _Pragma("unroll") for (int i = 0; i < 4; ++i) {                            \
    *(u32x4*)((st_) + wofs + 64 * i * LS) = ra[i];                           \
    *(u32x4*)((st_) + 256 * LS + wofs + 64 * i * LS) = rb[i];                \
  }
#define FREAD(dst_, st_, kk_)                                                                      \
  _Pragma("unroll") for (int i = 0; i < 4; ++i) af[dst_][i] = *(const bf16x8*)((st_) + aofs + i * 32 * LS + (kk_) * 16); \
  _Pragma("unroll") for (int j = 0; j < 2; ++j) bfr[dst_][j] = *(const bf16x8*)((st_) + bofs + j * 32 * LS + (kk_) * 16);
#define MMAS(src_)                                                           \
  _Pragma("unroll") for (int i = 0; i < 4; ++i)                              \
  _Pragma("unroll") for (int j = 0; j < 2; ++j) acc[i][j] = MFMA(bfr[src_][j], af[src_][i], acc[i][j]);
#define ILV()                                                                   \
  __builtin_amdgcn_sched_group_barrier(0x008, 2, 0);                            \
  __builtin_amdgcn_sched_group_barrier(0x100, 2, 0);                            \
  __builtin_amdgcn_sched_group_barrier(0x008, 2, 0);                            \
  __builtin_amdgcn_sched_group_barrier(0x100, 2, 0);                            \
  __builtin_amdgcn_sched_group_barrier(0x008, 2, 0);                            \
  __builtin_amdgcn_sched_group_barrier(0x100, 2, 0);                            \
  __builtin_amdgcn_sched_group_barrier(0x008, 2, 0);
  const int nk = K >> 6;
  bf16x8 af[2][4], bfr[2][2];
  GLOAD(0);
  __syncthreads();
  SWRITE(base);
  if (nk > 1) { GLOAD(1); }
  __syncthreads();
  FREAD(0, base, 0);
  for (int kt = 0; kt < nk; ++kt) {
    u16* cur = base + (kt & 1) * STAGE;
    u16* nxt = base + ((kt + 1) & 1) * STAGE;
    FREAD(1, cur, 1);
    if (kt + 1 < nk) { SWRITE(nxt); }
    MMAS(0);
#pragma unroll
    for (int z = 0; z < 7; ++z) {
      __builtin_amdgcn_sched_group_barrier(0x008, 1, 0);
      __builtin_amdgcn_sched_group_barrier(0x080, 2, 0);
    }
    __builtin_amdgcn_sched_group_barrier(0x008, 1, 0);
    __builtin_amdgcn_sched_barrier(0);
    if (kt + 2 < nk) { GLOAD(kt + 2); }
    FREAD(0, cur, 2);
    MMAS(1);
    ILV();
    __builtin_amdgcn_sched_barrier(0);
    FREAD(1, cur, 3);
    MMAS(0);
    ILV();
    __builtin_amdgcn_sched_barrier(0);
    __syncthreads();
    if (kt + 1 < nk) { FREAD(0, nxt, 0); }
    MMAS(1);
    ILV();
    __builtin_amdgcn_sched_barrier(0);
  }
#undef ILV
#undef GLOAD
#undef SWRITE
#undef FREAD
#undef MMAS
#pragma unroll
  for (int i = 0; i < 4; ++i)
#pragma unroll
    for (int j = 0; j < 2; ++j) elem(m0 + wm * 128 + i * 32, n0 + wn * 64 + j * 32, acc[i][j], r, h);
  u16* stg = base + wid * (128 * 72);
  if (HAS_T && useT(wn)) {
#pragma unroll
    for (int i = 0; i < 4; ++i)
#pragma unroll
      for (int j = 0; j < 2; ++j)
#pragma unroll
        for (int e = 0; e < 16; ++e) stg[(j * 32 + crow(e, h)) * 136 + i * 32 + r] = f2bf(acc[i][j][e]);
    __builtin_amdgcn_wave_barrier();
#pragma unroll 4
    for (int t = 0; t < 16; ++t) {
      const int id = lane + 64 * t, cl = id >> 4, cp = id & 15;
      u32x4 v = *(const u32x4*)(stg + cl * 136 + cp * 8);
      storeT(n0 + wn * 64 + cl, m0 + wm * 128 + cp * 8, v);
    }
  } else {
#pragma unroll
    for (int i = 0; i < 4; ++i)
#pragma unroll
      for (int j = 0; j < 2; ++j)
#pragma unroll
        for (int q4 = 0; q4 < 4; ++q4) {
          u32x2 w;
          w.x = pack2(acc[i][j][4 * q4], acc[i][j][4 * q4 + 1]);
          w.y = pack2(acc[i][j][4 * q4 + 2], acc[i][j][4 * q4 + 3]);
          *(u32x2*)(stg + (i * 32 + r) * 72 + j * 32 + 8 * q4 + 4 * h) = w;
        }
    __builtin_amdgcn_wave_barrier();
#pragma unroll 4
    for (int t = 0; t < 16; ++t) {
      const int id = lane + 64 * t, rl = id >> 3, cp = id & 7;
      u32x4 v = *(const u32x4*)(stg + rl * 72 + cp * 8);
      store(m0 + wm * 128 + rl, n0 + wn * 64 + cp * 8, v);
    }
  }
}

DI int xcd_tile(int it, int ntiles, int skip_tail = 0) {
  const int b = lbid(), g = gridDim.x;
  const int local = (b >> 3) + it * (g >> 3);
  const int per = ntiles >> 3;
  return local < per - skip_tail ? (b & 7) * per + local : -1;
}

DI void conv_tile(const float* __restrict__ src, int K, int N, u16* __restrict__ dst, const float* __restrict__ scale,
                  int tk, int tn, char* smem) {
  float* tile = (float*)smem;
  const int tid = ltid(), tx = tid & 63, ty = tid >> 6;
  const int k0 = tk * 64, n0 = tn * 64;
  __syncthreads();
#pragma unroll 4
  for (int i = 0; i < 8; ++i) {
    int kr = ty + 8 * i;
    float v = 0.f;
    if (n0 + tx < N) v = src[(size_t)(k0 + kr) * N + n0 + tx];
    if (scale) v *= scale[k0 + kr];
    tile[kr * 65 + tx] = v;
  }
  __syncthreads();
#pragma unroll 4
  for (int i = 0; i < 8; ++i) {
    int nr = ty + 8 * i;
    dst[(size_t)(n0 + nr) * K + k0 + tx] = f2bf(tile[tx * 65 + nr]);
  }
}

DI void convert_weights(const float* src, int K, int N, int Npad, u16* dst, const float* scale, char* smem) {
  const int tks = K / 64, tns = Npad / 64;
  for (int t = lbid(); t < tks * tns; t += gridDim.x) conv_tile(src, K, N, dst, scale, t / tns, t % tns, smem);
}

DI void prologue_phase(const Params& p, char* smem) {
  float* sc = (float*)smem;
  float* red = sc + 9 * 1024;
  const int tid = ltid();
  for (int i = tid; i < 9 * 1024; i += NTHR) {
    int j = i >> 10, k = i & 1023;
    float v = j < 8 ? p.c[j * 1024 + k] : p.c_ctx[k];
    sc[i] = v / (1.f + __expf(-v));
  }
  __syncthreads();
  for (int task = lbid(); task < DEPTH * 96; task += gridDim.x) {
    const int l = task / 96, n0 = (task % 96) * 64, nn = tid & 63, kq = tid >> 6;
    float acc[9];
#pragma unroll
    for (int j = 0; j < 9; ++j) acc[j] = 0.f;
    const float* w = p.w_ada + ((size_t)l * 1024 + kq * 128) * 6144 + n0 + nn;
    const float* scq = sc + kq * 128;
#pragma unroll 4
    for (int k = 0; k < 128; ++k) {
      float wv = w[(size_t)k * 6144];
#pragma unroll
      for (int j = 0; j < 9; ++j) acc[j] += scq[j * 1024 + k] * wv;
    }
#pragma unroll
    for (int j = 0; j < 9; ++j) red[(kq * 9 + j) * 64 + nn] = acc[j];
    __syncthreads();
    for (int idx = tid; idx < 576; idx += NTHR) {
      int j = idx >> 6, n2 = idx & 63;
      float s = p.b_ada[l * 6144 + n0 + n2];
#pragma unroll
      for (int q = 0; q < 8; ++q) s += red[(q * 9 + j) * 64 + n2];
      p.mod[(size_t)(l * 9 + j) * 6144 + n0 + n2] = s;
    }
    __syncthreads();
  }
  for (int i = lbid() * NTHR + tid; i < 4 * DEPTH * CNT_STRIDE + 64; i += gridDim.x * NTHR) p.cnt[i] = 0;
  if (lbid() == gridDim.x - 1) {
    for (int i = tid; i < 64 * 16; i += NTHR) {
      int pos = i >> 4, j = i & 15;
      float inv_freq = exp2f(-(float)(2 * j) / 32.f * 13.287712379549449f);
      float ang = (float)pos * inv_freq;
      float k = rintf(ang * 0.15915494309189535f);
      float red2 = fmaf(-k, 6.2831854820251465f, ang);
      red2 = fmaf(-k, -1.7484555314695172e-07f, red2);
      p.ropetab[2 * i] = __cosf(red2);
      p.ropetab[2 * i + 1] = __sinf(red2);
    }
  }
}

DI void ew_row(const Params& p, int layer, int kind, int row, int lane) {
  const bool has_branch = !(kind == 0 && layer == 0);
  const bool src_in = (layer == 0 && kind <= 1);
  const bool store_x = has_branch;
  const int blayer = (kind == 1) ? layer : (kind == 0 ? layer - 1 : DEPTH - 1);
  const float* gpost = (kind == 1) ? p.g_post_mix + blayer * D : p.g_post_ff + (blayer < 0 ? 0 : blayer) * D;
  const int gate_off = (kind == 1) ? 2 * D : 5 * D;
  const float* gpre = (kind == 0) ? p.g_pre_mix + layer * D : p.g_pre_ff + (kind == 1 ? layer : 0) * D;
  const int shift_off = (kind == 0) ? 0 : 3 * D, scale_off = (kind == 0) ? D : 4 * D;
  const float* xl = src_in ? p.x : p.out;
  const float* xc = src_in ? p.ctx : p.xctx;
    const int b = row / SP, s = row - b * SP;
    const bool lat = s < SEQ;
    if ((kind == 2 || (kind == 1 && layer == DEPTH - 1)) && !lat) return;
    const size_t xoff = lat ? ((size_t)(b * SEQ + s) * D) : ((size_t)(b * CTX + s - SEQ) * D);
    const unsigned long long msk = lat ? ~0ull : 0ull;
    const float* xs = (const float*)(((unsigned long long)xl & msk) | ((unsigned long long)xc & ~msk)) + xoff;
    float* xd = (float*)(((unsigned long long)p.out & msk) | ((unsigned long long)p.xctx & ~msk)) + xoff;
    const int mi = lat ? b : 8;
    f32x4 xv[4];
#pragma unroll
    for (int i = 0; i < 4; ++i) xv[i] = *(const f32x4*)(xs + lane * 4 + 256 * i);
    if (has_branch) {
      const float* modb = p.mod + (size_t)(blayer * 9 + mi) * 6144 + gate_off;
      f32x4 yv[4];
      const u16* ysrc = (kind == 1) ? p.Y : p.F;
#pragma unroll
      for (int i = 0; i < 4; ++i) {
        u32x2 w = *(const u32x2*)(ysrc + (size_t)row * D + lane * 4 + 256 * i);
        yv[i] = f32x4{bflo(w.x), bfhi(w.x), bflo(w.y), bfhi(w.y)};
      }
      float ss = 0.f;
#pragma unroll
      for (int i = 0; i < 4; ++i) ss += yv[i].x * yv[i].x + yv[i].y * yv[i].y + yv[i].z * yv[i].z + yv[i].w * yv[i].w;
      ss = wave_sum(ss);
      const float rstd = rsqrtf(ss * (1.f / D) + EPS);
#pragma unroll
      for (int i = 0; i < 4; ++i) {
        const int col = lane * 4 + 256 * i;
        f32x4 g = *(const f32x4*)(gpost + col);
        f32x4 gt = *(const f32x4*)(modb + col);
        xv[i].x += gt.x * (yv[i].x * rstd * g.x);
        xv[i].y += gt.y * (yv[i].y * rstd * g.y);
        xv[i].z += gt.z * (yv[i].z * rstd * g.z);
        xv[i].w += gt.w * (yv[i].w * rstd * g.w);
      }
      if (store_x) {
#pragma unroll
        for (int i = 0; i < 4; ++i) *(f32x4*)(xd + lane * 4 + 256 * i) = xv[i];
      }
    }
    if (kind != 2) {
      const float* modl = p.mod + (size_t)(layer * 9 + mi) * 6144;
      float ss = 0.f;
#pragma unroll
      for (int i = 0; i < 4; ++i) ss += xv[i].x * xv[i].x + xv[i].y * xv[i].y + xv[i].z * xv[i].z + xv[i].w * xv[i].w;
      ss = wave_sum(ss);
      const float rstd = rsqrtf(ss * (1.f / D) + EPS);
#pragma unroll
      for (int i = 0; i < 4; ++i) {
        const int col = lane * 4 + 256 * i;
        f32x4 g = *(const f32x4*)(gpre + col);
        f32x4 sh = *(const f32x4*)(modl + shift_off + col);
        f32x4 sc = *(const f32x4*)(modl + scale_off + col);
        float h0 = xv[i].x * rstd * g.x * (1.f + sc.x) + sh.x;
        float h1 = xv[i].y * rstd * g.y * (1.f + sc.y) + sh.y;
        float h2 = xv[i].z * rstd * g.z * (1.f + sc.z) + sh.z;
        float h3 = xv[i].w * rstd * g.w * (1.f + sc.w) + sh.w;
        u32x2 w;
        w.x = pack2(h0, h1);
        w.y = pack2(h2, h3);
        *(u32x2*)(p.H + (size_t)row * D + col) = w;
      }
    }
}

DI void ew_phase(const Params& p, int layer, int kind) {
  const int tid = ltid(), lane = tid & 63, wid = __builtin_amdgcn_readfirstlane(tid >> 6);
  for (int rg = lbid(); rg < T / 8; rg += gridDim.x) ew_row(p, layer, kind, rg * 8 + wid, lane);
}

DI void tile_done(int* cnt, int tm) {
  asm volatile("s_waitcnt vmcnt(0)" ::: "memory");
  __syncthreads();
  if (ltid() == 0) __hip_atomic_fetch_add(cnt + tm, 1, __ATOMIC_RELAXED, __HIP_MEMORY_SCOPE_AGENT);
}
template <class ConvF>
DI void ew_consume(const Params& p, int* cnt, int need, int layer, int kind, bool skip_ctx, int nconv, ConvF conv,
                   char* smem) {
  int* sh = (int*)(smem + SMEM_BYTES - 16);
  const int tid = ltid(), lane = tid & 63, wid = __builtin_amdgcn_readfirstlane(tid >> 6);
  for (;;) {
    __syncthreads();
    if (tid == 0) *sh = __hip_atomic_fetch_add(cnt + 136, 1, __ATOMIC_RELAXED, __HIP_MEMORY_SCOPE_AGENT);
    __syncthreads();
    const int q = *sh;
    if (q >= nconv + 544) break;
    if (q < nconv) { conv(q); continue; }
    const int c = q - nconv, mseq = c >> 2, j = mseq >> 3, bb = mseq & 7, tm = bb * 17 + j;
    if (skip_ctx && j == 16) continue;
    if (tid == 0) {
      while (__hip_atomic_load(cnt + tm, __ATOMIC_RELAXED, __HIP_MEMORY_SCOPE_AGENT) < need) __builtin_amdgcn_s_sleep(4);
      __builtin_amdgcn_fence(__ATOMIC_ACQUIRE, "agent");
    }
    __syncthreads();
    const int row0 = tm * 256 + (c & 3) * 64 + wid * 8;
#pragma unroll 1
    for (int i = 0; i < 8; ++i) ew_row(p, layer, kind, row0 + i, lane);
  }
}

DI void row_rstd(const u16* __restrict__ base, int ld, int ncols, int m0, float* rs) {
  const int tid = ltid(), row = tid >> 1, half = tid & 1;
  const int per = ncols / 2;
  const u16* ptr = base + (size_t)(m0 + row) * ld + half * per;
  float ss = 0.f;
  for (int i = 0; i < per; i += 8) {
    u32x4 v = *(const u32x4*)(ptr + i);
#pragma unroll
    for (int e = 0; e < 8; ++e) {
      float f = uw(v, e);
      ss += f * f;
    }
  }
  ss += __shfl_xor(ss, 1);
  if (half == 0) rs[row] = rsqrtf(ss / (float)ncols + EPS);
}

DI void qkv_tasks(const Params& p, char* smem, int qb, int qe, int kb_, int ke, int stp) {
  float* rs = (float*)(smem + 2 * 2 * 256 * 72 * 2);
  const int MT = T / 256;
  auto noT = [](int, int, u32x4) {};
  auto neverT = [](int) { return false; };
  for (int t = qb; t < qe; t += stp) {
    const int tm = t / 3, tn = t % 3, m0 = tm * 256;
    __syncthreads();
    row_rstd(p.P, NINP, 256, m0, rs);
    const bool lat = (m0 % SP) < SEQ;
    const int s0 = m0 % SP;
    gemm_tile<false>(
        p.P, NINP, p.wt_uq, 256, 256, m0, tn * 256, smem,
        [&](int mb, int nb, f32x16& acc, int r, int h) {
          const int rowl = mb - m0 + r;
          const float sc = rs[rowl];
#pragma unroll
          for (int e = 0; e < 16; ++e) acc[e] *= sc;
          const int cb = nb % 192;
          if (lat && cb >= 128) {
            const int s = s0 + rowl;
            const int pos = (cb == 128) ? (s >> 6) : (s & 63);
#pragma unroll
            for (int e = 0; e < 8; ++e) {
              const int j = crow(e, h);
              const float cs = p.ropetab[2 * (pos * 16 + j)], sn = p.ropetab[2 * (pos * 16 + j) + 1];
              const float x1 = acc[e], x2 = acc[e + 8];
              acc[e] = x1 * cs - x2 * sn;
              acc[e + 8] = x1 * sn + x2 * cs;
            }
          }
        },
        [&](int row, int col, u32x4 v) { *(u32x4*)(p.Q + (size_t)row * 768 + col) = v; }, noT, neverT);
  }
  for (int t = kb_; t < ke; t += stp) {
    const int tm = t / 4, tn = t % 4, m0 = tm * 256;
    const int b = m0 / SP, s0 = m0 % SP;
    const bool lat = s0 < SEQ;
    __syncthreads();
    row_rstd(p.P + 256, NINP, 128, m0, rs);
    if (tn == 0) {
      for (int idx = ltid(); idx < 256 * 32; idx += NTHR) {
        const int rowl = idx >> 5, q = idx & 31, blk = q >> 4, j = q & 15;
        const u16* src = p.P + (size_t)(m0 + rowl) * NINP + 384 + blk * 32 + j;
        float x1 = bf2f(src[0]), x2 = bf2f(src[16]);
        float o1 = x1, o2 = x2;
        if (lat) {
          const int s = s0 + rowl;
          const int pos = blk == 0 ? (s >> 6) : (s & 63);
          const float cs = p.ropetab[2 * (pos * 16 + j)], sn = p.ropetab[2 * (pos * 16 + j) + 1];
          o1 = x1 * cs - x2 * sn;
          o2 = x1 * sn + x2 * cs;
        }
        u16* dst = p.Kr + (size_t)(m0 + rowl) * 64 + blk * 32 + j;
        dst[0] = f2bf(o1);
        dst[16] = f2bf(o2);
      }
    }
    const int n0 = tn * 256;
    u16* vbase = p.Vt + (size_t)(b * 4 + tn) * 128 * SP + s0;
    gemm_tile<true>(
        p.P + 256, NINP, p.wt_ukv, 128, 128, m0, n0, smem,
        [&](int mb, int nb, f32x16& acc, int r, int h) {
          const float sc = rs[mb - m0 + r];
#pragma unroll
          for (int e = 0; e < 16; ++e) acc[e] *= sc;
        },
        [&](int row, int col, u32x4 v) { *(u32x4*)(p.Kn + (size_t)row * 512 + tn * 128 + (col - n0)) = v; },
        [&](int col, int row, u32x4 v) { *(u32x4*)(vbase + (size_t)(col - n0 - 128) * SP + (row - m0)) = v; },
        [](int wn) { return wn >= 2; });
  }
}

DI void cm_tasks(const Params& p, int layer, char* smem, int tb, int te, int stp) {
  const int ftid = ltid(), vb = ftid >> 8, tid = ftid & 255;
  u16* vnT = (u16*)(smem + vb * VSMEM);
  const int lane = tid & 63, wid = tid >> 6, r = lane & 31, h = lane >> 5;
  const float* gn = p.cm_norm_g + layer * 256;
  const float* bs = p.cm_b_s + layer * 512;
  for (int t0 = tb; t0 < te; t0 += stp) {
    const int task = t0 + vb;
    const int row0 = task * 128;
    __syncthreads();
#pragma unroll 4
    for (int i = 0; i < 32; ++i) {
      const int s = wid * 32 + i;
      const u16* src = p.P + (size_t)(row0 + s) * NINP + 704;
      float v[4];
      float sum = 0.f;
#pragma unroll
      for (int q = 0; q < 4; ++q) {
        v[q] = gelu_f(bf2f(src[lane + 64 * q]));
        sum += v[q];
      }
      const float mean = wave_sum(sum) * (1.f / 256.f);
      float var = 0.f;
#pragma unroll
      for (int q = 0; q < 4; ++q) {
        v[q] -= mean;
        var += v[q] * v[q];
      }
      const float rstd = rsqrtf(wave_sum(var) * (1.f / 256.f) + EPS);
#pragma unroll
      for (int q = 0; q < 4; ++q) vnT[(lane + 64 * q) * 136 + s] = f2bf(v[q] * rstd * gn[lane + 64 * q]);
    }
    __syncthreads();
    const int t = wid * 32 + r;
    for (int g = 0; g < 4; ++g) {
      bf16x8 wf[8];
#pragma unroll
      for (int kk = 0; kk < 8; ++kk) wf[kk] = *(const bf16x8*)(p.wsb + ((size_t)(g * 128 + t)) * 128 + kk * 16 + h * 8);
      const float bias = bs[g * 128 + t];
#pragma unroll
      for (int cb = 0; cb < 2; ++cb) {
        f32x16 acc;
#pragma unroll
        for (int e = 0; e < 16; ++e) acc[e] = 0.f;
#pragma unroll
        for (int kk = 0; kk < 8; ++kk) {
          bf16x8 a = *(const bf16x8*)(vnT + (g * 64 + cb * 32 + r) * 136 + kk * 16 + h * 8);
          acc = MFMA(a, wf[kk], acc);
        }
#pragma unroll
        for (int q4 = 0; q4 < 4; ++q4) {
          const int ch0 = g * 64 + cb * 32 + 8 * q4 + 4 * h;
          u32x2 uwd = *(const u32x2*)(p.P + (size_t)(row0 + t) * NINP + 448 + ch0);
          float u0 = gelu_f(bflo(uwd.x)), u1 = gelu_f(bfhi(uwd.x)), u2 = gelu_f(bflo(uwd.y)), u3 = gelu_f(bfhi(uwd.y));
          u32x2 w;
          w.x = pack2(u0 * (acc[4 * q4] + bias), u1 * (acc[4 * q4 + 1] + bias));
          w.y = pack2(u2 * (acc[4 * q4 + 2] + bias), u3 * (acc[4 * q4 + 3] + bias));
          *(u32x2*)(p.H + (size_t)(row0 + t) * D + 512 + ch0) = w;
        }
      }
    }
  }
}

struct ConvW { f32x4 w0a, w0b, w1a, w1b, w2a, w2b, ba, bb; };
DI ConvW load_convw(const Params& p, int layer, int ch) {
  const float* cw = p.conv_w + (size_t)layer * 3 * 768 + ch;
  const float* cb = p.conv_b + layer * 768 + ch;
  ConvW c;
  c.w0a = *(const f32x4*)(cw); c.w0b = *(const f32x4*)(cw + 4);
  c.w1a = *(const f32x4*)(cw + 768); c.w1b = *(const f32x4*)(cw + 772);
  c.w2a = *(const f32x4*)(cw + 1536); c.w2b = *(const f32x4*)(cw + 1540);
  c.ba = *(const f32x4*)(cb); c.bb = *(const f32x4*)(cb + 4);
  return c;
}
DI float convw_get(const f32x4& a, const f32x4& b, int e) { return e < 4 ? a[e & 3] : b[e & 3]; }
DI void conv8(const Params& p, const ConvW& c, int row, int ch, bool hasPrev, bool hasNext, float out[8]) {
  const u16* base = p.P + (size_t)row * NINP + 1216 + ch;
  u32x4 cur = *(const u32x4*)base;
  u32x4 prv = *(const u32x4*)(base - (hasPrev ? NINP : 0));
  u32x4 nxt = *(const u32x4*)(base + (hasNext ? NINP : 0));
  const float mp = hasPrev ? 1.f : 0.f, mn = hasNext ? 1.f : 0.f;
#pragma unroll
  for (int e = 0; e < 8; ++e) {
    float y = convw_get(c.w0a, c.w0b, e) * (mp * uw(prv, e)) + convw_get(c.w1a, c.w1b, e) * uw(cur, e) +
              convw_get(c.w2a, c.w2b, e) * (mn * uw(nxt, e)) + convw_get(c.ba, c.bb, e);
    out[e] = silu_f(y);
  }
}

template <int RPT, class F>
DI void conv_stage(const Params& p, int layer, int row0, int chbase, int cp, int tb, bool cPrev, bool cNext, F emit) {
  const ConvW c = load_convw(p, layer, chbase + cp * 8);
  const int r0 = tb * RPT;
  const bool hp = cPrev || r0 > 0, hn = cNext || (r0 + RPT) < 128;
  const u16* base = p.P + (size_t)(row0 + r0) * NINP + 1216 + chbase + cp * 8;
  u32x4 raw[RPT + 2];
  raw[0] = *(const u32x4*)(base - (hp ? NINP : 0));
#pragma unroll
  for (int k = 0; k < RPT; ++k) raw[k + 1] = *(const u32x4*)(base + (size_t)k * NINP);
  raw[RPT + 1] = *(const u32x4*)(base + (size_t)(hn ? RPT : RPT - 1) * NINP);
  const float mp = hp ? 1.f : 0.f, mn = hn ? 1.f : 0.f;
#pragma unroll
  for (int i = 0; i < RPT; ++i) {
    const float fp = (i == 0) ? mp : 1.f, fn = (i == RPT - 1) ? mn : 1.f;
    float v[8];
#pragma unroll
    for (int e = 0; e < 8; ++e) {
      float y = convw_get(c.w0a, c.w0b, e) * (fp * uw(raw[i], e)) + convw_get(c.w1a, c.w1b, e) * uw(raw[i + 1], e) +
                convw_get(c.w2a, c.w2b, e) * (fn * uw(raw[i + 2], e)) + convw_get(c.ba, c.bb, e);
      v[e] = silu_f(y);
    }
    emit(r0 + i, v);
  }
}

DI void ssd_dt_arrays(const Params& p, int layer, int row0, int hh, int t, float* arr) {
  float* dt0 = arr;
  float* dt1 = arr + 128;
  float* c0 = arr + 256;
  float* s1 = arr + 384;
  float* a0 = arr + 512;
  float* a1 = arr + 640;
  const float d0 = softplus_f(p.dtraw[(size_t)(row0 + t) * 8 + hh] + p.dt_bias[layer * 8 + hh]);
  const float d1 = softplus_f(p.dtraw[(size_t)(row0 + t) * 8 + 4 + hh] + p.dt_bias[layer * 8 + 4 + hh]);
  dt0[t] = d0;
  dt1[t] = d1;
  a0[t] = -d0 * __expf(p.a_log[layer * 8 + hh]);
  a1[t] = -d1 * __expf(p.a_log[layer * 8 + 4 + hh]);
}
DI float wave_incl_prefix(float x, int lane) {
#pragma unroll
  for (int o = 1; o < 64; o <<= 1) {
    float y = __shfl_up(x, o);
    if (lane >= o) x += y;
  }
  return x;
}
DI void ssd_cum_arrays(int t, float* arr) {
  float* c0 = arr + 256;
  float* s1 = arr + 384;
  const float* a0 = arr + 512;
  const float* a1 = arr + 640;
  const int lane = t & 63, w = t >> 6;
  const float x0 = a0[t], o0 = a0[t ^ 64], x1 = a1[t], o1 = a1[t ^ 64];
  const float tot_o0 = wave_sum(o0), tot_o1 = wave_sum(o1), tot_x1 = wave_sum(x1);
  float p0 = wave_incl_prefix(x0, lane);
  float p1 = wave_incl_prefix(x1, lane);
  if (w == 1) p0 += tot_o0;
  float sf = tot_x1 - p1 + x1;
  if (w == 0) sf += tot_o1;
  c0[t] = p0;
  s1[t] = sf;
}

DI void ssd_s1_tasks(const Params& p, int layer, char* smem, int tb, int te, int stp) {
  const int ftid = ltid(), vb = ftid >> 8, tid = ftid & 255;
  u16* xsT0 = (u16*)(smem + vb * VSMEM);
  u16* xsT1 = xsT0 + 64 * 136;
  u16* BT = xsT1 + 64 * 136;
  float* arr = (float*)(BT + 128 * 136);
  float* w0 = arr + 768;
  float* w1 = w0 + 128;
  const int lane = tid & 63, wid = tid >> 6, r = lane & 31, h = lane >> 5;
  for (int t0 = tb; t0 < te; t0 += stp) {
    const int task = t0 + vb;
    const int hh = task & 3, bc = task >> 2, c = bc % NCH, b = bc / NCH;
    const int g = hh >> 1;
    const int row0 = bc * 128;
    const bool cPrev = (c != 0 && c != 32), cNext = (c != 31 && c != 33);
    __syncthreads();
    if (tid < 128) ssd_dt_arrays(p, layer, row0, hh, tid, arr);
    __syncthreads();
    if (tid < 128) ssd_cum_arrays(tid, arr);
    __syncthreads();
    if (tid < 128) {
      const float* dt0 = arr;
      const float* dt1 = arr + 128;
      const float* c0 = arr + 256;
      const float* s1 = arr + 384;
      w0[tid] = __expf(c0[127] - c0[tid]) * dt0[tid];
      w1[tid] = __expf(s1[0] - s1[tid]) * dt1[tid];
      if (tid == 0) {
        p.atot[((size_t)bc * 2 + 0) * 4 + hh] = c0[127];
        p.atot[((size_t)bc * 2 + 1) * 4 + hh] = s1[0];
      }
    }
    __syncthreads();
    conv_stage<4>(p, layer, row0, hh * 64, tid & 7, tid >> 3, cPrev, cNext, [&](int t, const float (&v)[8]) {
      const float f0 = w0[t], f1 = w1[t];
      const int cp = tid & 7;
#pragma unroll
      for (int e = 0; e < 8; ++e) {
        xsT0[(cp * 8 + e) * 136 + t] = f2bf(v[e] * f0);
        xsT1[(cp * 8 + e) * 136 + t] = f2bf(v[e] * f1);
      }
    });
    conv_stage<8>(p, layer, row0, 256 + g * 128, tid & 15, tid >> 4, cPrev, cNext, [&](int t, const float (&v)[8]) {
      const int cp = tid & 15;
#pragma unroll
      for (int e = 0; e < 8; ++e) BT[(cp * 8 + e) * 136 + t] = f2bf(v[e]);
    });
    __syncthreads();
#pragma unroll
    for (int d = 0; d < 2; ++d) {
      const u16* xsT = d ? xsT1 : xsT0;
#pragma unroll
      for (int pb = 0; pb < 2; ++pb) {
        f32x16 acc;
#pragma unroll
        for (int e = 0; e < 16; ++e) acc[e] = 0.f;
#pragma unroll
        for (int kk = 0; kk < 8; ++kk) {
          bf16x8 a = *(const bf16x8*)(xsT + (pb * 32 + r) * 136 + kk * 16 + h * 8);
          bf16x8 bb = *(const bf16x8*)(BT + (wid * 32 + r) * 136 + kk * 16 + h * 8);
          acc = MFMA(a, bb, acc);
        }
        float* dst = p.CS + ((((size_t)bc * 2 + d) * 4 + hh) * 64 + pb * 32) * 128 + wid * 32 + r;
#pragma unroll
        for (int e = 0; e < 16; ++e) dst[(size_t)crow(e, h) * 128] = acc[e];
      }
    }
  }
}

DI void ssd_scan_phase(const Params& p) {
  const int total = NB * 2 * 4 * 8192;
  for (int idx = lbid() * NTHR + ltid(); idx < total; idx += gridDim.x * NTHR) {
    const int e = idx & 8191, hh = (idx >> 13) & 3, d = (idx >> 15) & 1, b = idx >> 16;
    float st = 0.f;
#pragma unroll 2
    for (int i = 0; i < NCH; ++i) {
      int c;
      if (d == 0) c = i < 2 ? 32 + i : i - 2;
      else c = i < 2 ? 33 - i : 33 - i;
      const size_t bc = (size_t)b * NCH + c;
      float* ptr = p.CS + ((bc * 2 + d) * 4 + hh) * 8192 + e;
      const float v = *ptr;
      const float dec = __expf(p.atot[(bc * 2 + d) * 4 + hh]);
      *ptr = st;
      st = dec * st + v;
    }
  }
}

template <int G>
DI float ssd_s3_group(const Params& p, int layer, int bc, bool cPrev, bool cNext, u16* Bg, u16* xsT, float* arr, int tid) {
  f32x16 y[4];
#pragma unroll
  for (int i = 0; i < 4; ++i)
#pragma unroll
    for (int e = 0; e < 16; ++e) y[i][e] = 0.f;
  const int lane = tid & 63, wid = tid >> 6, r = lane & 31, h = lane >> 5;
  const int l = wid * 32 + r;
  const int row0 = bc * 128;
  __syncthreads();
  ssd_dt_arrays(p, layer, row0, 2 * G + (tid >> 7), tid & 127, arr + (tid >> 7) * 768);
  const ConvW cwc = load_convw(p, layer, 512 + G * 128 + (tid & 15) * 8);
#pragma unroll 1
  for (int i = 0; i < 8; ++i) {
    const int id = tid + VT * i, t = id >> 4, cp = id & 15;
    float v[8];
    conv8(p, cwc, row0 + t, 512 + G * 128 + cp * 8, cPrev || t > 0, cNext || t < 127, v);
    *(bf16x8*)(Bg + t * 136 + cp * 8) = pack8(v[0], v[1], v[2], v[3], v[4], v[5], v[6], v[7]);
  }
  const ConvW cwx = load_convw(p, layer, G * 128 + (tid & 15) * 8);
#pragma unroll 1
  for (int i = 0; i < 8; ++i) {
    const int id = tid + VT * i, t = id >> 4, cp = id & 15;
    float v[8];
    conv8(p, cwx, row0 + t, G * 128 + cp * 8, cPrev || t > 0, cNext || t < 127, v);
#pragma unroll
    for (int e = 0; e < 8; ++e) xsT[(cp * 8 + e) * 136 + t] = f2bf(v[e]);
  }
  __syncthreads();
  ssd_cum_arrays(tid & 127, arr + (tid >> 7) * 768);
  bf16x8 cf[8];
#pragma unroll
  for (int kk = 0; kk < 8; ++kk) cf[kk] = *(const bf16x8*)(Bg + l * 136 + kk * 16 + h * 8);
  __syncthreads();
  const ConvW cwb = load_convw(p, layer, 256 + G * 128 + (tid & 15) * 8);
#pragma unroll 1
  for (int i = 0; i < 8; ++i) {
    const int id = tid + VT * i, t = id >> 4, cp = id & 15;
    float v[8];
    conv8(p, cwb, row0 + t, 256 + G * 128 + cp * 8, cPrev || t > 0, cNext || t < 127, v);
    *(bf16x8*)(Bg + t * 136 + cp * 8) = pack8(v[0], v[1], v[2], v[3], v[4], v[5], v[6], v[7]);
  }
  __syncthreads();
  float ss = 0.f;
#pragma unroll 1
  for (int hd2 = 0; hd2 < 2; ++hd2) {
    const int hh = 2 * G + hd2;
    const float* ah = arr + hd2 * 768;
    const float c0l = ah[256 + l], s1l = ah[384 + l];
    f32x16 y[2];
#pragma unroll
    for (int i = 0; i < 2; ++i)
#pragma unroll
      for (int e = 0; e < 16; ++e) y[i][e] = 0.f;
#pragma unroll 1
    for (int sb = 0; sb < 4; ++sb) {
      f32x16 gt;
#pragma unroll
      for (int e = 0; e < 16; ++e) gt[e] = 0.f;
#pragma unroll
      for (int kk = 0; kk < 8; ++kk) {
        bf16x8 a = *(const bf16x8*)(Bg + (sb * 32 + r) * 136 + kk * 16 + h * 8);
        gt = MFMA(a, cf[kk], gt);
      }
      f32x16 wv;
      if (sb != wid) {
        const float ref = sb < wid ? c0l : s1l;
        const float* cumv = ah + (sb < wid ? 256 : 384) + sb * 32 + 4 * h;
        const float* dtv = ah + (sb < wid ? 0 : 128) + sb * 32 + 4 * h;
#pragma unroll
        for (int q4 = 0; q4 < 4; ++q4) {
          const f32x4 cv = *(const f32x4*)(cumv + 8 * q4), dv = *(const f32x4*)(dtv + 8 * q4);
#pragma unroll
          for (int k = 0; k < 4; ++k) wv[4 * q4 + k] = gt[4 * q4 + k] * (__expf(ref - cv[k]) * dv[k]);
        }
      } else {
#pragma unroll
        for (int q4 = 0; q4 < 4; ++q4) {
          const int s4 = sb * 32 + 8 * q4 + 4 * h;
          const f32x4 c0v = *(const f32x4*)(ah + 256 + s4), d0v = *(const f32x4*)(ah + s4);
          const f32x4 s1v = *(const f32x4*)(ah + 384 + s4), d1v = *(const f32x4*)(ah + 128 + s4);
#pragma unroll
          for (int k = 0; k < 4; ++k) {
            const int s = s4 + k;
            const float a0 = (l >= s) ? (c0l - c0v[k]) : -1e30f;
            const float a1 = (l <= s) ? (s1l - s1v[k]) : -1e30f;
            wv[4 * q4 + k] = gt[4 * q4 + k] * (__expf(a0) * d0v[k] + __expf(a1) * d1v[k]);
          }
          __builtin_amdgcn_sched_barrier(0);
        }
      }
      bf16x8 wp0 = pack8(wv[0], wv[1], wv[2], wv[3], wv[4], wv[5], wv[6], wv[7]);
      bf16x8 wp1 = pack8(wv[8], wv[9], wv[10], wv[11], wv[12], wv[13], wv[14], wv[15]);
#pragma unroll
      for (int pb = 0; pb < 2; ++pb) {
        const u16* xrow = xsT + (hd2 * 64 + pb * 32 + r) * 136 + sb * 32 + 4 * h;
        s16x4 lo0 = *(const s16x4*)(xrow), hi0 = *(const s16x4*)(xrow + 8);
        s16x4 lo1 = *(const s16x4*)(xrow + 16), hi1 = *(const s16x4*)(xrow + 24);
        bf16x8 a0 = __builtin_shufflevector(lo0, hi0, 0, 1, 2, 3, 4, 5, 6, 7);
        bf16x8 a1 = __builtin_shufflevector(lo1, hi1, 0, 1, 2, 3, 4, 5, 6, 7);
        y[pb] = MFMA(a0, wp0, y[pb]);
        y[pb] = MFMA(a1, wp1, y[pb]);
      }
    }
#pragma unroll 1
    for (int d = 0; d < 2; ++d) {
      const float el = __expf(d == 0 ? c0l : s1l);
#pragma unroll
      for (int pb = 0; pb < 2; ++pb) {
        const float* srow = p.CS + ((((size_t)bc * 2 + d) * 4 + hh) * 64 + pb * 32 + r) * 128 + h * 8;
        f32x16 tmp;
#pragma unroll
        for (int e = 0; e < 16; ++e) tmp[e] = 0.f;
#pragma unroll
        for (int kk = 0; kk < 8; ++kk) {
          f32x4 s0 = *(const f32x4*)(srow + kk * 16), s1 = *(const f32x4*)(srow + kk * 16 + 4);
          bf16x8 a = pack8(s0.x, s0.y, s0.z, s0.w, s1.x, s1.y, s1.z, s1.w);
          tmp = MFMA(a, cf[kk], tmp);
        }
#pragma unroll
        for (int e = 0; e < 16; ++e) y[pb][e] += el * tmp[e];
      }
    }
    const float dsk = p.ssd_d[layer * 8 + hh] + p.ssd_d[layer * 8 + 4 + hh];
#pragma unroll
    for (int pb = 0; pb < 2; ++pb) {
#pragma unroll
      for (int q4 = 0; q4 < 4; ++q4) {
        const int cl = hd2 * 64 + pb * 32 + 8 * q4 + 4 * h;
        const int ch0 = G * 128 + cl;
        u32x2 zw = *(const u32x2*)(p.P + (size_t)(row0 + l) * NINP + 960 + ch0);
        f32x4 o;
        o.x = (y[pb][4 * q4] + dsk * bf2f(xsT[(cl + 0) * 136 + l])) * silu_f(bflo(zw.x));
        o.y = (y[pb][4 * q4 + 1] + dsk * bf2f(xsT[(cl + 1) * 136 + l])) * silu_f(bfhi(zw.x));
        o.z = (y[pb][4 * q4 + 2] + dsk * bf2f(xsT[(cl + 2) * 136 + l])) * silu_f(bflo(zw.y));
        o.w = (y[pb][4 * q4 + 3] + dsk * bf2f(xsT[(cl + 3) * 136 + l])) * silu_f(bfhi(zw.y));
        ss += o.x * o.x + o.y * o.y + o.z * o.z + o.w * o.w;
        *(f32x4*)(p.ytmp + (size_t)(row0 + l) * 256 + ch0) = o;
      }
    }
  }
  return ss;
}

DI void ssd_s3_tasks(const Params& p, int layer, char* smem) {
  const int ftid = ltid(), vb = ftid >> 8, tid = ftid & 255;
  u16* Bg = (u16*)(smem + vb * VSMEM);
  u16* xsT = Bg + 128 * 136;
  float* arr = (float*)(xsT + 128 * 136);
  const int lane = tid & 63, wid = tid >> 6, r = lane & 31, h = lane >> 5;
  const int l = wid * 32 + r;
  for (int t0 = lbid() * 2; t0 < NB * NCH; t0 += gridDim.x * 2) {
    const int bc = t0 + vb, c = bc % NCH;
    const int row0 = bc * 128;
    const bool cPrev = (c != 0 && c != 32), cNext = (c != 31 && c != 33);
    float ss = ssd_s3_group<0>(p, layer, bc, cPrev, cNext, Bg, xsT, arr, tid);
    ss += ssd_s3_group<1>(p, layer, bc, cPrev, cNext, Bg, xsT, arr, tid);
    ss += __shfl_xor(ss, 32);
    const float rstd = rsqrtf(ss * (1.f / 256.f) + EPS);
    const float* gn = p.ssd_norm_g + layer * 256;
#pragma unroll 4
    for (int i = 0; i < 32; ++i) {
      const int ch0 = (i >> 2) * 32 + 8 * (i & 3) + 4 * h;
      f32x4 v = *(const f32x4*)(p.ytmp + (size_t)(row0 + l) * 256 + ch0);
      f32x4 gv = *(const f32x4*)(gn + ch0);
      u32x2 w;
      w.x = pack2(v.x * rstd * gv.x, v.y * rstd * gv.y);
      w.y = pack2(v.z * rstd * gv.z, v.w * rstd * gv.w);
      *(u32x2*)(p.H + (size_t)(row0 + l) * D + 768 + ch0) = w;
    }
  }
}

constexpr int QREG = 12;
DI void attn_qk(const u16* Ks, const bf16x8 (&qf)[QREG], const u16* qs, f32x16 (&st)[2], int r, int h) {
#pragma unroll
  for (int kb = 0; kb < 2; ++kb)
#pragma unroll
    for (int e = 0; e < 16; ++e) st[kb][e] = 0.f;
  const u16* kp = Ks + r * 200 + h * 8;
#pragma unroll
  for (int kk = 0; kk < 12; ++kk) {
    bf16x8 k0 = *(const bf16x8*)(kp + kk * 16);
    bf16x8 k1 = *(const bf16x8*)(kp + 32 * 200 + kk * 16);
    bf16x8 q;
    if (kk < QREG) q = qf[kk];
    else q = *(const bf16x8*)(qs + (kk - QREG) * 512);
    st[0] = MFMA(k0, q, st[0]);
    st[1] = MFMA(k1, q, st[1]);
  }
}
DI void attn_softmax(f32x16 (&st)[2], f32x16 (&o)[4], bf16x8 (&pf)[4], float& m_run, float& l_run, float sc) {
  float mx = st[0][0];
#pragma unroll
  for (int kb = 0; kb < 2; ++kb)
#pragma unroll
    for (int e = 0; e < 16; ++e) mx = fmaxf(mx, st[kb][e]);
  mx = fmaxf(mx, __shfl_xor(mx, 32));
  const float m_new = fmaxf(m_run, mx * sc);
  const float alpha = __builtin_amdgcn_exp2f(m_run - m_new);
  m_run = m_new;
  float ls = 0.f;
#pragma unroll
  for (int kb = 0; kb < 2; ++kb)
#pragma unroll
    for (int e = 0; e < 16; ++e) {
      float pv = __builtin_amdgcn_exp2f(fmaf(st[kb][e], sc, -m_new));
      ls += pv;
      st[kb][e] = pv;
    }
  l_run = l_run * alpha + ls;
  if (__builtin_amdgcn_ballot_w64(alpha != 1.f) != 0ull) {
#pragma unroll
    for (int i = 0; i < 4; ++i)
#pragma unroll
      for (int e = 0; e < 16; ++e) o[i][e] *= alpha;
  }
#pragma unroll
  for (int ks = 0; ks < 4; ++ks) {
    const int kb = ks >> 1, s2 = ks & 1;
    pf[ks] = pack8(st[kb][8 * s2], st[kb][8 * s2 + 1], st[kb][8 * s2 + 2], st[kb][8 * s2 + 3], st[kb][8 * s2 + 4],
                   st[kb][8 * s2 + 5], st[kb][8 * s2 + 6], st[kb][8 * s2 + 7]);
  }
}
DI void attn_pv(const u16* Vs, const bf16x8 (&pf)[4], f32x16 (&o)[4], int r, int h) {
#pragma unroll
  for (int ks = 0; ks < 4; ++ks) {
#pragma unroll
    for (int db = 0; db < 4; ++db) {
      bf16x8 a = *(const bf16x8*)(Vs + (db * 32 + r) * 72 + ks * 16 + 8 * h);
      o[db] = MFMA(a, pf[ks], o[db]);
    }
  }
}

DI void attn_tasks(const Params& p, char* smem) {
  u16* Ks0 = (u16*)smem;
  u16* Vs0 = Ks0 + 2 * 64 * 200;
  const int tid = ltid(), lane = tid & 63, wid = __builtin_amdgcn_readfirstlane(tid >> 6), r = lane & 31, h = lane >> 5;
  u16* qs = Vs0 + 2 * 128 * 72 + wid * ((12 - QREG) * 512) + lane * 8;
  const float sc = 0.07216878364870322f * 1.4426950408889634f;
  for (int task = lbid(); task < NB * 4 * 17; task += gridDim.x) {
    int b, hd, qt;
    if (task < 512) {
      qt = task & 15; hd = (task >> 4) & 3; b = task >> 6;
    } else {
      const int t2 = task - 512;
      qt = 16; hd = t2 & 3; b = t2 >> 2;
    }
    const int koff = (qt < 16) ? 0 : SEQ;
    const int nkt = ((qt < 16) ? SP : CTX) / 64;
    const int qrow = b * SP + qt * 256 + wid * 32 + r;
    bf16x8 qf[QREG];
#pragma unroll
    for (int kk = 0; kk < QREG; ++kk) qf[kk] = *(const bf16x8*)(p.Q + (size_t)qrow * 768 + hd * 192 + kk * 16 + h * 8);
#pragma unroll
    for (int kk = QREG; kk < 12; ++kk)
      *(bf16x8*)(qs + (kk - QREG) * 512) = *(const bf16x8*)(p.Q + (size_t)qrow * 768 + hd * 192 + kk * 16 + h * 8);
    f32x16 o[4];
#pragma unroll
    for (int i = 0; i < 4; ++i)
#pragma unroll
      for (int e = 0; e < 16; ++e) o[i][e] = 0.f;
    float m_run = -1e30f, l_run = 0.f;
    u32x4 kn[2], kr[1], vv[2];
    const u16* knb = p.Kn + ((size_t)(b * SP + koff) + (tid >> 4)) * 512 + hd * 128 + (tid & 15) * 8;
    const u16* krb = p.Kr + ((size_t)(b * SP + koff) + (tid >> 3)) * 64 + (tid & 7) * 8;
    const u16* vb = p.Vt + ((size_t)(b * 4 + hd) * 128 + (tid >> 3)) * SP + koff + (tid & 7) * 8;
#define ALOAD(ko_)                                                                               \
  {                                                                                              \
    _Pragma("unroll") for (int i = 0; i < 2; ++i) kn[i] = *(const u32x4*)(knb + ((ko_) + 32 * i) * 512); \
    kr[0] = *(const u32x4*)(krb + (ko_) * 64);                                                   \
    _Pragma("unroll") for (int i = 0; i < 2; ++i) vv[i] = *(const u32x4*)(vb + (size_t)(64 * i) * SP + (ko_)); \
  }
#define AWRITE(buf_)                                                                             \
  {                                                                                              \
    u16* Kw = Ks0 + (buf_) * (64 * 200);                                                         \
    u16* Vw = Vs0 + (buf_) * (128 * 72);                                                         \
    _Pragma("unroll") for (int i = 0; i < 2; ++i) *(u32x4*)(Kw + ((tid >> 4) + 32 * i) * 200 + (tid & 15) * 8) = kn[i]; \
    *(u32x4*)(Kw + (tid >> 3) * 200 + 128 + (tid & 7) * 8) = kr[0];                              \
    _Pragma("unroll") for (int i = 0; i < 2; ++i) {                                              \
      u16* dst = Vw + ((tid >> 3) + 64 * i) * 72 + ((tid & 7) >> 1) * 16 + ((tid & 7) & 1) * 4;  \
      *(u32x2*)dst = u32x2{vv[i].x, vv[i].y};                                                    \
      *(u32x2*)(dst + 8) = u32x2{vv[i].z, vv[i].w};                                              \
    }                                                                                            \
  }
    ALOAD((size_t)0);
    AWRITE(0);
    ALOAD((size_t)64);
    for (int kt = 0; kt < nkt; ++kt) {
      __syncthreads();
      if (kt + 1 < nkt) AWRITE((kt + 1) & 1);
      {
        const size_t ko = (size_t)(kt + 2 < nkt ? kt + 2 : nkt - 1) * 64;
        ALOAD(ko);
      }
      __builtin_amdgcn_sched_barrier(0);
      f32x16 st[2];
      bf16x8 pf[4];
      attn_qk(Ks0 + (kt & 1) * (64 * 200), qf, qs, st, r, h);
      attn_softmax(st, o, pf, m_run, l_run, sc);
      attn_pv(Vs0 + (kt & 1) * (128 * 72), pf, o, r, h);
    }
#undef ALOAD
#undef AWRITE
    const float ltot = l_run + __shfl_xor(l_run, 32);
    const float inv = 1.f / ltot;
    u16* orow = p.H + (size_t)qrow * D + hd * 128;
#pragma unroll
    for (int db = 0; db < 4; ++db)
#pragma unroll
      for (int q4 = 0; q4 < 4; ++q4) {
        u32x2 w;
        w.x = pack2(o[db][4 * q4] * inv, o[db][4 * q4 + 1] * inv);
        w.y = pack2(o[db][4 * q4 + 2] * inv, o[db][4 * q4 + 3] * inv);
        *(u32x2*)(orow + db * 32 + 8 * q4 + 4 * h) = w;
      }
  }
}

constexpr int NPHASE = 2 + DEPTH * 6;

DI void conv_item_ffn(const Params& p, int layer, int q, char* smem) {
#pragma unroll 1
  for (int u = 0; u < 8; ++u) {
    const int tile = q * 8 + u;
    if (tile < 1024) conv_tile(p.w_ff1 + (size_t)layer * D * DFF, D, DFF, p.wt_ff1, nullptr, tile >> 6, tile & 63, smem);
    else conv_tile(p.w_ff2 + (size_t)layer * DFF * D, DFF, D, p.wt_ff2, nullptr, (tile - 1024) >> 4, (tile - 1024) & 15, smem);
  }
}
DI void conv_item_mix(const Params& p, int layer, int q, char* smem) {
#pragma unroll 1
  for (int u = 0; u < 8; ++u) {
    int tile = q * 8 + u;
    if (tile < 512) { conv_tile(p.w_in + (size_t)layer * D * NIN, D, NIN, p.wt_in, nullptr, tile >> 5, tile & 31, smem); continue; }
    tile -= 512;
    if (tile < 48) { conv_tile(p.w_uq + (size_t)layer * 256 * 768, 256, 768, p.wt_uq, p.g_q + layer * 256, tile / 12, tile % 12, smem); continue; }
    tile -= 48;
    if (tile < 32) { conv_tile(p.w_ukv + (size_t)layer * 128 * 1024, 128, 1024, p.wt_ukv, p.g_kv + layer * 128, tile >> 4, tile & 15, smem); continue; }
    tile -= 32;
    if (tile < 256) { conv_tile(p.w_out + (size_t)layer * D * D, D, D, p.wt_out, nullptr, tile >> 4, tile & 15, smem); continue; }
    tile -= 256;
    for (int i = ltid(); i < 4096; i += NTHR) p.wsb[tile * 4096 + i] = f2bf(p.cm_w_s[(size_t)layer * 65536 + tile * 4096 + i]);
  }
}

DI void run_phase(const Params& p, int ph, char* smem) {
  if (ph == 0) { prologue_phase(p, smem); return; }
  const int MT = T / 256;
  auto noT = [](int, int, u32x4) {};
  auto neverT = [](int) { return false; };
  if (ph == 1) {
    ew_phase(p, 0, 0);
    for (int q = lbid(); q < 108; q += gridDim.x) conv_item_mix(p, 0, q, smem);
    return;
  }
  const int layer = (ph - 2) / 6, sub = (ph - 2) % 6;
  const bool last = layer == DEPTH - 1;
  switch (sub) {
    case 0: {
      for (int it = 0;; ++it) {
        const int t = xcd_tile(it, MT * 8);
        if (t < 0) break;
        const int tm = t >> 3, tn = t & 7;
        gemm_tile<false>(
            p.H, D, p.wt_in, D, D, tm * 256, tn * 256, smem,
            [&](int mb, int nb, f32x16& acc, int r, int h) {
              if (nb == 1984) {
                f32x4 v = {acc[0], acc[1], acc[2], acc[3]};
                *(f32x4*)(p.dtraw + (size_t)(mb + r) * 8 + 4 * h) = v;
              }
            },
            [&](int row, int col, u32x4 v) { *(u32x4*)(p.P + (size_t)row * NINP + col) = v; }, noT, neverT);
      }
    } break;
    case 1: {
      int* wq = p.cnt + (2 * DEPTH + layer) * CNT_STRIDE;
      int* sh = (int*)(smem + SMEM_BYTES - 16);
      for (;;) {
        __syncthreads();
        if (ltid() == 0) *sh = __hip_atomic_fetch_add(wq, 1, __ATOMIC_RELAXED, __HIP_MEMORY_SCOPE_AGENT);
        __syncthreads();
        const int q = *sh;
        if (q >= 544 + 136 + 408 + 544) break;
        if (q < 544) ssd_s1_tasks(p, layer, smem, 2 * q, 2 * q + 1, 2);
        else if (q < 680) cm_tasks(p, layer, smem, 2 * (q - 544), 2 * (q - 544) + 1, 2);
        else if (q < 1088) qkv_tasks(p, smem, q - 680, q - 679, 0, 0, 1);
        else qkv_tasks(p, smem, 0, 0, q - 1088, q - 1087, 1);
      }
    } break;
    case 2: ssd_scan_phase(p); break;
    case 3: {
      attn_tasks(p, smem);
      ssd_s3_tasks(p, layer, smem);
    } break;
    case 4: {
      int* cnt = p.cnt + (2 * layer) * CNT_STRIDE;
      for (int it = 0;; ++it) {
        const int t = xcd_tile(it, MT * 4, last ? 4 : 0);
        if (t < 0) break;
        const int tm = t >> 2, tn = t & 3;
        gemm_tile<false>(
            p.H, D, p.wt_out, D, D, tm * 256, tn * 256, smem, [](int, int, f32x16&, int, int) {},
            [&](int row, int col, u32x4 v) { st_wt(p.Y + (size_t)row * D + col, v); }, noT, neverT);
        tile_done(cnt, tm);
      }
      ew_consume(p, cnt, 4, layer, 1, last, 256, [&](int q) { conv_item_ffn(p, layer, q, smem); }, smem);
    } break;
    case 5: {
      int* cnt1 = p.cnt + (3 * DEPTH + layer) * CNT_STRIDE;
      for (int it = 0;; ++it) {
        const int t = xcd_tile(it, MT * 16, last ? 16 : 0);
        if (t < 0) break;
        const int tm = t >> 4, tn = t & 15;
        gemm_tile<false>(
            p.H, D, p.wt_ff1, D, D, tm * 256, tn * 256, smem,
            [](int, int, f32x16& acc, int, int) {
#pragma unroll
              for (int e = 0; e < 16; ++e) {
                float v = fmaxf(acc[e], 0.f);
                acc[e] = v * v;
              }
            },
            [&](int row, int col, u32x4 v) { st_wt(p.Hd + (size_t)row * DFF + col, v); }, noT, neverT);
        tile_done(cnt1, tm);
      }
      int* cnt = p.cnt + (2 * layer + 1) * CNT_STRIDE;
      for (int it = 0;; ++it) {
        const int t = xcd_tile(it, MT * 4, last ? 4 : 0);
        if (t < 0) break;
        const int tm = t >> 2, tn = t & 3;
        if (ltid() == 0) {
          while (__hip_atomic_load(cnt1 + tm, __ATOMIC_RELAXED, __HIP_MEMORY_SCOPE_AGENT) < 16) __builtin_amdgcn_s_sleep(4);
      __builtin_amdgcn_fence(__ATOMIC_ACQUIRE, "agent");
        }
        __syncthreads();
        gemm_tile<false>(
            p.Hd, DFF, p.wt_ff2, DFF, DFF, tm * 256, tn * 256, smem, [](int, int, f32x16&, int, int) {},
            [&](int row, int col, u32x4 v) { st_wt(p.F + (size_t)row * D + col, v); }, noT, neverT);
        tile_done(cnt, tm);
      }
      if (last) ew_consume(p, cnt, 4, DEPTH, 2, true, 0, [](int) {}, smem);
      else ew_consume(p, cnt, 4, layer + 1, 0, false, 108, [&](int q) { conv_item_mix(p, layer + 1, q, smem); }, smem);
    } break;
  }
}

__global__ void __launch_bounds__(NTHR, 2) mega_kernel(Params p, int ph_begin, int ph_end) {
  extern __shared__ __attribute__((aligned(16))) char smem[];
  cg::grid_group grid = cg::this_grid();
  for (int ph = ph_begin; ph < ph_end; ++ph) {
    run_phase(p, ph, smem);
    if (ph + 1 < ph_end) {
      if (ph == 0) {
        grid.sync();
      } else {
        __syncthreads();
        if (threadIdx.x == 0) {
          int* bar = p.cnt + 4 * DEPTH * CNT_STRIDE + ph;
          __hip_atomic_fetch_add(bar, 1, __ATOMIC_RELEASE, __HIP_MEMORY_SCOPE_AGENT);
          while (__hip_atomic_load(bar, __ATOMIC_RELAXED, __HIP_MEMORY_SCOPE_AGENT) < (int)gridDim.x) __builtin_amdgcn_s_sleep(1);
      __builtin_amdgcn_fence(__ATOMIC_ACQUIRE, "agent");
        }
        __syncthreads();
      }
    }
  }
}

extern "C" void kernel_launch(void* const* d_in, const int* in_sizes, int n_in, void* d_out, int out_size, void* d_ws,
                              size_t ws_size, hipStream_t stream) {
  Params p{};
  const float* const* in = (const float* const*)d_in;
  p.x = in[0]; p.c = in[1]; p.ctx = in[2]; p.c_ctx = in[3]; p.w_ada = in[4]; p.b_ada = in[5];
  p.g_pre_mix = in[6]; p.g_post_mix = in[7]; p.g_pre_ff = in[8]; p.g_post_ff = in[9]; p.w_in = in[10];
  p.g_q = in[11]; p.w_uq = in[12]; p.g_kv = in[13]; p.w_ukv = in[14]; p.cm_norm_g = in[15]; p.cm_w_s = in[16];
  p.cm_b_s = in[17]; p.conv_w = in[18]; p.conv_b = in[19]; p.dt_bias = in[20]; p.a_log = in[21]; p.ssd_d = in[22];
  p.ssd_norm_g = in[23]; p.w_out = in[24]; p.w_ff1 = in[25]; p.w_ff2 = in[26];
  p.out = (float*)d_out;
  char* ws = (char*)d_ws;
  size_t off = 0;
  auto take = [&](size_t bytes) { char* q = ws + off; off += (bytes + 255) & ~(size_t)255; return q; };
  p.wt_in = (u16*)take((size_t)NINP * D * 2);
  p.wt_uq = (u16*)take((size_t)768 * 256 * 2);
  p.wt_ukv = (u16*)take((size_t)1024 * 128 * 2);
  p.wt_out = (u16*)take((size_t)D * D * 2);
  p.wt_ff1 = (u16*)take((size_t)DFF * D * 2);
  p.wt_ff2 = (u16*)take((size_t)D * DFF * 2);
  p.wsb = (u16*)take((size_t)4 * 128 * 128 * 2);
  p.mod = (float*)take((size_t)DEPTH * 9 * 6144 * 4);
  p.ropetab = (float*)take((size_t)64 * 16 * 2 * 4);
  p.atot = (float*)take((size_t)NB * NCH * 2 * 4 * 4);
  p.xctx = (float*)take((size_t)NB * CTX * D * 4);
  char* r1 = take((size_t)T * DFF * 2);
  p.Hd = (u16*)r1;
  p.Y = (u16*)r1;
  {
    size_t o2 = 0;
    p.P = (u16*)(r1 + o2); o2 += (size_t)T * NINP * 2;
    p.Q = (u16*)(r1 + o2); o2 += (size_t)T * 768 * 2;
    p.Kn = (u16*)(r1 + o2); o2 += (size_t)T * 512 * 2;
    p.Kr = (u16*)(r1 + o2); o2 += (size_t)T * 64 * 2;
    p.Vt = (u16*)(r1 + o2); o2 += (size_t)NB * 4 * 128 * SP * 2;
    p.dtraw = (float*)(r1 + o2); o2 += (size_t)T * 8 * 4;
  }
  p.H = (u16*)take((size_t)T * D * 2);
  p.CS = (float*)take((size_t)NB * NCH * 2 * 4 * 8192 * 4);
  p.F = (u16*)p.CS;
  p.ytmp = (float*)take((size_t)T * 256 * 4);
  p.cnt = (int*)take((size_t)(4 * DEPTH * CNT_STRIDE + 64) * 4);
  if (off > ws_size) {
    fprintf(stderr, "workspace too small: need %zu have %zu\n", off, ws_size);
    return;
  }
  static int grid_blocks = 0;
  if (!grid_blocks) {
    int dev = 0, cus = 0, per_cu = 0;
    hipGetDevice(&dev);
    hipDeviceGetAttribute(&cus, hipDeviceAttributeMultiprocessorCount, dev);
    hipFuncSetAttribute((const void*)mega_kernel, hipFuncAttributeMaxDynamicSharedMemorySize, SMEM_BYTES);
    hipOccupancyMaxActiveBlocksPerMultiprocessor(&per_cu, mega_kernel, NTHR, SMEM_BYTES);
    if (per_cu < 1) per_cu = 1;
    if (per_cu > 1) per_cu = 1;
    grid_blocks = cus * per_cu;
  }
  int pb = 0, pe = NPHASE;
  void* args[] = {&p, &pb, &pe};
  hipError_t e = hipLaunchCooperativeKernel((void*)mega_kernel, dim3(grid_blocks), dim3(NTHR), args, SMEM_BYTES, stream);
  if (e != hipSuccess) fprintf(stderr, "cooperative launch failed: %s (grid %d)\n", hipGetErrorString(e), grid_blocks);
}
```

```cpp
#include <hip/hip_runtime.h>
#include <hip/hip_cooperative_groups.h>
#include <cstdio>
namespace cg = cooperative_groups;

#define DI __device__ __forceinline__
typedef unsigned short u16;
using bf16x8 = __attribute__((ext_vector_type(8))) short;
using s16x4 = __attribute__((ext_vector_type(4))) short;
using f32x16 = __attribute__((ext_vector_type(16))) float;
using u32x4 = __attribute__((ext_vector_type(4))) unsigned;
using u32x2 = __attribute__((ext_vector_type(2))) unsigned;
using f32x4 = __attribute__((ext_vector_type(4))) float;
typedef __bf16 bf2_t __attribute__((ext_vector_type(2)));
typedef float f2_t __attribute__((ext_vector_type(2)));
#define MFMA(a, b, c) __builtin_amdgcn_mfma_f32_32x32x16_bf16((a), (b), (c), 0, 0, 0)

constexpr int NB = 8, SEQ = 4096, CTX = 256, SP = 4352, T = NB * SP, D = 1024, DFF = 4096;
constexpr int NIN = 1992, NINP = 2048, NCH = 34, DEPTH = 4;
constexpr int NTHR = 512;
constexpr int VT = 256;
constexpr int VSMEM = 75 * 1024;
constexpr int SMEM_BYTES = 2 * VSMEM;
constexpr float EPS = 1e-6f;
constexpr int CNT_STRIDE = 160;

struct Params {
  const float *x, *c, *ctx, *c_ctx, *w_ada, *b_ada, *g_pre_mix, *g_post_mix, *g_pre_ff, *g_post_ff, *w_in, *g_q, *w_uq,
      *g_kv, *w_ukv, *cm_norm_g, *cm_w_s, *cm_b_s, *conv_w, *conv_b, *dt_bias, *a_log, *ssd_d, *ssd_norm_g, *w_out,
      *w_ff1, *w_ff2;
  float* out;
  u16 *wt_in, *wt_uq, *wt_ukv, *wt_out, *wt_ff1, *wt_ff2, *wsb;
  float *mod, *ropetab, *atot, *xctx;
  u16 *P, *Q, *Kn, *Kr, *Vt, *Hd;
  u16* Y;
  float* dtraw;
  u16* H;
  float* CS;
  u16* F;
  float* ytmp;
  int* cnt;
};

DI int ltid() { int t = threadIdx.x; asm volatile("" : "+v"(t)); return t; }
DI int lbid() { int t = blockIdx.x; asm volatile("" : "+s"(t)); return t; }
DI void st_wt(void* ptr, u32x4 v) { asm volatile("global_store_dwordx4 %0, %1, off sc0 sc1" ::"v"(ptr), "v"(v) : "memory"); }
DI int crow(int e, int h) { return (e & 3) + 8 * (e >> 2) + 4 * h; }
DI unsigned pack2(float a, float b) {
  f2_t v = {a, b};
  bf2_t r = __builtin_convertvector(v, bf2_t);
  return __builtin_bit_cast(unsigned, r);
}
DI u16 f2bf(float a) { return (u16)(pack2(a, 0.f) & 0xffffu); }
DI float bf2f(u16 v) { return __uint_as_float(((unsigned)v) << 16); }
DI float bflo(unsigned w) { return __uint_as_float(w << 16); }
DI float bfhi(unsigned w) { return __uint_as_float(w & 0xffff0000u); }
DI bf16x8 pack8(float a0, float a1, float a2, float a3, float a4, float a5, float a6, float a7) {
  u32x4 u;
  u.x = pack2(a0, a1); u.y = pack2(a2, a3); u.z = pack2(a4, a5); u.w = pack2(a6, a7);
  return __builtin_bit_cast(bf16x8, u);
}
DI float wave_sum(float v) {
#pragma unroll
  for (int o = 32; o > 0; o >>= 1) v += __shfl_xor(v, o);
  return v;
}
DI float silu_f(float y) { return y * __builtin_amdgcn_rcpf(1.f + __expf(-y)); }
DI float gelu_f(float x) {
  float u = 0.7978845608028654f * (x + 0.044715f * x * x * x);
  float t = 1.f - 2.f * __builtin_amdgcn_rcpf(1.f + __expf(2.f * u));
  return 0.5f * x * (1.f + t);
}
DI float softplus_f(float x) { return x > 20.f ? x : log1pf(__expf(x)); }
DI float uw(const u32x4& v, int i) {
  unsigned w = (i >> 1) == 0 ? v.x : (i >> 1) == 1 ? v.y : (i >> 1) == 2 ? v.z : v.w;
  return (i & 1) ? bfhi(w) : bflo(w);
}

template <bool HAS_T, class ElemF, class StoreF, class StoreTF, class UseTF>
DI void gemm_tile(const u16* __restrict__ A, int lda, const u16* __restrict__ Bt, int ldb, int K, int m0, int n0,
                  char* smem, ElemF elem, StoreF store, StoreTF storeT, UseTF useT) {
  constexpr int LS = 72;
  constexpr int STAGE = 2 * 256 * LS;
  u16* base = (u16*)smem;
  const int tid = ltid(), lane = tid & 63, wid = tid >> 6, wm = wid >> 2, wn = wid & 3, r = lane & 31, h = lane >> 5;
  f32x16 acc[4][2];
#pragma unroll
  for (int i = 0; i < 4; ++i)
#pragma unroll
    for (int j = 0; j < 2; ++j)
#pragma unroll
      for (int e = 0; e < 16; ++e) acc[i][j][e] = 0.f;
  u32x4 ra[4], rb[4];
  const int lrow = tid >> 3, lcp = (tid & 7) * 8;
  const u16* ga = A + (size_t)(m0 + lrow) * lda + lcp;
  const u16* gb = Bt + (size_t)(n0 + lrow) * ldb + lcp;
  const int wofs = lrow * LS + lcp;
  const int aofs = (wm * 128 + r) * LS + h * 8;
  const int bofs = 256 * LS + (wn * 64 + r) * LS + h * 8;
#define GLOAD(kt_)                                                           \
  _Pragma("unroll") for (int i = 0; i < 4; ++i) {                            \
    ra[i] = *(const u32x4*)(ga + (size_t)(64 * i) * lda + (kt_) * 64);       \
    rb[i] = *(const u32x4*)(gb + (size_t)(64 * i) * ldb + (kt_) * 64);       \
  }
#define SWRITE(st_)                                                          \
  _Pragma("unroll") for (int i = 0; i < 4; ++i) {                            \
    *(u32x4*)((st_) + wofs + 64 * i * LS) = ra[i];                           \
    *(u32x4*)((st_) + 256 * LS + wofs + 64 * i * LS) = rb[i];                \
  }
#define FREAD(dst_, st_, kk_)                                                                      \
  _Pragma("unroll") for (int i = 0; i < 4; ++i) af[dst_][i] = *(const bf16x8*)((st_) + aofs + i * 32 * LS + (kk_) * 16); \
  _Pragma("unroll") for (int j = 0; j < 2; ++j) bfr[dst_][j] = *(const bf16x8*)((st_) + bofs + j * 32 * LS + (kk_) * 16);
#define MMAS(src_)                                                           \
  _Pragma("unroll") for (int i = 0; i < 4; ++i)                              \
  _Pragma("unroll") for (int j = 0; j < 2; ++j) acc[i][j] = MFMA(bfr[src_][j], af[src_][i], acc[i][j]);
#define ILV()                                                                   \
  __builtin_amdgcn_sched_group_barrier(0x008, 2, 0);                            \
  __builtin_amdgcn_sched_group_barrier(0x100, 2, 0);                            \
  __builtin_amdgcn_sched_group_barrier(0x008, 2, 0);                            \
  __builtin_amdgcn_sched_group_barrier(0x100, 2, 0);                            \
  __builtin_amdgcn_sched_group_barrier(0x008, 2, 0);                            \
  __builtin_amdgcn_sched_group_barrier(0x100, 2, 0);                            \
  __builtin_amdgcn_sched_group_barrier(0x008, 2, 0);
  const int nk = K >> 6;
  bf16x8 af[2][4], bfr[2][2];
  GLOAD(0);
  __syncthreads();
  SWRITE(base);
  if (nk > 1) { GLOAD(1); }
  __syncthreads();
  FREAD(0, base, 0);
  for (int kt = 0; kt < nk; ++kt) {
    u16* cur = base + (kt & 1) * STAGE;
    u16* nxt = base + ((kt + 1) & 1) * STAGE;
    FREAD(1, cur, 1);
    if (kt + 1 < nk) { SWRITE(nxt); }
    MMAS(0);
#pragma unroll
    for (int z = 0; z < 7; ++z) {
      __builtin_amdgcn_sched_group_barrier(0x008, 1, 0);
      __builtin_amdgcn_sched_group_barrier(0x080, 2, 0);
    }
    __builtin_amdgcn_sched_group_barrier(0x008, 1, 0);
    __builtin_amdgcn_sched_barrier(0);
    if (kt + 2 < nk) { GLOAD(kt + 2); }
    FREAD(0, cur, 2);
    MMAS(1);
    ILV();
    __builtin_amdgcn_sched_barrier(0);
    FREAD(1, cur, 3);
    MMAS(0);
    ILV();
    __builtin_amdgcn_sched_barrier(0);
    __syncthreads();
    if (kt + 1 < nk) { FREAD(0, nxt, 0); }
    MMAS(1);
    ILV();
    __builtin_amdgcn_sched_barrier(0);
  }
#undef ILV
#undef GLOAD
#undef SWRITE
#undef FREAD
#undef MMAS
#pragma unroll
  for (int i = 0; i < 4; ++i)
#pragma unroll
    for (int j = 0; j < 2; ++j) elem(m0 + wm * 128 + i * 32, n0 + wn * 64 + j * 32, acc[i][j], r, h);
  u16* stg = base + wid * (128 * 72);
  if (HAS_T && useT(wn)) {
#pragma unroll
    for (int i = 0; i < 4; ++i)
#pragma unroll
      for (int j = 0; j < 2; ++j)
#pragma unroll
        for (int e = 0; e < 16; ++e) stg[(j * 32 + crow(e, h)) * 136 + i * 32 + r] = f2bf(acc[i][j][e]);
    __builtin_amdgcn_wave_barrier();
#pragma unroll 4
    for (int t = 0; t < 16; ++t) {
      const int id = lane + 64 * t, cl = id >> 4, cp = id & 15;
      u32x4 v = *(const u32x4*)(stg + cl * 136 + cp * 8);
      storeT(n0 + wn * 64 + cl, m0 + wm * 128 + cp * 8, v);
    }
  } else {
#pragma unroll
    for (int i = 0; i < 4; ++i)
#pragma unroll
      for (int j = 0; j < 2; ++j)
#pragma unroll
        for (int q4 = 0; q4 < 4; ++q4) {
          u32x2 w;
          w.x = pack2(acc[i][j][4 * q4], acc[i][j][4 * q4 + 1]);
          w.y = pack2(acc[i][j][4 * q4 + 2], acc[i][j][4 * q4 + 3]);
          *(u32x2*)(stg + (i * 32 + r) * 72 + j * 32 + 8 * q4 + 4 * h) = w;
        }
    __builtin_amdgcn_wave_barrier();
#pragma unroll 4
    for (int t = 0; t < 16; ++t) {
      const int id = lane + 64 * t, rl = id >> 3, cp = id & 7;
      u32x4 v = *(const u32x4*)(stg + rl * 72 + cp * 8);
      store(m0 + wm * 128 + rl, n0 + wn * 64 + cp * 8, v);
    }
  }
}

DI int xcd_tile(int it, int ntiles, int skip_tail = 0) {
  const int b = lbid(), g = gridDim.x;
  const int local = (b >> 3) + it * (g >> 3);
  const int per = ntiles >> 3;
  return local < per - skip_tail ? (b & 7) * per + local : -1;
}

DI void conv_tile(const float* __restrict__ src, int K, int N, u16* __restrict__ dst, const float* __restrict__ scale,
                  int tk, int tn, char* smem) {
  float* tile = (float*)smem;
  const int tid = ltid(), tx = tid & 63, ty = tid >> 6;
  const int k0 = tk * 64, n0 = tn * 64;
  __syncthreads();
#pragma unroll 4
  for (int i = 0; i < 8; ++i) {
    int kr = ty + 8 * i;
    float v = 0.f;
    if (n0 + tx < N) v = src[(size_t)(k0 + kr) * N + n0 + tx];
    if (scale) v *= scale[k0 + kr];
    tile[kr * 65 + tx] = v;
  }
  __syncthreads();
#pragma unroll 4
  for (int i = 0; i < 8; ++i) {
    int nr = ty + 8 * i;
    dst[(size_t)(n0 + nr) * K + k0 + tx] = f2bf(tile[tx * 65 + nr]);
  }
}

DI void convert_weights(const float* src, int K, int N, int Npad, u16* dst, const float* scale, char* smem) {
  const int tks = K / 64, tns = Npad / 64;
  for (int t = lbid(); t < tks * tns; t += gridDim.x) conv_tile(src, K, N, dst, scale, t / tns, t % tns, smem);
}

DI void prologue_phase(const Params& p, char* smem) {
  float* sc = (float*)smem;
  float* red = sc + 9 * 1024;
  const int tid = ltid();
  for (int i = tid; i < 9 * 1024; i += NTHR) {
    int j = i >> 10, k = i & 1023;
    float v = j < 8 ? p.c[j * 1024 + k] : p.c_ctx[k];
    sc[i] = v / (1.f + __expf(-v));
  }
  __syncthreads();
  for (int task = lbid(); task < DEPTH * 96; task += gridDim.x) {
    const int l = task / 96, n0 = (task % 96) * 64, nn = tid & 63, kq = tid >> 6;
    float acc[9];
#pragma unroll
    for (int j = 0; j < 9; ++j) acc[j] = 0.f;
    const float* w = p.w_ada + ((size_t)l * 1024 + kq * 128) * 6144 + n0 + nn;
    const float* scq = sc + kq * 128;
#pragma unroll 4
    for (int k = 0; k < 128; ++k) {
      float wv = w[(size_t)k * 6144];
#pragma unroll
      for (int j = 0; j < 9; ++j) acc[j] += scq[j * 1024 + k] * wv;
    }
#pragma unroll
    for (int j = 0; j < 9; ++j) red[(kq * 9 + j) * 64 + nn] = acc[j];
    __syncthreads();
    for (int idx = tid; idx < 576; idx += NTHR) {
      int j = idx >> 6, n2 = idx & 63;
      float s = p.b_ada[l * 6144 + n0 + n2];
#pragma unroll
      for (int q = 0; q < 8; ++q) s += red[(q * 9 + j) * 64 + n2];
      p.mod[(size_t)(l * 9 + j) * 6144 + n0 + n2] = s;
    }
    __syncthreads();
  }
  for (int i = lbid() * NTHR + tid; i < 4 * DEPTH * CNT_STRIDE + 64; i += gridDim.x * NTHR) p.cnt[i] = 0;
  if (lbid() == gridDim.x - 1) {
    for (int i = tid; i < 64 * 16; i += NTHR) {
      int pos = i >> 4, j = i & 15;
      float inv_freq = exp2f(-(float)(2 * j) / 32.f * 13.287712379549449f);
      float ang = (float)pos * inv_freq;
      float k = rintf(ang * 0.15915494309189535f);
      float red2 = fmaf(-k, 6.2831854820251465f, ang);
      red2 = fmaf(-k, -1.7484555314695172e-07f, red2);
      p.ropetab[2 * i] = __cosf(red2);
      p.ropetab[2 * i + 1] = __sinf(red2);
    }
  }
}

DI void ew_row(const Params& p, int layer, int kind, int row, int lane) {
  const bool has_branch = !(kind == 0 && layer == 0);
  const bool src_in = (layer == 0 && kind <= 1);
  const bool store_x = has_branch;
  const int blayer = (kind == 1) ? layer : (kind == 0 ? layer - 1 : DEPTH - 1);
  const float* gpost = (kind == 1) ? p.g_post_mix + blayer * D : p.g_post_ff + (blayer < 0 ? 0 : blayer) * D;
  const int gate_off = (kind == 1) ? 2 * D : 5 * D;
  const float* gpre = (kind == 0) ? p.g_pre_mix + layer * D : p.g_pre_ff + (kind == 1 ? layer : 0) * D;
  const int shift_off = (kind == 0) ? 0 : 3 * D, scale_off = (kind == 0) ? D : 4 * D;
  const float* xl = src_in ? p.x : p.out;
  const float* xc = src_in ? p.ctx : p.xctx;
    const int b = row / SP, s = row - b * SP;
    const bool lat = s < SEQ;
    if ((kind == 2 || (kind == 1 && layer == DEPTH - 1)) && !lat) return;
    const size_t xoff = lat ? ((size_t)(b * SEQ + s) * D) : ((size_t)(b * CTX + s - SEQ) * D);
    const unsigned long long msk = lat ? ~0ull : 0ull;
    const float* xs = (const float*)(((unsigned long long)xl & msk) | ((unsigned long long)xc & ~msk)) + xoff;
    float* xd = (float*)(((unsigned long long)p.out & msk) | ((unsigned long long)p.xctx & ~msk)) + xoff;
    const int mi = lat ? b : 8;
    f32x4 xv[4];
#pragma unroll
    for (int i = 0; i < 4; ++i) xv[i] = *(const f32x4*)(xs + lane * 4 + 256 * i);
    if (has_branch) {
      const float* modb = p.mod + (size_t)(blayer * 9 + mi) * 6144 + gate_off;
      f32x4 yv[4];
      const u16* ysrc = (kind == 1) ? p.Y : p.F;
      {
        u32x2 w0, w1, w2, w3;
        const u16* yp = ysrc + (size_t)row * D + lane * 4;
        asm volatile("global_load_dwordx2 %0, %1, off sc0 sc1" : "=v"(w0) : "v"(yp) : "memory");
        asm volatile("global_load_dwordx2 %0, %1, off offset:512 sc0 sc1" : "=v"(w1) : "v"(yp) : "memory");
        asm volatile("global_load_dwordx2 %0, %1, off offset:1024 sc0 sc1" : "=v"(w2) : "v"(yp) : "memory");
        asm volatile("global_load_dwordx2 %0, %1, off offset:1536 sc0 sc1" : "=v"(w3) : "v"(yp) : "memory");
        asm volatile("s_waitcnt vmcnt(0)" : "+v"(w0), "+v"(w1), "+v"(w2), "+v"(w3)::"memory");
        yv[0] = f32x4{bflo(w0.x), bfhi(w0.x), bflo(w0.y), bfhi(w0.y)};
        yv[1] = f32x4{bflo(w1.x), bfhi(w1.x), bflo(w1.y), bfhi(w1.y)};
        yv[2] = f32x4{bflo(w2.x), bfhi(w2.x), bflo(w2.y), bfhi(w2.y)};
        yv[3] = f32x4{bflo(w3.x), bfhi(w3.x), bflo(w3.y), bfhi(w3.y)};
      }
      float ss = 0.f;
#pragma unroll
      for (int i = 0; i < 4; ++i) ss += yv[i].x * yv[i].x + yv[i].y * yv[i].y + yv[i].z * yv[i].z + yv[i].w * yv[i].w;
      ss = wave_sum(ss);
      const float rstd = rsqrtf(ss * (1.f / D) + EPS);
#pragma unroll
      for (int i = 0; i < 4; ++i) {
        const int col = lane * 4 + 256 * i;
        f32x4 g = *(const f32x4*)(gpost + col);
        f32x4 gt = *(const f32x4*)(modb + col);
        xv[i].x += gt.x * (yv[i].x * rstd * g.x);
        xv[i].y += gt.y * (yv[i].y * rstd * g.y);
        xv[i].z += gt.z * (yv[i].z * rstd * g.z);
        xv[i].w += gt.w * (yv[i].w * rstd * g.w);
      }
      if (store_x) {
#pragma unroll
        for (int i = 0; i < 4; ++i) *(f32x4*)(xd + lane * 4 + 256 * i) = xv[i];
      }
    }
    if (kind != 2) {
      const float* modl = p.mod + (size_t)(layer * 9 + mi) * 6144;
      float ss = 0.f;
#pragma unroll
      for (int i = 0; i < 4; ++i) ss += xv[i].x * xv[i].x + xv[i].y * xv[i].y + xv[i].z * xv[i].z + xv[i].w * xv[i].w;
      ss = wave_sum(ss);
      const float rstd = rsqrtf(ss * (1.f / D) + EPS);
#pragma unroll
      for (int i = 0; i < 4; ++i) {
        const int col = lane * 4 + 256 * i;
        f32x4 g = *(const f32x4*)(gpre + col);
        f32x4 sh = *(const f32x4*)(modl + shift_off + col);
        f32x4 sc = *(const f32x4*)(modl + scale_off + col);
        float h0 = xv[i].x * rstd * g.x * (1.f + sc.x) + sh.x;
        float h1 = xv[i].y * rstd * g.y * (1.f + sc.y) + sh.y;
        float h2 = xv[i].z * rstd * g.z * (1.f + sc.z) + sh.z;
        float h3 = xv[i].w * rstd * g.w * (1.f + sc.w) + sh.w;
        u32x2 w;
        w.x = pack2(h0, h1);
        w.y = pack2(h2, h3);
        *(u32x2*)(p.H + (size_t)row * D + col) = w;
      }
    }
}

DI void ew_phase(const Params& p, int layer, int kind) {
  const int tid = ltid(), lane = tid & 63, wid = __builtin_amdgcn_readfirstlane(tid >> 6);
  for (int rg = lbid(); rg < T / 8; rg += gridDim.x) ew_row(p, layer, kind, rg * 8 + wid, lane);
}

DI void tile_done(int* cnt, int tm) {
  asm volatile("s_waitcnt vmcnt(0)" ::: "memory");
  __syncthreads();
  if (ltid() == 0) __hip_atomic_fetch_add(cnt + tm, 1, __ATOMIC_RELAXED, __HIP_MEMORY_SCOPE_AGENT);
}
template <class ConvF>
DI void ew_consume(const Params& p, int* cnt, int need, int layer, int kind, bool skip_ctx, int nconv, ConvF conv,
                   char* smem) {
  int* sh = (int*)(smem + SMEM_BYTES - 16);
  const int tid = ltid(), lane = tid & 63, wid = __builtin_amdgcn_readfirstlane(tid >> 6);
  for (;;) {
    __syncthreads();
    if (tid == 0) *sh = __hip_atomic_fetch_add(cnt + 136, 1, __ATOMIC_RELAXED, __HIP_MEMORY_SCOPE_AGENT);
    __syncthreads();
    const int q = *sh;
    if (q >= nconv + 544) break;
    if (q < nconv) { conv(q); continue; }
    const int c = q - nconv, mseq = c >> 2, j = mseq >> 3, bb = mseq & 7, tm = bb * 17 + j;
    if (skip_ctx && j == 16) continue;
    if (tid == 0) {
      while (__hip_atomic_load(cnt + tm, __ATOMIC_RELAXED, __HIP_MEMORY_SCOPE_AGENT) < need) __builtin_amdgcn_s_sleep(4);
    }
    __syncthreads();
    const int row0 = tm * 256 + (c & 3) * 64 + wid * 8;
#pragma unroll 1
    for (int i = 0; i < 8; ++i) ew_row(p, layer, kind, row0 + i, lane);
  }
}

DI void row_rstd(const u16* __restrict__ base, int ld, int ncols, int m0, float* rs) {
  const int tid = ltid(), row = tid >> 1, half = tid & 1;
  const int per = ncols / 2;
  const u16* ptr = base + (size_t)(m0 + row) * ld + half * per;
  float ss = 0.f;
  for (int i = 0; i < per; i += 8) {
    u32x4 v = *(const u32x4*)(ptr + i);
#pragma unroll
    for (int e = 0; e < 8; ++e) {
      float f = uw(v, e);
      ss += f * f;
    }
  }
  ss += __shfl_xor(ss, 1);
  if (half == 0) rs[row] = rsqrtf(ss / (float)ncols + EPS);
}

DI void qkv_tasks(const Params& p, char* smem, int qb, int qe, int kb_, int ke, int stp) {
  float* rs = (float*)(smem + 2 * 2 * 256 * 72 * 2);
  const int MT = T / 256;
  auto noT = [](int, int, u32x4) {};
  auto neverT = [](int) { return false; };
  for (int t = qb; t < qe; t += stp) {
    const int tm = t / 3, tn = t % 3, m0 = tm * 256;
    __syncthreads();
    row_rstd(p.P, NINP, 256, m0, rs);
    const bool lat = (m0 % SP) < SEQ;
    const int s0 = m0 % SP;
    gemm_tile<false>(
        p.P, NINP, p.wt_uq, 256, 256, m0, tn * 256, smem,
        [&](int mb, int nb, f32x16& acc, int r, int h) {
          const int rowl = mb - m0 + r;
          const float sc = rs[rowl];
#pragma unroll
          for (int e = 0; e < 16; ++e) acc[e] *= sc;
          const int cb = nb % 192;
          if (lat && cb >= 128) {
            const int s = s0 + rowl;
            const int pos = (cb == 128) ? (s >> 6) : (s & 63);
#pragma unroll
            for (int e = 0; e < 8; ++e) {
              const int j = crow(e, h);
              const float cs = p.ropetab[2 * (pos * 16 + j)], sn = p.ropetab[2 * (pos * 16 + j) + 1];
              const float x1 = acc[e], x2 = acc[e + 8];
              acc[e] = x1 * cs - x2 * sn;
              acc[e + 8] = x1 * sn + x2 * cs;
            }
          }
        },
        [&](int row, int col, u32x4 v) { *(u32x4*)(p.Q + (size_t)row * 768 + col) = v; }, noT, neverT);
  }
  for (int t = kb_; t < ke; t += stp) {
    const int tm = t / 4, tn = t % 4, m0 = tm * 256;
    const int b = m0 / SP, s0 = m0 % SP;
    const bool lat = s0 < SEQ;
    __syncthreads();
    row_rstd(p.P + 256, NINP, 128, m0, rs);
    if (tn == 0) {
      for (int idx = ltid(); idx < 256 * 32; idx += NTHR) {
        const int rowl = idx >> 5, q = idx & 31, blk = q >> 4, j = q & 15;
        const u16* src = p.P + (size_t)(m0 + rowl) * NINP + 384 + blk * 32 + j;
        float x1 = bf2f(src[0]), x2 = bf2f(src[16]);
        float o1 = x1, o2 = x2;
        if (lat) {
          const int s = s0 + rowl;
          const int pos = blk == 0 ? (s >> 6) : (s & 63);
          const float cs = p.ropetab[2 * (pos * 16 + j)], sn = p.ropetab[2 * (pos * 16 + j) + 1];
          o1 = x1 * cs - x2 * sn;
          o2 = x1 * sn + x2 * cs;
        }
        u16* dst = p.Kr + (size_t)(m0 + rowl) * 64 + blk * 32 + j;
        dst[0] = f2bf(o1);
        dst[16] = f2bf(o2);
      }
    }
    const int n0 = tn * 256;
    u16* vbase = p.Vt + (size_t)(b * 4 + tn) * 128 * SP + s0;
    gemm_tile<true>(
        p.P + 256, NINP, p.wt_ukv, 128, 128, m0, n0, smem,
        [&](int mb, int nb, f32x16& acc, int r, int h) {
          const float sc = rs[mb - m0 + r];
#pragma unroll
          for (int e = 0; e < 16; ++e) acc[e] *= sc;
        },
        [&](int row, int col, u32x4 v) { *(u32x4*)(p.Kn + (size_t)row * 512 + tn * 128 + (col - n0)) = v; },
        [&](int col, int row, u32x4 v) { *(u32x4*)(vbase + (size_t)(col - n0 - 128) * SP + (row - m0)) = v; },
        [](int wn) { return wn >= 2; });
  }
}

DI void cm_tasks(const Params& p, int layer, char* smem, int tb, int te, int stp) {
  const int ftid = ltid(), vb = ftid >> 8, tid = ftid & 255;
  u16* vnT = (u16*)(smem + vb * VSMEM);
  const int lane = tid & 63, wid = tid >> 6, r = lane & 31, h = lane >> 5;
  const float* gn = p.cm_norm_g + layer * 256;
  const float* bs = p.cm_b_s + layer * 512;
  for (int t0 = tb; t0 < te; t0 += stp) {
    const int task = t0 + vb;
    const int row0 = task * 128;
    __syncthreads();
#pragma unroll 4
    for (int i = 0; i < 32; ++i) {
      const int s = wid * 32 + i;
      const u16* src = p.P + (size_t)(row0 + s) * NINP + 704;
      float v[4];
      float sum = 0.f;
#pragma unroll
      for (int q = 0; q < 4; ++q) {
        v[q] = gelu_f(bf2f(src[lane + 64 * q]));
        sum += v[q];
      }
      const float mean = wave_sum(sum) * (1.f / 256.f);
      float var = 0.f;
#pragma unroll
      for (int q = 0; q < 4; ++q) {
        v[q] -= mean;
        var += v[q] * v[q];
      }
      const float rstd = rsqrtf(wave_sum(var) * (1.f / 256.f) + EPS);
#pragma unroll
      for (int q = 0; q < 4; ++q) vnT[(lane + 64 * q) * 136 + s] = f2bf(v[q] * rstd * gn[lane + 64 * q]);
    }
    __syncthreads();
    const int t = wid * 32 + r;
    for (int g = 0; g < 4; ++g) {
      bf16x8 wf[8];
#pragma unroll
      for (int kk = 0; kk < 8; ++kk) wf[kk] = *(const bf16x8*)(p.wsb + ((size_t)(g * 128 + t)) * 128 + kk * 16 + h * 8);
      const float bias = bs[g * 128 + t];
#pragma unroll
      for (int cb = 0; cb < 2; ++cb) {
        f32x16 acc;
#pragma unroll
        for (int e = 0; e < 16; ++e) acc[e] = 0.f;
#pragma unroll
        for (int kk = 0; kk < 8; ++kk) {
          bf16x8 a = *(const bf16x8*)(vnT + (g * 64 + cb * 32 + r) * 136 + kk * 16 + h * 8);
          acc = MFMA(a, wf[kk], acc);
        }
#pragma unroll
        for (int q4 = 0; q4 < 4; ++q4) {
          const int ch0 = g * 64 + cb * 32 + 8 * q4 + 4 * h;
          u32x2 uwd = *(const u32x2*)(p.P + (size_t)(row0 + t) * NINP + 448 + ch0);
          float u0 = gelu_f(bflo(uwd.x)), u1 = gelu_f(bfhi(uwd.x)), u2 = gelu_f(bflo(uwd.y)), u3 = gelu_f(bfhi(uwd.y));
          u32x2 w;
          w.x = pack2(u0 * (acc[4 * q4] + bias), u1 * (acc[4 * q4 + 1] + bias));
          w.y = pack2(u2 * (acc[4 * q4 + 2] + bias), u3 * (acc[4 * q4 + 3] + bias));
          *(u32x2*)(p.H + (size_t)(row0 + t) * D + 512 + ch0) = w;
        }
      }
    }
  }
}

struct ConvW { f32x4 w0a, w0b, w1a, w1b, w2a, w2b, ba, bb; };
DI ConvW load_convw(const Params& p, int layer, int ch) {
  const float* cw = p.conv_w + (size_t)layer * 3 * 768 + ch;
  const float* cb = p.conv_b + layer * 768 + ch;
  ConvW c;
  c.w0a = *(const f32x4*)(cw); c.w0b = *(const f32x4*)(cw + 4);
  c.w1a = *(const f32x4*)(cw + 768); c.w1b = *(const f32x4*)(cw + 772);
  c.w2a = *(const f32x4*)(cw + 1536); c.w2b = *(const f32x4*)(cw + 1540);
  c.ba = *(const f32x4*)(cb); c.bb = *(const f32x4*)(cb + 4);
  return c;
}
DI float convw_get(const f32x4& a, const f32x4& b, int e) { return e < 4 ? a[e & 3] : b[e & 3]; }
DI void conv8(const Params& p, const ConvW& c, int row, int ch, bool hasPrev, bool hasNext, float out[8]) {
  const u16* base = p.P + (size_t)row * NINP + 1216 + ch;
  u32x4 cur = *(const u32x4*)base;
  u32x4 prv = *(const u32x4*)(base - (hasPrev ? NINP : 0));
  u32x4 nxt = *(const u32x4*)(base + (hasNext ? NINP : 0));
  const float mp = hasPrev ? 1.f : 0.f, mn = hasNext ? 1.f : 0.f;
#pragma unroll
  for (int e = 0; e < 8; ++e) {
    float y = convw_get(c.w0a, c.w0b, e) * (mp * uw(prv, e)) + convw_get(c.w1a, c.w1b, e) * uw(cur, e) +
              convw_get(c.w2a, c.w2b, e) * (mn * uw(nxt, e)) + convw_get(c.ba, c.bb, e);
    out[e] = silu_f(y);
  }
}

template <int RPT, class F>
DI void conv_stage(const Params& p, int layer, int row0, int chbase, int cp, int tb, bool cPrev, bool cNext, F emit) {
  const ConvW c = load_convw(p, layer, chbase + cp * 8);
  const int r0 = tb * RPT;
  const bool hp = cPrev || r0 > 0, hn = cNext || (r0 + RPT) < 128;
  const u16* base = p.P + (size_t)(row0 + r0) * NINP + 1216 + chbase + cp * 8;
  u32x4 raw[RPT + 2];
  raw[0] = *(const u32x4*)(base - (hp ? NINP : 0));
#pragma unroll
  for (int k = 0; k < RPT; ++k) raw[k + 1] = *(const u32x4*)(base + (size_t)k * NINP);
  raw[RPT + 1] = *(const u32x4*)(base + (size_t)(hn ? RPT : RPT - 1) * NINP);
  const float mp = hp ? 1.f : 0.f, mn = hn ? 1.f : 0.f;
#pragma unroll
  for (int i = 0; i < RPT; ++i) {
    const float fp = (i == 0) ? mp : 1.f, fn = (i == RPT - 1) ? mn : 1.f;
    float v[8];
#pragma unroll
    for (int e = 0; e < 8; ++e) {
      float y = convw_get(c.w0a, c.w0b, e) * (fp * uw(raw[i], e)) + convw_get(c.w1a, c.w1b, e) * uw(raw[i + 1], e) +
                convw_get(c.w2a, c.w2b, e) * (fn * uw(raw[i + 2], e)) + convw_get(c.ba, c.bb, e);
      v[e] = silu_f(y);
    }
    emit(r0 + i, v);
  }
}

DI void ssd_dt_arrays(const Params& p, int layer, int row0, int hh, int t, float* arr) {
  float* dt0 = arr;
  float* dt1 = arr + 128;
  float* c0 = arr + 256;
  float* s1 = arr + 384;
  float* a0 = arr + 512;
  float* a1 = arr + 640;
  const float d0 = softplus_f(p.dtraw[(size_t)(row0 + t) * 8 + hh] + p.dt_bias[layer * 8 + hh]);
  const float d1 = softplus_f(p.dtraw[(size_t)(row0 + t) * 8 + 4 + hh] + p.dt_bias[layer * 8 + 4 + hh]);
  dt0[t] = d0;
  dt1[t] = d1;
  a0[t] = -d0 * __expf(p.a_log[layer * 8 + hh]);
  a1[t] = -d1 * __expf(p.a_log[layer * 8 + 4 + hh]);
}
DI float wave_incl_prefix(float x, int lane) {
#pragma unroll
  for (int o = 1; o < 64; o <<= 1) {
    float y = __shfl_up(x, o);
    if (lane >= o) x += y;
  }
  return x;
}
DI void ssd_cum_arrays(int t, float* arr) {
  float* c0 = arr + 256;
  float* s1 = arr + 384;
  const float* a0 = arr + 512;
  const float* a1 = arr + 640;
  const int lane = t & 63, w = t >> 6;
  const float x0 = a0[t], o0 = a0[t ^ 64], x1 = a1[t], o1 = a1[t ^ 64];
  const float tot_o0 = wave_sum(o0), tot_o1 = wave_sum(o1), tot_x1 = wave_sum(x1);
  float p0 = wave_incl_prefix(x0, lane);
  float p1 = wave_incl_prefix(x1, lane);
  if (w == 1) p0 += tot_o0;
  float sf = tot_x1 - p1 + x1;
  if (w == 0) sf += tot_o1;
  c0[t] = p0;
  s1[t] = sf;
}

DI void ssd_s1_tasks(const Params& p, int layer, char* smem, int tb, int te, int stp) {
  const int ftid = ltid(), vb = ftid >> 8, tid = ftid & 255;
  u16* xsT0 = (u16*)(smem + vb * VSMEM);
  u16* xsT1 = xsT0 + 64 * 136;
  u16* BT = xsT1 + 64 * 136;
  float* arr = (float*)(BT + 128 * 136);
  float* w0 = arr + 768;
  float* w1 = w0 + 128;
  const int lane = tid & 63, wid = tid >> 6, r = lane & 31, h = lane >> 5;
  for (int t0 = tb; t0 < te; t0 += stp) {
    const int task = t0 + vb;
    const int hh = task & 3, bc = task >> 2, c = bc % NCH, b = bc / NCH;
    const int g = hh >> 1;
    const int row0 = bc * 128;
    const bool cPrev = (c != 0 && c != 32), cNext = (c != 31 && c != 33);
    __syncthreads();
    if (tid < 128) ssd_dt_arrays(p, layer, row0, hh, tid, arr);
    __syncthreads();
    if (tid < 128) ssd_cum_arrays(tid, arr);
    __syncthreads();
    if (tid < 128) {
      const float* dt0 = arr;
      const float* dt1 = arr + 128;
      const float* c0 = arr + 256;
      const float* s1 = arr + 384;
      w0[tid] = __expf(c0[127] - c0[tid]) * dt0[tid];
      w1[tid] = __expf(s1[0] - s1[tid]) * dt1[tid];
      if (tid == 0) {
        p.atot[((size_t)bc * 2 + 0) * 4 + hh] = c0[127];
        p.atot[((size_t)bc * 2 + 1) * 4 + hh] = s1[0];
      }
    }
    __syncthreads();
    conv_stage<4>(p, layer, row0, hh * 64, tid & 7, tid >> 3, cPrev, cNext, [&](int t, const float (&v)[8]) {
      const float f0 = w0[t], f1 = w1[t];
      const int cp = tid & 7;
#pragma unroll
      for (int e = 0; e < 8; ++e) {
        xsT0[(cp * 8 + e) * 136 + t] = f2bf(v[e] * f0);
        xsT1[(cp * 8 + e) * 136 + t] = f2bf(v[e] * f1);
      }
    });
    conv_stage<8>(p, layer, row0, 256 + g * 128, tid & 15, tid >> 4, cPrev, cNext, [&](int t, const float (&v)[8]) {
      const int cp = tid & 15;
#pragma unroll
      for (int e = 0; e < 8; ++e) BT[(cp * 8 + e) * 136 + t] = f2bf(v[e]);
    });
    __syncthreads();
#pragma unroll
    for (int d = 0; d < 2; ++d) {
      const u16* xsT = d ? xsT1 : xsT0;
#pragma unroll
      for (int pb = 0; pb < 2; ++pb) {
        f32x16 acc;
#pragma unroll
        for (int e = 0; e < 16; ++e) acc[e] = 0.f;
#pragma unroll
        for (int kk = 0; kk < 8; ++kk) {
          bf16x8 a = *(const bf16x8*)(xsT + (pb * 32 + r) * 136 + kk * 16 + h * 8);
          bf16x8 bb = *(const bf16x8*)(BT + (wid * 32 + r) * 136 + kk * 16 + h * 8);
          acc = MFMA(a, bb, acc);
        }
        float* dst = p.CS + ((((size_t)bc * 2 + d) * 4 + hh) * 64 + pb * 32) * 128 + wid * 32 + r;
#pragma unroll
        for (int e = 0; e < 16; ++e) dst[(size_t)crow(e, h) * 128] = acc[e];
      }
    }
  }
}

DI void ssd_scan_phase(const Params& p) {
  const int total = NB * 2 * 4 * 8192;
  for (int idx = lbid() * NTHR + ltid(); idx < total; idx += gridDim.x * NTHR) {
    const int e = idx & 8191, hh = (idx >> 13) & 3, d = (idx >> 15) & 1, b = idx >> 16;
    float st = 0.f;
#pragma unroll 2
    for (int i = 0; i < NCH; ++i) {
      int c;
      if (d == 0) c = i < 2 ? 32 + i : i - 2;
      else c = i < 2 ? 33 - i : 33 - i;
      const size_t bc = (size_t)b * NCH + c;
      float* ptr = p.CS + ((bc * 2 + d) * 4 + hh) * 8192 + e;
      const float v = *ptr;
      const float dec = __expf(p.atot[(bc * 2 + d) * 4 + hh]);
      *ptr = st;
      st = dec * st + v;
    }
  }
}

template <int G>
DI float ssd_s3_group(const Params& p, int layer, int bc, bool cPrev, bool cNext, u16* Bg, u16* xsT, float* arr, int tid) {
  f32x16 y[4];
#pragma unroll
  for (int i = 0; i < 4; ++i)
#pragma unroll
    for (int e = 0; e < 16; ++e) y[i][e] = 0.f;
  const int lane = tid & 63, wid = tid >> 6, r = lane & 31, h = lane >> 5;
  const int l = wid * 32 + r;
  const int row0 = bc * 128;
  __syncthreads();
  ssd_dt_arrays(p, layer, row0, 2 * G + (tid >> 7), tid & 127, arr + (tid >> 7) * 768);
  const ConvW cwc = load_convw(p, layer, 512 + G * 128 + (tid & 15) * 8);
#pragma unroll 1
  for (int i = 0; i < 8; ++i) {
    const int id = tid + VT * i, t = id >> 4, cp = id & 15;
    float v[8];
    conv8(p, cwc, row0 + t, 512 + G * 128 + cp * 8, cPrev || t > 0, cNext || t < 127, v);
    *(bf16x8*)(Bg + t * 136 + cp * 8) = pack8(v[0], v[1], v[2], v[3], v[4], v[5], v[6], v[7]);
  }
  const ConvW cwx = load_convw(p, layer, G * 128 + (tid & 15) * 8);
#pragma unroll 1
  for (int i = 0; i < 8; ++i) {
    const int id = tid + VT * i, t = id >> 4, cp = id & 15;
    float v[8];
    conv8(p, cwx, row0 + t, G * 128 + cp * 8, cPrev || t > 0, cNext || t < 127, v);
#pragma unroll
    for (int e = 0; e < 8; ++e) xsT[(cp * 8 + e) * 136 + t] = f2bf(v[e]);
  }
  __syncthreads();
  ssd_cum_arrays(tid & 127, arr + (tid >> 7) * 768);
  bf16x8 cf[8];
#pragma unroll
  for (int kk = 0; kk < 8; ++kk) cf[kk] = *(const bf16x8*)(Bg + l * 136 + kk * 16 + h * 8);
  __syncthreads();
  const ConvW cwb = load_convw(p, layer, 256 + G * 128 + (tid & 15) * 8);
#pragma unroll 1
  for (int i = 0; i < 8; ++i) {
    const int id = tid + VT * i, t = id >> 4, cp = id & 15;
    float v[8];
    conv8(p, cwb, row0 + t, 256 + G * 128 + cp * 8, cPrev || t > 0, cNext || t < 127, v);
    *(bf16x8*)(Bg + t * 136 + cp * 8) = pack8(v[0], v[1], v[2], v[3], v[4], v[5], v[6], v[7]);
  }
  __syncthreads();
  float ss = 0.f;
#pragma unroll 1
  for (int hd2 = 0; hd2 < 2; ++hd2) {
    const int hh = 2 * G + hd2;
    const float* ah = arr + hd2 * 768;
    const float c0l = ah[256 + l], s1l = ah[384 + l];
    f32x16 y[2];
#pragma unroll
    for (int i = 0; i < 2; ++i)
#pragma unroll
      for (int e = 0; e < 16; ++e) y[i][e] = 0.f;
#pragma unroll 1
    for (int sb = 0; sb < 4; ++sb) {
      f32x16 gt;
#pragma unroll
      for (int e = 0; e < 16; ++e) gt[e] = 0.f;
#pragma unroll
      for (int kk = 0; kk < 8; ++kk) {
        bf16x8 a = *(const bf16x8*)(Bg + (sb * 32 + r) * 136 + kk * 16 + h * 8);
        gt = MFMA(a, cf[kk], gt);
      }
      f32x16 wv;
      if (sb != wid) {
        const float ref = sb < wid ? c0l : s1l;
        const float* cumv = ah + (sb < wid ? 256 : 384) + sb * 32 + 4 * h;
        const float* dtv = ah + (sb < wid ? 0 : 128) + sb * 32 + 4 * h;
#pragma unroll
        for (int q4 = 0; q4 < 4; ++q4) {
          const f32x4 cv = *(const f32x4*)(cumv + 8 * q4), dv = *(const f32x4*)(dtv + 8 * q4);
#pragma unroll
          for (int k = 0; k < 4; ++k) wv[4 * q4 + k] = gt[4 * q4 + k] * (__expf(ref - cv[k]) * dv[k]);
        }
      } else {
#pragma unroll
        for (int q4 = 0; q4 < 4; ++q4) {
          const int s4 = sb * 32 + 8 * q4 + 4 * h;
          const f32x4 c0v = *(const f32x4*)(ah + 256 + s4), d0v = *(const f32x4*)(ah + s4);
          const f32x4 s1v = *(const f32x4*)(ah + 384 + s4), d1v = *(const f32x4*)(ah + 128 + s4);
#pragma unroll
          for (int k = 0; k < 4; ++k) {
            const int s = s4 + k;
            const float a0 = (l >= s) ? (c0l - c0v[k]) : -1e30f;
            const float a1 = (l <= s) ? (s1l - s1v[k]) : -1e30f;
            wv[4 * q4 + k] = gt[4 * q4 + k] * (__expf(a0) * d0v[k] + __expf(a1) * d1v[k]);
          }
          __builtin_amdgcn_sched_barrier(0);
        }
      }
      bf16x8 wp0 = pack8(wv[0], wv[1], wv[2], wv[3], wv[4], wv[5], wv[6], wv[7]);
      bf16x8 wp1 = pack8(wv[8], wv[9], wv[10], wv[11], wv[12], wv[13], wv[14], wv[15]);
#pragma unroll
      for (int pb = 0; pb < 2; ++pb) {
        const u16* xrow = xsT + (hd2 * 64 + pb * 32 + r) * 136 + sb * 32 + 4 * h;
        s16x4 lo0 = *(const s16x4*)(xrow), hi0 = *(const s16x4*)(xrow + 8);
        s16x4 lo1 = *(const s16x4*)(xrow + 16), hi1 = *(const s16x4*)(xrow + 24);
        bf16x8 a0 = __builtin_shufflevector(lo0, hi0, 0, 1, 2, 3, 4, 5, 6, 7);
        bf16x8 a1 = __builtin_shufflevector(lo1, hi1, 0, 1, 2, 3, 4, 5, 6, 7);
        y[pb] = MFMA(a0, wp0, y[pb]);
        y[pb] = MFMA(a1, wp1, y[pb]);
      }
    }
#pragma unroll 1
    for (int d = 0; d < 2; ++d) {
      const float el = __expf(d == 0 ? c0l : s1l);
#pragma unroll
      for (int pb = 0; pb < 2; ++pb) {
        const float* srow = p.CS + ((((size_t)bc * 2 + d) * 4 + hh) * 64 + pb * 32 + r) * 128 + h * 8;
        f32x16 tmp;
#pragma unroll
        for (int e = 0; e < 16; ++e) tmp[e] = 0.f;
#pragma unroll
        for (int kk = 0; kk < 8; ++kk) {
          f32x4 s0 = *(const f32x4*)(srow + kk * 16), s1 = *(const f32x4*)(srow + kk * 16 + 4);
          bf16x8 a = pack8(s0.x, s0.y, s0.z, s0.w, s1.x, s1.y, s1.z, s1.w);
          tmp = MFMA(a, cf[kk], tmp);
        }
#pragma unroll
        for (int e = 0; e < 16; ++e) y[pb][e] += el * tmp[e];
      }
    }
    const float dsk = p.ssd_d[layer * 8 + hh] + p.ssd_d[layer * 8 + 4 + hh];
#pragma unroll
    for (int pb = 0; pb < 2; ++pb) {
#pragma unroll
      for (int q4 = 0; q4 < 4; ++q4) {
        const int cl = hd2 * 64 + pb * 32 + 8 * q4 + 4 * h;
        const int ch0 = G * 128 + cl;
        u32x2 zw = *(const u32x2*)(p.P + (size_t)(row0 + l) * NINP + 960 + ch0);
        f32x4 o;
        o.x = (y[pb][4 * q4] + dsk * bf2f(xsT[(cl + 0) * 136 + l])) * silu_f(bflo(zw.x));
        o.y = (y[pb][4 * q4 + 1] + dsk * bf2f(xsT[(cl + 1) * 136 + l])) * silu_f(bfhi(zw.x));
        o.z = (y[pb][4 * q4 + 2] + dsk * bf2f(xsT[(cl + 2) * 136 + l])) * silu_f(bflo(zw.y));
        o.w = (y[pb][4 * q4 + 3] + dsk * bf2f(xsT[(cl + 3) * 136 + l])) * silu_f(bfhi(zw.y));
        ss += o.x * o.x + o.y * o.y + o.z * o.z + o.w * o.w;
        *(f32x4*)(p.ytmp + (size_t)(row0 + l) * 256 + ch0) = o;
      }
    }
  }
  return ss;
}

DI void ssd_s3_tasks(const Params& p, int layer, char* smem) {
  const int ftid = ltid(), vb = ftid >> 8, tid = ftid & 255;
  u16* Bg = (u16*)(smem + vb * VSMEM);
  u16* xsT = Bg + 128 * 136;
  float* arr = (float*)(xsT + 128 * 136);
  const int lane = tid & 63, wid = tid >> 6, r = lane & 31, h = lane >> 5;
  const int l = wid * 32 + r;
  for (int t0 = lbid() * 2; t0 < NB * NCH; t0 += gridDim.x * 2) {
    const int bc = t0 + vb, c = bc % NCH;
    const int row0 = bc * 128;
    const bool cPrev = (c != 0 && c != 32), cNext = (c != 31 && c != 33);
    float ss = ssd_s3_group<0>(p, layer, bc, cPrev, cNext, Bg, xsT, arr, tid);
    ss += ssd_s3_group<1>(p, layer, bc, cPrev, cNext, Bg, xsT, arr, tid);
    ss += __shfl_xor(ss, 32);
    const float rstd = rsqrtf(ss * (1.f / 256.f) + EPS);
    const float* gn = p.ssd_norm_g + layer * 256;
#pragma unroll 4
    for (int i = 0; i < 32; ++i) {
      const int ch0 = (i >> 2) * 32 + 8 * (i & 3) + 4 * h;
      f32x4 v = *(const f32x4*)(p.ytmp + (size_t)(row0 + l) * 256 + ch0);
      f32x4 gv = *(const f32x4*)(gn + ch0);
      u32x2 w;
      w.x = pack2(v.x * rstd * gv.x, v.y * rstd * gv.y);
      w.y = pack2(v.z * rstd * gv.z, v.w * rstd * gv.w);
      *(u32x2*)(p.H + (size_t)(row0 + l) * D + 768 + ch0) = w;
    }
  }
}

constexpr int QREG = 12;
DI void attn_qk(const u16* Ks, const bf16x8 (&qf)[QREG], const u16* qs, f32x16 (&st)[2], int r, int h) {
#pragma unroll
  for (int kb = 0; kb < 2; ++kb)
#pragma unroll
    for (int e = 0; e < 16; ++e) st[kb][e] = 0.f;
  const u16* kp = Ks + r * 200 + h * 8;
#pragma unroll
  for (int kk = 0; kk < 12; ++kk) {
    bf16x8 k0 = *(const bf16x8*)(kp + kk * 16);
    bf16x8 k1 = *(const bf16x8*)(kp + 32 * 200 + kk * 16);
    bf16x8 q;
    if (kk < QREG) q = qf[kk];
    else q = *(const bf16x8*)(qs + (kk - QREG) * 512);
    st[0] = MFMA(k0, q, st[0]);
    st[1] = MFMA(k1, q, st[1]);
  }
}
DI void attn_softmax(f32x16 (&st)[2], f32x16 (&o)[4], bf16x8 (&pf)[4], float& m_run, float& l_run, float sc) {
  float mx = st[0][0];
#pragma unroll
  for (int kb = 0; kb < 2; ++kb)
#pragma unroll
    for (int e = 0; e < 16; ++e) mx = fmaxf(mx, st[kb][e]);
  mx = fmaxf(mx, __shfl_xor(mx, 32));
  const float m_new = fmaxf(m_run, mx * sc);
  const float alpha = __builtin_amdgcn_exp2f(m_run - m_new);
  m_run = m_new;
  float ls = 0.f;
#pragma unroll
  for (int kb = 0; kb < 2; ++kb)
#pragma unroll
    for (int e = 0; e < 16; ++e) {
      float pv = __builtin_amdgcn_exp2f(fmaf(st[kb][e], sc, -m_new));
      ls += pv;
      st[kb][e] = pv;
    }
  l_run = l_run * alpha + ls;
  if (__builtin_amdgcn_ballot_w64(alpha != 1.f) != 0ull) {
#pragma unroll
    for (int i = 0; i < 4; ++i)
#pragma unroll
      for (int e = 0; e < 16; ++e) o[i][e] *= alpha;
  }
#pragma unroll
  for (int ks = 0; ks < 4; ++ks) {
    const int kb = ks >> 1, s2 = ks & 1;
    pf[ks] = pack8(st[kb][8 * s2], st[kb][8 * s2 + 1], st[kb][8 * s2 + 2], st[kb][8 * s2 + 3], st[kb][8 * s2 + 4],
                   st[kb][8 * s2 + 5], st[kb][8 * s2 + 6], st[kb][8 * s2 + 7]);
  }
}
DI void attn_pv(const u16* Vs, const bf16x8 (&pf)[4], f32x16 (&o)[4], int r, int h) {
#pragma unroll
  for (int ks = 0; ks < 4; ++ks) {
#pragma unroll
    for (int db = 0; db < 4; ++db) {
      bf16x8 a = *(const bf16x8*)(Vs + (db * 32 + r) * 72 + ks * 16 + 8 * h);
      o[db] = MFMA(a, pf[ks], o[db]);
    }
  }
}

DI void attn_tasks(const Params& p, char* smem) {
  u16* Ks0 = (u16*)smem;
  u16* Vs0 = Ks0 + 2 * 64 * 200;
  const int tid = ltid(), lane = tid & 63, wid = __builtin_amdgcn_readfirstlane(tid >> 6), r = lane & 31, h = lane >> 5;
  u16* qs = Vs0 + 2 * 128 * 72 + wid * ((12 - QREG) * 512) + lane * 8;
  const float sc = 0.07216878364870322f * 1.4426950408889634f;
  for (int task = lbid(); task < NB * 4 * 17; task += gridDim.x) {
    int b, hd, qt;
    if (task < 512) {
      qt = task & 15; hd = (task >> 4) & 3; b = task >> 6;
    } else {
      const int t2 = task - 512;
      qt = 16; hd = t2 & 3; b = t2 >> 2;
    }
    const int koff = (qt < 16) ? 0 : SEQ;
    const int nkt = ((qt < 16) ? SP : CTX) / 64;
    const int qrow = b * SP + qt * 256 + wid * 32 + r;
    bf16x8 qf[QREG];
#pragma unroll
    for (int kk = 0; kk < QREG; ++kk) qf[kk] = *(const bf16x8*)(p.Q + (size_t)qrow * 768 + hd * 192 + kk * 16 + h * 8);
#pragma unroll
    for (int kk = QREG; kk < 12; ++kk)
      *(bf16x8*)(qs + (kk - QREG) * 512) = *(const bf16x8*)(p.Q + (size_t)qrow * 768 + hd * 192 + kk * 16 + h * 8);
    f32x16 o[4];
#pragma unroll
    for (int i = 0; i < 4; ++i)
#pragma unroll
      for (int e = 0; e < 16; ++e) o[i][e] = 0.f;
    float m_run = -1e30f, l_run = 0.f;
    u32x4 kn[2], kr[1], vv[2];
    const u16* knb = p.Kn + ((size_t)(b * SP + koff) + (tid >> 4)) * 512 + hd * 128 + (tid & 15) * 8;
    const u16* krb = p.Kr + ((size_t)(b * SP + koff) + (tid >> 3)) * 64 + (tid & 7) * 8;
    const u16* vb = p.Vt + ((size_t)(b * 4 + hd) * 128 + (tid >> 3)) * SP + koff + (tid & 7) * 8;
#define ALOAD(ko_)                                                                               \
  {                                                                                              \
    _Pragma("unroll") for (int i = 0; i < 2; ++i) kn[i] = *(const u32x4*)(knb + ((ko_) + 32 * i) * 512); \
    kr[0] = *(const u32x4*)(krb + (ko_) * 64);                                                   \
    _Pragma("unroll") for (int i = 0; i < 2; ++i) vv[i] = *(const u32x4*)(vb + (size_t)(64 * i) * SP + (ko_)); \
  }
#define AWRITE(buf_)                                                                             \
  {                                                                                              \
    u16* Kw = Ks0 + (buf_) * (64 * 200);                                                         \
    u16* Vw = Vs0 + (buf_) * (128 * 72);                                                         \
    _Pragma("unroll") for (int i = 0; i < 2; ++i) *(u32x4*)(Kw + ((tid >> 4) + 32 * i) * 200 + (tid & 15) * 8) = kn[i]; \
    *(u32x4*)(Kw + (tid >> 3) * 200 + 128 + (tid & 7) * 8) = kr[0];                              \
    _Pragma("unroll") for (int i = 0; i < 2; ++i) {                                              \
      u16* dst = Vw + ((tid >> 3) + 64 * i) * 72 + ((tid & 7) >> 1) * 16 + ((tid & 7) & 1) * 4;  \
      *(u32x2*)dst = u32x2{vv[i].x, vv[i].y};                                                    \
      *(u32x2*)(dst + 8) = u32x2{vv[i].z, vv[i].w};                                              \
    }                                                                                            \
  }
    ALOAD((size_t)0);
    AWRITE(0);
    ALOAD((size_t)64);
    for (int kt = 0; kt < nkt; ++kt) {
      __syncthreads();
      if (kt + 1 < nkt) AWRITE((kt + 1) & 1);
      {
        const size_t ko = (size_t)(kt + 2 < nkt ? kt + 2 : nkt - 1) * 64;
        ALOAD(ko);
      }
      __builtin_amdgcn_sched_barrier(0);
      f32x16 st[2];
      bf16x8 pf[4];
      attn_qk(Ks0 + (kt & 1) * (64 * 200), qf, qs, st, r, h);
      attn_softmax(st, o, pf, m_run, l_run, sc);
      attn_pv(Vs0 + (kt & 1) * (128 * 72), pf, o, r, h);
    }
#undef ALOAD
#undef AWRITE
    const float ltot = l_run + __shfl_xor(l_run, 32);
    const float inv = 1.f / ltot;
    u16* orow = p.H + (size_t)qrow * D + hd * 128;
#pragma unroll
    for (int db = 0; db < 4; ++db)
#pragma unroll
      for (int q4 = 0; q4 < 4; ++q4) {
        u32x2 w;
        w.x = pack2(o[db][4 * q4] * inv, o[db][4 * q4 + 1] * inv);
        w.y = pack2(o[db][4 * q4 + 2] * inv, o[db][4 * q4 + 3] * inv);
        *(u32x2*)(orow + db * 32 + 8 * q4 + 4 * h) = w;
      }
  }
}

constexpr int NPHASE = 2 + DEPTH * 6;

DI void conv_item_ffn(const Params& p, int layer, int q, char* smem) {
#pragma unroll 1
  for (int u = 0; u < 8; ++u) {
    const int tile = q * 8 + u;
    if (tile < 1024) conv_tile(p.w_ff1 + (size_t)layer * D * DFF, D, DFF, p.wt_ff1, nullptr, tile >> 6, tile & 63, smem);
    else conv_tile(p.w_ff2 + (size_t)layer * DFF * D, DFF, D, p.wt_ff2, nullptr, (tile - 1024) >> 4, (tile - 1024) & 15, smem);
  }
}
DI void conv_item_mix(const Params& p, int layer, int q, char* smem) {
#pragma unroll 1
  for (int u = 0; u < 8; ++u) {
    int tile = q * 8 + u;
    if (tile < 512) { conv_tile(p.w_in + (size_t)layer * D * NIN, D, NIN, p.wt_in, nullptr, tile >> 5, tile & 31, smem); continue; }
    tile -= 512;
    if (tile < 48) { conv_tile(p.w_uq + (size_t)layer * 256 * 768, 256, 768, p.wt_uq, p.g_q + layer * 256, tile / 12, tile % 12, smem); continue; }
    tile -= 48;
    if (tile < 32) { conv_tile(p.w_ukv + (size_t)layer * 128 * 1024, 128, 1024, p.wt_ukv, p.g_kv + layer * 128, tile >> 4, tile & 15, smem); continue; }
    tile -= 32;
    if (tile < 256) { conv_tile(p.w_out + (size_t)layer * D * D, D, D, p.wt_out, nullptr, tile >> 4, tile & 15, smem); continue; }
    tile -= 256;
    for (int i = ltid(); i < 4096; i += NTHR) p.wsb[tile * 4096 + i] = f2bf(p.cm_w_s[(size_t)layer * 65536 + tile * 4096 + i]);
  }
}

DI void run_phase(const Params& p, int ph, char* smem) {
  if (ph == 0) { prologue_phase(p, smem); return; }
  const int MT = T / 256;
  auto noT = [](int, int, u32x4) {};
  auto neverT = [](int) { return false; };
  if (ph == 1) {
    ew_phase(p, 0, 0);
    for (int q = lbid(); q < 108; q += gridDim.x) conv_item_mix(p, 0, q, smem);
    return;
  }
  const int layer = (ph - 2) / 6, sub = (ph - 2) % 6;
  const bool last = layer == DEPTH - 1;
  switch (sub) {
    case 0: {
      for (int it = 0;; ++it) {
        const int t = xcd_tile(it, MT * 8);
        if (t < 0) break;
        const int tm = t >> 3, tn = t & 7;
        gemm_tile<false>(
            p.H, D, p.wt_in, D, D, tm * 256, tn * 256, smem,
            [&](int mb, int nb, f32x16& acc, int r, int h) {
              if (nb == 1984) {
                f32x4 v = {acc[0], acc[1], acc[2], acc[3]};
                *(f32x4*)(p.dtraw + (size_t)(mb + r) * 8 + 4 * h) = v;
              }
            },
            [&](int row, int col, u32x4 v) { *(u32x4*)(p.P + (size_t)row * NINP + col) = v; }, noT, neverT);
      }
    } break;
    case 1: {
      int* wq = p.cnt + (2 * DEPTH + layer) * CNT_STRIDE;
      int* sh = (int*)(smem + SMEM_BYTES - 16);
      for (;;) {
        __syncthreads();
        if (ltid() == 0) *sh = __hip_atomic_fetch_add(wq, 1, __ATOMIC_RELAXED, __HIP_MEMORY_SCOPE_AGENT);
        __syncthreads();
        const int q = *sh;
        if (q >= 544 + 136 + 408 + 544) break;
        if (q < 544) ssd_s1_tasks(p, layer, smem, 2 * q, 2 * q + 1, 2);
        else if (q < 680) cm_tasks(p, layer, smem, 2 * (q - 544), 2 * (q - 544) + 1, 2);
        else if (q < 1088) qkv_tasks(p, smem, q - 680, q - 679, 0, 0, 1);
        else qkv_tasks(p, smem, 0, 0, q - 1088, q - 1087, 1);
      }
    } break;
    case 2: ssd_scan_phase(p); break;
    case 3: {
      attn_tasks(p, smem);
      ssd_s3_tasks(p, layer, smem);
    } break;
    case 4: {
      int* cnt = p.cnt + (2 * layer) * CNT_STRIDE;
      for (int it = 0;; ++it) {
        const int t = xcd_tile(it, MT * 4, last ? 4 : 0);
        if (t < 0) break;
        const int tm = t >> 2, tn = t & 3;
        gemm_tile<false>(
            p.H, D, p.wt_out, D, D, tm * 256, tn * 256, smem, [](int, int, f32x16&, int, int) {},
            [&](int row, int col, u32x4 v) { st_wt(p.Y + (size_t)row * D + col, v); }, noT, neverT);
        tile_done(cnt, tm);
      }
      ew_consume(p, cnt, 4, layer, 1, last, 256, [&](int q) { conv_item_ffn(p, layer, q, smem); }, smem);
    } break;
    case 5: {
      int* cnt1 = p.cnt + (3 * DEPTH + layer) * CNT_STRIDE;
      for (int it = 0;; ++it) {
        const int t = xcd_tile(it, MT * 16, last ? 16 : 0);
        if (t < 0) break;
        const int tm = t >> 4, tn = t & 15;
        gemm_tile<false>(
            p.H, D, p.wt_ff1, D, D, tm * 256, tn * 256, smem,
            [](int, int, f32x16& acc, int, int) {
#pragma unroll
              for (int e = 0; e < 16; ++e) {
                float v = fmaxf(acc[e], 0.f);
                acc[e] = v * v;
              }
            },
            [&](int row, int col, u32x4 v) { st_wt(p.Hd + (size_t)row * DFF + col, v); }, noT, neverT);
        tile_done(cnt1, tm);
      }
      int* cnt = p.cnt + (2 * layer + 1) * CNT_STRIDE;
      for (int it = 0;; ++it) {
        const int t = xcd_tile(it, MT * 4, last ? 4 : 0);
        if (t < 0) break;
        const int tm = t >> 2, tn = t & 3;
        if (ltid() == 0) {
          while (__hip_atomic_load(cnt1 + tm, __ATOMIC_RELAXED, __HIP_MEMORY_SCOPE_AGENT) < 16) __builtin_amdgcn_s_sleep(4);
      __builtin_amdgcn_fence(__ATOMIC_ACQUIRE, "agent");
        }
        __syncthreads();
        gemm_tile<false>(
            p.Hd, DFF, p.wt_ff2, DFF, DFF, tm * 256, tn * 256, smem, [](int, int, f32x16&, int, int) {},
            [&](int row, int col, u32x4 v) { st_wt(p.F + (size_t)row * D + col, v); }, noT, neverT);
        tile_done(cnt, tm);
      }
      if (last) ew_consume(p, cnt, 4, DEPTH, 2, true, 0, [](int) {}, smem);
      else ew_consume(p, cnt, 4, layer + 1, 0, false, 108, [&](int q) { conv_item_mix(p, layer + 1, q, smem); }, smem);
    } break;
  }
}

__global__ void __launch_bounds__(NTHR, 2) mega_kernel(Params p, int ph_begin, int ph_end) {
  extern __shared__ __attribute__((aligned(16))) char smem[];
  cg::grid_group grid = cg::this_grid();
  for (int ph = ph_begin; ph < ph_end; ++ph) {
    run_phase(p, ph, smem);
    if (ph + 1 < ph_end) {
      if (ph == 0) {
        grid.sync();
      } else {
        __syncthreads();
        if (threadIdx.x == 0) {
          int* bar = p.cnt + 4 * DEPTH * CNT_STRIDE + ph;
          __hip_atomic_fetch_add(bar, 1, __ATOMIC_RELEASE, __HIP_MEMORY_SCOPE_AGENT);
          while (__hip_atomic_load(bar, __ATOMIC_RELAXED, __HIP_MEMORY_SCOPE_AGENT) < (int)gridDim.x) __builtin_amdgcn_s_sleep(1);
      __builtin_amdgcn_fence(__ATOMIC_ACQUIRE, "agent");
        }
        __syncthreads();
      }
    }
  }
}

extern "C" void kernel_launch(void* const* d_in, const int* in_sizes, int n_in, void* d_out, int out_size, void* d_ws,
                              size_t ws_size, hipStream_t stream) {
  Params p{};
  const float* const* in = (const float* const*)d_in;
  p.x = in[0]; p.c = in[1]; p.ctx = in[2]; p.c_ctx = in[3]; p.w_ada = in[4]; p.b_ada = in[5];
  p.g_pre_mix = in[6]; p.g_post_mix = in[7]; p.g_pre_ff = in[8]; p.g_post_ff = in[9]; p.w_in = in[10];
  p.g_q = in[11]; p.w_uq = in[12]; p.g_kv = in[13]; p.w_ukv = in[14]; p.cm_norm_g = in[15]; p.cm_w_s = in[16];
  p.cm_b_s = in[17]; p.conv_w = in[18]; p.conv_b = in[19]; p.dt_bias = in[20]; p.a_log = in[21]; p.ssd_d = in[22];
  p.ssd_norm_g = in[23]; p.w_out = in[24]; p.w_ff1 = in[25]; p.w_ff2 = in[26];
  p.out = (float*)d_out;
  char* ws = (char*)d_ws;
  size_t off = 0;
  auto take = [&](size_t bytes) { char* q = ws + off; off += (bytes + 255) & ~(size_t)255; return q; };
  p.wt_in = (u16*)take((size_t)NINP * D * 2);
  p.wt_uq = (u16*)take((size_t)768 * 256 * 2);
  p.wt_ukv = (u16*)take((size_t)1024 * 128 * 2);
  p.wt_out = (u16*)take((size_t)D * D * 2);
  p.wt_ff1 = (u16*)take((size_t)DFF * D * 2);
  p.wt_ff2 = (u16*)take((size_t)D * DFF * 2);
  p.wsb = (u16*)take((size_t)4 * 128 * 128 * 2);
  p.mod = (float*)take((size_t)DEPTH * 9 * 6144 * 4);
  p.ropetab = (float*)take((size_t)64 * 16 * 2 * 4);
  p.atot = (float*)take((size_t)NB * NCH * 2 * 4 * 4);
  p.xctx = (float*)take((size_t)NB * CTX * D * 4);
  char* r1 = take((size_t)T * DFF * 2);
  p.Hd = (u16*)r1;
  p.Y = (u16*)r1;
  {
    size_t o2 = 0;
    p.P = (u16*)(r1 + o2); o2 += (size_t)T * NINP * 2;
    p.Q = (u16*)(r1 + o2); o2 += (size_t)T * 768 * 2;
    p.Kn = (u16*)(r1 + o2); o2 += (size_t)T * 512 * 2;
    p.Kr = (u16*)(r1 + o2); o2 += (size_t)T * 64 * 2;
    p.Vt = (u16*)(r1 + o2); o2 += (size_t)NB * 4 * 128 * SP * 2;
    p.dtraw = (float*)(r1 + o2); o2 += (size_t)T * 8 * 4;
  }
  p.H = (u16*)take((size_t)T * D * 2);
  p.CS = (float*)take((size_t)NB * NCH * 2 * 4 * 8192 * 4);
  p.F = (u16*)p.CS;
  p.ytmp = (float*)take((size_t)T * 256 * 4);
  p.cnt = (int*)take((size_t)(4 * DEPTH * CNT_STRIDE + 64) * 4);
  if (off > ws_size) {
    fprintf(stderr, "workspace too small: need %zu have %zu\n", off, ws_size);
    return;
  }
  static int grid_blocks = 0;
  if (!grid_blocks) {
    int dev = 0, cus = 0, per_cu = 0;
    hipGetDevice(&dev);
    hipDeviceGetAttribute(&cus, hipDeviceAttributeMultiprocessorCount, dev);
    hipFuncSetAttribute((const void*)mega_kernel, hipFuncAttributeMaxDynamicSharedMemorySize, SMEM_BYTES);
    hipOccupancyMaxActiveBlocksPerMultiprocessor(&per_cu, mega_kernel, NTHR, SMEM_BYTES);
    if (per_cu < 1) per_cu = 1;
    if (per_cu > 1) per_cu = 1;
    grid_blocks = cus * per_cu;
  }
  int pb = 0, pe = NPHASE;
  void* args[] = {&p, &pb, &pe};
  hipError_t e = hipLaunchCooperativeKernel((void*)mega_kernel, dim3(grid_blocks), dim3(NTHR), args, SMEM_BYTES, stream);
  if (e != hipSuccess) fprintf(stderr, "cooperative launch failed: %s (grid %d)\n", hipGetErrorString(e), grid_blocks);
}
```

```cpp
#include <hip/hip_runtime.h>
#include <hip/hip_cooperative_groups.h>
#include <cstdio>
namespace cg = cooperative_groups;

#define DI __device__ __forceinline__
typedef unsigned short u16;
using bf16x8 = __attribute__((ext_vector_type(8))) short;
using s16x4 = __attribute__((ext_vector_type(4))) short;
using f32x16 = __attribute__((ext_vector_type(16))) float;
using u32x4 = __attribute__((ext_vector_type(4))) unsigned;
using u32x2 = __attribute__((ext_vector_type(2))) unsigned;
using f32x4 = __attribute__((ext_vector_type(4))) float;
typedef __bf16 bf2_t __attribute__((ext_vector_type(2)));
typedef float f2_t __attribute__((ext_vector_type(2)));
#define MFMA(a, b, c) __builtin_amdgcn_mfma_f32_32x32x16_bf16((a), (b), (c), 0, 0, 0)

constexpr int NB = 8, SEQ = 4096, CTX = 256, SP = 4352, T = NB * SP, D = 1024, DFF = 4096;
constexpr int NIN = 1992, NINP = 2048, NCH = 34, DEPTH = 4;
constexpr int NTHR = 512;
constexpr int VT = 256;
constexpr int VSMEM = 75 * 1024;
constexpr int SMEM_BYTES = 2 * VSMEM;
constexpr float EPS = 1e-6f;
constexpr int CNT_STRIDE = 160;

struct Params {
  const float *x, *c, *ctx, *c_ctx, *w_ada, *b_ada, *g_pre_mix, *g_post_mix, *g_pre_ff, *g_post_ff, *w_in, *g_q, *w_uq,
      *g_kv, *w_ukv, *cm_norm_g, *cm_w_s, *cm_b_s, *conv_w, *conv_b, *dt_bias, *a_log, *ssd_d, *ssd_norm_g, *w_out,
      *w_ff1, *w_ff2;
  float* out;
  u16 *wt_in, *wt_uq, *wt_ukv, *wt_out, *wt_ff1, *wt_ff2, *wsb;
  float *mod, *ropetab, *atot, *xctx;
  u16 *P, *Q, *Kn, *Kr, *Vt, *Hd;
  u16* Y;
  float* dtraw;
  u16* H;
  float* CS;
  u16* F;
  float* ytmp;
  int* cnt;
};

DI int ltid() { int t = threadIdx.x; asm volatile("" : "+v"(t)); return t; }
DI int lbid() { int t = blockIdx.x; asm volatile("" : "+s"(t)); return t; }
DI void st_wt(void* ptr, u32x4 v) { asm volatile("global_store_dwordx4 %0, %1, off sc0 sc1" ::"v"(ptr), "v"(v) : "memory"); }
DI void st_wt16f(float* ptr, f32x4 v) { asm volatile("global_store_dwordx4 %0, %1, off sc0 sc1" ::"v"(ptr), "v"(v) : "memory"); }
DI int crow(int e, int h) { return (e & 3) + 8 * (e >> 2) + 4 * h; }
DI unsigned pack2(float a, float b) {
  f2_t v = {a, b};
  bf2_t r = __builtin_convertvector(v, bf2_t);
  return __builtin_bit_cast(unsigned, r);
}
DI u16 f2bf(float a) { return (u16)(pack2(a, 0.f) & 0xffffu); }
DI float bf2f(u16 v) { return __uint_as_float(((unsigned)v) << 16); }
DI float bflo(unsigned w) { return __uint_as_float(w << 16); }
DI float bfhi(unsigned w) { return __uint_as_float(w & 0xffff0000u); }
DI bf16x8 pack8(float a0, float a1, float a2, float a3, float a4, float a5, float a6, float a7) {
  u32x4 u;
  u.x = pack2(a0, a1); u.y = pack2(a2, a3); u.z = pack2(a4, a5); u.w = pack2(a6, a7);
  return __builtin_bit_cast(bf16x8, u);
}
DI float wave_sum(float v) {
#pragma unroll
  for (int o = 32; o > 0; o >>= 1) v += __shfl_xor(v, o);
  return v;
}
DI float silu_f(float y) { return y * __builtin_amdgcn_rcpf(1.f + __expf(-y)); }
DI float gelu_f(float x) {
  float u = 0.7978845608028654f * (x + 0.044715f * x * x * x);
  float t = 1.f - 2.f * __builtin_amdgcn_rcpf(1.f + __expf(2.f * u));
  return 0.5f * x * (1.f + t);
}
DI float softplus_f(float x) { return x > 20.f ? x : log1pf(__expf(x)); }
DI float uw(const u32x4& v, int i) {
  unsigned w = (i >> 1) == 0 ? v.x : (i >> 1) == 1 ? v.y : (i >> 1) == 2 ? v.z : v.w;
  return (i & 1) ? bfhi(w) : bflo(w);
}

template <bool HAS_T, class ElemF, class StoreF, class StoreTF, class UseTF>
DI void gemm_tile(const u16* __restrict__ A, int lda, const u16* __restrict__ Bt, int ldb, int K, int m0, int n0,
                  char* smem, ElemF elem, StoreF store, StoreTF storeT, UseTF useT) {
  constexpr int LS = 72;
  constexpr int STAGE = 2 * 256 * LS;
  u16* base = (u16*)smem;
  const int tid = ltid(), lane = tid & 63, wid = tid >> 6, wm = wid >> 2, wn = wid & 3, r = lane & 31, h = lane >> 5;
  f32x16 acc[4][2];
#pragma unroll
  for (int i = 0; i < 4; ++i)
#pragma unroll
    for (int j = 0; j < 2; ++j)
#pragma unroll
      for (int e = 0; e < 16; ++e) acc[i][j][e] = 0.f;
  u32x4 ra[4], rb[4];
  const int lrow = tid >> 3, lcp = (tid & 7) * 8;
  const u16* ga = A + (size_t)(m0 + lrow) * lda + lcp;
  const u16* gb = Bt + (size_t)(n0 + lrow) * ldb + lcp;
  const int wofs = lrow * LS + lcp;
  const int aofs = (wm * 128 + r) * LS + h * 8;
  const int bofs = 256 * LS + (wn * 64 + r) * LS + h * 8;
#define GLOAD(kt_)                                                           \
  _Pragma("unroll") for (int i = 0; i < 4; ++i) {                            \
    ra[i] = *(const u32x4*)(ga + (size_t)(64 * i) * lda + (kt_) * 64);       \
    rb[i] = *(const u32x4*)(gb + (size_t)(64 * i) * ldb + (kt_) * 64);       \
  }
#define SWRITE(st_)                                                          \
  _Pragma("unroll") for (int i = 0; i < 4; ++i) {                            \
    *(u32x4*)((st_) + wofs + 64 * i * LS) = ra[i];                           \
    *(u32x4*)((st_) + 256 * LS + wofs + 64 * i * LS) = rb[i];                \
  }
#define FREAD(dst_, st_, kk_)                                                                      \
  _Pragma("unroll") for (int i = 0; i < 4; ++i) af[dst_][i] = *(const bf16x8*)((st_) + aofs + i * 32 * LS + (kk_) * 16); \
  _Pragma("unroll") for (int j = 0; j < 2; ++j) bfr[dst_][j] = *(const bf16x8*)((st_) + bofs + j * 32 * LS + (kk_) * 16);
#define MMAS(src_)                                                           \
  _Pragma("unroll") for (int i = 0; i < 4; ++i)                              \
  _Pragma("unroll") for (int j = 0; j < 2; ++j) acc[i][j] = MFMA(bfr[src_][j], af[src_][i], acc[i][j]);
#define ILV()                                                                   \
  __builtin_amdgcn_sched_group_barrier(0x008, 2, 0);                            \
  __builtin_amdgcn_sched_group_barrier(0x100, 2, 0);                            \
  __builtin_amdgcn_sched_group_barrier(0x008, 2, 0);                            \
  __builtin_amdgcn_sched_group_barrier(0x100, 2, 0);                            \
  __builtin_amdgcn_sched_group_barrier(0x008, 2, 0);                            \
  __builtin_amdgcn_sched_group_barrier(0x100, 2, 0);                            \
  __builtin_amdgcn_sched_group_barrier(0x008, 2, 0);
  const int nk = K >> 6;
  bf16x8 af[2][4], bfr[2][2];
  GLOAD(0);
  __syncthreads();
  SWRITE(base);
  if (nk > 1) { GLOAD(1); }
  __syncthreads();
  FREAD(0, base, 0);
  for (int kt = 0; kt < nk; ++kt) {
    u16* cur = base + (kt & 1) * STAGE;
    u16* nxt = base + ((kt + 1) & 1) * STAGE;
    FREAD(1, cur, 1);
    if (kt + 1 < nk) { SWRITE(nxt); }
    MMAS(0);
#pragma unroll
    for (int z = 0; z < 7; ++z) {
      __builtin_amdgcn_sched_group_barrier(0x008, 1, 0);
      __builtin_amdgcn_sched_group_barrier(0x080, 2, 0);
    }
    __builtin_amdgcn_sched_group_barrier(0x008, 1, 0);
    __builtin_amdgcn_sched_barrier(0);
    if (kt + 2 < nk) { GLOAD(kt + 2); }
    FREAD(0, cur, 2);
    MMAS(1);
    ILV();
    __builtin_amdgcn_sched_barrier(0);
    FREAD(1, cur, 3);
    MMAS(0);
    ILV();
    __builtin_amdgcn_sched_barrier(0);
    __syncthreads();
    if (kt + 1 < nk) { FREAD(0, nxt, 0); }
    MMAS(1);
    ILV();
    __builtin_amdgcn_sched_barrier(0);
  }
#undef ILV
#undef GLOAD
#undef SWRITE
#undef FREAD
#undef MMAS
#pragma unroll
  for (int i = 0; i < 4; ++i)
#pragma unroll
    for (int j = 0; j < 2; ++j) elem(m0 + wm * 128 + i * 32, n0 + wn * 64 + j * 32, acc[i][j], r, h);
  u16* stg = base + wid * (128 * 72);
  if (HAS_T && useT(wn)) {
#pragma unroll
    for (int i = 0; i < 4; ++i)
#pragma unroll
      for (int j = 0; j < 2; ++j)
#pragma unroll
        for (int e = 0; e < 16; ++e) stg[(j * 32 + crow(e, h)) * 136 + i * 32 + r] = f2bf(acc[i][j][e]);
    __builtin_amdgcn_wave_barrier();
#pragma unroll 4
    for (int t = 0; t < 16; ++t) {
      const int id = lane + 64 * t, cl = id >> 4, cp = id & 15;
      u32x4 v = *(const u32x4*)(stg + cl * 136 + cp * 8);
      storeT(n0 + wn * 64 + cl, m0 + wm * 128 + cp * 8, v);
    }
  } else {
#pragma unroll
    for (int i = 0; i < 4; ++i)
#pragma unroll
      for (int j = 0; j < 2; ++j)
#pragma unroll
        for (int q4 = 0; q4 < 4; ++q4) {
          u32x2 w;
          w.x = pack2(acc[i][j][4 * q4], acc[i][j][4 * q4 + 1]);
          w.y = pack2(acc[i][j][4 * q4 + 2], acc[i][j][4 * q4 + 3]);
          *(u32x2*)(stg + (i * 32 + r) * 72 + j * 32 + 8 * q4 + 4 * h) = w;
        }
    __builtin_amdgcn_wave_barrier();
#pragma unroll 4
    for (int t = 0; t < 16; ++t) {
      const int id = lane + 64 * t, rl = id >> 3, cp = id & 7;
      u32x4 v = *(const u32x4*)(stg + rl * 72 + cp * 8);
      store(m0 + wm * 128 + rl, n0 + wn * 64 + cp * 8, v);
    }
  }
}

DI int xcd_tile(int it, int ntiles, int skip_tail = 0) {
  const int b = lbid(), g = gridDim.x;
  const int local = (b >> 3) + it * (g >> 3);
  const int per = ntiles >> 3;
  return local < per - skip_tail ? (b & 7) * per + local : -1;
}

DI void conv_tile(const float* __restrict__ src, int K, int N, u16* __restrict__ dst, const float* __restrict__ scale,
                  int tk, int tn, char* smem) {
  float* tile = (float*)smem;
  const int tid = ltid(), tx = tid & 63, ty = tid >> 6;
  const int k0 = tk * 64, n0 = tn * 64;
  __syncthreads();
#pragma unroll 4
  for (int i = 0; i < 8; ++i) {
    int kr = ty + 8 * i;
    float v = 0.f;
    if (n0 + tx < N) v = src[(size_t)(k0 + kr) * N + n0 + tx];
    if (scale) v *= scale[k0 + kr];
    tile[kr * 65 + tx] = v;
  }
  __syncthreads();
#pragma unroll 4
  for (int i = 0; i < 8; ++i) {
    int nr = ty + 8 * i;
    dst[(size_t)(n0 + nr) * K + k0 + tx] = f2bf(tile[tx * 65 + nr]);
  }
}

DI void convert_weights(const float* src, int K, int N, int Npad, u16* dst, const float* scale, char* smem) {
  const int tks = K / 64, tns = Npad / 64;
  for (int t = lbid(); t < tks * tns; t += gridDim.x) conv_tile(src, K, N, dst, scale, t / tns, t % tns, smem);
}

DI void prologue_phase(const Params& p, char* smem) {
  float* sc = (float*)smem;
  float* red = sc + 9 * 1024;
  const int tid = ltid();
  for (int i = tid; i < 9 * 1024; i += NTHR) {
    int j = i >> 10, k = i & 1023;
    float v = j < 8 ? p.c[j * 1024 + k] : p.c_ctx[k];
    sc[i] = v / (1.f + __expf(-v));
  }
  __syncthreads();
  for (int task = lbid(); task < DEPTH * 96; task += gridDim.x) {
    const int l = task / 96, n0 = (task % 96) * 64, nn = tid & 63, kq = tid >> 6;
    float acc[9];
#pragma unroll
    for (int j = 0; j < 9; ++j) acc[j] = 0.f;
    const float* w = p.w_ada + ((size_t)l * 1024 + kq * 128) * 6144 + n0 + nn;
    const float* scq = sc + kq * 128;
#pragma unroll 4
    for (int k = 0; k < 128; ++k) {
      float wv = w[(size_t)k * 6144];
#pragma unroll
      for (int j = 0; j < 9; ++j) acc[j] += scq[j * 1024 + k] * wv;
    }
#pragma unroll
    for (int j = 0; j < 9; ++j) red[(kq * 9 + j) * 64 + nn] = acc[j];
    __syncthreads();
    for (int idx = tid; idx < 576; idx += NTHR) {
      int j = idx >> 6, n2 = idx & 63;
      float s = p.b_ada[l * 6144 + n0 + n2];
#pragma unroll
      for (int q = 0; q < 8; ++q) s += red[(q * 9 + j) * 64 + n2];
      p.mod[(size_t)(l * 9 + j) * 6144 + n0 + n2] = s;
    }
    __syncthreads();
  }
  for (int i = lbid() * NTHR + tid; i < 5 * DEPTH * CNT_STRIDE + 64; i += gridDim.x * NTHR) p.cnt[i] = 0;
  if (lbid() == gridDim.x - 1) {
    for (int i = tid; i < 64 * 16; i += NTHR) {
      int pos = i >> 4, j = i & 15;
      float inv_freq = exp2f(-(float)(2 * j) / 32.f * 13.287712379549449f);
      float ang = (float)pos * inv_freq;
      float k = rintf(ang * 0.15915494309189535f);
      float red2 = fmaf(-k, 6.2831854820251465f, ang);
      red2 = fmaf(-k, -1.7484555314695172e-07f, red2);
      p.ropetab[2 * i] = __cosf(red2);
      p.ropetab[2 * i + 1] = __sinf(red2);
    }
  }
}

DI void ew_row(const Params& p, int layer, int kind, int row, int lane) {
  const bool has_branch = !(kind == 0 && layer == 0);
  const bool src_in = (layer == 0 && kind <= 1);
  const bool store_x = has_branch;
  const int blayer = (kind == 1) ? layer : (kind == 0 ? layer - 1 : DEPTH - 1);
  const float* gpost = (kind == 1) ? p.g_post_mix + blayer * D : p.g_post_ff + (blayer < 0 ? 0 : blayer) * D;
  const int gate_off = (kind == 1) ? 2 * D : 5 * D;
  const float* gpre = (kind == 0) ? p.g_pre_mix + layer * D : p.g_pre_ff + (kind == 1 ? layer : 0) * D;
  const int shift_off = (kind == 0) ? 0 : 3 * D, scale_off = (kind == 0) ? D : 4 * D;
  const float* xl = src_in ? p.x : p.out;
  const float* xc = src_in ? p.ctx : p.xctx;
    const int b = row / SP, s = row - b * SP;
    const bool lat = s < SEQ;
    if ((kind == 2 || (kind == 1 && layer == DEPTH - 1)) && !lat) return;
    const size_t xoff = lat ? ((size_t)(b * SEQ + s) * D) : ((size_t)(b * CTX + s - SEQ) * D);
    const unsigned long long msk = lat ? ~0ull : 0ull;
    const float* xs = (const float*)(((unsigned long long)xl & msk) | ((unsigned long long)xc & ~msk)) + xoff;
    float* xd = (float*)(((unsigned long long)p.out & msk) | ((unsigned long long)p.xctx & ~msk)) + xoff;
    const int mi = lat ? b : 8;
    f32x4 xv[4];
#pragma unroll
    for (int i = 0; i < 4; ++i) xv[i] = *(const f32x4*)(xs + lane * 4 + 256 * i);
    if (has_branch) {
      const float* modb = p.mod + (size_t)(blayer * 9 + mi) * 6144 + gate_off;
      f32x4 yv[4];
      const u16* ysrc = (kind == 1) ? p.Y : p.F;
      {
        u32x2 w0, w1, w2, w3;
        const u16* yp = ysrc + (size_t)row * D + lane * 4;
        asm volatile("global_load_dwordx2 %0, %1, off sc0 sc1" : "=v"(w0) : "v"(yp) : "memory");
        asm volatile("global_load_dwordx2 %0, %1, off offset:512 sc0 sc1" : "=v"(w1) : "v"(yp) : "memory");
        asm volatile("global_load_dwordx2 %0, %1, off offset:1024 sc0 sc1" : "=v"(w2) : "v"(yp) : "memory");
        asm volatile("global_load_dwordx2 %0, %1, off offset:1536 sc0 sc1" : "=v"(w3) : "v"(yp) : "memory");
        asm volatile("s_waitcnt vmcnt(0)" : "+v"(w0), "+v"(w1), "+v"(w2), "+v"(w3)::"memory");
        yv[0] = f32x4{bflo(w0.x), bfhi(w0.x), bflo(w0.y), bfhi(w0.y)};
        yv[1] = f32x4{bflo(w1.x), bfhi(w1.x), bflo(w1.y), bfhi(w1.y)};
        yv[2] = f32x4{bflo(w2.x), bfhi(w2.x), bflo(w2.y), bfhi(w2.y)};
        yv[3] = f32x4{bflo(w3.x), bfhi(w3.x), bflo(w3.y), bfhi(w3.y)};
      }
      float ss = 0.f;
#pragma unroll
      for (int i = 0; i < 4; ++i) ss += yv[i].x * yv[i].x + yv[i].y * yv[i].y + yv[i].z * yv[i].z + yv[i].w * yv[i].w;
      ss = wave_sum(ss);
      const float rstd = rsqrtf(ss * (1.f / D) + EPS);
#pragma unroll
      for (int i = 0; i < 4; ++i) {
        const int col = lane * 4 + 256 * i;
        f32x4 g = *(const f32x4*)(gpost + col);
        f32x4 gt = *(const f32x4*)(modb + col);
        xv[i].x += gt.x * (yv[i].x * rstd * g.x);
        xv[i].y += gt.y * (yv[i].y * rstd * g.y);
        xv[i].z += gt.z * (yv[i].z * rstd * g.z);
        xv[i].w += gt.w * (yv[i].w * rstd * g.w);
      }
      if (store_x) {
#pragma unroll
        for (int i = 0; i < 4; ++i) *(f32x4*)(xd + lane * 4 + 256 * i) = xv[i];
      }
    }
    if (kind != 2) {
      const float* modl = p.mod + (size_t)(layer * 9 + mi) * 6144;
      float ss = 0.f;
#pragma unroll
      for (int i = 0; i < 4; ++i) ss += xv[i].x * xv[i].x + xv[i].y * xv[i].y + xv[i].z * xv[i].z + xv[i].w * xv[i].w;
      ss = wave_sum(ss);
      const float rstd = rsqrtf(ss * (1.f / D) + EPS);
#pragma unroll
      for (int i = 0; i < 4; ++i) {
        const int col = lane * 4 + 256 * i;
        f32x4 g = *(const f32x4*)(gpre + col);
        f32x4 sh = *(const f32x4*)(modl + shift_off + col);
        f32x4 sc = *(const f32x4*)(modl + scale_off + col);
        float h0 = xv[i].x * rstd * g.x * (1.f + sc.x) + sh.x;
        float h1 = xv[i].y * rstd * g.y * (1.f + sc.y) + sh.y;
        float h2 = xv[i].z * rstd * g.z * (1.f + sc.z) + sh.z;
        float h3 = xv[i].w * rstd * g.w * (1.f + sc.w) + sh.w;
        u32x2 w;
        w.x = pack2(h0, h1);
        w.y = pack2(h2, h3);
        *(u32x2*)(p.H + (size_t)row * D + col) = w;
      }
    }
}

DI void ew_phase(const Params& p, int layer, int kind) {
  const int tid = ltid(), lane = tid & 63, wid = __builtin_amdgcn_readfirstlane(tid >> 6);
  for (int rg = lbid(); rg < T / 8; rg += gridDim.x) ew_row(p, layer, kind, rg * 8 + wid, lane);
}

DI void tile_done(int* cnt, int tm) {
  asm volatile("s_waitcnt vmcnt(0)" ::: "memory");
  __syncthreads();
  if (ltid() == 0) __hip_atomic_fetch_add(cnt + tm, 1, __ATOMIC_RELAXED, __HIP_MEMORY_SCOPE_AGENT);
}
template <class ConvF>
DI void ew_consume(const Params& p, int* cnt, int need, int layer, int kind, bool skip_ctx, int nconv, ConvF conv,
                   char* smem) {
  int* sh = (int*)(smem + SMEM_BYTES - 16);
  const int tid = ltid(), lane = tid & 63, wid = __builtin_amdgcn_readfirstlane(tid >> 6);
  for (;;) {
    __syncthreads();
    if (tid == 0) *sh = __hip_atomic_fetch_add(cnt + 136, 1, __ATOMIC_RELAXED, __HIP_MEMORY_SCOPE_AGENT);
    __syncthreads();
    const int q = *sh;
    if (q >= nconv + 544) break;
    if (q < nconv) { conv(q); continue; }
    const int c = q - nconv, mseq = c >> 2, j = mseq >> 3, bb = mseq & 7, tm = bb * 17 + j;
    if (skip_ctx && j == 16) continue;
    if (tid == 0) {
      while (__hip_atomic_load(cnt + tm, __ATOMIC_RELAXED, __HIP_MEMORY_SCOPE_AGENT) < need) __builtin_amdgcn_s_sleep(4);
    }
    __syncthreads();
    const int row0 = tm * 256 + (c & 3) * 64 + wid * 8;
#pragma unroll 1
    for (int i = 0; i < 8; ++i) ew_row(p, layer, kind, row0 + i, lane);
  }
}

DI void row_rstd(const u16* __restrict__ base, int ld, int ncols, int m0, float* rs) {
  const int tid = ltid(), row = tid >> 1, half = tid & 1;
  const int per = ncols / 2;
  const u16* ptr = base + (size_t)(m0 + row) * ld + half * per;
  float ss = 0.f;
  for (int i = 0; i < per; i += 8) {
    u32x4 v = *(const u32x4*)(ptr + i);
#pragma unroll
    for (int e = 0; e < 8; ++e) {
      float f = uw(v, e);
      ss += f * f;
    }
  }
  ss += __shfl_xor(ss, 1);
  if (half == 0) rs[row] = rsqrtf(ss / (float)ncols + EPS);
}

DI void qkv_tasks(const Params& p, char* smem, int qb, int qe, int kb_, int ke, int stp) {
  float* rs = (float*)(smem + 2 * 2 * 256 * 72 * 2);
  const int MT = T / 256;
  auto noT = [](int, int, u32x4) {};
  auto neverT = [](int) { return false; };
  for (int t = qb; t < qe; t += stp) {
    const int tm = t / 3, tn = t % 3, m0 = tm * 256;
    __syncthreads();
    row_rstd(p.P, NINP, 256, m0, rs);
    const bool lat = (m0 % SP) < SEQ;
    const int s0 = m0 % SP;
    gemm_tile<false>(
        p.P, NINP, p.wt_uq, 256, 256, m0, tn * 256, smem,
        [&](int mb, int nb, f32x16& acc, int r, int h) {
          const int rowl = mb - m0 + r;
          const float sc = rs[rowl];
#pragma unroll
          for (int e = 0; e < 16; ++e) acc[e] *= sc;
          const int cb = nb % 192;
          if (lat && cb >= 128) {
            const int s = s0 + rowl;
            const int pos = (cb == 128) ? (s >> 6) : (s & 63);
#pragma unroll
            for (int e = 0; e < 8; ++e) {
              const int j = crow(e, h);
              const float cs = p.ropetab[2 * (pos * 16 + j)], sn = p.ropetab[2 * (pos * 16 + j) + 1];
              const float x1 = acc[e], x2 = acc[e + 8];
              acc[e] = x1 * cs - x2 * sn;
              acc[e + 8] = x1 * sn + x2 * cs;
            }
          }
        },
        [&](int row, int col, u32x4 v) { *(u32x4*)(p.Q + (size_t)row * 768 + col) = v; }, noT, neverT);
  }
  for (int t = kb_; t < ke; t += stp) {
    const int tm = t / 4, tn = t % 4, m0 = tm * 256;
    const int b = m0 / SP, s0 = m0 % SP;
    const bool lat = s0 < SEQ;
    __syncthreads();
    row_rstd(p.P + 256, NINP, 128, m0, rs);
    if (tn == 0) {
      for (int idx = ltid(); idx < 256 * 32; idx += NTHR) {
        const int rowl = idx >> 5, q = idx & 31, blk = q >> 4, j = q & 15;
        const u16* src = p.P + (size_t)(m0 + rowl) * NINP + 384 + blk * 32 + j;
        float x1 = bf2f(src[0]), x2 = bf2f(src[16]);
        float o1 = x1, o2 = x2;
        if (lat) {
          const int s = s0 + rowl;
          const int pos = blk == 0 ? (s >> 6) : (s & 63);
          const float cs = p.ropetab[2 * (pos * 16 + j)], sn = p.ropetab[2 * (pos * 16 + j) + 1];
          o1 = x1 * cs - x2 * sn;
          o2 = x1 * sn + x2 * cs;
        }
        u16* dst = p.Kr + (size_t)(m0 + rowl) * 64 + blk * 32 + j;
        dst[0] = f2bf(o1);
        dst[16] = f2bf(o2);
      }
    }
    const int n0 = tn * 256;
    u16* vbase = p.Vt + (size_t)(b * 4 + tn) * 128 * SP + s0;
    gemm_tile<true>(
        p.P + 256, NINP, p.wt_ukv, 128, 128, m0, n0, smem,
        [&](int mb, int nb, f32x16& acc, int r, int h) {
          const float sc = rs[mb - m0 + r];
#pragma unroll
          for (int e = 0; e < 16; ++e) acc[e] *= sc;
        },
        [&](int row, int col, u32x4 v) { *(u32x4*)(p.Kn + (size_t)row * 512 + tn * 128 + (col - n0)) = v; },
        [&](int col, int row, u32x4 v) { *(u32x4*)(vbase + (size_t)(col - n0 - 128) * SP + (row - m0)) = v; },
        [](int wn) { return wn >= 2; });
  }
}

DI void cm_tasks(const Params& p, int layer, char* smem, int tb, int te, int stp) {
  const int ftid = ltid(), vb = ftid >> 8, tid = ftid & 255;
  u16* vnT = (u16*)(smem + vb * VSMEM);
  const int lane = tid & 63, wid = tid >> 6, r = lane & 31, h = lane >> 5;
  const float* gn = p.cm_norm_g + layer * 256;
  const float* bs = p.cm_b_s + layer * 512;
  for (int t0 = tb; t0 < te; t0 += stp) {
    const int task = t0 + vb;
    const int row0 = task * 128;
    __syncthreads();
#pragma unroll 4
    for (int i = 0; i < 32; ++i) {
      const int s = wid * 32 + i;
      const u16* src = p.P + (size_t)(row0 + s) * NINP + 704;
      float v[4];
      float sum = 0.f;
#pragma unroll
      for (int q = 0; q < 4; ++q) {
        v[q] = gelu_f(bf2f(src[lane + 64 * q]));
        sum += v[q];
      }
      const float mean = wave_sum(sum) * (1.f / 256.f);
      float var = 0.f;
#pragma unroll
      for (int q = 0; q < 4; ++q) {
        v[q] -= mean;
        var += v[q] * v[q];
      }
      const float rstd = rsqrtf(wave_sum(var) * (1.f / 256.f) + EPS);
#pragma unroll
      for (int q = 0; q < 4; ++q) vnT[(lane + 64 * q) * 136 + s] = f2bf(v[q] * rstd * gn[lane + 64 * q]);
    }
    __syncthreads();
    const int t = wid * 32 + r;
    for (int g = 0; g < 4; ++g) {
      bf16x8 wf[8];
#pragma unroll
      for (int kk = 0; kk < 8; ++kk) wf[kk] = *(const bf16x8*)(p.wsb + ((size_t)(g * 128 + t)) * 128 + kk * 16 + h * 8);
      const float bias = bs[g * 128 + t];
#pragma unroll
      for (int cb = 0; cb < 2; ++cb) {
        f32x16 acc;
#pragma unroll
        for (int e = 0; e < 16; ++e) acc[e] = 0.f;
#pragma unroll
        for (int kk = 0; kk < 8; ++kk) {
          bf16x8 a = *(const bf16x8*)(vnT + (g * 64 + cb * 32 + r) * 136 + kk * 16 + h * 8);
          acc = MFMA(a, wf[kk], acc);
        }
#pragma unroll
        for (int q4 = 0; q4 < 4; ++q4) {
          const int ch0 = g * 64 + cb * 32 + 8 * q4 + 4 * h;
          u32x2 uwd = *(const u32x2*)(p.P + (size_t)(row0 + t) * NINP + 448 + ch0);
          float u0 = gelu_f(bflo(uwd.x)), u1 = gelu_f(bfhi(uwd.x)), u2 = gelu_f(bflo(uwd.y)), u3 = gelu_f(bfhi(uwd.y));
          u32x2 w;
          w.x = pack2(u0 * (acc[4 * q4] + bias), u1 * (acc[4 * q4 + 1] + bias));
          w.y = pack2(u2 * (acc[4 * q4 + 2] + bias), u3 * (acc[4 * q4 + 3] + bias));
          *(u32x2*)(p.H + (size_t)(row0 + t) * D + 512 + ch0) = w;
        }
      }
    }
  }
}

struct ConvW { f32x4 w0a, w0b, w1a, w1b, w2a, w2b, ba, bb; };
DI ConvW load_convw(const Params& p, int layer, int ch) {
  const float* cw = p.conv_w + (size_t)layer * 3 * 768 + ch;
  const float* cb = p.conv_b + layer * 768 + ch;
  ConvW c;
  c.w0a = *(const f32x4*)(cw); c.w0b = *(const f32x4*)(cw + 4);
  c.w1a = *(const f32x4*)(cw + 768); c.w1b = *(const f32x4*)(cw + 772);
  c.w2a = *(const f32x4*)(cw + 1536); c.w2b = *(const f32x4*)(cw + 1540);
  c.ba = *(const f32x4*)(cb); c.bb = *(const f32x4*)(cb + 4);
  return c;
}
DI float convw_get(const f32x4& a, const f32x4& b, int e) { return e < 4 ? a[e & 3] : b[e & 3]; }
DI void conv8(const Params& p, const ConvW& c, int row, int ch, bool hasPrev, bool hasNext, float out[8]) {
  const u16* base = p.P + (size_t)row * NINP + 1216 + ch;
  u32x4 cur = *(const u32x4*)base;
  u32x4 prv = *(const u32x4*)(base - (hasPrev ? NINP : 0));
  u32x4 nxt = *(const u32x4*)(base + (hasNext ? NINP : 0));
  const float mp = hasPrev ? 1.f : 0.f, mn = hasNext ? 1.f : 0.f;
#pragma unroll
  for (int e = 0; e < 8; ++e) {
    float y = convw_get(c.w0a, c.w0b, e) * (mp * uw(prv, e)) + convw_get(c.w1a, c.w1b, e) * uw(cur, e) +
              convw_get(c.w2a, c.w2b, e) * (mn * uw(nxt, e)) + convw_get(c.ba, c.bb, e);
    out[e] = silu_f(y);
  }
}

template <int RPT, class F>
DI void conv_stage(const Params& p, int layer, int row0, int chbase, int cp, int tb, bool cPrev, bool cNext, F emit) {
  const ConvW c = load_convw(p, layer, chbase + cp * 8);
  const int r0 = tb * RPT;
  const bool hp = cPrev || r0 > 0, hn = cNext || (r0 + RPT) < 128;
  const u16* base = p.P + (size_t)(row0 + r0) * NINP + 1216 + chbase + cp * 8;
  u32x4 raw[RPT + 2];
  raw[0] = *(const u32x4*)(base - (hp ? NINP : 0));
#pragma unroll
  for (int k = 0; k < RPT; ++k) raw[k + 1] = *(const u32x4*)(base + (size_t)k * NINP);
  raw[RPT + 1] = *(const u32x4*)(base + (size_t)(hn ? RPT : RPT - 1) * NINP);
  const float mp = hp ? 1.f : 0.f, mn = hn ? 1.f : 0.f;
#pragma unroll
  for (int i = 0; i < RPT; ++i) {
    const float fp = (i == 0) ? mp : 1.f, fn = (i == RPT - 1) ? mn : 1.f;
    float v[8];
#pragma unroll
    for (int e = 0; e < 8; ++e) {
      float y = convw_get(c.w0a, c.w0b, e) * (fp * uw(raw[i], e)) + convw_get(c.w1a, c.w1b, e) * uw(raw[i + 1], e) +
                convw_get(c.w2a, c.w2b, e) * (fn * uw(raw[i + 2], e)) + convw_get(c.ba, c.bb, e);
      v[e] = silu_f(y);
    }
    emit(r0 + i, v);
  }
}

DI void ssd_dt_arrays(const Params& p, int layer, int row0, int hh, int t, float* arr) {
  float* dt0 = arr;
  float* dt1 = arr + 128;
  float* c0 = arr + 256;
  float* s1 = arr + 384;
  float* a0 = arr + 512;
  float* a1 = arr + 640;
  const float d0 = softplus_f(p.dtraw[(size_t)(row0 + t) * 8 + hh] + p.dt_bias[layer * 8 + hh]);
  const float d1 = softplus_f(p.dtraw[(size_t)(row0 + t) * 8 + 4 + hh] + p.dt_bias[layer * 8 + 4 + hh]);
  dt0[t] = d0;
  dt1[t] = d1;
  a0[t] = -d0 * __expf(p.a_log[layer * 8 + hh]);
  a1[t] = -d1 * __expf(p.a_log[layer * 8 + 4 + hh]);
}
DI float wave_incl_prefix(float x, int lane) {
#pragma unroll
  for (int o = 1; o < 64; o <<= 1) {
    float y = __shfl_up(x, o);
    if (lane >= o) x += y;
  }
  return x;
}
DI void ssd_cum_arrays(int t, float* arr) {
  float* c0 = arr + 256;
  float* s1 = arr + 384;
  const float* a0 = arr + 512;
  const float* a1 = arr + 640;
  const int lane = t & 63, w = t >> 6;
  const float x0 = a0[t], o0 = a0[t ^ 64], x1 = a1[t], o1 = a1[t ^ 64];
  const float tot_o0 = wave_sum(o0), tot_o1 = wave_sum(o1), tot_x1 = wave_sum(x1);
  float p0 = wave_incl_prefix(x0, lane);
  float p1 = wave_incl_prefix(x1, lane);
  if (w == 1) p0 += tot_o0;
  float sf = tot_x1 - p1 + x1;
  if (w == 0) sf += tot_o1;
  c0[t] = p0;
  s1[t] = sf;
}

DI void ssd_s1_tasks(const Params& p, int layer, char* smem, int tb, int te, int stp) {
  const int ftid = ltid(), vb = ftid >> 8, tid = ftid & 255;
  u16* xsT0 = (u16*)(smem + vb * VSMEM);
  u16* xsT1 = xsT0 + 64 * 136;
  u16* BT = xsT1 + 64 * 136;
  float* arr = (float*)(BT + 128 * 136);
  float* w0 = arr + 768;
  float* w1 = w0 + 128;
  const int lane = tid & 63, wid = tid >> 6, r = lane & 31, h = lane >> 5;
  for (int t0 = tb; t0 < te; t0 += stp) {
    const int task = t0 + vb;
    const int hh = task & 3, bc = task >> 2, c = bc % NCH, b = bc / NCH;
    const int g = hh >> 1;
    const int row0 = bc * 128;
    const bool cPrev = (c != 0 && c != 32), cNext = (c != 31 && c != 33);
    __syncthreads();
    if (tid < 128) ssd_dt_arrays(p, layer, row0, hh, tid, arr);
    __syncthreads();
    if (tid < 128) ssd_cum_arrays(tid, arr);
    __syncthreads();
    if (tid < 128) {
      const float* dt0 = arr;
      const float* dt1 = arr + 128;
      const float* c0 = arr + 256;
      const float* s1 = arr + 384;
      w0[tid] = __expf(c0[127] - c0[tid]) * dt0[tid];
      w1[tid] = __expf(s1[0] - s1[tid]) * dt1[tid];
      if (tid == 0) {
        p.atot[((size_t)bc * 2 + 0) * 4 + hh] = c0[127];
        p.atot[((size_t)bc * 2 + 1) * 4 + hh] = s1[0];
      }
    }
    __syncthreads();
    conv_stage<4>(p, layer, row0, hh * 64, tid & 7, tid >> 3, cPrev, cNext, [&](int t, const float (&v)[8]) {
      const float f0 = w0[t], f1 = w1[t];
      const int cp = tid & 7;
#pragma unroll
      for (int e = 0; e < 8; ++e) {
        xsT0[(cp * 8 + e) * 136 + t] = f2bf(v[e] * f0);
        xsT1[(cp * 8 + e) * 136 + t] = f2bf(v[e] * f1);
      }
    });
    conv_stage<8>(p, layer, row0, 256 + g * 128, tid & 15, tid >> 4, cPrev, cNext, [&](int t, const float (&v)[8]) {
      const int cp = tid & 15;
#pragma unroll
      for (int e = 0; e < 8; ++e) BT[(cp * 8 + e) * 136 + t] = f2bf(v[e]);
    });
    __syncthreads();
#pragma unroll
    for (int d = 0; d < 2; ++d) {
      const u16* xsT = d ? xsT1 : xsT0;
#pragma unroll
      for (int pb = 0; pb < 2; ++pb) {
        f32x16 acc;
#pragma unroll
        for (int e = 0; e < 16; ++e) acc[e] = 0.f;
#pragma unroll
        for (int kk = 0; kk < 8; ++kk) {
          bf16x8 a = *(const bf16x8*)(xsT + (pb * 32 + r) * 136 + kk * 16 + h * 8);
          bf16x8 bb = *(const bf16x8*)(BT + (wid * 32 + r) * 136 + kk * 16 + h * 8);
          acc = MFMA(a, bb, acc);
        }
        float* dst = p.CS + ((((size_t)bc * 2 + d) * 4 + hh) * 64 + pb * 32) * 128 + wid * 32 + r;
#pragma unroll
        for (int e = 0; e < 16; ++e) dst[(size_t)crow(e, h) * 128] = acc[e];
      }
    }
  }
}

DI void ssd_scan_phase(const Params& p) {
  const int total = NB * 2 * 4 * 8192;
  for (int idx = lbid() * NTHR + ltid(); idx < total; idx += gridDim.x * NTHR) {
    const int e = idx & 8191, hh = (idx >> 13) & 3, d = (idx >> 15) & 1, b = idx >> 16;
    float st = 0.f;
#pragma unroll 2
    for (int i = 0; i < NCH; ++i) {
      int c;
      if (d == 0) c = i < 2 ? 32 + i : i - 2;
      else c = i < 2 ? 33 - i : 33 - i;
      const size_t bc = (size_t)b * NCH + c;
      float* ptr = p.CS + ((bc * 2 + d) * 4 + hh) * 8192 + e;
      const float v = *ptr;
      const float dec = __expf(p.atot[(bc * 2 + d) * 4 + hh]);
      *ptr = st;
      st = dec * st + v;
    }
  }
}

template <int G>
DI float ssd_s3_group(const Params& p, int layer, int bc, bool cPrev, bool cNext, u16* Bg, u16* xsT, float* arr, int tid) {
  f32x16 y[4];
#pragma unroll
  for (int i = 0; i < 4; ++i)
#pragma unroll
    for (int e = 0; e < 16; ++e) y[i][e] = 0.f;
  const int lane = tid & 63, wid = tid >> 6, r = lane & 31, h = lane >> 5;
  const int l = wid * 32 + r;
  const int row0 = bc * 128;
  __syncthreads();
  ssd_dt_arrays(p, layer, row0, 2 * G + (tid >> 7), tid & 127, arr + (tid >> 7) * 768);
  const ConvW cwc = load_convw(p, layer, 512 + G * 128 + (tid & 15) * 8);
#pragma unroll 1
  for (int i = 0; i < 8; ++i) {
    const int id = tid + VT * i, t = id >> 4, cp = id & 15;
    float v[8];
    conv8(p, cwc, row0 + t, 512 + G * 128 + cp * 8, cPrev || t > 0, cNext || t < 127, v);
    *(bf16x8*)(Bg + t * 136 + cp * 8) = pack8(v[0], v[1], v[2], v[3], v[4], v[5], v[6], v[7]);
  }
  const ConvW cwx = load_convw(p, layer, G * 128 + (tid & 15) * 8);
#pragma unroll 1
  for (int i = 0; i < 8; ++i) {
    const int id = tid + VT * i, t = id >> 4, cp = id & 15;
    float v[8];
    conv8(p, cwx, row0 + t, G * 128 + cp * 8, cPrev || t > 0, cNext || t < 127, v);
#pragma unroll
    for (int e = 0; e < 8; ++e) xsT[(cp * 8 + e) * 136 + t] = f2bf(v[e]);
  }
  __syncthreads();
  ssd_cum_arrays(tid & 127, arr + (tid >> 7) * 768);
  bf16x8 cf[8];
#pragma unroll
  for (int kk = 0; kk < 8; ++kk) cf[kk] = *(const bf16x8*)(Bg + l * 136 + kk * 16 + h * 8);
  __syncthreads();
  const ConvW cwb = load_convw(p, layer, 256 + G * 128 + (tid & 15) * 8);
#pragma unroll 1
  for (int i = 0; i < 8; ++i) {
    const int id = tid + VT * i, t = id >> 4, cp = id & 15;
    float v[8];
    conv8(p, cwb, row0 + t, 256 + G * 128 + cp * 8, cPrev || t > 0, cNext || t < 127, v);
    *(bf16x8*)(Bg + t * 136 + cp * 8) = pack8(v[0], v[1], v[2], v[3], v[4], v[5], v[6], v[7]);
  }
  __syncthreads();
  float ss = 0.f;
#pragma unroll 1
  for (int hd2 = 0; hd2 < 2; ++hd2) {
    const int hh = 2 * G + hd2;
    const float* ah = arr + hd2 * 768;
    const float c0l = ah[256 + l], s1l = ah[384 + l];
    f32x16 y[2];
#pragma unroll
    for (int i = 0; i < 2; ++i)
#pragma unroll
      for (int e = 0; e < 16; ++e) y[i][e] = 0.f;
#pragma unroll 1
    for (int sb = 0; sb < 4; ++sb) {
      f32x16 gt;
#pragma unroll
      for (int e = 0; e < 16; ++e) gt[e] = 0.f;
#pragma unroll
      for (int kk = 0; kk < 8; ++kk) {
        bf16x8 a = *(const bf16x8*)(Bg + (sb * 32 + r) * 136 + kk * 16 + h * 8);
        gt = MFMA(a, cf[kk], gt);
      }
      f32x16 wv;
      if (sb != wid) {
        const float ref = sb < wid ? c0l : s1l;
        const float* cumv = ah + (sb < wid ? 256 : 384) + sb * 32 + 4 * h;
        const float* dtv = ah + (sb < wid ? 0 : 128) + sb * 32 + 4 * h;
#pragma unroll
        for (int q4 = 0; q4 < 4; ++q4) {
          const f32x4 cv = *(const f32x4*)(cumv + 8 * q4), dv = *(const f32x4*)(dtv + 8 * q4);
#pragma unroll
          for (int k = 0; k < 4; ++k) wv[4 * q4 + k] = gt[4 * q4 + k] * (__expf(ref - cv[k]) * dv[k]);
        }
      } else {
#pragma unroll
        for (int q4 = 0; q4 < 4; ++q4) {
          const int s4 = sb * 32 + 8 * q4 + 4 * h;
          const f32x4 c0v = *(const f32x4*)(ah + 256 + s4), d0v = *(const f32x4*)(ah + s4);
          const f32x4 s1v = *(const f32x4*)(ah + 384 + s4), d1v = *(const f32x4*)(ah + 128 + s4);
#pragma unroll
          for (int k = 0; k < 4; ++k) {
            const int s = s4 + k;
            const float a0 = (l >= s) ? (c0l - c0v[k]) : -1e30f;
            const float a1 = (l <= s) ? (s1l - s1v[k]) : -1e30f;
            wv[4 * q4 + k] = gt[4 * q4 + k] * (__expf(a0) * d0v[k] + __expf(a1) * d1v[k]);
          }
          __builtin_amdgcn_sched_barrier(0);
        }
      }
      bf16x8 wp0 = pack8(wv[0], wv[1], wv[2], wv[3], wv[4], wv[5], wv[6], wv[7]);
      bf16x8 wp1 = pack8(wv[8], wv[9], wv[10], wv[11], wv[12], wv[13], wv[14], wv[15]);
#pragma unroll
      for (int pb = 0; pb < 2; ++pb) {
        const u16* xrow = xsT + (hd2 * 64 + pb * 32 + r) * 136 + sb * 32 + 4 * h;
        s16x4 lo0 = *(const s16x4*)(xrow), hi0 = *(const s16x4*)(xrow + 8);
        s16x4 lo1 = *(const s16x4*)(xrow + 16), hi1 = *(const s16x4*)(xrow + 24);
        bf16x8 a0 = __builtin_shufflevector(lo0, hi0, 0, 1, 2, 3, 4, 5, 6, 7);
        bf16x8 a1 = __builtin_shufflevector(lo1, hi1, 0, 1, 2, 3, 4, 5, 6, 7);
        y[pb] = MFMA(a0, wp0, y[pb]);
        y[pb] = MFMA(a1, wp1, y[pb]);
      }
    }
#pragma unroll 1
    for (int d = 0; d < 2; ++d) {
      const float el = __expf(d == 0 ? c0l : s1l);
#pragma unroll
      for (int pb = 0; pb < 2; ++pb) {
        const float* srow = p.CS + ((((size_t)bc * 2 + d) * 4 + hh) * 64 + pb * 32 + r) * 128 + h * 8;
        f32x16 tmp;
#pragma unroll
        for (int e = 0; e < 16; ++e) tmp[e] = 0.f;
#pragma unroll
        for (int kk = 0; kk < 8; ++kk) {
          f32x4 s0 = *(const f32x4*)(srow + kk * 16), s1 = *(const f32x4*)(srow + kk * 16 + 4);
          bf16x8 a = pack8(s0.x, s0.y, s0.z, s0.w, s1.x, s1.y, s1.z, s1.w);
          tmp = MFMA(a, cf[kk], tmp);
        }
#pragma unroll
        for (int e = 0; e < 16; ++e) y[pb][e] += el * tmp[e];
      }
    }
    const float dsk = p.ssd_d[layer * 8 + hh] + p.ssd_d[layer * 8 + 4 + hh];
#pragma unroll
    for (int pb = 0; pb < 2; ++pb) {
#pragma unroll
      for (int q4 = 0; q4 < 4; ++q4) {
        const int cl = hd2 * 64 + pb * 32 + 8 * q4 + 4 * h;
        const int ch0 = G * 128 + cl;
        u32x2 zw = *(const u32x2*)(p.P + (size_t)(row0 + l) * NINP + 960 + ch0);
        f32x4 o;
        o.x = (y[pb][4 * q4] + dsk * bf2f(xsT[(cl + 0) * 136 + l])) * silu_f(bflo(zw.x));
        o.y = (y[pb][4 * q4 + 1] + dsk * bf2f(xsT[(cl + 1) * 136 + l])) * silu_f(bfhi(zw.x));
        o.z = (y[pb][4 * q4 + 2] + dsk * bf2f(xsT[(cl + 2) * 136 + l])) * silu_f(bflo(zw.y));
        o.w = (y[pb][4 * q4 + 3] + dsk * bf2f(xsT[(cl + 3) * 136 + l])) * silu_f(bfhi(zw.y));
        ss += o.x * o.x + o.y * o.y + o.z * o.z + o.w * o.w;
        *(f32x4*)(p.ytmp + (size_t)(row0 + l) * 256 + ch0) = o;
      }
    }
  }
  return ss;
}

DI void ssd_s3_tasks(const Params& p, int layer, char* smem) {
  const int ftid = ltid(), vb = ftid >> 8, tid = ftid & 255;
  u16* Bg = (u16*)(smem + vb * VSMEM);
  u16* xsT = Bg + 128 * 136;
  float* arr = (float*)(xsT + 128 * 136);
  const int lane = tid & 63, wid = tid >> 6, r = lane & 31, h = lane >> 5;
  const int l = wid * 32 + r;
  for (int t0 = lbid() * 2; t0 < NB * NCH; t0 += gridDim.x * 2) {
    const int bc = t0 + vb, c = bc % NCH;
    const int row0 = bc * 128;
    const bool cPrev = (c != 0 && c != 32), cNext = (c != 31 && c != 33);
    float ss = ssd_s3_group<0>(p, layer, bc, cPrev, cNext, Bg, xsT, arr, tid);
    ss += ssd_s3_group<1>(p, layer, bc, cPrev, cNext, Bg, xsT, arr, tid);
    ss += __shfl_xor(ss, 32);
    const float rstd = rsqrtf(ss * (1.f / 256.f) + EPS);
    const float* gn = p.ssd_norm_g + layer * 256;
#pragma unroll 4
    for (int i = 0; i < 32; ++i) {
      const int ch0 = (i >> 2) * 32 + 8 * (i & 3) + 4 * h;
      f32x4 v = *(const f32x4*)(p.ytmp + (size_t)(row0 + l) * 256 + ch0);
      f32x4 gv = *(const f32x4*)(gn + ch0);
      u32x2 w;
      w.x = pack2(v.x * rstd * gv.x, v.y * rstd * gv.y);
      w.y = pack2(v.z * rstd * gv.z, v.w * rstd * gv.w);
      *(u32x2*)(p.H + (size_t)(row0 + l) * D + 768 + ch0) = w;
    }
  }
}

constexpr int QREG = 12;
DI void attn_qk(const u16* Ks, const bf16x8 (&qf)[QREG], const u16* qs, f32x16 (&st)[2], int r, int h) {
#pragma unroll
  for (int kb = 0; kb < 2; ++kb)
#pragma unroll
    for (int e = 0; e < 16; ++e) st[kb][e] = 0.f;
  const u16* kp = Ks + r * 200 + h * 8;
#pragma unroll
  for (int kk = 0; kk < 12; ++kk) {
    bf16x8 k0 = *(const bf16x8*)(kp + kk * 16);
    bf16x8 k1 = *(const bf16x8*)(kp + 32 * 200 + kk * 16);
    bf16x8 q;
    if (kk < QREG) q = qf[kk];
    else q = *(const bf16x8*)(qs + (kk - QREG) * 512);
    st[0] = MFMA(k0, q, st[0]);
    st[1] = MFMA(k1, q, st[1]);
  }
}
DI void attn_softmax(f32x16 (&st)[2], f32x16 (&o)[4], bf16x8 (&pf)[4], float& m_run, float& l_run, float sc) {
  float mx = st[0][0];
#pragma unroll
  for (int kb = 0; kb < 2; ++kb)
#pragma unroll
    for (int e = 0; e < 16; ++e) mx = fmaxf(mx, st[kb][e]);
  mx = fmaxf(mx, __shfl_xor(mx, 32));
  const float m_new = fmaxf(m_run, mx * sc);
  const float alpha = __builtin_amdgcn_exp2f(m_run - m_new);
  m_run = m_new;
  float ls = 0.f;
#pragma unroll
  for (int kb = 0; kb < 2; ++kb)
#pragma unroll
    for (int e = 0; e < 16; ++e) {
      float pv = __builtin_amdgcn_exp2f(fmaf(st[kb][e], sc, -m_new));
      ls += pv;
      st[kb][e] = pv;
    }
  l_run = l_run * alpha + ls;
  if (__builtin_amdgcn_ballot_w64(alpha != 1.f) != 0ull) {
#pragma unroll
    for (int i = 0; i < 4; ++i)
#pragma unroll
      for (int e = 0; e < 16; ++e) o[i][e] *= alpha;
  }
#pragma unroll
  for (int ks = 0; ks < 4; ++ks) {
    const int kb = ks >> 1, s2 = ks & 1;
    pf[ks] = pack8(st[kb][8 * s2], st[kb][8 * s2 + 1], st[kb][8 * s2 + 2], st[kb][8 * s2 + 3], st[kb][8 * s2 + 4],
                   st[kb][8 * s2 + 5], st[kb][8 * s2 + 6], st[kb][8 * s2 + 7]);
  }
}
DI void attn_pv(const u16* Vs, const bf16x8 (&pf)[4], f32x16 (&o)[4], int r, int h) {
#pragma unroll
  for (int ks = 0; ks < 4; ++ks) {
#pragma unroll
    for (int db = 0; db < 4; ++db) {
      bf16x8 a = *(const bf16x8*)(Vs + (db * 32 + r) * 72 + ks * 16 + 8 * h);
      o[db] = MFMA(a, pf[ks], o[db]);
    }
  }
}

DI void attn_tasks(const Params& p, char* smem) {
  u16* Ks0 = (u16*)smem;
  u16* Vs0 = Ks0 + 2 * 64 * 200;
  const int tid = ltid(), lane = tid & 63, wid = __builtin_amdgcn_readfirstlane(tid >> 6), r = lane & 31, h = lane >> 5;
  u16* qs = Vs0 + 2 * 128 * 72 + wid * ((12 - QREG) * 512) + lane * 8;
  const float sc = 0.07216878364870322f * 1.4426950408889634f;
  for (int task = lbid(); task < NB * 4 * 17; task += gridDim.x) {
    int b, hd, qt;
    if (task < 512) {
      qt = task & 15; hd = (task >> 4) & 3; b = task >> 6;
    } else {
      const int t2 = task - 512;
      qt = 16; hd = t2 & 3; b = t2 >> 2;
    }
    const int koff = (qt < 16) ? 0 : SEQ;
    const int nkt = ((qt < 16) ? SP : CTX) / 64;
    const int qrow = b * SP + qt * 256 + wid * 32 + r;
    bf16x8 qf[QREG];
#pragma unroll
    for (int kk = 0; kk < QREG; ++kk) qf[kk] = *(const bf16x8*)(p.Q + (size_t)qrow * 768 + hd * 192 + kk * 16 + h * 8);
#pragma unroll
    for (int kk = QREG; kk < 12; ++kk)
      *(bf16x8*)(qs + (kk - QREG) * 512) = *(const bf16x8*)(p.Q + (size_t)qrow * 768 + hd * 192 + kk * 16 + h * 8);
    f32x16 o[4];
#pragma unroll
    for (int i = 0; i < 4; ++i)
#pragma unroll
      for (int e = 0; e < 16; ++e) o[i][e] = 0.f;
    float m_run = -1e30f, l_run = 0.f;
    u32x4 kn[2], kr[1], vv[2];
    const u16* knb = p.Kn + ((size_t)(b * SP + koff) + (tid >> 4)) * 512 + hd * 128 + (tid & 15) * 8;
    const u16* krb = p.Kr + ((size_t)(b * SP + koff) + (tid >> 3)) * 64 + (tid & 7) * 8;
    const u16* vb = p.Vt + ((size_t)(b * 4 + hd) * 128 + (tid >> 3)) * SP + koff + (tid & 7) * 8;
#define ALOAD(ko_)                                                                               \
  {                                                                                              \
    _Pragma("unroll") for (int i = 0; i < 2; ++i) kn[i] = *(const u32x4*)(knb + ((ko_) + 32 * i) * 512); \
    kr[0] = *(const u32x4*)(krb + (ko_) * 64);                                                   \
    _Pragma("unroll") for (int i = 0; i < 2; ++i) vv[i] = *(const u32x4*)(vb + (size_t)(64 * i) * SP + (ko_)); \
  }
#define AWRITE(buf_)                                                                             \
  {                                                                                              \
    u16* Kw = Ks0 + (buf_) * (64 * 200);                                                         \
    u16* Vw = Vs0 + (buf_) * (128 * 72);                                                         \
    _Pragma("unroll") for (int i = 0; i < 2; ++i) *(u32x4*)(Kw + ((tid >> 4) + 32 * i) * 200 + (tid & 15) * 8) = kn[i]; \
    *(u32x4*)(Kw + (tid >> 3) * 200 + 128 + (tid & 7) * 8) = kr[0];                              \
    _Pragma("unroll") for (int i = 0; i < 2; ++i) {                                              \
      u16* dst = Vw + ((tid >> 3) + 64 * i) * 72 + ((tid & 7) >> 1) * 16 + ((tid & 7) & 1) * 4;  \
      *(u32x2*)dst = u32x2{vv[i].x, vv[i].y};                                                    \
      *(u32x2*)(dst + 8) = u32x2{vv[i].z, vv[i].w};                                              \
    }                                                                                            \
  }
    ALOAD((size_t)0);
    AWRITE(0);
    ALOAD((size_t)64);
    for (int kt = 0; kt < nkt; ++kt) {
      __syncthreads();
      if (kt + 1 < nkt) AWRITE((kt + 1) & 1);
      {
        const size_t ko = (size_t)(kt + 2 < nkt ? kt + 2 : nkt - 1) * 64;
        ALOAD(ko);
      }
      __builtin_amdgcn_sched_barrier(0);
      f32x16 st[2];
      bf16x8 pf[4];
      attn_qk(Ks0 + (kt & 1) * (64 * 200), qf, qs, st, r, h);
      attn_softmax(st, o, pf, m_run, l_run, sc);
      attn_pv(Vs0 + (kt & 1) * (128 * 72), pf, o, r, h);
    }
#undef ALOAD
#undef AWRITE
    const float ltot = l_run + __shfl_xor(l_run, 32);
    const float inv = 1.f / ltot;
    u16* orow = p.H + (size_t)qrow * D + hd * 128;
#pragma unroll
    for (int db = 0; db < 4; ++db)
#pragma unroll
      for (int q4 = 0; q4 < 4; ++q4) {
        u32x2 w;
        w.x = pack2(o[db][4 * q4] * inv, o[db][4 * q4 + 1] * inv);
        w.y = pack2(o[db][4 * q4 + 2] * inv, o[db][4 * q4 + 3] * inv);
        *(u32x2*)(orow + db * 32 + 8 * q4 + 4 * h) = w;
      }
  }
}

constexpr int NPHASE = 2 + DEPTH * 6;

DI void conv_item_ffn(const Params& p, int layer, int q, char* smem) {
#pragma unroll 1
  for (int u = 0; u < 8; ++u) {
    const int tile = q * 8 + u;
    if (tile < 1024) conv_tile(p.w_ff1 + (size_t)layer * D * DFF, D, DFF, p.wt_ff1, nullptr, tile >> 6, tile & 63, smem);
    else conv_tile(p.w_ff2 + (size_t)layer * DFF * D, DFF, D, p.wt_ff2, nullptr, (tile - 1024) >> 4, (tile - 1024) & 15, smem);
  }
}
DI void conv_item_mix(const Params& p, int layer, int q, char* smem) {
#pragma unroll 1
  for (int u = 0; u < 8; ++u) {
    int tile = q * 8 + u;
    if (tile < 512) { conv_tile(p.w_in + (size_t)layer * D * NIN, D, NIN, p.wt_in, nullptr, tile >> 5, tile & 31, smem); continue; }
    tile -= 512;
    if (tile < 48) { conv_tile(p.w_uq + (size_t)layer * 256 * 768, 256, 768, p.wt_uq, p.g_q + layer * 256, tile / 12, tile % 12, smem); continue; }
    tile -= 48;
    if (tile < 32) { conv_tile(p.w_ukv + (size_t)layer * 128 * 1024, 128, 1024, p.wt_ukv, p.g_kv + layer * 128, tile >> 4, tile & 15, smem); continue; }
    tile -= 32;
    if (tile < 256) { conv_tile(p.w_out + (size_t)layer * D * D, D, D, p.wt_out, nullptr, tile >> 4, tile & 15, smem); continue; }
    tile -= 256;
    for (int i = ltid(); i < 4096; i += NTHR) p.wsb[tile * 4096 + i] = f2bf(p.cm_w_s[(size_t)layer * 65536 + tile * 4096 + i]);
  }
}

DI void run_phase(const Params& p, int ph, char* smem) {
  if (ph == 0) { prologue_phase(p, smem); return; }
  const int MT = T / 256;
  auto noT = [](int, int, u32x4) {};
  auto neverT = [](int) { return false; };
  if (ph == 1) {
    ew_phase(p, 0, 0);
    for (int q = lbid(); q < 108; q += gridDim.x) conv_item_mix(p, 0, q, smem);
    return;
  }
  const int layer = (ph - 2) / 6, sub = (ph - 2) % 6;
  const bool last = layer == DEPTH - 1;
  switch (sub) {
    case 0: {
      int* cntP = p.cnt + (4 * DEPTH + layer) * CNT_STRIDE;
      for (int it = 0;; ++it) {
        const int t = xcd_tile(it, MT * 8);
        if (t < 0) break;
        const int tm = t >> 3, tn = t & 7;
        gemm_tile<false>(
            p.H, D, p.wt_in, D, D, tm * 256, tn * 256, smem,
            [&](int mb, int nb, f32x16& acc, int r, int h) {
              if (nb == 1984) {
                f32x4 v = {acc[0], acc[1], acc[2], acc[3]};
                st_wt16f(p.dtraw + (size_t)(mb + r) * 8 + 4 * h, v);
              }
            },
            [&](int row, int col, u32x4 v) { st_wt(p.P + (size_t)row * NINP + col, v); }, noT, neverT);
        tile_done(cntP, tm);
      }
      int* wq = p.cnt + (2 * DEPTH + layer) * CNT_STRIDE;
      int* sh = (int*)(smem + SMEM_BYTES - 16);
      for (;;) {
        __syncthreads();
        if (ltid() == 0) *sh = __hip_atomic_fetch_add(wq, 1, __ATOMIC_RELAXED, __HIP_MEMORY_SCOPE_AGENT);
        __syncthreads();
        const int q = *sh;
        if (q >= 544 + 136 + 408 + 544) break;
        int tmA, tmB, s1t0 = 0;
        if (q < 544) {
          int bb, c, hp;
          if (q < 512) { bb = q >> 6; c = (q & 63) >> 1; hp = q & 1; }
          else { const int i2 = q - 512; bb = i2 >> 2; c = 32 + ((i2 >> 1) & 1); hp = i2 & 1; }
          s1t0 = (bb * NCH + c) * 4 + hp * 2;
          tmA = bb * 17 + (c >> 1);
          tmB = tmA;
          if ((c & 1) && c != 31 && c != 33) tmB = tmA + 1;
          if (!(c & 1) && c != 0 && c != 32) tmB = tmA - 1;
        } else if (q < 680) { tmA = tmB = q - 544; }
        else if (q < 1088) { tmA = tmB = (q - 680) / 3; }
        else { tmA = tmB = (q - 1088) >> 2; }
        if (ltid() == 0) {
          while (__hip_atomic_load(cntP + tmA, __ATOMIC_RELAXED, __HIP_MEMORY_SCOPE_AGENT) < 8) __builtin_amdgcn_s_sleep(4);
          while (__hip_atomic_load(cntP + tmB, __ATOMIC_RELAXED, __HIP_MEMORY_SCOPE_AGENT) < 8) __builtin_amdgcn_s_sleep(4);
          __builtin_amdgcn_fence(__ATOMIC_ACQUIRE, "agent");
        }
        __syncthreads();
        if (q < 544) ssd_s1_tasks(p, layer, smem, s1t0, s1t0 + 1, 2);
        else if (q < 680) cm_tasks(p, layer, smem, 2 * (q - 544), 2 * (q - 544) + 1, 2);
        else if (q < 1088) qkv_tasks(p, smem, q - 680, q - 679, 0, 0, 1);
        else qkv_tasks(p, smem, 0, 0, q - 1088, q - 1087, 1);
      }
    } break;
    case 1: break;
    case 2: ssd_scan_phase(p); break;
    case 3: {
      attn_tasks(p, smem);
      ssd_s3_tasks(p, layer, smem);
    } break;
    case 4: {
      int* cnt = p.cnt + (2 * layer) * CNT_STRIDE;
      for (int it = 0;; ++it) {
        const int t = xcd_tile(it, MT * 4, last ? 4 : 0);
        if (t < 0) break;
        const int tm = t >> 2, tn = t & 3;
        gemm_tile<false>(
            p.H, D, p.wt_out, D, D, tm * 256, tn * 256, smem, [](int, int, f32x16&, int, int) {},
            [&](int row, int col, u32x4 v) { st_wt(p.Y + (size_t)row * D + col, v); }, noT, neverT);
        tile_done(cnt, tm);
      }
      ew_consume(p, cnt, 4, layer, 1, last, 256, [&](int q) { conv_item_ffn(p, layer, q, smem); }, smem);
    } break;
    case 5: {
      int* cnt1 = p.cnt + (3 * DEPTH + layer) * CNT_STRIDE;
      for (int it = 0;; ++it) {
        const int t = xcd_tile(it, MT * 16, last ? 16 : 0);
        if (t < 0) break;
        const int tm = t >> 4, tn = t & 15;
        gemm_tile<false>(
            p.H, D, p.wt_ff1, D, D, tm * 256, tn * 256, smem,
            [](int, int, f32x16& acc, int, int) {
#pragma unroll
              for (int e = 0; e < 16; ++e) {
                float v = fmaxf(acc[e], 0.f);
                acc[e] = v * v;
              }
            },
            [&](int row, int col, u32x4 v) { st_wt(p.Hd + (size_t)row * DFF + col, v); }, noT, neverT);
        tile_done(cnt1, tm);
      }
      int* cnt = p.cnt + (2 * layer + 1) * CNT_STRIDE;
      for (int it = 0;; ++it) {
        const int t = xcd_tile(it, MT * 4, last ? 4 : 0);
        if (t < 0) break;
        const int tm = t >> 2, tn = t & 3;
        if (ltid() == 0) {
          while (__hip_atomic_load(cnt1 + tm, __ATOMIC_RELAXED, __HIP_MEMORY_SCOPE_AGENT) < 16) __builtin_amdgcn_s_sleep(4);
      __builtin_amdgcn_fence(__ATOMIC_ACQUIRE, "agent");
        }
        __syncthreads();
        gemm_tile<false>(
            p.Hd, DFF, p.wt_ff2, DFF, DFF, tm * 256, tn * 256, smem, [](int, int, f32x16&, int, int) {},
            [&](int row, int col, u32x4 v) { st_wt(p.F + (size_t)row * D + col, v); }, noT, neverT);
        tile_done(cnt, tm);
      }
      if (last) ew_consume(p, cnt, 4, DEPTH, 2, true, 0, [](int) {}, smem);
      else ew_consume(p, cnt, 4, layer + 1, 0, false, 108, [&](int q) { conv_item_mix(p, layer + 1, q, smem); }, smem);
    } break;
  }
}

__global__ void __launch_bounds__(NTHR, 2) mega_kernel(Params p, int ph_begin, int ph_end) {
  extern __shared__ __attribute__((aligned(16))) char smem[];
  cg::grid_group grid = cg::this_grid();
  for (int ph = ph_begin; ph < ph_end; ++ph) {
    if (ph >= 2 && (ph - 2) % 6 == 1) continue;
    run_phase(p, ph, smem);
    if (ph + 1 < ph_end) {
      if (ph == 0) {
        grid.sync();
      } else {
        __syncthreads();
        if (threadIdx.x == 0) {
          int* bar = p.cnt + 5 * DEPTH * CNT_STRIDE + ph;
          __hip_atomic_fetch_add(bar, 1, __ATOMIC_RELEASE, __HIP_MEMORY_SCOPE_AGENT);
          while (__hip_atomic_load(bar, __ATOMIC_RELAXED, __HIP_MEMORY_SCOPE_AGENT) < (int)gridDim.x) __builtin_amdgcn_s_sleep(1);
      __builtin_amdgcn_fence(__ATOMIC_ACQUIRE, "agent");
        }
        __syncthreads();
      }
    }
  }
}

extern "C" void kernel_launch(void* const* d_in, const int* in_sizes, int n_in, void* d_out, int out_size, void* d_ws,
                              size_t ws_size, hipStream_t stream) {
  Params p{};
  const float* const* in = (const float* const*)d_in;
  p.x = in[0]; p.c = in[1]; p.ctx = in[2]; p.c_ctx = in[3]; p.w_ada = in[4]; p.b_ada = in[5];
  p.g_pre_mix = in[6]; p.g_post_mix = in[7]; p.g_pre_ff = in[8]; p.g_post_ff = in[9]; p.w_in = in[10];
  p.g_q = in[11]; p.w_uq = in[12]; p.g_kv = in[13]; p.w_ukv = in[14]; p.cm_norm_g = in[15]; p.cm_w_s = in[16];
  p.cm_b_s = in[17]; p.conv_w = in[18]; p.conv_b = in[19]; p.dt_bias = in[20]; p.a_log = in[21]; p.ssd_d = in[22];
  p.ssd_norm_g = in[23]; p.w_out = in[24]; p.w_ff1 = in[25]; p.w_ff2 = in[26];
  p.out = (float*)d_out;
  char* ws = (char*)d_ws;
  size_t off = 0;
  auto take = [&](size_t bytes) { char* q = ws + off; off += (bytes + 255) & ~(size_t)255; return q; };
  p.wt_in = (u16*)take((size_t)NINP * D * 2);
  p.wt_uq = (u16*)take((size_t)768 * 256 * 2);
  p.wt_ukv = (u16*)take((size_t)1024 * 128 * 2);
  p.wt_out = (u16*)take((size_t)D * D * 2);
  p.wt_ff1 = (u16*)take((size_t)DFF * D * 2);
  p.wt_ff2 = (u16*)take((size_t)D * DFF * 2);
  p.wsb = (u16*)take((size_t)4 * 128 * 128 * 2);
  p.mod = (float*)take((size_t)DEPTH * 9 * 6144 * 4);
  p.ropetab = (float*)take((size_t)64 * 16 * 2 * 4);
  p.atot = (float*)take((size_t)NB * NCH * 2 * 4 * 4);
  p.xctx = (float*)take((size_t)NB * CTX * D * 4);
  char* r1 = take((size_t)T * DFF * 2);
  p.Hd = (u16*)r1;
  p.Y = (u16*)r1;
  {
    size_t o2 = 0;
    p.P = (u16*)(r1 + o2); o2 += (size_t)T * NINP * 2;
    p.Q = (u16*)(r1 + o2); o2 += (size_t)T * 768 * 2;
    p.Kn = (u16*)(r1 + o2); o2 += (size_t)T * 512 * 2;
    p.Kr = (u16*)(r1 + o2); o2 += (size_t)T * 64 * 2;
    p.Vt = (u16*)(r1 + o2); o2 += (size_t)NB * 4 * 128 * SP * 2;
    p.dtraw = (float*)(r1 + o2); o2 += (size_t)T * 8 * 4;
  }
  p.H = (u16*)take((size_t)T * D * 2);
  p.CS = (float*)take((size_t)NB * NCH * 2 * 4 * 8192 * 4);
  p.F = (u16*)p.CS;
  p.ytmp = (float*)take((size_t)T * 256 * 4);
  p.cnt = (int*)take((size_t)(5 * DEPTH * CNT_STRIDE + 64) * 4);
  if (off > ws_size) {
    fprintf(stderr, "workspace too small: need %zu have %zu\n", off, ws_size);
    return;
  }
  static int grid_blocks = 0;
  if (!grid_blocks) {
    int dev = 0, cus = 0, per_cu = 0;
    hipGetDevice(&dev);
    hipDeviceGetAttribute(&cus, hipDeviceAttributeMultiprocessorCount, dev);
    hipFuncSetAttribute((const void*)mega_kernel, hipFuncAttributeMaxDynamicSharedMemorySize, SMEM_BYTES);
    hipOccupancyMaxActiveBlocksPerMultiprocessor(&per_cu, mega_kernel, NTHR, SMEM_BYTES);
    if (per_cu < 1) per_cu = 1;
    if (per_cu > 1) per_cu = 1;
    grid_blocks = cus * per_cu;
  }
  int pb = 0, pe = NPHASE;
  void* args[] = {&p, &pb, &pe};
  hipError_t e = hipLaunchCooperativeKernel((void*)mega_kernel, dim3(grid_blocks), dim3(NTHR), args, SMEM_BYTES, stream);
  if (e != hipSuccess) fprintf(stderr, "cooperative launch failed: %s (grid %d)\n", hipGetErrorString(e), grid_blocks);
}
```

```cpp
#include <hip/hip_runtime.h>
#include <hip/hip_cooperative_groups.h>
#include <cstdio>
namespace cg = cooperative_groups;

#define DI __device__ __forceinline__
typedef unsigned short u16;
using bf16x8 = __attribute__((ext_vector_type(8))) short;
using s16x4 = __attribute__((ext_vector_type(4))) short;
using f32x16 = __attribute__((ext_vector_type(16))) float;
using u32x4 = __attribute__((ext_vector_type(4))) unsigned;
using u32x2 = __attribute__((ext_vector_type(2))) unsigned;
using f32x4 = __attribute__((ext_vector_type(4))) float;
typedef __bf16 bf2_t __attribute__((ext_vector_type(2)));
typedef float f2_t __attribute__((ext_vector_type(2)));
#define MFMA(a, b, c) __builtin_amdgcn_mfma_f32_32x32x16_bf16((a), (b), (c), 0, 0, 0)

constexpr int NB = 8, SEQ = 4096, CTX = 256, SP = 4352, T = NB * SP, D = 1024, DFF = 4096;
constexpr int NIN = 1992, NINP = 2048, NCH = 34, DEPTH = 4;
constexpr int NTHR = 512;
constexpr int VT = 256;
constexpr int VSMEM = 75 * 1024;
constexpr int SMEM_BYTES = 2 * VSMEM;
constexpr float EPS = 1e-6f;
constexpr int CNT_STRIDE = 160;

struct Params {
  const float *x, *c, *ctx, *c_ctx, *w_ada, *b_ada, *g_pre_mix, *g_post_mix, *g_pre_ff, *g_post_ff, *w_in, *g_q, *w_uq,
      *g_kv, *w_ukv, *cm_norm_g, *cm_w_s, *cm_b_s, *conv_w, *conv_b, *dt_bias, *a_log, *ssd_d, *ssd_norm_g, *w_out,
      *w_ff1, *w_ff2;
  float* out;
  u16 *wt_in, *wt_uq, *wt_ukv, *wt_out, *wt_ff1, *wt_ff2, *wsb;
  float *mod, *ropetab, *atot, *xctx;
  u16 *P, *Q, *Kn, *Kr, *Vt, *Hd;
  u16* Y;
  float* dtraw;
  u16* H;
  float* CS;
  u16* F;
  float* ytmp;
  int* cnt;
};

DI int ltid() { int t = threadIdx.x; asm volatile("" : "+v"(t)); return t; }
DI int lbid() { int t = blockIdx.x; asm volatile("" : "+s"(t)); return t; }
DI void st_wt(void* ptr, u32x4 v) { asm volatile("global_store_dwordx4 %0, %1, off sc0 sc1" ::"v"(ptr), "v"(v) : "memory"); }
DI void st_wt16f(float* ptr, f32x4 v) { asm volatile("global_store_dwordx4 %0, %1, off sc0 sc1" ::"v"(ptr), "v"(v) : "memory"); }
DI int crow(int e, int h) { return (e & 3) + 8 * (e >> 2) + 4 * h; }
DI unsigned pack2(float a, float b) {
  f2_t v = {a, b};
  bf2_t r = __builtin_convertvector(v, bf2_t);
  return __builtin_bit_cast(unsigned, r);
}
DI u16 f2bf(float a) { return (u16)(pack2(a, 0.f) & 0xffffu); }
DI float bf2f(u16 v) { return __uint_as_float(((unsigned)v) << 16); }
DI float bflo(unsigned w) { return __uint_as_float(w << 16); }
DI float bfhi(unsigned w) { return __uint_as_float(w & 0xffff0000u); }
DI bf16x8 pack8(float a0, float a1, float a2, float a3, float a4, float a5, float a6, float a7) {
  u32x4 u;
  u.x = pack2(a0, a1); u.y = pack2(a2, a3); u.z = pack2(a4, a5); u.w = pack2(a6, a7);
  return __builtin_bit_cast(bf16x8, u);
}
DI float wave_sum(float v) {
#pragma unroll
  for (int o = 32; o > 0; o >>= 1) v += __shfl_xor(v, o);
  return v;
}
DI float silu_f(float y) { return y * __builtin_amdgcn_rcpf(1.f + __expf(-y)); }
DI float gelu_f(float x) {
  float u = 0.7978845608028654f * (x + 0.044715f * x * x * x);
  float t = 1.f - 2.f * __builtin_amdgcn_rcpf(1.f + __expf(2.f * u));
  return 0.5f * x * (1.f + t);
}
DI float softplus_f(float x) { return x > 20.f ? x : log1pf(__expf(x)); }
DI float uw(const u32x4& v, int i) {
  unsigned w = (i >> 1) == 0 ? v.x : (i >> 1) == 1 ? v.y : (i >> 1) == 2 ? v.z : v.w;
  return (i & 1) ? bfhi(w) : bflo(w);
}

template <bool HAS_T, class ElemF, class StoreF, class StoreTF, class UseTF>
DI void gemm_tile(const u16* __restrict__ A, int lda, const u16* __restrict__ Bt, int ldb, int K, int m0, int n0,
                  char* smem, ElemF elem, StoreF store, StoreTF storeT, UseTF useT) {
  constexpr int LS = 72;
  constexpr int STAGE = 2 * 256 * LS;
  u16* base = (u16*)smem;
  const int tid = ltid(), lane = tid & 63, wid = tid >> 6, wm = wid >> 2, wn = wid & 3, r = lane & 31, h = lane >> 5;
  f32x16 acc[4][2];
#pragma unroll
  for (int i = 0; i < 4; ++i)
#pragma unroll
    for (int j = 0; j < 2; ++j)
#pragma unroll
      for (int e = 0; e < 16; ++e) acc[i][j][e] = 0.f;
  u32x4 ra[4], rb[4];
  const int lrow = tid >> 3, lcp = (tid & 7) * 8;
  const u16* ga = A + (size_t)(m0 + lrow) * lda + lcp;
  const u16* gb = Bt + (size_t)(n0 + lrow) * ldb + lcp;
  const int wofs = lrow * LS + lcp;
  const int aofs = (wm * 128 + r) * LS + h * 8;
  const int bofs = 256 * LS + (wn * 64 + r) * LS + h * 8;
#define GLOAD(kt_)                                                           \
  _Pragma("unroll") for (int i = 0; i < 4; ++i) {                            \
    ra[i] = *(const u32x4*)(ga + (size_t)(64 * i) * lda + (kt_) * 64);       \
    rb[i] = *(const u32x4*)(gb + (size_t)(64 * i) * ldb + (kt_) * 64);       \
  }
#define SWRITE(st_)                                                          \
  _Pragma("unroll") for (int i = 0; i < 4; ++i) {                            \
    *(u32x4*)((st_) + wofs + 64 * i * LS) = ra[i];                           \
    *(u32x4*)((st_) + 256 * LS + wofs + 64 * i * LS) = rb[i];                \
  }
#define FREAD(dst_, st_, kk_)                                                                      \
  _Pragma("unroll") for (int i = 0; i < 4; ++i) af[dst_][i] = *(const bf16x8*)((st_) + aofs + i * 32 * LS + (kk_) * 16); \
  _Pragma("unroll") for (int j = 0; j < 2; ++j) bfr[dst_][j] = *(const bf16x8*)((st_) + bofs + j * 32 * LS + (kk_) * 16);
#define MMAS(src_)                                                           \
  _Pragma("unroll") for (int i = 0; i < 4; ++i)                              \
  _Pragma("unroll") for (int j = 0; j < 2; ++j) acc[i][j] = MFMA(bfr[src_][j], af[src_][i], acc[i][j]);
#define ILV()                                                                   \
  __builtin_amdgcn_sched_group_barrier(0x008, 2, 0);                            \
  __builtin_amdgcn_sched_group_barrier(0x100, 2, 0);                            \
  __builtin_amdgcn_sched_group_barrier(0x008, 2, 0);                            \
  __builtin_amdgcn_sched_group_barrier(0x100, 2, 0);                            \
  __builtin_amdgcn_sched_group_barrier(0x008, 2, 0);                            \
  __builtin_amdgcn_sched_group_barrier(0x100, 2, 0);                            \
  __builtin_amdgcn_sched_group_barrier(0x008, 2, 0);
  const int nk = K >> 6;
  bf16x8 af[2][4], bfr[2][2];
  GLOAD(0);
  __syncthreads();
  SWRITE(base);
  if (nk > 1) { GLOAD(1); }
  __syncthreads();
  FREAD(0, base, 0);
  for (int kt = 0; kt < nk; ++kt) {
    u16* cur = base + (kt & 1) * STAGE;
    u16* nxt = base + ((kt + 1) & 1) * STAGE;
    FREAD(1, cur, 1);
    if (kt + 1 < nk) { SWRITE(nxt); }
    MMAS(0);
#pragma unroll
    for (int z = 0; z < 7; ++z) {
      __builtin_amdgcn_sched_group_barrier(0x008, 1, 0);
      __builtin_amdgcn_sched_group_barrier(0x080, 2, 0);
    }
    __builtin_amdgcn_sched_group_barrier(0x008, 1, 0);
    __builtin_amdgcn_sched_barrier(0);
    if (kt + 2 < nk) { GLOAD(kt + 2); }
    FREAD(0, cur, 2);
    MMAS(1);
    ILV();
    __builtin_amdgcn_sched_barrier(0);
    FREAD(1, cur, 3);
    MMAS(0);
    ILV();
    __builtin_amdgcn_sched_barrier(0);
    __syncthreads();
    if (kt + 1 < nk) { FREAD(0, nxt, 0); }
    MMAS(1);
    ILV();
    __builtin_amdgcn_sched_barrier(0);
  }
#undef ILV
#undef GLOAD
#undef SWRITE
#undef FREAD
#undef MMAS
#pragma unroll
  for (int i = 0; i < 4; ++i)
#pragma unroll
    for (int j = 0; j < 2; ++j) elem(m0 + wm * 128 + i * 32, n0 + wn * 64 + j * 32, acc[i][j], r, h);
  u16* stg = base + wid * (128 * 72);
  if (HAS_T && useT(wn)) {
#pragma unroll
    for (int i = 0; i < 4; ++i)
#pragma unroll
      for (int j = 0; j < 2; ++j)
#pragma unroll
        for (int e = 0; e < 16; ++e) stg[(j * 32 + crow(e, h)) * 136 + i * 32 + r] = f2bf(acc[i][j][e]);
    __builtin_amdgcn_wave_barrier();
#pragma unroll 4
    for (int t = 0; t < 16; ++t) {
      const int id = lane + 64 * t, cl = id >> 4, cp = id & 15;
      u32x4 v = *(const u32x4*)(stg + cl * 136 + cp * 8);
      storeT(n0 + wn * 64 + cl, m0 + wm * 128 + cp * 8, v);
    }
  } else {
#pragma unroll
    for (int i = 0; i < 4; ++i)
#pragma unroll
      for (int j = 0; j < 2; ++j)
#pragma unroll
        for (int q4 = 0; q4 < 4; ++q4) {
          u32x2 w;
          w.x = pack2(acc[i][j][4 * q4], acc[i][j][4 * q4 + 1]);
          w.y = pack2(acc[i][j][4 * q4 + 2], acc[i][j][4 * q4 + 3]);
          *(u32x2*)(stg + (i * 32 + r) * 72 + j * 32 + 8 * q4 + 4 * h) = w;
        }
    __builtin_amdgcn_wave_barrier();
#pragma unroll 4
    for (int t = 0; t < 16; ++t) {
      const int id = lane + 64 * t, rl = id >> 3, cp = id & 7;
      u32x4 v = *(const u32x4*)(stg + rl * 72 + cp * 8);
      store(m0 + wm * 128 + rl, n0 + wn * 64 + cp * 8, v);
    }
  }
}

DI int xcd_tile(int it, int ntiles, int skip_tail = 0) {
  const int b = lbid(), g = gridDim.x;
  const int local = (b >> 3) + it * (g >> 3);
  const int per = ntiles >> 3;
  return local < per - skip_tail ? (b & 7) * per + local : -1;
}

DI void conv_tile(const float* __restrict__ src, int K, int N, u16* __restrict__ dst, const float* __restrict__ scale,
                  int tk, int tn, char* smem) {
  float* tile = (float*)smem;
  const int tid = ltid(), tx = tid & 63, ty = tid >> 6;
  const int k0 = tk * 64, n0 = tn * 64;
  __syncthreads();
#pragma unroll
  for (int i = 0; i < 8; ++i) {
    int kr = ty + 8 * i;
    float v = 0.f;
    if (n0 + tx < N) v = src[(size_t)(k0 + kr) * N + n0 + tx];
    if (scale) v *= scale[k0 + kr];
    tile[kr * 65 + tx] = v;
  }
  __syncthreads();
#pragma unroll
  for (int i = 0; i < 8; ++i) {
    int nr = ty + 8 * i;
    dst[(size_t)(n0 + nr) * K + k0 + tx] = f2bf(tile[tx * 65 + nr]);
  }
}

DI void convert_weights(const float* src, int K, int N, int Npad, u16* dst, const float* scale, char* smem) {
  const int tks = K / 64, tns = Npad / 64;
  for (int t = lbid(); t < tks * tns; t += gridDim.x) conv_tile(src, K, N, dst, scale, t / tns, t % tns, smem);
}

DI void prologue_phase(const Params& p, char* smem) {
  float* sc = (float*)smem;
  float* red = sc + 9 * 1024;
  const int tid = ltid();
  for (int i = tid; i < 9 * 1024; i += NTHR) {
    int j = i >> 10, k = i & 1023;
    float v = j < 8 ? p.c[j * 1024 + k] : p.c_ctx[k];
    sc[i] = v / (1.f + __expf(-v));
  }
  __syncthreads();
  for (int task = lbid(); task < DEPTH * 96; task += gridDim.x) {
    const int l = task / 96, n0 = (task % 96) * 64, nn = tid & 63, kq = tid >> 6;
    float acc[9];
#pragma unroll
    for (int j = 0; j < 9; ++j) acc[j] = 0.f;
    const float* w = p.w_ada + ((size_t)l * 1024 + kq * 128) * 6144 + n0 + nn;
    const float* scq = sc + kq * 128;
#pragma unroll 4
    for (int k = 0; k < 128; ++k) {
      float wv = w[(size_t)k * 6144];
#pragma unroll
      for (int j = 0; j < 9; ++j) acc[j] += scq[j * 1024 + k] * wv;
    }
#pragma unroll
    for (int j = 0; j < 9; ++j) red[(kq * 9 + j) * 64 + nn] = acc[j];
    __syncthreads();
    for (int idx = tid; idx < 576; idx += NTHR) {
      int j = idx >> 6, n2 = idx & 63;
      float s = p.b_ada[l * 6144 + n0 + n2];
#pragma unroll
      for (int q = 0; q < 8; ++q) s += red[(q * 9 + j) * 64 + n2];
      p.mod[(size_t)(l * 9 + j) * 6144 + n0 + n2] = s;
    }
    __syncthreads();
  }
  for (int i = lbid() * NTHR + tid; i < 5 * DEPTH * CNT_STRIDE + 64; i += gridDim.x * NTHR) p.cnt[i] = 0;
  if (lbid() == gridDim.x - 1) {
    for (int i = tid; i < 64 * 16; i += NTHR) {
      int pos = i >> 4, j = i & 15;
      float inv_freq = exp2f(-(float)(2 * j) / 32.f * 13.287712379549449f);
      float ang = (float)pos * inv_freq;
      float k = rintf(ang * 0.15915494309189535f);
      float red2 = fmaf(-k, 6.2831854820251465f, ang);
      red2 = fmaf(-k, -1.7484555314695172e-07f, red2);
      p.ropetab[2 * i] = __cosf(red2);
      p.ropetab[2 * i + 1] = __sinf(red2);
    }
  }
}

DI void ew_row(const Params& p, int layer, int kind, int row, int lane) {
  const bool has_branch = !(kind == 0 && layer == 0);
  const bool src_in = (layer == 0 && kind <= 1);
  const bool store_x = has_branch;
  const int blayer = (kind == 1) ? layer : (kind == 0 ? layer - 1 : DEPTH - 1);
  const float* gpost = (kind == 1) ? p.g_post_mix + blayer * D : p.g_post_ff + (blayer < 0 ? 0 : blayer) * D;
  const int gate_off = (kind == 1) ? 2 * D : 5 * D;
  const float* gpre = (kind == 0) ? p.g_pre_mix + layer * D : p.g_pre_ff + (kind == 1 ? layer : 0) * D;
  const int shift_off = (kind == 0) ? 0 : 3 * D, scale_off = (kind == 0) ? D : 4 * D;
  const float* xl = src_in ? p.x : p.out;
  const float* xc = src_in ? p.ctx : p.xctx;
    const int b = row / SP, s = row - b * SP;
    const bool lat = s < SEQ;
    if ((kind == 2 || (kind == 1 && layer == DEPTH - 1)) && !lat) return;
    const size_t xoff = lat ? ((size_t)(b * SEQ + s) * D) : ((size_t)(b * CTX + s - SEQ) * D);
    const unsigned long long msk = lat ? ~0ull : 0ull;
    const float* xs = (const float*)(((unsigned long long)xl & msk) | ((unsigned long long)xc & ~msk)) + xoff;
    float* xd = (float*)(((unsigned long long)p.out & msk) | ((unsigned long long)p.xctx & ~msk)) + xoff;
    const int mi = lat ? b : 8;
    f32x4 xv[4];
#pragma unroll
    for (int i = 0; i < 4; ++i) xv[i] = *(const f32x4*)(xs + lane * 4 + 256 * i);
    if (has_branch) {
      const float* modb = p.mod + (size_t)(blayer * 9 + mi) * 6144 + gate_off;
      f32x4 yv[4];
      const u16* ysrc = (kind == 1) ? p.Y : p.F;
      {
        u32x2 w0, w1, w2, w3;
        const u16* yp = ysrc + (size_t)row * D + lane * 4;
        asm volatile("global_load_dwordx2 %0, %1, off sc0 sc1" : "=v"(w0) : "v"(yp) : "memory");
        asm volatile("global_load_dwordx2 %0, %1, off offset:512 sc0 sc1" : "=v"(w1) : "v"(yp) : "memory");
        asm volatile("global_load_dwordx2 %0, %1, off offset:1024 sc0 sc1" : "=v"(w2) : "v"(yp) : "memory");
        asm volatile("global_load_dwordx2 %0, %1, off offset:1536 sc0 sc1" : "=v"(w3) : "v"(yp) : "memory");
        asm volatile("s_waitcnt vmcnt(0)" : "+v"(w0), "+v"(w1), "+v"(w2), "+v"(w3)::"memory");
        yv[0] = f32x4{bflo(w0.x), bfhi(w0.x), bflo(w0.y), bfhi(w0.y)};
        yv[1] = f32x4{bflo(w1.x), bfhi(w1.x), bflo(w1.y), bfhi(w1.y)};
        yv[2] = f32x4{bflo(w2.x), bfhi(w2.x), bflo(w2.y), bfhi(w2.y)};
        yv[3] = f32x4{bflo(w3.x), bfhi(w3.x), bflo(w3.y), bfhi(w3.y)};
      }
      float ss = 0.f;
#pragma unroll
      for (int i = 0; i < 4; ++i) ss += yv[i].x * yv[i].x + yv[i].y * yv[i].y + yv[i].z * yv[i].z + yv[i].w * yv[i].w;
      ss = wave_sum(ss);
      const float rstd = rsqrtf(ss * (1.f / D) + EPS);
#pragma unroll
      for (int i = 0; i < 4; ++i) {
        const int col = lane * 4 + 256 * i;
        f32x4 g = *(const f32x4*)(gpost + col);
        f32x4 gt = *(const f32x4*)(modb + col);
        xv[i].x += gt.x * (yv[i].x * rstd * g.x);
        xv[i].y += gt.y * (yv[i].y * rstd * g.y);
        xv[i].z += gt.z * (yv[i].z * rstd * g.z);
        xv[i].w += gt.w * (yv[i].w * rstd * g.w);
      }
      if (store_x) {
#pragma unroll
        for (int i = 0; i < 4; ++i) *(f32x4*)(xd + lane * 4 + 256 * i) = xv[i];
      }
    }
    if (kind != 2) {
      const float* modl = p.mod + (size_t)(layer * 9 + mi) * 6144;
      float ss = 0.f;
#pragma unroll
      for (int i = 0; i < 4; ++i) ss += xv[i].x * xv[i].x + xv[i].y * xv[i].y + xv[i].z * xv[i].z + xv[i].w * xv[i].w;
      ss = wave_sum(ss);
      const float rstd = rsqrtf(ss * (1.f / D) + EPS);
#pragma unroll
      for (int i = 0; i < 4; ++i) {
        const int col = lane * 4 + 256 * i;
        f32x4 g = *(const f32x4*)(gpre + col);
        f32x4 sh = *(const f32x4*)(modl + shift_off + col);
        f32x4 sc = *(const f32x4*)(modl + scale_off + col);
        float h0 = xv[i].x * rstd * g.x * (1.f + sc.x) + sh.x;
        float h1 = xv[i].y * rstd * g.y * (1.f + sc.y) + sh.y;
        float h2 = xv[i].z * rstd * g.z * (1.f + sc.z) + sh.z;
        float h3 = xv[i].w * rstd * g.w * (1.f + sc.w) + sh.w;
        u32x2 w;
        w.x = pack2(h0, h1);
        w.y = pack2(h2, h3);
        *(u32x2*)(p.H + (size_t)row * D + col) = w;
      }
    }
}

DI void ew_phase(const Params& p, int layer, int kind) {
  const int tid = ltid(), lane = tid & 63, wid = __builtin_amdgcn_readfirstlane(tid >> 6);
  for (int rg = lbid(); rg < T / 8; rg += gridDim.x) ew_row(p, layer, kind, rg * 8 + wid, lane);
}

DI void tile_done(int* cnt, int tm) {
  asm volatile("s_waitcnt vmcnt(0)" ::: "memory");
  __syncthreads();
  if (ltid() == 0) __hip_atomic_fetch_add(cnt + tm, 1, __ATOMIC_RELAXED, __HIP_MEMORY_SCOPE_AGENT);
}
template <class ConvF>
DI void ew_consume(const Params& p, int* cnt, int need, int layer, int kind, bool skip_ctx, int nconv, ConvF conv,
                   char* smem) {
  int* sh = (int*)(smem + SMEM_BYTES - 16);
  const int tid = ltid(), lane = tid & 63, wid = __builtin_amdgcn_readfirstlane(tid >> 6);
  for (;;) {
    __syncthreads();
    if (tid == 0) *sh = __hip_atomic_fetch_add(cnt + 136, 1, __ATOMIC_RELAXED, __HIP_MEMORY_SCOPE_AGENT);
    __syncthreads();
    const int q = *sh;
    if (q >= nconv + 544) break;
    if (q < nconv) { conv(q); continue; }
    const int c = q - nconv, mseq = c >> 2, j = mseq >> 3, bb = mseq & 7, tm = bb * 17 + j;
    if (skip_ctx && j == 16) continue;
    if (tid == 0) {
      while (__hip_atomic_load(cnt + tm, __ATOMIC_RELAXED, __HIP_MEMORY_SCOPE_AGENT) < need) __builtin_amdgcn_s_sleep(4);
    }
    __syncthreads();
    const int row0 = tm * 256 + (c & 3) * 64 + wid * 8;
#pragma unroll 1
    for (int i = 0; i < 8; ++i) ew_row(p, layer, kind, row0 + i, lane);
  }
}

DI void row_rstd(const u16* __restrict__ base, int ld, int ncols, int m0, float* rs) {
  const int tid = ltid(), row = tid >> 1, half = tid & 1;
  const int per = ncols / 2;
  const u16* ptr = base + (size_t)(m0 + row) * ld + half * per;
  float ss = 0.f;
  for (int i = 0; i < per; i += 8) {
    u32x4 v = *(const u32x4*)(ptr + i);
#pragma unroll
    for (int e = 0; e < 8; ++e) {
      float f = uw(v, e);
      ss += f * f;
    }
  }
  ss += __shfl_xor(ss, 1);
  if (half == 0) rs[row] = rsqrtf(ss / (float)ncols + EPS);
}

DI void qkv_tasks(const Params& p, char* smem, int qb, int qe, int kb_, int ke, int stp) {
  float* rs = (float*)(smem + 2 * 2 * 256 * 72 * 2);
  const int MT = T / 256;
  auto noT = [](int, int, u32x4) {};
  auto neverT = [](int) { return false; };
  for (int t = qb; t < qe; t += stp) {
    const int tm = t / 3, tn = t % 3, m0 = tm * 256;
    __syncthreads();
    row_rstd(p.P, NINP, 256, m0, rs);
    const bool lat = (m0 % SP) < SEQ;
    const int s0 = m0 % SP;
    gemm_tile<false>(
        p.P, NINP, p.wt_uq, 256, 256, m0, tn * 256, smem,
        [&](int mb, int nb, f32x16& acc, int r, int h) {
          const int rowl = mb - m0 + r;
          const float sc = rs[rowl];
#pragma unroll
          for (int e = 0; e < 16; ++e) acc[e] *= sc;
          const int cb = nb % 192;
          if (lat && cb >= 128) {
            const int s = s0 + rowl;
            const int pos = (cb == 128) ? (s >> 6) : (s & 63);
#pragma unroll
            for (int e = 0; e < 8; ++e) {
              const int j = crow(e, h);
              const float cs = p.ropetab[2 * (pos * 16 + j)], sn = p.ropetab[2 * (pos * 16 + j) + 1];
              const float x1 = acc[e], x2 = acc[e + 8];
              acc[e] = x1 * cs - x2 * sn;
              acc[e + 8] = x1 * sn + x2 * cs;
            }
          }
        },
        [&](int row, int col, u32x4 v) { *(u32x4*)(p.Q + (size_t)row * 768 + col) = v; }, noT, neverT);
  }
  for (int t = kb_; t < ke; t += stp) {
    const int tm = t / 4, tn = t % 4, m0 = tm * 256;
    const int b = m0 / SP, s0 = m0 % SP;
    const bool lat = s0 < SEQ;
    __syncthreads();
    row_rstd(p.P + 256, NINP, 128, m0, rs);
    if (tn == 0) {
      for (int idx = ltid(); idx < 256 * 32; idx += NTHR) {
        const int rowl = idx >> 5, q = idx & 31, blk = q >> 4, j = q & 15;
        const u16* src = p.P + (size_t)(m0 + rowl) * NINP + 384 + blk * 32 + j;
        float x1 = bf2f(src[0]), x2 = bf2f(src[16]);
        float o1 = x1, o2 = x2;
        if (lat) {
          const int s = s0 + rowl;
          const int pos = blk == 0 ? (s >> 6) : (s & 63);
          const float cs = p.ropetab[2 * (pos * 16 + j)], sn = p.ropetab[2 * (pos * 16 + j) + 1];
          o1 = x1 * cs - x2 * sn;
          o2 = x1 * sn + x2 * cs;
        }
        u16* dst = p.Kr + (size_t)(m0 + rowl) * 64 + blk * 32 + j;
        dst[0] = f2bf(o1);
        dst[16] = f2bf(o2);
      }
    }
    const int n0 = tn * 256;
    u16* vbase = p.Vt + (size_t)(b * 4 + tn) * 128 * SP + s0;
    gemm_tile<true>(
        p.P + 256, NINP, p.wt_ukv, 128, 128, m0, n0, smem,
        [&](int mb, int nb, f32x16& acc, int r, int h) {
          const float sc = rs[mb - m0 + r];
#pragma unroll
          for (int e = 0; e < 16; ++e) acc[e] *= sc;
        },
        [&](int row, int col, u32x4 v) { *(u32x4*)(p.Kn + (size_t)row * 512 + tn * 128 + (col - n0)) = v; },
        [&](int col, int row, u32x4 v) { *(u32x4*)(vbase + (size_t)(col - n0 - 128) * SP + (row - m0)) = v; },
        [](int wn) { return wn >= 2; });
  }
}

DI void cm_tasks(const Params& p, int layer, char* smem, int tb, int te, int stp) {
  const int ftid = ltid(), vb = ftid >> 8, tid = ftid & 255;
  u16* vnT = (u16*)(smem + vb * VSMEM);
  const int lane = tid & 63, wid = tid >> 6, r = lane & 31, h = lane >> 5;
  const float* gn = p.cm_norm_g + layer * 256;
  const float* bs = p.cm_b_s + layer * 512;
  for (int t0 = tb; t0 < te; t0 += stp) {
    const int task = t0 + vb;
    const int row0 = task * 128;
    __syncthreads();
#pragma unroll 4
    for (int i = 0; i < 32; ++i) {
      const int s = wid * 32 + i;
      const u16* src = p.P + (size_t)(row0 + s) * NINP + 704;
      float v[4];
      float sum = 0.f;
#pragma unroll
      for (int q = 0; q < 4; ++q) {
        v[q] = gelu_f(bf2f(src[lane + 64 * q]));
        sum += v[q];
      }
      const float mean = wave_sum(sum) * (1.f / 256.f);
      float var = 0.f;
#pragma unroll
      for (int q = 0; q < 4; ++q) {
        v[q] -= mean;
        var += v[q] * v[q];
      }
      const float rstd = rsqrtf(wave_sum(var) * (1.f / 256.f) + EPS);
#pragma unroll
      for (int q = 0; q < 4; ++q) vnT[(lane + 64 * q) * 136 + s] = f2bf(v[q] * rstd * gn[lane + 64 * q]);
    }
    __syncthreads();
    const int t = wid * 32 + r;
    for (int g = 0; g < 4; ++g) {
      bf16x8 wf[8];
#pragma unroll
      for (int kk = 0; kk < 8; ++kk) wf[kk] = *(const bf16x8*)(p.wsb + ((size_t)(g * 128 + t)) * 128 + kk * 16 + h * 8);
      const float bias = bs[g * 128 + t];
#pragma unroll
      for (int cb = 0; cb < 2; ++cb) {
        f32x16 acc;
#pragma unroll
        for (int e = 0; e < 16; ++e) acc[e] = 0.f;
#pragma unroll
        for (int kk = 0; kk < 8; ++kk) {
          bf16x8 a = *(const bf16x8*)(vnT + (g * 64 + cb * 32 + r) * 136 + kk * 16 + h * 8);
          acc = MFMA(a, wf[kk], acc);
        }
#pragma unroll
        for (int q4 = 0; q4 < 4; ++q4) {
          const int ch0 = g * 64 + cb * 32 + 8 * q4 + 4 * h;
          u32x2 uwd = *(const u32x2*)(p.P + (size_t)(row0 + t) * NINP + 448 + ch0);
          float u0 = gelu_f(bflo(uwd.x)), u1 = gelu_f(bfhi(uwd.x)), u2 = gelu_f(bflo(uwd.y)), u3 = gelu_f(bfhi(uwd.y));
          u32x2 w;
          w.x = pack2(u0 * (acc[4 * q4] + bias), u1 * (acc[4 * q4 + 1] + bias));
          w.y = pack2(u2 * (acc[4 * q4 + 2] + bias), u3 * (acc[4 * q4 + 3] + bias));
          *(u32x2*)(p.H + (size_t)(row0 + t) * D + 512 + ch0) = w;
        }
      }
    }
  }
}

struct ConvW { f32x4 w0a, w0b, w1a, w1b, w2a, w2b, ba, bb; };
DI ConvW load_convw(const Params& p, int layer, int ch) {
  const float* cw = p.conv_w + (size_t)layer * 3 * 768 + ch;
  const float* cb = p.conv_b + layer * 768 + ch;
  ConvW c;
  c.w0a = *(const f32x4*)(cw); c.w0b = *(const f32x4*)(cw + 4);
  c.w1a = *(const f32x4*)(cw + 768); c.w1b = *(const f32x4*)(cw + 772);
  c.w2a = *(const f32x4*)(cw + 1536); c.w2b = *(const f32x4*)(cw + 1540);
  c.ba = *(const f32x4*)(cb); c.bb = *(const f32x4*)(cb + 4);
  return c;
}
DI float convw_get(const f32x4& a, const f32x4& b, int e) { return e < 4 ? a[e & 3] : b[e & 3]; }
DI void conv8(const Params& p, const ConvW& c, int row, int ch, bool hasPrev, bool hasNext, float out[8]) {
  const u16* base = p.P + (size_t)row * NINP + 1216 + ch;
  u32x4 cur = *(const u32x4*)base;
  u32x4 prv = *(const u32x4*)(base - (hasPrev ? NINP : 0));
  u32x4 nxt = *(const u32x4*)(base + (hasNext ? NINP : 0));
  const float mp = hasPrev ? 1.f : 0.f, mn = hasNext ? 1.f : 0.f;
#pragma unroll
  for (int e = 0; e < 8; ++e) {
    float y = convw_get(c.w0a, c.w0b, e) * (mp * uw(prv, e)) + convw_get(c.w1a, c.w1b, e) * uw(cur, e) +
              convw_get(c.w2a, c.w2b, e) * (mn * uw(nxt, e)) + convw_get(c.ba, c.bb, e);
    out[e] = silu_f(y);
  }
}

template <int RPT, class F>
DI void conv_stage(const Params& p, int layer, int row0, int chbase, int cp, int tb, bool cPrev, bool cNext, F emit) {
  const ConvW c = load_convw(p, layer, chbase + cp * 8);
  const int r0 = tb * RPT;
  const bool hp = cPrev || r0 > 0, hn = cNext || (r0 + RPT) < 128;
  const u16* base = p.P + (size_t)(row0 + r0) * NINP + 1216 + chbase + cp * 8;
  u32x4 raw[RPT + 2];
  raw[0] = *(const u32x4*)(base - (hp ? NINP : 0));
#pragma unroll
  for (int k = 0; k < RPT; ++k) raw[k + 1] = *(const u32x4*)(base + (size_t)k * NINP);
  raw[RPT + 1] = *(const u32x4*)(base + (size_t)(hn ? RPT : RPT - 1) * NINP);
  const float mp = hp ? 1.f : 0.f, mn = hn ? 1.f : 0.f;
#pragma unroll
  for (int i = 0; i < RPT; ++i) {
    const float fp = (i == 0) ? mp : 1.f, fn = (i == RPT - 1) ? mn : 1.f;
    float v[8];
#pragma unroll
    for (int e = 0; e < 8; ++e) {
      float y = convw_get(c.w0a, c.w0b, e) * (fp * uw(raw[i], e)) + convw_get(c.w1a, c.w1b, e) * uw(raw[i + 1], e) +
                convw_get(c.w2a, c.w2b, e) * (fn * uw(raw[i + 2], e)) + convw_get(c.ba, c.bb, e);
      v[e] = silu_f(y);
    }
    emit(r0 + i, v);
  }
}

DI void ssd_dt_arrays(const Params& p, int layer, int row0, int hh, int t, float* arr) {
  float* dt0 = arr;
  float* dt1 = arr + 128;
  float* c0 = arr + 256;
  float* s1 = arr + 384;
  float* a0 = arr + 512;
  float* a1 = arr + 640;
  const float d0 = softplus_f(p.dtraw[(size_t)(row0 + t) * 8 + hh] + p.dt_bias[layer * 8 + hh]);
  const float d1 = softplus_f(p.dtraw[(size_t)(row0 + t) * 8 + 4 + hh] + p.dt_bias[layer * 8 + 4 + hh]);
  dt0[t] = d0;
  dt1[t] = d1;
  a0[t] = -d0 * __expf(p.a_log[layer * 8 + hh]);
  a1[t] = -d1 * __expf(p.a_log[layer * 8 + 4 + hh]);
}
DI float wave_incl_prefix(float x, int lane) {
#pragma unroll
  for (int o = 1; o < 64; o <<= 1) {
    float y = __shfl_up(x, o);
    if (lane >= o) x += y;
  }
  return x;
}
DI void ssd_cum_arrays(int t, float* arr) {
  float* c0 = arr + 256;
  float* s1 = arr + 384;
  const float* a0 = arr + 512;
  const float* a1 = arr + 640;
  const int lane = t & 63, w = t >> 6;
  const float x0 = a0[t], o0 = a0[t ^ 64], x1 = a1[t], o1 = a1[t ^ 64];
  const float tot_o0 = wave_sum(o0), tot_o1 = wave_sum(o1), tot_x1 = wave_sum(x1);
  float p0 = wave_incl_prefix(x0, lane);
  float p1 = wave_incl_prefix(x1, lane);
  if (w == 1) p0 += tot_o0;
  float sf = tot_x1 - p1 + x1;
  if (w == 0) sf += tot_o1;
  c0[t] = p0;
  s1[t] = sf;
}

DI void ssd_s1_tasks(const Params& p, int layer, char* smem, int tb, int te, int stp) {
  const int ftid = ltid(), vb = ftid >> 8, tid = ftid & 255;
  u16* xsT0 = (u16*)(smem + vb * VSMEM);
  u16* xsT1 = xsT0 + 64 * 136;
  u16* BT = xsT1 + 64 * 136;
  float* arr = (float*)(BT + 128 * 136);
  float* w0 = arr + 768;
  float* w1 = w0 + 128;
  const int lane = tid & 63, wid = tid >> 6, r = lane & 31, h = lane >> 5;
  for (int t0 = tb; t0 < te; t0 += stp) {
    const int task = t0 + vb;
    const int hh = task & 3, bc = task >> 2, c = bc % NCH, b = bc / NCH;
    const int g = hh >> 1;
    const int row0 = bc * 128;
    const bool cPrev = (c != 0 && c != 32), cNext = (c != 31 && c != 33);
    __syncthreads();
    if (tid < 128) ssd_dt_arrays(p, layer, row0, hh, tid, arr);
    __syncthreads();
    if (tid < 128) ssd_cum_arrays(tid, arr);
    __syncthreads();
    if (tid < 128) {
      const float* dt0 = arr;
      const float* dt1 = arr + 128;
      const float* c0 = arr + 256;
      const float* s1 = arr + 384;
      w0[tid] = __expf(c0[127] - c0[tid]) * dt0[tid];
      w1[tid] = __expf(s1[0] - s1[tid]) * dt1[tid];
      if (tid == 0) {
        p.atot[((size_t)bc * 2 + 0) * 4 + hh] = c0[127];
        p.atot[((size_t)bc * 2 + 1) * 4 + hh] = s1[0];
      }
    }
    __syncthreads();
    conv_stage<4>(p, layer, row0, hh * 64, tid & 7, tid >> 3, cPrev, cNext, [&](int t, const float (&v)[8]) {
      const float f0 = w0[t], f1 = w1[t];
      const int cp = tid & 7;
#pragma unroll
      for (int e = 0; e < 8; ++e) {
        xsT0[(cp * 8 + e) * 136 + t] = f2bf(v[e] * f0);
        xsT1[(cp * 8 + e) * 136 + t] = f2bf(v[e] * f1);
      }
    });
    conv_stage<8>(p, layer, row0, 256 + g * 128, tid & 15, tid >> 4, cPrev, cNext, [&](int t, const float (&v)[8]) {
      const int cp = tid & 15;
#pragma unroll
      for (int e = 0; e < 8; ++e) BT[(cp * 8 + e) * 136 + t] = f2bf(v[e]);
    });
    __syncthreads();
#pragma unroll
    for (int d = 0; d < 2; ++d) {
      const u16* xsT = d ? xsT1 : xsT0;
#pragma unroll
      for (int pb = 0; pb < 2; ++pb) {
        f32x16 acc;
#pragma unroll
        for (int e = 0; e < 16; ++e) acc[e] = 0.f;
#pragma unroll
        for (int kk = 0; kk < 8; ++kk) {
          bf16x8 a = *(const bf16x8*)(xsT + (pb * 32 + r) * 136 + kk * 16 + h * 8);
          bf16x8 bb = *(const bf16x8*)(BT + (wid * 32 + r) * 136 + kk * 16 + h * 8);
          acc = MFMA(a, bb, acc);
        }
        float* dst = p.CS + ((((size_t)bc * 2 + d) * 4 + hh) * 64 + pb * 32) * 128 + wid * 32 + r;
#pragma unroll
        for (int e = 0; e < 16; ++e) dst[(size_t)crow(e, h) * 128] = acc[e];
      }
    }
  }
}

DI void ssd_scan_phase(const Params& p) {
  const int total = NB * 2 * 4 * 8192;
  for (int idx = lbid() * NTHR + ltid(); idx < total; idx += gridDim.x * NTHR) {
    const int e = idx & 8191, hh = (idx >> 13) & 3, d = (idx >> 15) & 1, b = idx >> 16;
    float* base = p.CS + (((size_t)b * NCH * 2 + d) * 4 + hh) * 8192 + e;
    const float* ab = p.atot + ((size_t)b * NCH * 2 + d) * 4 + hh;
    float v[NCH], dec[NCH];
#pragma unroll
    for (int i = 0; i < NCH; ++i) {
      const int c = (d == 0) ? (i < 2 ? 32 + i : i - 2) : 33 - i;
      v[i] = base[(size_t)c * 65536];
      dec[i] = ab[c * 8];
    }
    float st = 0.f;
#pragma unroll
    for (int i = 0; i < NCH; ++i) {
      const int c = (d == 0) ? (i < 2 ? 32 + i : i - 2) : 33 - i;
      base[(size_t)c * 65536] = st;
      st = __expf(dec[i]) * st + v[i];
    }
  }
}

template <int G>
DI float ssd_s3_group(const Params& p, int layer, int bc, bool cPrev, bool cNext, u16* Bg, u16* xsT, float* arr, int tid) {
  f32x16 y[4];
#pragma unroll
  for (int i = 0; i < 4; ++i)
#pragma unroll
    for (int e = 0; e < 16; ++e) y[i][e] = 0.f;
  const int lane = tid & 63, wid = tid >> 6, r = lane & 31, h = lane >> 5;
  const int l = wid * 32 + r;
  const int row0 = bc * 128;
  __syncthreads();
  ssd_dt_arrays(p, layer, row0, 2 * G + (tid >> 7), tid & 127, arr + (tid >> 7) * 768);
  const ConvW cwc = load_convw(p, layer, 512 + G * 128 + (tid & 15) * 8);
#pragma unroll 1
  for (int i = 0; i < 8; ++i) {
    const int id = tid + VT * i, t = id >> 4, cp = id & 15;
    float v[8];
    conv8(p, cwc, row0 + t, 512 + G * 128 + cp * 8, cPrev || t > 0, cNext || t < 127, v);
    *(bf16x8*)(Bg + t * 136 + cp * 8) = pack8(v[0], v[1], v[2], v[3], v[4], v[5], v[6], v[7]);
  }
  const ConvW cwx = load_convw(p, layer, G * 128 + (tid & 15) * 8);
#pragma unroll 1
  for (int i = 0; i < 8; ++i) {
    const int id = tid + VT * i, t = id >> 4, cp = id & 15;
    float v[8];
    conv8(p, cwx, row0 + t, G * 128 + cp * 8, cPrev || t > 0, cNext || t < 127, v);
#pragma unroll
    for (int e = 0; e < 8; ++e) xsT[(cp * 8 + e) * 136 + t] = f2bf(v[e]);
  }
  __syncthreads();
  ssd_cum_arrays(tid & 127, arr + (tid >> 7) * 768);
  bf16x8 cf[8];
#pragma unroll
  for (int kk = 0; kk < 8; ++kk) cf[kk] = *(const bf16x8*)(Bg + l * 136 + kk * 16 + h * 8);
  __syncthreads();
  const ConvW cwb = load_convw(p, layer, 256 + G * 128 + (tid & 15) * 8);
#pragma unroll 1
  for (int i = 0; i < 8; ++i) {
    const int id = tid + VT * i, t = id >> 4, cp = id & 15;
    float v[8];
    conv8(p, cwb, row0 + t, 256 + G * 128 + cp * 8, cPrev || t > 0, cNext || t < 127, v);
    *(bf16x8*)(Bg + t * 136 + cp * 8) = pack8(v[0], v[1], v[2], v[3], v[4], v[5], v[6], v[7]);
  }
  __syncthreads();
  float ss = 0.f;
#pragma unroll 1
  for (int hd2 = 0; hd2 < 2; ++hd2) {
    const int hh = 2 * G + hd2;
    const float* ah = arr + hd2 * 768;
    const float c0l = ah[256 + l], s1l = ah[384 + l];
    f32x16 y[2];
#pragma unroll
    for (int i = 0; i < 2; ++i)
#pragma unroll
      for (int e = 0; e < 16; ++e) y[i][e] = 0.f;
#pragma unroll 1
    for (int sb = 0; sb < 4; ++sb) {
      f32x16 gt;
#pragma unroll
      for (int e = 0; e < 16; ++e) gt[e] = 0.f;
#pragma unroll
      for (int kk = 0; kk < 8; ++kk) {
        bf16x8 a = *(const bf16x8*)(Bg + (sb * 32 + r) * 136 + kk * 16 + h * 8);
        gt = MFMA(a, cf[kk], gt);
      }
      f32x16 wv;
      if (sb != wid) {
        const float ref = sb < wid ? c0l : s1l;
        const float* cumv = ah + (sb < wid ? 256 : 384) + sb * 32 + 4 * h;
        const float* dtv = ah + (sb < wid ? 0 : 128) + sb * 32 + 4 * h;
#pragma unroll
        for (int q4 = 0; q4 < 4; ++q4) {
          const f32x4 cv = *(const f32x4*)(cumv + 8 * q4), dv = *(const f32x4*)(dtv + 8 * q4);
#pragma unroll
          for (int k = 0; k < 4; ++k) wv[4 * q4 + k] = gt[4 * q4 + k] * (__expf(ref - cv[k]) * dv[k]);
        }
      } else {
#pragma unroll
        for (int q4 = 0; q4 < 4; ++q4) {
          const int s4 = sb * 32 + 8 * q4 + 4 * h;
          const f32x4 c0v = *(const f32x4*)(ah + 256 + s4), d0v = *(const f32x4*)(ah + s4);
          const f32x4 s1v = *(const f32x4*)(ah + 384 + s4), d1v = *(const f32x4*)(ah + 128 + s4);
#pragma unroll
          for (int k = 0; k < 4; ++k) {
            const int s = s4 + k;
            const float a0 = (l >= s) ? (c0l - c0v[k]) : -1e30f;
            const float a1 = (l <= s) ? (s1l - s1v[k]) : -1e30f;
            wv[4 * q4 + k] = gt[4 * q4 + k] * (__expf(a0) * d0v[k] + __expf(a1) * d1v[k]);
          }
          __builtin_amdgcn_sched_barrier(0);
        }
      }
      bf16x8 wp0 = pack8(wv[0], wv[1], wv[2], wv[3], wv[4], wv[5], wv[6], wv[7]);
      bf16x8 wp1 = pack8(wv[8], wv[9], wv[10], wv[11], wv[12], wv[13], wv[14], wv[15]);
#pragma unroll
      for (int pb = 0; pb < 2; ++pb) {
        const u16* xrow = xsT + (hd2 * 64 + pb * 32 + r) * 136 + sb * 32 + 4 * h;
        s16x4 lo0 = *(const s16x4*)(xrow), hi0 = *(const s16x4*)(xrow + 8);
        s16x4 lo1 = *(const s16x4*)(xrow + 16), hi1 = *(const s16x4*)(xrow + 24);
        bf16x8 a0 = __builtin_shufflevector(lo0, hi0, 0, 1, 2, 3, 4, 5, 6, 7);
        bf16x8 a1 = __builtin_shufflevector(lo1, hi1, 0, 1, 2, 3, 4, 5, 6, 7);
        y[pb] = MFMA(a0, wp0, y[pb]);
        y[pb] = MFMA(a1, wp1, y[pb]);
      }
    }
#pragma unroll 1
    for (int d = 0; d < 2; ++d) {
      const float el = __expf(d == 0 ? c0l : s1l);
#pragma unroll
      for (int pb = 0; pb < 2; ++pb) {
        const float* srow = p.CS + ((((size_t)bc * 2 + d) * 4 + hh) * 64 + pb * 32 + r) * 128 + h * 8;
        f32x16 tmp;
#pragma unroll
        for (int e = 0; e < 16; ++e) tmp[e] = 0.f;
#pragma unroll
        for (int kk = 0; kk < 8; ++kk) {
          f32x4 s0 = *(const f32x4*)(srow + kk * 16), s1 = *(const f32x4*)(srow + kk * 16 + 4);
          bf16x8 a = pack8(s0.x, s0.y, s0.z, s0.w, s1.x, s1.y, s1.z, s1.w);
          tmp = MFMA(a, cf[kk], tmp);
        }
#pragma unroll
        for (int e = 0; e < 16; ++e) y[pb][e] += el * tmp[e];
      }
    }
    const float dsk = p.ssd_d[layer * 8 + hh] + p.ssd_d[layer * 8 + 4 + hh];
#pragma unroll
    for (int pb = 0; pb < 2; ++pb) {
#pragma unroll
      for (int q4 = 0; q4 < 4; ++q4) {
        const int cl = hd2 * 64 + pb * 32 + 8 * q4 + 4 * h;
        const int ch0 = G * 128 + cl;
        u32x2 zw = *(const u32x2*)(p.P + (size_t)(row0 + l) * NINP + 960 + ch0);
        f32x4 o;
        o.x = (y[pb][4 * q4] + dsk * bf2f(xsT[(cl + 0) * 136 + l])) * silu_f(bflo(zw.x));
        o.y = (y[pb][4 * q4 + 1] + dsk * bf2f(xsT[(cl + 1) * 136 + l])) * silu_f(bfhi(zw.x));
        o.z = (y[pb][4 * q4 + 2] + dsk * bf2f(xsT[(cl + 2) * 136 + l])) * silu_f(bflo(zw.y));
        o.w = (y[pb][4 * q4 + 3] + dsk * bf2f(xsT[(cl + 3) * 136 + l])) * silu_f(bfhi(zw.y));
        ss += o.x * o.x + o.y * o.y + o.z * o.z + o.w * o.w;
        *(f32x4*)(p.ytmp + (size_t)(row0 + l) * 256 + ch0) = o;
      }
    }
  }
  return ss;
}

DI void ssd_s3_tasks(const Params& p, int layer, char* smem) {
  const int ftid = ltid(), vb = ftid >> 8, tid = ftid & 255;
  u16* Bg = (u16*)(smem + vb * VSMEM);
  u16* xsT = Bg + 128 * 136;
  float* arr = (float*)(xsT + 128 * 136);
  const int lane = tid & 63, wid = tid >> 6, r = lane & 31, h = lane >> 5;
  const int l = wid * 32 + r;
  for (int t0 = lbid() * 2; t0 < NB * NCH; t0 += gridDim.x * 2) {
    const int bc = t0 + vb, c = bc % NCH;
    const int row0 = bc * 128;
    const bool cPrev = (c != 0 && c != 32), cNext = (c != 31 && c != 33);
    float ss = ssd_s3_group<0>(p, layer, bc, cPrev, cNext, Bg, xsT, arr, tid);
    ss += ssd_s3_group<1>(p, layer, bc, cPrev, cNext, Bg, xsT, arr, tid);
    ss += __shfl_xor(ss, 32);
    const float rstd = rsqrtf(ss * (1.f / 256.f) + EPS);
    const float* gn = p.ssd_norm_g + layer * 256;
#pragma unroll 4
    for (int i = 0; i < 32; ++i) {
      const int ch0 = (i >> 2) * 32 + 8 * (i & 3) + 4 * h;
      f32x4 v = *(const f32x4*)(p.ytmp + (size_t)(row0 + l) * 256 + ch0);
      f32x4 gv = *(const f32x4*)(gn + ch0);
      u32x2 w;
      w.x = pack2(v.x * rstd * gv.x, v.y * rstd * gv.y);
      w.y = pack2(v.z * rstd * gv.z, v.w * rstd * gv.w);
      *(u32x2*)(p.H + (size_t)(row0 + l) * D + 768 + ch0) = w;
    }
  }
}

constexpr int QREG = 12;
DI void attn_qk(const u16* Ks, const bf16x8 (&qf)[QREG], const u16* qs, f32x16 (&st)[2], int r, int h) {
#pragma unroll
  for (int kb = 0; kb < 2; ++kb)
#pragma unroll
    for (int e = 0; e < 16; ++e) st[kb][e] = 0.f;
  const u16* kp = Ks + r * 200 + h * 8;
#pragma unroll
  for (int kk = 0; kk < 12; ++kk) {
    bf16x8 k0 = *(const bf16x8*)(kp + kk * 16);
    bf16x8 k1 = *(const bf16x8*)(kp + 32 * 200 + kk * 16);
    bf16x8 q;
    if (kk < QREG) q = qf[kk];
    else q = *(const bf16x8*)(qs + (kk - QREG) * 512);
    st[0] = MFMA(k0, q, st[0]);
    st[1] = MFMA(k1, q, st[1]);
  }
}
DI void attn_softmax(f32x16 (&st)[2], f32x16 (&o)[4], bf16x8 (&pf)[4], float& m_run, float& l_run, float sc) {
  float mx = st[0][0];
#pragma unroll
  for (int kb = 0; kb < 2; ++kb)
#pragma unroll
    for (int e = 0; e < 16; ++e) mx = fmaxf(mx, st[kb][e]);
  mx = fmaxf(mx, __shfl_xor(mx, 32));
  const float m_new = fmaxf(m_run, mx * sc);
  const float alpha = __builtin_amdgcn_exp2f(m_run - m_new);
  m_run = m_new;
  float ls = 0.f;
#pragma unroll
  for (int kb = 0; kb < 2; ++kb)
#pragma unroll
    for (int e = 0; e < 16; ++e) {
      float pv = __builtin_amdgcn_exp2f(fmaf(st[kb][e], sc, -m_new));
      ls += pv;
      st[kb][e] = pv;
    }
  l_run = l_run * alpha + ls;
  if (__builtin_amdgcn_ballot_w64(alpha != 1.f) != 0ull) {
#pragma unroll
    for (int i = 0; i < 4; ++i)
#pragma unroll
      for (int e = 0; e < 16; ++e) o[i][e] *= alpha;
  }
#pragma unroll
  for (int ks = 0; ks < 4; ++ks) {
    const int kb = ks >> 1, s2 = ks & 1;
    pf[ks] = pack8(st[kb][8 * s2], st[kb][8 * s2 + 1], st[kb][8 * s2 + 2], st[kb][8 * s2 + 3], st[kb][8 * s2 + 4],
                   st[kb][8 * s2 + 5], st[kb][8 * s2 + 6], st[kb][8 * s2 + 7]);
  }
}
DI void attn_pv(const u16* Vs, const bf16x8 (&pf)[4], f32x16 (&o)[4], int r, int h) {
#pragma unroll
  for (int ks = 0; ks < 4; ++ks) {
#pragma unroll
    for (int db = 0; db < 4; ++db) {
      bf16x8 a = *(const bf16x8*)(Vs + (db * 32 + r) * 72 + ks * 16 + 8 * h);
      o[db] = MFMA(a, pf[ks], o[db]);
    }
  }
}

DI void attn_tasks(const Params& p, char* smem) {
  u16* Ks0 = (u16*)smem;
  u16* Vs0 = Ks0 + 2 * 64 * 200;
  const int tid = ltid(), lane = tid & 63, wid = __builtin_amdgcn_readfirstlane(tid >> 6), r = lane & 31, h = lane >> 5;
  u16* qs = Vs0 + 2 * 128 * 72 + wid * ((12 - QREG) * 512) + lane * 8;
  const float sc = 0.07216878364870322f * 1.4426950408889634f;
  for (int task = lbid(); task < NB * 4 * 17; task += gridDim.x) {
    int b, hd, qt;
    if (task < 512) {
      qt = task & 15; hd = (task >> 4) & 3; b = task >> 6;
    } else {
      const int t2 = task - 512;
      qt = 16; hd = t2 & 3; b = t2 >> 2;
    }
    const int koff = (qt < 16) ? 0 : SEQ;
    const int nkt = ((qt < 16) ? SP : CTX) / 64;
    const int qrow = b * SP + qt * 256 + wid * 32 + r;
    bf16x8 qf[QREG];
#pragma unroll
    for (int kk = 0; kk < QREG; ++kk) qf[kk] = *(const bf16x8*)(p.Q + (size_t)qrow * 768 + hd * 192 + kk * 16 + h * 8);
#pragma unroll
    for (int kk = QREG; kk < 12; ++kk)
      *(bf16x8*)(qs + (kk - QREG) * 512) = *(const bf16x8*)(p.Q + (size_t)qrow * 768 + hd * 192 + kk * 16 + h * 8);
    f32x16 o[4];
#pragma unroll
    for (int i = 0; i < 4; ++i)
#pragma unroll
      for (int e = 0; e < 16; ++e) o[i][e] = 0.f;
    float m_run = -1e30f, l_run = 0.f;
    u32x4 kn[2], kr[1], vv[2];
    const u16* knb = p.Kn + ((size_t)(b * SP + koff) + (tid >> 4)) * 512 + hd * 128 + (tid & 15) * 8;
    const u16* krb = p.Kr + ((size_t)(b * SP + koff) + (tid >> 3)) * 64 + (tid & 7) * 8;
    const u16* vb = p.Vt + ((size_t)(b * 4 + hd) * 128 + (tid >> 3)) * SP + koff + (tid & 7) * 8;
#define ALOAD(ko_)                                                                               \
  {                                                                                              \
    _Pragma("unroll") for (int i = 0; i < 2; ++i) kn[i] = *(const u32x4*)(knb + ((ko_) + 32 * i) * 512); \
    kr[0] = *(const u32x4*)(krb + (ko_) * 64);                                                   \
    _Pragma("unroll") for (int i = 0; i < 2; ++i) vv[i] = *(const u32x4*)(vb + (size_t)(64 * i) * SP + (ko_)); \
  }
#define AWRITE(buf_)                                                                             \
  {                                                                                              \
    u16* Kw = Ks0 + (buf_) * (64 * 200);                                                         \
    u16* Vw = Vs0 + (buf_) * (128 * 72);                                                         \
    _Pragma("unroll") for (int i = 0; i < 2; ++i) *(u32x4*)(Kw + ((tid >> 4) + 32 * i) * 200 + (tid & 15) * 8) = kn[i]; \
    *(u32x4*)(Kw + (tid >> 3) * 200 + 128 + (tid & 7) * 8) = kr[0];                              \
    _Pragma("unroll") for (int i = 0; i < 2; ++i) {                                              \
      u16* dst = Vw + ((tid >> 3) + 64 * i) * 72 + ((tid & 7) >> 1) * 16 + ((tid & 7) & 1) * 4;  \
      *(u32x2*)dst = u32x2{vv[i].x, vv[i].y};                                                    \
      *(u32x2*)(dst + 8) = u32x2{vv[i].z, vv[i].w};                                              \
    }                                                                                            \
  }
    ALOAD((size_t)0);
    AWRITE(0);
    ALOAD((size_t)64);
    for (int kt = 0; kt < nkt; ++kt) {
      __syncthreads();
      if (kt + 1 < nkt) AWRITE((kt + 1) & 1);
      {
        const size_t ko = (size_t)(kt + 2 < nkt ? kt + 2 : nkt - 1) * 64;
        ALOAD(ko);
      }
      __builtin_amdgcn_sched_barrier(0);
      f32x16 st[2];
      bf16x8 pf[4];
      attn_qk(Ks0 + (kt & 1) * (64 * 200), qf, qs, st, r, h);
      attn_softmax(st, o, pf, m_run, l_run, sc);
      attn_pv(Vs0 + (kt & 1) * (128 * 72), pf, o, r, h);
    }
#undef ALOAD
#undef AWRITE
    const float ltot = l_run + __shfl_xor(l_run, 32);
    const float inv = 1.f / ltot;
    u16* orow = p.H + (size_t)qrow * D + hd * 128;
#pragma unroll
    for (int db = 0; db < 4; ++db)
#pragma unroll
      for (int q4 = 0; q4 < 4; ++q4) {
        u32x2 w;
        w.x = pack2(o[db][4 * q4] * inv, o[db][4 * q4 + 1] * inv);
        w.y = pack2(o[db][4 * q4 + 2] * inv, o[db][4 * q4 + 3] * inv);
        *(u32x2*)(orow + db * 32 + 8 * q4 + 4 * h) = w;
      }
  }
}

constexpr int NPHASE = 2 + DEPTH * 6;

DI void conv_item_ffn(const Params& p, int layer, int q, char* smem) {
#pragma unroll 1
  for (int u = 0; u < 8; ++u) {
    const int tile = q * 8 + u;
    if (tile < 1024) conv_tile(p.w_ff1 + (size_t)layer * D * DFF, D, DFF, p.wt_ff1, nullptr, tile >> 6, tile & 63, smem);
    else conv_tile(p.w_ff2 + (size_t)layer * DFF * D, DFF, D, p.wt_ff2, nullptr, (tile - 1024) >> 4, (tile - 1024) & 15, smem);
  }
}
DI void conv_item_mix(const Params& p, int layer, int q, char* smem) {
#pragma unroll 1
  for (int u = 0; u < 8; ++u) {
    int tile = q * 8 + u;
    if (tile < 512) { conv_tile(p.w_in + (size_t)layer * D * NIN, D, NIN, p.wt_in, nullptr, tile >> 5, tile & 31, smem); continue; }
    tile -= 512;
    if (tile < 48) { conv_tile(p.w_uq + (size_t)layer * 256 * 768, 256, 768, p.wt_uq, p.g_q + layer * 256, tile / 12, tile % 12, smem); continue; }
    tile -= 48;
    if (tile < 32) { conv_tile(p.w_ukv + (size_t)layer * 128 * 1024, 128, 1024, p.wt_ukv, p.g_kv + layer * 128, tile >> 4, tile & 15, smem); continue; }
    tile -= 32;
    if (tile < 256) { conv_tile(p.w_out + (size_t)layer * D * D, D, D, p.wt_out, nullptr, tile >> 4, tile & 15, smem); continue; }
    tile -= 256;
    for (int i = ltid(); i < 4096; i += NTHR) p.wsb[tile * 4096 + i] = f2bf(p.cm_w_s[(size_t)layer * 65536 + tile * 4096 + i]);
  }
}

DI void run_phase(const Params& p, int ph, char* smem) {
  if (ph == 0) { prologue_phase(p, smem); return; }
  const int MT = T / 256;
  auto noT = [](int, int, u32x4) {};
  auto neverT = [](int) { return false; };
  if (ph == 1) {
    ew_phase(p, 0, 0);
    for (int q = lbid(); q < 108; q += gridDim.x) conv_item_mix(p, 0, q, smem);
    return;
  }
  const int layer = (ph - 2) / 6, sub = (ph - 2) % 6;
  const bool last = layer == DEPTH - 1;
  switch (sub) {
    case 0: {
      int* cntP = p.cnt + (4 * DEPTH + layer) * CNT_STRIDE;
      for (int it = 0;; ++it) {
        const int t = xcd_tile(it, MT * 8);
        if (t < 0) break;
        const int tm = t >> 3, tn = t & 7;
        gemm_tile<false>(
            p.H, D, p.wt_in, D, D, tm * 256, tn * 256, smem,
            [&](int mb, int nb, f32x16& acc, int r, int h) {
              if (nb == 1984) {
                f32x4 v = {acc[0], acc[1], acc[2], acc[3]};
                st_wt16f(p.dtraw + (size_t)(mb + r) * 8 + 4 * h, v);
              }
            },
            [&](int row, int col, u32x4 v) { st_wt(p.P + (size_t)row * NINP + col, v); }, noT, neverT);
        tile_done(cntP, tm);
      }
      int* wq = p.cnt + (2 * DEPTH + layer) * CNT_STRIDE;
      int* sh = (int*)(smem + SMEM_BYTES - 16);
      for (;;) {
        __syncthreads();
        if (ltid() == 0) *sh = __hip_atomic_fetch_add(wq, 1, __ATOMIC_RELAXED, __HIP_MEMORY_SCOPE_AGENT);
        __syncthreads();
        const int q = *sh;
        if (q >= 544 + 136 + 408 + 544) break;
        int tmA, tmB, s1t0 = 0;
        if (q < 544) {
          int bb, c, hp;
          if (q < 512) { bb = q >> 6; c = (q & 63) >> 1; hp = q & 1; }
          else { const int i2 = q - 512; bb = i2 >> 2; c = 32 + ((i2 >> 1) & 1); hp = i2 & 1; }
          s1t0 = (bb * NCH + c) * 4 + hp * 2;
          tmA = bb * 17 + (c >> 1);
          tmB = tmA;
          if ((c & 1) && c != 31 && c != 33) tmB = tmA + 1;
          if (!(c & 1) && c != 0 && c != 32) tmB = tmA - 1;
        } else if (q < 680) { tmA = tmB = q - 544; }
        else if (q < 1088) { tmA = tmB = (q - 680) / 3; }
        else { tmA = tmB = (q - 1088) >> 2; }
        if (ltid() == 0) {
          while (__hip_atomic_load(cntP + tmA, __ATOMIC_RELAXED, __HIP_MEMORY_SCOPE_AGENT) < 8) __builtin_amdgcn_s_sleep(4);
          while (__hip_atomic_load(cntP + tmB, __ATOMIC_RELAXED, __HIP_MEMORY_SCOPE_AGENT) < 8) __builtin_amdgcn_s_sleep(4);
          __builtin_amdgcn_fence(__ATOMIC_ACQUIRE, "agent");
        }
        __syncthreads();
        if (q < 544) ssd_s1_tasks(p, layer, smem, s1t0, s1t0 + 1, 2);
        else if (q < 680) cm_tasks(p, layer, smem, 2 * (q - 544), 2 * (q - 544) + 1, 2);
        else if (q < 1088) qkv_tasks(p, smem, q - 680, q - 679, 0, 0, 1);
        else qkv_tasks(p, smem, 0, 0, q - 1088, q - 1087, 1);
      }
    } break;
    case 1: break;
    case 2: ssd_scan_phase(p); break;
    case 3: {
      attn_tasks(p, smem);
      ssd_s3_tasks(p, layer, smem);
    } break;
    case 4: {
      int* cnt = p.cnt + (2 * layer) * CNT_STRIDE;
      for (int it = 0;; ++it) {
        const int t = xcd_tile(it, MT * 4, last ? 4 : 0);
        if (t < 0) break;
        const int tm = t >> 2, tn = t & 3;
        gemm_tile<false>(
            p.H, D, p.wt_out, D, D, tm * 256, tn * 256, smem, [](int, int, f32x16&, int, int) {},
            [&](int row, int col, u32x4 v) { st_wt(p.Y + (size_t)row * D + col, v); }, noT, neverT);
        tile_done(cnt, tm);
      }
      ew_consume(p, cnt, 4, layer, 1, last, 256, [&](int q) { conv_item_ffn(p, layer, q, smem); }, smem);
    } break;
    case 5: {
      int* cnt1 = p.cnt + (3 * DEPTH + layer) * CNT_STRIDE;
      for (int it = 0;; ++it) {
        const int t = xcd_tile(it, MT * 16, last ? 16 : 0);
        if (t < 0) break;
        const int tm = t >> 4, tn = t & 15;
        gemm_tile<false>(
            p.H, D, p.wt_ff1, D, D, tm * 256, tn * 256, smem,
            [](int, int, f32x16& acc, int, int) {
#pragma unroll
              for (int e = 0; e < 16; ++e) {
                float v = fmaxf(acc[e], 0.f);
                acc[e] = v * v;
              }
            },
            [&](int row, int col, u32x4 v) { st_wt(p.Hd + (size_t)row * DFF + col, v); }, noT, neverT);
        tile_done(cnt1, tm);
      }
      int* cnt = p.cnt + (2 * layer + 1) * CNT_STRIDE;
      for (int it = 0;; ++it) {
        const int t = xcd_tile(it, MT * 4, last ? 4 : 0);
        if (t < 0) break;
        const int tm = t >> 2, tn = t & 3;
        if (ltid() == 0) {
          while (__hip_atomic_load(cnt1 + tm, __ATOMIC_RELAXED, __HIP_MEMORY_SCOPE_AGENT) < 16) __builtin_amdgcn_s_sleep(4);
      __builtin_amdgcn_fence(__ATOMIC_ACQUIRE, "agent");
        }
        __syncthreads();
        gemm_tile<false>(
            p.Hd, DFF, p.wt_ff2, DFF, DFF, tm * 256, tn * 256, smem, [](int, int, f32x16&, int, int) {},
            [&](int row, int col, u32x4 v) { st_wt(p.F + (size_t)row * D + col, v); }, noT, neverT);
        tile_done(cnt, tm);
      }
      if (last) ew_consume(p, cnt, 4, DEPTH, 2, true, 0, [](int) {}, smem);
      else ew_consume(p, cnt, 4, layer + 1, 0, false, 108, [&](int q) { conv_item_mix(p, layer + 1, q, smem); }, smem);
    } break;
  }
}

__global__ void __launch_bounds__(NTHR, 2) mega_kernel(Params p, int ph_begin, int ph_end) {
  extern __shared__ __attribute__((aligned(16))) char smem[];
  cg::grid_group grid = cg::this_grid();
  for (int ph = ph_begin; ph < ph_end; ++ph) {
    if (ph >= 2 && (ph - 2) % 6 == 1) continue;
    run_phase(p, ph, smem);
    if (ph + 1 < ph_end) {
      if (ph == 0) {
        grid.sync();
      } else {
        __syncthreads();
        if (threadIdx.x == 0) {
          int* bar = p.cnt + 5 * DEPTH * CNT_STRIDE + ph;
          __hip_atomic_fetch_add(bar, 1, __ATOMIC_RELEASE, __HIP_MEMORY_SCOPE_AGENT);
          while (__hip_atomic_load(bar, __ATOMIC_RELAXED, __HIP_MEMORY_SCOPE_AGENT) < (int)gridDim.x) __builtin_amdgcn_s_sleep(1);
      __builtin_amdgcn_fence(__ATOMIC_ACQUIRE, "agent");
        }
        __syncthreads();
      }
    }
  }
}

extern "C" void kernel_launch(void* const* d_in, const int* in_sizes, int n_in, void* d_out, int out_size, void* d_ws,
                              size_t ws_size, hipStream_t stream) {
  Params p{};
  const float* const* in = (const float* const*)d_in;
  p.x = in[0]; p.c = in[1]; p.ctx = in[2]; p.c_ctx = in[3]; p.w_ada = in[4]; p.b_ada = in[5];
  p.g_pre_mix = in[6]; p.g_post_mix = in[7]; p.g_pre_ff = in[8]; p.g_post_ff = in[9]; p.w_in = in[10];
  p.g_q = in[11]; p.w_uq = in[12]; p.g_kv = in[13]; p.w_ukv = in[14]; p.cm_norm_g = in[15]; p.cm_w_s = in[16];
  p.cm_b_s = in[17]; p.conv_w = in[18]; p.conv_b = in[19]; p.dt_bias = in[20]; p.a_log = in[21]; p.ssd_d = in[22];
  p.ssd_norm_g = in[23]; p.w_out = in[24]; p.w_ff1 = in[25]; p.w_ff2 = in[26];
  p.out = (float*)d_out;
  char* ws = (char*)d_ws;
  size_t off = 0;
  auto take = [&](size_t bytes) { char* q = ws + off; off += (bytes + 255) & ~(size_t)255; return q; };
  p.wt_in = (u16*)take((size_t)NINP * D * 2);
  p.wt_uq = (u16*)take((size_t)768 * 256 * 2);
  p.wt_ukv = (u16*)take((size_t)1024 * 128 * 2);
  p.wt_out = (u16*)take((size_t)D * D * 2);
  p.wt_ff1 = (u16*)take((size_t)DFF * D * 2);
  p.wt_ff2 = (u16*)take((size_t)D * DFF * 2);
  p.wsb = (u16*)take((size_t)4 * 128 * 128 * 2);
  p.mod = (float*)take((size_t)DEPTH * 9 * 6144 * 4);
  p.ropetab = (float*)take((size_t)64 * 16 * 2 * 4);
  p.atot = (float*)take((size_t)NB * NCH * 2 * 4 * 4);
  p.xctx = (float*)take((size_t)NB * CTX * D * 4);
  char* r1 = take((size_t)T * DFF * 2);
  p.Hd = (u16*)r1;
  p.Y = (u16*)r1;
  {
    size_t o2 = 0;
    p.P = (u16*)(r1 + o2); o2 += (size_t)T * NINP * 2;
    p.Q = (u16*)(r1 + o2); o2 += (size_t)T * 768 * 2;
    p.Kn = (u16*)(r1 + o2); o2 += (size_t)T * 512 * 2;
    p.Kr = (u16*)(r1 + o2); o2 += (size_t)T * 64 * 2;
    p.Vt = (u16*)(r1 + o2); o2 += (size_t)NB * 4 * 128 * SP * 2;
    p.dtraw = (float*)(r1 + o2); o2 += (size_t)T * 8 * 4;
  }
  p.H = (u16*)take((size_t)T * D * 2);
  p.CS = (float*)take((size_t)NB * NCH * 2 * 4 * 8192 * 4);
  p.F = (u16*)p.CS;
  p.ytmp = (float*)take((size_t)T * 256 * 4);
  p.cnt = (int*)take((size_t)(5 * DEPTH * CNT_STRIDE + 64) * 4);
  if (off > ws_size) {
    fprintf(stderr, "workspace too small: need %zu have %zu\n", off, ws_size);
    return;
  }
  static int grid_blocks = 0;
  if (!grid_blocks) {
    int dev = 0, cus = 0, per_cu = 0;
    hipGetDevice(&dev);
    hipDeviceGetAttribute(&cus, hipDeviceAttributeMultiprocessorCount, dev);
    hipFuncSetAttribute((const void*)mega_kernel, hipFuncAttributeMaxDynamicSharedMemorySize, SMEM_BYTES);
    hipOccupancyMaxActiveBlocksPerMultiprocessor(&per_cu, mega_kernel, NTHR, SMEM_BYTES);
    if (per_cu < 1) per_cu = 1;
    if (per_cu > 1) per_cu = 1;
    grid_blocks = cus * per_cu;
  }
  int pb = 0, pe = NPHASE;
  void* args[] = {&p, &pb, &pe};
  hipError_t e = hipLaunchCooperativeKernel((void*)mega_kernel, dim3(grid_blocks), dim3(NTHR), args, SMEM_BYTES, stream);
  if (e != hipSuccess) fprintf(stderr, "cooperative launch failed: %s (grid %d)\n", hipGetErrorString(e), grid_blocks);
}
```
